# Optimizing an MI355X kernel written in HIP

```python
import jax
import jax.numpy as jnp
from jax import lax
import numpy as np

D_MODEL = 2048
BATCH = 4
SEQ = 2048
DEPTH = 2

GRID_W = 64
CTX_LEN = 256
Q_BLOCK = 128
SCAN_CHUNK = 16
ROPE_THETA = 10000.0
NORM_EPS = 1e-6
A_HEADS = 8
A_DK = 128
A_DV = 128
B_HEADS = 8
B_Q_LORA = 512
B_KV_LORA = 256
B_NOPE = 128
B_ROPE = 64
B_DV = 128
C_HEADS = 8
C_KV_HEADS = 2
C_DH = 128
D_HEADS = 4
D_DK = 128
D_DV = 256
D_GATE_RANK = 16
GLA_TAU = 16.0
N_EXPERTS = 16
N_GROUPS = 4
TOP_K = 2
EXPERT_DIM = 512
N_AB = (DEPTH + 1) // 2
N_CD = DEPTH // 2

kernel_name = 'hybrid_hgrn2_mla_gqa_gla_moe_dit'


def rms_norm(x, g):
    xf = x.astype(jnp.float32)
    y = xf * lax.rsqrt(jnp.mean(xf * xf, axis=-1, keepdims=True) + NORM_EPS)
    return (y * g.astype(jnp.float32)).astype(x.dtype)


def modulate(h, shift, scale):
    return h * (1 + scale) + shift


def split_cols(p, sizes):
    cuts = np.cumsum(np.array(sizes))[:-1].tolist()
    return jnp.split(p, cuts, axis=-1)


def heads(x, h):
    b, t, w = x.shape
    return x.reshape(b, t, h, w // h).transpose(0, 2, 1, 3)


def merge(x):
    b, h, t, d = x.shape
    return x.transpose(0, 2, 1, 3).reshape(b, t, h * d)


def axial_angles(t_len, d_rope):
    rows = t_len // GRID_W
    quarter = d_rope // 4
    freqs = ROPE_THETA ** (-jnp.arange(quarter, dtype=jnp.float32) / quarter)
    row = jnp.repeat(jnp.arange(rows, dtype=jnp.float32), GRID_W)
    col = jnp.tile(jnp.arange(GRID_W, dtype=jnp.float32), rows)
    return jnp.concatenate([row[:, None] * freqs, col[:, None] * freqs], axis=-1)


def apply_rope(x, ang):
    half = x.shape[-1] // 2
    x1, x2 = x[..., :half], x[..., half:]
    cos, sin = jnp.cos(ang), jnp.sin(ang)
    return jnp.concatenate([x1 * cos - x2 * sin, x2 * cos + x1 * sin], axis=-1).astype(x.dtype)


def block_attention(q, k, v, scale):
    b, hk, g, t, dq = q.shape
    dv = v.shape[-1]
    nb = t // Q_BLOCK
    qb = jnp.moveaxis(q.reshape(b, hk, g, nb, Q_BLOCK, dq), 3, 0)

    def one_block(qi):
        s = jnp.einsum('bhgtd,bhsd->bhgts', qi, k, preferred_element_type=jnp.float32) * scale
        p = jax.nn.softmax(s, axis=-1)
        return jnp.einsum('bhgts,bhsv->bhgtv', p.astype(v.dtype), v)

    o = lax.map(one_block, qb)
    return jnp.moveaxis(o, 0, 3).reshape(b, hk * g, t, dv)


def chunked_gated_scan(q, k, v, g, s0):
    b, h, t, dk = q.shape
    n = t // SCAN_CHUNK

    def to_chunks(a):
        return a.astype(jnp.float32).reshape(b, h, n, SCAN_CHUNK, a.shape[-1]).transpose(2, 0, 1, 3, 4)

    mask = jnp.tril(jnp.ones((SCAN_CHUNK, SCAN_CHUNK), dtype=bool))[:, :, None]

    def step(state, inp):
        qc, kc, vc, gc = inp
        cum = jnp.cumsum(gc, axis=-2)
        rel = jnp.where(mask, cum[..., :, None, :] - cum[..., None, :, :], -jnp.inf)
        scores = jnp.einsum('bhtd,bhsd,bhtsd->bhts', qc, kc, jnp.exp(rel))
        o = jnp.einsum('bhts,bhsv->bhtv', scores, vc) + jnp.einsum('bhtd,bhdv->bhtv', qc * jnp.exp(cum), state)
        last = cum[..., -1:, :]
        state = state * jnp.exp(last)[..., 0, :, None] + jnp.einsum('bhsd,bhsv->bhdv', kc * jnp.exp(last - cum), vc)
        return state, o

    s_final, o = lax.scan(step, s0.astype(jnp.float32), (to_chunks(q), to_chunks(k), to_chunks(v), to_chunks(g)))
    o = o.transpose(1, 2, 0, 3, 4).reshape(b, h, t, v.shape[-1])
    return o.astype(v.dtype), s_final


def scan_ctx_then_lat(c_args, x_args, reverse):
    if reverse:
        c_args = tuple(jnp.flip(a, axis=2) for a in c_args)
        x_args = tuple(jnp.flip(a, axis=2) for a in x_args)
    b, h, _, dk = c_args[0].shape
    dv = c_args[2].shape[-1]
    oc, s_ctx = chunked_gated_scan(*c_args, jnp.zeros((b, h, dk, dv), jnp.float32))
    ox, _ = chunked_gated_scan(*x_args, s_ctx)
    if reverse:
        oc, ox = jnp.flip(oc, axis=2), jnp.flip(ox, axis=2)
    return oc, ox


def mixer_ab(hc, hx, w_in, w_out, lb_f, lb_b, hg_norm_g, mq_norm_g, w_uq, mkv_norm_g, w_ukv, ang, need_ctx):
    sizes = (A_HEADS * A_DK,) * 3 + (A_HEADS * A_DV,) * 2 + (B_Q_LORA, B_KV_LORA, B_ROPE)
    pc = split_cols(hc @ w_in, sizes)
    px = split_cols(hx @ w_in, sizes)

    def hgrn_args(p):
        q = heads(jax.nn.silu(p[0]), A_HEADS) * A_DK ** -0.5
        v = heads(p[3], A_HEADS)

        def direction(f_logit, lb):
            f = lb + (1 - lb) * jax.nn.sigmoid(f_logit.astype(jnp.float32))
            return heads(1 - f, A_HEADS), heads(jnp.log(f), A_HEADS)

        kf, gf = direction(p[1], lb_f)
        kb, gb = direction(p[2], lb_b)
        return (q, kf, v, gf), (q, kb, v, gb)

    c_fwd, c_bwd = hgrn_args(pc)
    x_fwd, x_bwd = hgrn_args(px)
    oc_f, ox_f = scan_ctx_then_lat(c_fwd, x_fwd, False)
    oc_b, ox_b = scan_ctx_then_lat(c_bwd, x_bwd, True)

    def hgrn_out(o, gate):
        return merge(rms_norm(o, hg_norm_g) * jax.nn.sigmoid(heads(gate, A_HEADS)))

    def mla_qkv(p, rotate):
        q = heads(rms_norm(p[5], mq_norm_g) @ w_uq, B_HEADS)
        kv = heads(rms_norm(p[6], mkv_norm_g) @ w_ukv, B_HEADS)
        q_nope, q_rope = q[..., :B_NOPE], q[..., B_NOPE:]
        k_nope, v = kv[..., :B_NOPE], kv[..., B_NOPE:]
        k_rope = p[7][:, None]
        if rotate:
            q_rope, k_rope = apply_rope(q_rope, ang), apply_rope(k_rope, ang)
        k = jnp.concatenate([k_nope, jnp.broadcast_to(k_rope, k_nope.shape[:-1] + (B_ROPE,))], axis=-1)
        return jnp.concatenate([q_nope, q_rope], axis=-1), k, v

    qc, kc, vc = mla_qkv(pc, False)
    qx, kx, vx = mla_qkv(px, True)
    scale = (B_NOPE + B_ROPE) ** -0.5
    ox_mla = block_attention(qx[:, :, None], jnp.concatenate([kc, kx], axis=2), jnp.concatenate([vc, vx], axis=2), scale)
    out_x = jnp.concatenate([hgrn_out(ox_f + ox_b, px[4]), merge(ox_mla)], axis=-1) @ w_out
    if not need_ctx:
        return None, out_x
    oc_mla = block_attention(qc[:, :, None], kc, vc, scale)
    out_c = jnp.concatenate([hgrn_out(oc_f + oc_b, pc[4]), merge(oc_mla)], axis=-1) @ w_out
    return out_c, out_x


def mixer_cd(hc, hx, w_in, w_out, q_norm_g, k_norm_g, w_a2, b_a, gla_norm_g, ang, need_ctx):
    sizes = (C_HEADS * C_DH, C_KV_HEADS * C_DH, C_KV_HEADS * C_DH, D_HEADS * D_DK, D_HEADS * D_DK,
             D_HEADS * D_DV, D_HEADS * D_DV, D_GATE_RANK, D_GATE_RANK)
    pc = split_cols(hc @ w_in, sizes)
    px = split_cols(hx @ w_in, sizes)

    def gqa_qkv(p, rotate):
        q = rms_norm(heads(p[0], C_HEADS), q_norm_g)
        k = rms_norm(heads(p[1], C_KV_HEADS), k_norm_g)
        v = heads(p[2], C_KV_HEADS)
        if rotate:
            q, k = apply_rope(q, ang), apply_rope(k, ang)
        b, _, t, _ = q.shape
        return q.reshape(b, C_KV_HEADS, C_HEADS // C_KV_HEADS, t, C_DH), k, v

    qc, kc, vc = gqa_qkv(pc, False)
    qx, kx, vx = gqa_qkv(px, True)
    scale = C_DH ** -0.5
    ox_att = block_attention(qx, jnp.concatenate([kc, kx], axis=2), jnp.concatenate([vc, vx], axis=2), scale)

    def gla_args(p):
        q = heads(p[3], D_HEADS) * D_DK ** -0.5
        k = heads(p[4], D_HEADS)
        v = heads(p[5], D_HEADS)

        def direction(a, d):
            return heads(jax.nn.log_sigmoid((a @ w_a2[d] + b_a[d]).astype(jnp.float32)) / GLA_TAU, D_HEADS)

        return (q, k, v, direction(p[7], 0)), (q, k, v, direction(p[8], 1))

    c_fwd, c_bwd = gla_args(pc)
    x_fwd, x_bwd = gla_args(px)
    oc_f, ox_f = scan_ctx_then_lat(c_fwd, x_fwd, False)
    oc_b, ox_b = scan_ctx_then_lat(c_bwd, x_bwd, True)

    def gla_out(o, gate):
        return merge(rms_norm(o, gla_norm_g) * jax.nn.silu(heads(gate, D_HEADS)))

    out_x = jnp.concatenate([merge(ox_att), gla_out(ox_f + ox_b, px[6])], axis=-1) @ w_out
    if not need_ctx:
        return None, out_x
    oc_att = block_attention(qc, kc, vc, scale)
    out_c = jnp.concatenate([merge(oc_att), gla_out(oc_f + oc_b, pc[6])], axis=-1) @ w_out
    return out_c, out_x


def moe(h, router_w, router_b, w1, w3, w2):
    shape = h.shape
    hf = h.reshape(-1, shape[-1])
    scores = jax.nn.sigmoid((hf @ router_w).astype(jnp.float32))
    sel = scores + router_b.astype(jnp.float32)
    per_group = N_EXPERTS // N_GROUPS
    grp_top, _ = lax.top_k(sel.reshape(-1, N_GROUPS, per_group), 2)
    g_idx = jnp.argmax(grp_top.sum(-1), axis=-1)
    g_mask = jnp.repeat(jnp.arange(N_GROUPS)[None, :] == g_idx[:, None], per_group, axis=1)
    _, e_idx = lax.top_k(jnp.where(g_mask, sel, -jnp.inf), TOP_K)
    w = jnp.take_along_axis(scores, e_idx, axis=-1)
    w = w / jnp.sum(w, axis=-1, keepdims=True)
    combine = jnp.sum(jax.nn.one_hot(e_idx, N_EXPERTS, dtype=jnp.float32) * w[..., None], axis=1)
    hidden = jax.nn.silu(jnp.einsum('nd,edf->nef', hf, w1)) * jnp.einsum('nd,edf->nef', hf, w3)
    y = jnp.einsum('nef,efd->nd', hidden * combine[..., None].astype(hidden.dtype), w2)
    return y.reshape(shape)


def setup_inputs(seed: int = 0) -> dict:
    key = jax.random.key(seed)
    ks = jax.random.split(key, 29)
    D = D_MODEL
    ab_in = 3 * A_HEADS * A_DK + 2 * A_HEADS * A_DV + B_Q_LORA + B_KV_LORA + B_ROPE
    ab_mix = A_HEADS * A_DV + B_HEADS * B_DV
    cd_in = (C_HEADS + 2 * C_KV_HEADS) * C_DH + 2 * D_HEADS * D_DK + 2 * D_HEADS * D_DV + 2 * D_GATE_RANK
    cd_mix = C_HEADS * C_DH + D_HEADS * D_DV
    mod_init = 0.5

    def nrm(i, shape, scale):
        return jax.random.normal(ks[i], shape, jnp.float32) * scale

    def gain(i, shape):
        return 1.0 + nrm(i, shape, 0.02)

    return {
        'x': nrm(0, (BATCH, SEQ, D), 1.0),
        'c': nrm(1, (BATCH, D), 1.0),
        'ctx': nrm(2, (BATCH, CTX_LEN, D), 1.0),
        'c_ctx': nrm(3, (D,), 1.0),
        'mod_w': nrm(4, (DEPTH, D, 6 * D), mod_init * D ** -0.5),
        'mod_b': nrm(5, (DEPTH, 6 * D), 0.02),
        'norm_attn_g': gain(6, (DEPTH, D)),
        'norm_ffn_g': gain(7, (DEPTH, D)),
        'final_norm_g': gain(8, (D,)),
        'ab_w_in': nrm(9, (N_AB, D, ab_in), D ** -0.5),
        'ab_w_out': nrm(10, (N_AB, ab_mix, D), ab_mix ** -0.5),
        'hgrn_lb_logits': nrm(11, (2, DEPTH + 1, A_HEADS * A_DK), 0.1),
        'hgrn_norm_g': gain(12, (N_AB, A_DV)),
        'mla_q_norm_g': gain(13, (N_AB, B_Q_LORA)),
        'mla_w_uq': nrm(14, (N_AB, B_Q_LORA, B_HEADS * (B_NOPE + B_ROPE)), B_Q_LORA ** -0.5),
        'mla_kv_norm_g': gain(15, (N_AB, B_KV_LORA)),
        'mla_w_ukv': nrm(16, (N_AB, B_KV_LORA, B_HEADS * (B_NOPE + B_DV)), B_KV_LORA ** -0.5),
        'cd_w_in': nrm(17, (N_CD, D, cd_in), D ** -0.5),
        'cd_w_out': nrm(18, (N_CD, cd_mix, D), cd_mix ** -0.5),
        'gqa_q_norm_g': gain(19, (N_CD, C_DH)),
        'gqa_k_norm_g': gain(20, (N_CD, C_DH)),
        'gla_w_a2': nrm(21, (N_CD, 2, D_GATE_RANK, D_HEADS * D_DK), D_GATE_RANK ** -0.5),
        'gla_b_a': nrm(22, (N_CD, 2, D_HEADS * D_DK), 0.1),
        'gla_norm_g': gain(23, (N_CD, D_DV)),
        'router_w': nrm(24, (D, N_EXPERTS), D ** -0.5),
        'router_b': nrm(25, (N_EXPERTS,), 0.01),
        'moe_w1': nrm(26, (DEPTH, N_EXPERTS, D, EXPERT_DIM), D ** -0.5),
        'moe_w3': nrm(27, (DEPTH, N_EXPERTS, D, EXPERT_DIM), D ** -0.5),
        'moe_w2': nrm(28, (DEPTH, N_EXPERTS, EXPERT_DIM, D), EXPERT_DIM ** -0.5),
    }


def reference(x, c, ctx, c_ctx, mod_w, mod_b, norm_attn_g, norm_ffn_g, final_norm_g,
              ab_w_in, ab_w_out, hgrn_lb_logits, hgrn_norm_g, mla_q_norm_g, mla_w_uq, mla_kv_norm_g, mla_w_ukv,
              cd_w_in, cd_w_out, gqa_q_norm_g, gqa_k_norm_g, gla_w_a2, gla_b_a, gla_norm_g,
              router_w, router_b, moe_w1, moe_w3, moe_w2):
    t_len = x.shape[1]
    ang_b = axial_angles(t_len, B_ROPE)
    ang_c = axial_angles(t_len, C_DH)
    lb = jnp.cumsum(jax.nn.softmax(hgrn_lb_logits.astype(jnp.float32), axis=1), axis=1)
    xc = ctx
    for l in range(DEPTH):
        need_ctx = l < DEPTH - 1
        j = l // 2
        mx = (jax.nn.silu(c) @ mod_w[l] + mod_b[l])[:, None, :]
        mc = jax.nn.silu(c_ctx) @ mod_w[l] + mod_b[l]
        sx1, ax1, gx1, sx2, ax2, gx2 = jnp.split(mx, 6, axis=-1)
        sc1, ac1, gc1, sc2, ac2, gc2 = jnp.split(mc, 6, axis=-1)
        hx = modulate(rms_norm(x, norm_attn_g[l]), sx1, ax1)
        hc = modulate(rms_norm(xc, norm_attn_g[l]), sc1, ac1)
        if l % 2 == 0:
            oc, ox = mixer_ab(hc, hx, ab_w_in[j], ab_w_out[j], lb[0, l], lb[1, l], hgrn_norm_g[j],
                              mla_q_norm_g[j], mla_w_uq[j], mla_kv_norm_g[j], mla_w_ukv[j], ang_b, need_ctx)
        else:
            oc, ox = mixer_cd(hc, hx, cd_w_in[j], cd_w_out[j], gqa_q_norm_g[j], gqa_k_norm_g[j],
                              gla_w_a2[j], gla_b_a[j], gla_norm_g[j], ang_c, need_ctx)
        x = x + gx1 * ox
        hx = modulate(rms_norm(x, norm_ffn_g[l]), sx2, ax2)
        x = x + gx2 * moe(hx, router_w, router_b, moe_w1[l], moe_w3[l], moe_w2[l])
        if need_ctx:
            xc = xc + gc1 * oc
            hc = modulate(rms_norm(xc, norm_ffn_g[l]), sc2, ac2)
            xc = xc + gc2 * moe(hc, router_w, router_b, moe_w1[l], moe_w3[l], moe_w2[l])
    return rms_norm(x, final_norm_g)
```

```cpp
#include <hip/hip_runtime.h>
#include <cstdio>
#include <cstdint>

#define DEV __device__ __forceinline__
typedef unsigned short bf16_t;
typedef short bf16x8 __attribute__((ext_vector_type(8)));
typedef float f32x4 __attribute__((ext_vector_type(4)));
typedef unsigned u32x4 __attribute__((ext_vector_type(4)));
typedef unsigned u32x2 __attribute__((ext_vector_type(2)));

constexpr int NB = 4, TL = 2048, TC = 256, S = TL + TC, R = NB * S, D = 2048;
constexpr int NT = 512;
constexpr float EPS = 1e-6f;
constexpr int AB_IN = 5952, AB_INP = 6144, CD_IN = 4640, CD_INP = 4864;
constexpr int NE = 16, EDIM = 512;
constexpr int MODN = 6 * D;

constexpr size_t al256(size_t x) { return (x + 255) & ~(size_t)255; }
constexpr size_t WS_CTL = 0;
constexpr int    CW_CNT = 4096;
constexpr size_t CTL_BYTES = 32768;
constexpr size_t WS_MODV = WS_CTL + CTL_BYTES;
constexpr size_t WS_LB   = al256(WS_MODV + (size_t)2 * 5 * MODN * 4);
constexpr size_t WS_TABB = al256(WS_LB + 2 * 1024 * 4);
constexpr size_t WS_TABC = al256(WS_TABB + (size_t)TL * 32 * 8);
constexpr size_t WS_TOK  = al256(WS_TABC + (size_t)TL * 64 * 8);
constexpr size_t WS_LIST = al256(WS_TOK + (size_t)R * 16);
constexpr size_t WS_WABIN = al256(WS_LIST + (size_t)NE * R * 4);
constexpr size_t WS_WABOUT = al256(WS_WABIN + (size_t)AB_INP * D * 2);
constexpr size_t WS_WUQ  = al256(WS_WABOUT + (size_t)D * D * 2);
constexpr size_t WS_WUKV = al256(WS_WUQ + (size_t)1536 * 512 * 2);
constexpr size_t WS_WCDIN = al256(WS_WUKV + (size_t)2048 * 256 * 2);
constexpr size_t WS_WCDOUT = al256(WS_WCDIN + (size_t)CD_INP * D * 2);
constexpr size_t WS_W13  = al256(WS_WCDOUT + (size_t)D * D * 2);
constexpr size_t WS_W2   = al256(WS_W13 + (size_t)NE * 1024 * D * 2);
constexpr size_t WS_XRES = al256(WS_W2 + (size_t)NE * D * EDIM * 2);
constexpr size_t WS_H    = al256(WS_XRES + (size_t)R * D * 4);
constexpr size_t WS_P    = al256(WS_H + (size_t)R * D * 2);
constexpr size_t WS_ODIR = al256(WS_P + (size_t)R * AB_INP * 4);
constexpr size_t WS_A2   = al256(WS_ODIR + (size_t)2 * R * 1024 * 4);
constexpr size_t WS_GLAG = al256(WS_A2 + (size_t)R * D * 2);
constexpr size_t WS_QB   = al256(WS_GLAG + (size_t)2 * R * 512 * 4);
constexpr size_t WS_KB   = al256(WS_QB + (size_t)NB * 8 * S * 192 * 2);
constexpr size_t WS_VB   = al256(WS_KB + (size_t)NB * 8 * S * 192 * 2);
constexpr size_t WS_P5N  = al256(WS_VB + (size_t)NB * 8 * S * 128 * 2);
constexpr size_t WS_P6N  = al256(WS_P5N + (size_t)R * 512 * 2);
constexpr size_t WS_END  = al256(WS_P6N + (size_t)R * 256 * 2);
static_assert((size_t)R * 1536 * 4 <= WS_QB - WS_A2, "QFULL alias");
static_assert((size_t)(2 * R + 256) * 512 * 2 <= WS_KB - WS_QB, "HIDDEN alias");
static_assert((size_t)R * 2 * D * 4 <= WS_ODIR - WS_P, "YSLOTS alias");

struct Args { const float* in[29]; float* out; unsigned char* ws; int ph_lo, ph_hi; };

DEV unsigned cvtpk(float lo, float hi) { unsigned r; asm volatile("v_cvt_pk_bf16_f32 %0, %1, %2" : "=v"(r) : "v"(lo), "v"(hi)); return r; }
DEV bf16_t f2bf(float x) { return (bf16_t)(cvtpk(x, 0.f) & 0xffffu); }
DEV float bf2f(bf16_t x) { return __uint_as_float(((unsigned)x) << 16); }
DEV float sigmoidf_(float x) { return 1.f / (1.f + __expf(-x)); }
DEV float siluf_(float x) { return x / (1.f + __expf(-x)); }
DEV float wave_sum(float v) {
#pragma unroll
    for (int o = 32; o >= 1; o >>= 1) v += __shfl_xor(v, o);
    return v;
}
DEV float wave_max(float v) {
#pragma unroll
    for (int o = 32; o >= 1; o >>= 1) v = fmaxf(v, __shfl_xor(v, o));
    return v;
}
DEV int tid_opaque() { int t = threadIdx.x; asm volatile("" : "+v"(t)); return t; }
DEV int modvec_of_row(int r) { const int b = r / S, t = r - b * S; return t < TC ? 4 : b; }

constexpr int BM = 256, BK = 64, HALF = 128, HT = HALF * BK, SHM_GEMM = 8 * HT * 2;
DEV int lds_byte(int r, int c) { int st = (r >> 4) * 2 + (c >> 5), rr = r & 15, cc = c & 31, ob = rr * 64 + cc * 2; return st * 1024 + (ob ^ (((ob >> 9) & 1) << 5)); }
DEV void stage_rc(int b, int& Rr, int& Cc) { int st = b / 1024, sb = b % 1024, swz = sb ^ (((sb >> 9) & 1) << 5); Rr = (st >> 1) * 16 + swz / 64; Cc = (st & 1) * 32 + (swz % 64) / 2; }

template <bool GATHER, class Epi>
DEV void gemm_tile(const bf16_t* __restrict__ A, const bf16_t* __restrict__ Bt, int ld, int K, int brow, int bcol,
                   const int* __restrict__ rowmap, int nvalid, char* smem, const Epi& epi) {
    bf16_t* shm = (bf16_t*)smem;
#define SA(b, h) (shm + ((b) * 2 + (h)) * HT)
#define SB(b, h) (shm + (4 + (b) * 2 + (h)) * HT)
#define GLDS(gp, lp) __builtin_amdgcn_global_load_lds((const unsigned*)(gp), (unsigned*)(lp), 16, 0, 0)
#define STAGE_A(P, h, kt) do { _Pragma("unroll") for (int _i = 0; _i < 2; ++_i) { \
        const char* _sb = GATHER ? (const char*)A + (size_t)(kt) * (BK * 2) : (const char*)A + ((size_t)(brow + (h) * HALF + _i * 64) * ld + (size_t)(kt) * BK) * 2; \
        GLDS(_sb + (GATHER ? voffa[h][_i] : voff), (char*)(P) + tid16 + _i * 8192); } } while (0)
#define STAGE_B(P, h, kt) do { _Pragma("unroll") for (int _i = 0; _i < 2; ++_i) { \
        const char* _sb = (const char*)Bt + ((size_t)(bcol + (h) * HALF + _i * 64) * ld + (size_t)(kt) * BK) * 2; \
        GLDS(_sb + voff, (char*)(P) + tid16 + _i * 8192); } } while (0)
#define LDA(dst, b, h) _Pragma("unroll") for (int m = 0; m < 4; ++m) _Pragma("unroll") for (int k = 0; k < 2; ++k) \
        dst[m][k] = *reinterpret_cast<const bf16x8*>((char*)SA(b, h) + lds_byte(wr * 64 + m * 16 + fr, k * 32 + fq * 8))
#define LDB(dst, b, h) _Pragma("unroll") for (int n = 0; n < 2; ++n) _Pragma("unroll") for (int k = 0; k < 2; ++k) \
        dst[n][k] = *reinterpret_cast<const bf16x8*>((char*)SB(b, h) + lds_byte(wc * 32 + n * 16 + fr, k * 32 + fq * 8))
#define MMA(ai, bj, At_, Bt_) do { __builtin_amdgcn_s_setprio(1); \
        _Pragma("unroll") for (int m = 0; m < 4; ++m) _Pragma("unroll") for (int n = 0; n < 2; ++n) _Pragma("unroll") for (int k = 0; k < 2; ++k) \
            acc[ai][bj][m][n] = __builtin_amdgcn_mfma_f32_16x16x32_bf16(Bt_[n][k], At_[m][k], acc[ai][bj][m][n], 0, 0, 0); \
        __builtin_amdgcn_s_setprio(0); } while (0)
#define WAIT_V(n) asm volatile("s_waitcnt vmcnt(" #n ")" ::: "memory")
#define WAIT_L(n) asm volatile("s_waitcnt lgkmcnt(" #n ")" ::: "memory")
#define BAR __builtin_amdgcn_s_barrier()
#define SCHED __builtin_amdgcn_sched_barrier(0)
    int tid = threadIdx.x; asm volatile("" : "+v"(tid));
    int wid = tid >> 6, lane = tid & 63, wr = wid >> 2, wc = wid & 3, fr = lane & 15, fq = lane >> 4;
    const int tid16 = tid * 16;
    unsigned voff; unsigned voffa[2][2];
    {
        int r0, c0; stage_rc(tid16, r0, c0);
        voff = (unsigned)(r0 * ld + c0) * 2u;
#pragma unroll
        for (int h = 0; h < 2; ++h)
#pragma unroll
            for (int i = 0; i < 2; ++i) {
                if (GATHER) { int l0 = h * HALF + i * 64 + r0; l0 = l0 < nvalid ? l0 : nvalid - 1; voffa[h][i] = (unsigned)((rowmap[l0] >> 1) * ld + c0) * 2u; }
                else voffa[h][i] = 0u;
            }
    }
    f32x4 acc[2][2][4][2] = {};
    bf16x8 At[4][2], B0[2][2], B1[2][2];
    const int nt = K / BK;
    STAGE_B(SB(0, 0), 0, 0); STAGE_A(SA(0, 0), 0, 0);
    STAGE_B(SB(0, 1), 1, 0); STAGE_A(SA(0, 1), 1, 0);
    if (wr == 1) BAR;
    WAIT_V(4); BAR;
    STAGE_B(SB(1, 0), 0, 1); STAGE_A(SA(1, 0), 0, 1); STAGE_B(SB(1, 1), 1, 1);
    WAIT_V(6); BAR;
    for (int t = 0; t < nt - 2; t += 2) {
        LDB(B0, 0, 0); SCHED; LDA(At, 0, 0); STAGE_A(SA(1, 1), 1, t + 1);
        WAIT_L(8); BAR; WAIT_L(0); MMA(0, 0, At, B0); BAR; SCHED;
        LDB(B1, 0, 1); STAGE_B(SB(0, 0), 0, t + 2);
        BAR; WAIT_L(0); MMA(0, 1, At, B1); BAR;
        LDA(At, 0, 1); STAGE_A(SA(0, 0), 0, t + 2);
        BAR; WAIT_L(0); MMA(1, 0, At, B0); BAR; SCHED;
        STAGE_B(SB(0, 1), 1, t + 2);
        WAIT_V(6); BAR; MMA(1, 1, At, B1); BAR;
        LDB(B0, 1, 0); SCHED; LDA(At, 1, 0); STAGE_A(SA(0, 1), 1, t + 2);
        WAIT_L(8); BAR; WAIT_L(0); MMA(0, 0, At, B0); BAR; SCHED;
        LDB(B1, 1, 1); STAGE_B(SB(1, 0), 0, t + 3);
        BAR; WAIT_L(0); MMA(0, 1, At, B1); BAR;
        LDA(At, 1, 1); STAGE_A(SA(1, 0), 0, t + 3);
        BAR; WAIT_L(0); MMA(1, 0, At, B0); BAR; SCHED;
        STAGE_B(SB(1, 1), 1, t + 3);
        WAIT_V(6); BAR; MMA(1, 1, At, B1); BAR;
    }
    { LDB(B0, 0, 0); WAIT_V(0); LDA(At, 0, 0); STAGE_A(SA(1, 1), 1, nt - 1);
      BAR; WAIT_L(0); MMA(0, 0, At, B0); BAR;
      LDB(B1, 0, 1); BAR; WAIT_L(0); MMA(0, 1, At, B1); BAR;
      LDA(At, 0, 1); WAIT_V(4); BAR; WAIT_L(0); MMA(1, 0, At, B0); MMA(1, 1, At, B1); BAR; }
    { LDB(B0, 1, 0); LDA(At, 1, 0); WAIT_V(2); BAR; WAIT_L(0); MMA(0, 0, At, B0); BAR;
      LDB(B1, 1, 1); WAIT_V(0); BAR; WAIT_L(0); MMA(0, 1, At, B1); BAR;
      LDA(At, 1, 1); BAR; WAIT_L(0); MMA(1, 0, At, B0); MMA(1, 1, At, B1); BAR; }
    if (wr == 0) BAR;
    int tz = threadIdx.x; asm volatile("" : "+v"(tz)); wid = tz >> 6; lane = tz & 63; wr = wid >> 2; wc = wid & 3; fr = lane & 15; fq = lane >> 4;
    epi(acc, brow, bcol, wr, wc, fr, fq);
#undef SA
#undef SB
#undef STAGE_A
#undef STAGE_B
#undef GLDS
#undef LDA
#undef LDB
#undef MMA
}

struct EpiStoreF32 { float* C; int ldc;
    DEV void operator()(const f32x4 (&acc)[2][2][4][2], int brow, int bcol, int wr, int wc, int fr, int fq) const {
#pragma unroll
        for (int ai = 0; ai < 2; ++ai)
#pragma unroll
            for (int m = 0; m < 4; ++m) { float* rowp = C + (size_t)(brow + ai * HALF + wr * 64 + m * 16 + fr) * ldc + bcol + wc * 32 + fq * 4;
#pragma unroll
                for (int bj = 0; bj < 2; ++bj)
#pragma unroll
                    for (int n = 0; n < 2; ++n) *(f32x4*)(rowp + bj * HALF + n * 16) = acc[ai][bj][m][n]; }
    } };
struct EpiResidGate { float* X; const float* gate;
    DEV void operator()(const f32x4 (&acc)[2][2][4][2], int brow, int bcol, int wr, int wc, int fr, int fq) const {
        const float* g = gate + (size_t)modvec_of_row(brow) * MODN + bcol + wc * 32 + fq * 4;
        f32x4 gv[2][2];
#pragma unroll
        for (int bj = 0; bj < 2; ++bj)
#pragma unroll
            for (int n = 0; n < 2; ++n) gv[bj][n] = *(const f32x4*)(g + bj * HALF + n * 16);
#pragma unroll
        for (int ai = 0; ai < 2; ++ai)
#pragma unroll
            for (int m = 0; m < 4; ++m) { float* rowp = X + (size_t)(brow + ai * HALF + wr * 64 + m * 16 + fr) * D + bcol + wc * 32 + fq * 4;
#pragma unroll
                for (int bj = 0; bj < 2; ++bj)
#pragma unroll
                    for (int n = 0; n < 2; ++n) { f32x4 x = *(f32x4*)(rowp + bj * HALF + n * 16); x += gv[bj][n] * acc[ai][bj][m][n]; *(f32x4*)(rowp + bj * HALF + n * 16) = x; }
                if (m & 1) asm volatile("" ::: "memory"); }
    } };
struct EpiMoeUp { bf16_t* hid; int rowbase, nvalid;
    DEV void operator()(const f32x4 (&acc)[2][2][4][2], int brow, int bcol, int wr, int wc, int fr, int fq) const {
        const int hc = (bcol >> 1) + wc * 32 + fq * 4;
#pragma unroll
        for (int ai = 0; ai < 2; ++ai)
#pragma unroll
            for (int m = 0; m < 4; ++m) { const int lr = ai * HALF + wr * 64 + m * 16 + fr;
                if (lr < nvalid) { bf16_t* rowp = hid + (size_t)(rowbase + lr) * EDIM + hc;
#pragma unroll
                    for (int n = 0; n < 2; ++n) { const f32x4 a = acc[ai][0][m][n], b = acc[ai][1][m][n];
                        u32x2 w; w.x = cvtpk(siluf_(a[0]) * b[0], siluf_(a[1]) * b[1]); w.y = cvtpk(siluf_(a[2]) * b[2], siluf_(a[3]) * b[3]);
                        *(u32x2*)(rowp + n * 16) = w; } } }
    } };
struct EpiMoeDown { float* y; const int* list; int nvalid;
    DEV void operator()(const f32x4 (&acc)[2][2][4][2], int brow, int bcol, int wr, int wc, int fr, int fq) const {
#pragma unroll
        for (int ai = 0; ai < 2; ++ai)
#pragma unroll
            for (int m = 0; m < 4; ++m) { const int lr = ai * HALF + wr * 64 + m * 16 + fr;
                if (lr < nvalid) { float* rowp = y + (size_t)list[lr] * D + bcol + wc * 32 + fq * 4;
#pragma unroll
                    for (int bj = 0; bj < 2; ++bj)
#pragma unroll
                        for (int n = 0; n < 2; ++n) *(f32x4*)(rowp + bj * HALF + n * 16) = acc[ai][bj][m][n]; } }
    } };

template <class Epi>
DEV void gemm_phase(const bf16_t* A, const bf16_t* Bt, int M, int N, int K, char* smem, const Epi& epi, int& cursor) {
    const int nM = M / BM, nN = N / BM, n = nM * nN;
    int first = cursor; cursor += n;
    int u = blockIdx.x; while (u < first) u += gridDim.x;
    for (; u < first + n; u += gridDim.x) { const int t = u - first; const int pm = t % nM, pn = t / nM;
        gemm_tile<false>(A, Bt, K, K, pm * BM, pn * BM, nullptr, 0, smem, epi); }
}

DEV void cvt_weight(const float* __restrict__ src, bf16_t* __restrict__ dst, int K, int N, int Nout, int nb, size_t src_bs, size_t dst_bs,
                    int blk_rs, int blk_base, const float* __restrict__ kscale, char* smem) {
    float* tile = (float*)smem;
    const int tid = tid_opaque(), tK = K / 64, tN = Nout / 64, per = tK * tN, total = nb * per;
    for (int u = blockIdx.x; u < total; u += gridDim.x) {
        const int bt = u / per, rem = u - bt * per, kt = rem / tN, ntl = rem - kt * tN;
        const float* s = src + (size_t)bt * src_bs; bf16_t* d = dst + (size_t)bt * dst_bs;
        const int kk = tid >> 4, c4 = (tid & 15) * 4;
#pragma unroll
        for (int ps = 0; ps < 2; ++ps) { const int k = kt * 64 + kk + ps * 32, n = ntl * 64 + c4;
            f32x4 v = {0.f, 0.f, 0.f, 0.f};
            if (n < N) v = *(const f32x4*)(s + (size_t)k * N + n);
            if (kscale) v *= kscale[k];
            float* tp = tile + (kk + ps * 32) * 65 + c4; tp[0] = v[0]; tp[1] = v[1]; tp[2] = v[2]; tp[3] = v[3]; }
        __syncthreads();
        { const int nl = tid >> 3, kc = (tid & 7) * 8, n = ntl * 64 + nl;
          float e[8];
#pragma unroll
          for (int i = 0; i < 8; ++i) e[i] = tile[(kc + i) * 65 + nl];
          u32x4 w; w.x = cvtpk(e[0], e[1]); w.y = cvtpk(e[2], e[3]); w.z = cvtpk(e[4], e[5]); w.w = cvtpk(e[6], e[7]);
          const int drow = (n >> 7) * blk_rs + blk_base + (n & 127);
          *(u32x4*)(d + (size_t)drow * K + kt * 64 + kc) = w; }
        __syncthreads();
    }
}
DEV void cvt_moe_layer(const Args& a, int l, char* smem) {
    unsigned char* ws = a.ws;
    cvt_weight(a.in[26] + (size_t)l * NE * D * EDIM, (bf16_t*)(ws + WS_W13), D, EDIM, EDIM, NE, (size_t)D * EDIM, (size_t)1024 * D, 256, 0, nullptr, smem);
    cvt_weight(a.in[27] + (size_t)l * NE * D * EDIM, (bf16_t*)(ws + WS_W13), D, EDIM, EDIM, NE, (size_t)D * EDIM, (size_t)1024 * D, 256, 128, nullptr, smem);
    cvt_weight(a.in[28] + (size_t)l * NE * EDIM * D, (bf16_t*)(ws + WS_W2), EDIM, D, D, NE, (size_t)EDIM * D, (size_t)D * EDIM, 128, 0, nullptr, smem);
}

DEV void mod_phase(const Args& a, char* smem) {
    float* sc = (float*)smem;
    float* red = sc + 5 * D;
    const int tid = tid_opaque(), w = tid >> 6, lane = tid & 63, cg = lane & 7, rr = lane >> 3;
    for (int i = tid; i < 5 * D; i += NT) { const int v = i / D, k = i - v * D; const float x = v < 4 ? a.in[1][v * D + k] : a.in[3][k]; sc[i] = siluf_(x); }
    __syncthreads();
    float* modv = (float*)(a.ws + WS_MODV);
    for (int u = blockIdx.x; u < 2 * (MODN / 32); u += gridDim.x) {
        const int l = u / (MODN / 32), c0 = (u - l * (MODN / 32)) * 32;
        const float* wp = a.in[4] + (size_t)l * D * MODN + c0 + cg * 4;
        f32x4 acc[5] = {};
        for (int it = 0; it < D / 64; ++it) { const int k = it * 64 + w * 8 + rr;
            const f32x4 wv = *(const f32x4*)(wp + (size_t)k * MODN);
#pragma unroll
            for (int v = 0; v < 5; ++v) acc[v] += wv * sc[v * D + k]; }
#pragma unroll
        for (int v = 0; v < 5; ++v)
#pragma unroll
            for (int j = 0; j < 4; ++j) { float x = acc[v][j]; x += __shfl_xor(x, 8); x += __shfl_xor(x, 16); x += __shfl_xor(x, 32); acc[v][j] = x; }
        if (rr == 0) {
#pragma unroll
            for (int v = 0; v < 5; ++v)
#pragma unroll
                for (int j = 0; j < 4; ++j) red[(w * 5 + v) * 32 + cg * 4 + j] = acc[v][j]; }
        __syncthreads();
        if (tid < 160) { const int v = tid >> 5, c = tid & 31; float s = 0.f;
#pragma unroll
            for (int ww = 0; ww < 8; ++ww) s += red[(ww * 5 + v) * 32 + c];
            modv[((size_t)l * 5 + v) * MODN + c0 + c] = s + a.in[5][l * MODN + c0 + c]; }
        __syncthreads();
    }
}

DEV void misc_phase(const Args& a) {
    const int gt = blockIdx.x * NT + tid_opaque(), gs = gridDim.x * NT;
    float* lb = (float*)(a.ws + WS_LB);
    for (int i = gt; i < 2 * 1024; i += gs) { const int d = i >> 10, c = i & 1023; const float* p = a.in[11] + (size_t)d * 3 * 1024 + c;
        const float x0 = p[0], x1 = p[1024], x2 = p[2048], m = fmaxf(x0, fmaxf(x1, x2));
        const float e0 = expf(x0 - m), e1 = expf(x1 - m), e2 = expf(x2 - m); lb[i] = e0 / (e0 + e1 + e2); }
    float2* tb = (float2*)(a.ws + WS_TABB); float2* tc = (float2*)(a.ws + WS_TABC);
    for (int i = gt; i < TL * 32; i += gs) { const int t = i >> 5, j = i & 31, q = j & 15; const float fr = powf(10000.f, -(float)q / 16.f);
        const float pos = (j < 16) ? (float)(t >> 6) : (float)(t & 63); const float an = pos * fr; tb[i] = make_float2(cosf(an), sinf(an)); }
    for (int i = gt; i < TL * 64; i += gs) { const int t = i >> 6, j = i & 63, q = j & 31; const float fr = powf(10000.f, -(float)q / 32.f);
        const float pos = (j < 32) ? (float)(t >> 6) : (float)(t & 63); const float an = pos * fr; tc[i] = make_float2(cosf(an), sinf(an)); }
    f32x4* xr = (f32x4*)(a.ws + WS_XRES);
    for (int i = gt; i < R * (D / 4); i += gs) { const int r = i / (D / 4), c = i - r * (D / 4), b = r / S, t = r - b * S;
        const f32x4* src = t < TC ? (const f32x4*)(a.in[2] + ((size_t)b * TC + t) * D) : (const f32x4*)(a.in[0] + ((size_t)b * TL + (t - TC)) * D);
        xr[i] = src[c]; }
}

template <bool ROUTER>
DEV void norm_phase(const Args& a, int l, int chunk_shift, const float* gain, bool latent_only, char* smem) {
    const int tid = tid_opaque(), w = tid >> 6, lane = tid & 63;
    const float* xres = (const float*)(a.ws + WS_XRES); bf16_t* h = (bf16_t*)(a.ws + WS_H);
    const float* modv = (const float*)(a.ws + WS_MODV) + (size_t)l * 5 * MODN;
    unsigned* cnt = (unsigned*)(a.ws + WS_CTL) + CW_CNT + l * 16;
    int* tok = (int*)(a.ws + WS_TOK); int* list = (int*)(a.ws + WS_LIST);
    float* rw = (float*)smem;
    if (ROUTER) { for (int i = tid; i < D * 16 / 4; i += NT) ((f32x4*)rw)[i] = ((const f32x4*)a.in[24])[i]; __syncthreads(); }
    for (int r = blockIdx.x * 8 + w; r < R; r += gridDim.x * 8) {
        const int b = r / S, t = r - b * S; if (latent_only && t < TC) continue;
        const int v = t < TC ? 4 : b;
        const float* xp = xres + (size_t)r * D; const float* sh = modv + (size_t)v * MODN + chunk_shift * D; const float* sc = sh + D;
        f32x4 x[8]; float ss = 0.f;
#pragma unroll
        for (int j = 0; j < 8; ++j) { x[j] = *(const f32x4*)(xp + j * 256 + lane * 4); ss += x[j][0] * x[j][0] + x[j][1] * x[j][1] + x[j][2] * x[j][2] + x[j][3] * x[j][3]; }
        ss = wave_sum(ss); const float rstd = rsqrtf(ss * (1.f / D) + EPS);
        float lg[16];
        if (ROUTER) {
#pragma unroll
            for (int e = 0; e < 16; ++e) lg[e] = 0.f; }
#pragma unroll
        for (int j = 0; j < 8; ++j) { const int c = j * 256 + lane * 4;
            const f32x4 g = *(const f32x4*)(gain + c), s1 = *(const f32x4*)(sc + c), s0 = *(const f32x4*)(sh + c);
            f32x4 y = (x[j] * rstd * g) * (1.f + s1) + s0;
            u32x2 pk; pk.x = cvtpk(y[0], y[1]); pk.y = cvtpk(y[2], y[3]); *(u32x2*)(h + (size_t)r * D + c) = pk;
            if (ROUTER) {
#pragma unroll
                for (int i = 0; i < 4; ++i) { const f32x4* wrow = (const f32x4*)(rw + (size_t)(c + i) * 16);
#pragma unroll
                    for (int q = 0; q < 4; ++q) { const f32x4 wv = wrow[q]; lg[q * 4 + 0] += y[i] * wv[0]; lg[q * 4 + 1] += y[i] * wv[1]; lg[q * 4 + 2] += y[i] * wv[2]; lg[q * 4 + 3] += y[i] * wv[3]; } } }
        }
        if (ROUTER) {
#pragma unroll
            for (int e = 0; e < 16; ++e) lg[e] = wave_sum(lg[e]);
            if (lane == 0) {
                float scv[16], sel[16];
#pragma unroll
                for (int e = 0; e < 16; ++e) { scv[e] = 1.f / (1.f + expf(-lg[e])); sel[e] = scv[e] + a.in[25][e]; }
                int gbest = 0; float gbv = -1e30f;
#pragma unroll
                for (int g = 0; g < 4; ++g) { float m1 = -1e30f, m2 = -1e30f;
#pragma unroll
                    for (int i = 0; i < 4; ++i) { const float s_ = sel[g * 4 + i]; if (s_ > m1) { m2 = m1; m1 = s_; } else if (s_ > m2) m2 = s_; }
                    const float gs = m1 + m2; if (gs > gbv) { gbv = gs; gbest = g; } }
                int e0 = 0, e1 = 0; float m1 = -1e30f, m2 = -1e30f; float w0 = 0.f, w1 = 0.f;
#pragma unroll
                for (int g = 0; g < 4; ++g) if (g == gbest) {
#pragma unroll
                    for (int i = 0; i < 4; ++i) { const float s_ = sel[g * 4 + i]; const int e = g * 4 + i;
                        if (s_ > m1) { m2 = m1; e1 = e0; w1 = w0; m1 = s_; e0 = e; w0 = scv[e]; } else if (s_ > m2) { m2 = s_; e1 = e; w1 = scv[e]; } } }
                const float inv = 1.f / (w0 + w1);
                const unsigned s0 = atomicAdd(&cnt[e0], 1u), s1 = atomicAdd(&cnt[e1], 1u);
                list[(size_t)e0 * R + s0] = r * 2; list[(size_t)e1 * R + s1] = r * 2 + 1;
                tok[r * 4 + 0] = e0; tok[r * 4 + 1] = e1; ((float*)tok)[r * 4 + 2] = w0 * inv; ((float*)tok)[r * 4 + 3] = w1 * inv;
            }
        }
    }
}

DEV void prep_ab_phase(const Args& a) {
    const int tid = tid_opaque(), w = tid >> 6, lane = tid & 63;
    const float* P = (const float*)(a.ws + WS_P); bf16_t* p5n = (bf16_t*)(a.ws + WS_P5N); bf16_t* p6n = (bf16_t*)(a.ws + WS_P6N);
    bf16_t* Kb = (bf16_t*)(a.ws + WS_KB); const float2* tb = (const float2*)(a.ws + WS_TABB);
    for (int r = blockIdx.x * 8 + w; r < R; r += gridDim.x * 8) {
        const int b = r / S, t = r - b * S; const float* pr = P + (size_t)r * AB_INP;
        { const f32x4 x0 = *(const f32x4*)(pr + 5120 + lane * 8), x1 = *(const f32x4*)(pr + 5120 + lane * 8 + 4);
          float ss = x0[0] * x0[0] + x0[1] * x0[1] + x0[2] * x0[2] + x0[3] * x0[3] + x1[0] * x1[0] + x1[1] * x1[1] + x1[2] * x1[2] + x1[3] * x1[3];
          ss = wave_sum(ss); const float rs = rsqrtf(ss * (1.f / 512.f) + EPS);
          u32x4 o; o.x = cvtpk(x0[0] * rs, x0[1] * rs); o.y = cvtpk(x0[2] * rs, x0[3] * rs); o.z = cvtpk(x1[0] * rs, x1[1] * rs); o.w = cvtpk(x1[2] * rs, x1[3] * rs);
          *(u32x4*)(p5n + (size_t)r * 512 + lane * 8) = o; }
        { const f32x4 x0 = *(const f32x4*)(pr + 5632 + lane * 4);
          float ss = x0[0] * x0[0] + x0[1] * x0[1] + x0[2] * x0[2] + x0[3] * x0[3];
          ss = wave_sum(ss); const float rs = rsqrtf(ss * (1.f / 256.f) + EPS);
          u32x2 o; o.x = cvtpk(x0[0] * rs, x0[1] * rs); o.y = cvtpk(x0[2] * rs, x0[3] * rs);
          *(u32x2*)(p6n + (size_t)r * 256 + lane * 4) = o; }
        { float x = pr[5888 + lane]; const float xo = __shfl_xor(x, 32);
          if (t >= TC) { const float2 cs = tb[(t - TC) * 32 + (lane & 31)]; x = (lane < 32) ? (x * cs.x - xo * cs.y) : (x * cs.x + xo * cs.y); }
          const bf16_t kb = f2bf(x);
#pragma unroll
          for (int hh = 0; hh < 8; ++hh) Kb[(((size_t)b * 8 + hh) * S + t) * 192 + 128 + lane] = kb; }
    }
}
DEV void assemble_ab_phase(const Args& a) {
    const int tid = tid_opaque(), w = tid >> 6, lane = tid & 63;
    const float* QF = (const float*)(a.ws + WS_A2); const float* KVF = (const float*)(a.ws + WS_ODIR);
    bf16_t* Qb = (bf16_t*)(a.ws + WS_QB); bf16_t* Kb = (bf16_t*)(a.ws + WS_KB); bf16_t* Vb = (bf16_t*)(a.ws + WS_VB);
    const float2* tb = (const float2*)(a.ws + WS_TABB);
    for (int r = blockIdx.x * 8 + w; r < R; r += gridDim.x * 8) {
        const int b = r / S, t = r - b * S;
        float2 cs = make_float2(1.f, 0.f); if (t >= TC) cs = tb[(t - TC) * 32 + (lane & 31)];
#pragma unroll
        for (int hh = 0; hh < 8; ++hh) {
            const float* q = QF + (size_t)r * 1536 + hh * 192; bf16_t* qo = Qb + (((size_t)b * 8 + hh) * S + t) * 192;
            qo[lane] = f2bf(q[lane]); qo[64 + lane] = f2bf(q[64 + lane]);
            float x = q[128 + lane]; const float xo = __shfl_xor(x, 32);
            x = (lane < 32) ? (x * cs.x - xo * cs.y) : (x * cs.x + xo * cs.y);
            qo[128 + lane] = f2bf(x);
            const float* kv = KVF + (size_t)r * 2048 + hh * 256;
            bf16_t* ko = Kb + (((size_t)b * 8 + hh) * S + t) * 192; bf16_t* vo = Vb + (((size_t)b * 8 + hh) * S + t) * 128;
            ko[lane] = f2bf(kv[lane]); ko[64 + lane] = f2bf(kv[64 + lane]); vo[lane] = f2bf(kv[128 + lane]); vo[64 + lane] = f2bf(kv[192 + lane]);
        }
    }
}
DEV void prep_cd_phase(const Args& a, char* smem) {
    const int tid = tid_opaque(), w = tid >> 6, lane = tid & 63;
    const float* P = (const float*)(a.ws + WS_P); bf16_t* Qb = (bf16_t*)(a.ws + WS_QB); bf16_t* Kb = (bf16_t*)(a.ws + WS_KB); bf16_t* Vb = (bf16_t*)(a.ws + WS_VB);
    float* glag = (float*)(a.ws + WS_GLAG); const float2* tc = (const float2*)(a.ws + WS_TABC);
    float* wa = (float*)smem;
    for (int i = tid; i < 2 * 16 * 512; i += NT) wa[i] = a.in[21][i];
    for (int i = tid; i < 2 * 512; i += NT) wa[2 * 16 * 512 + i] = a.in[22][i];
    __syncthreads();
    const float gq0 = a.in[19][lane], gq1 = a.in[19][64 + lane], gk0 = a.in[20][lane], gk1 = a.in[20][64 + lane];
    for (int r = blockIdx.x * 8 + w; r < R; r += gridDim.x * 8) {
        const int b = r / S, t = r - b * S; const float* pr = P + (size_t)r * CD_INP;
        float2 cs = make_float2(1.f, 0.f); if (t >= TC) cs = tc[(t - TC) * 64 + lane];
        for (int hh = 0; hh < 10; ++hh) {
            const float* src = pr + hh * 128; float x0 = src[lane], x1 = src[64 + lane];
            float ss = wave_sum(x0 * x0 + x1 * x1); const float rs = rsqrtf(ss * (1.f / 128.f) + EPS);
            x0 = x0 * rs * (hh < 8 ? gq0 : gk0); x1 = x1 * rs * (hh < 8 ? gq1 : gk1);
            const float y0 = x0 * cs.x - x1 * cs.y, y1 = x1 * cs.x + x0 * cs.y;
            bf16_t* dst = hh < 8 ? Qb + (((size_t)b * 8 + hh) * S + t) * 128 : Kb + (((size_t)b * 2 + (hh - 8)) * S + t) * 128;
            dst[lane] = f2bf(y0); dst[64 + lane] = f2bf(y1);
        }
#pragma unroll
        for (int hh = 0; hh < 2; ++hh) { const float* src = pr + 1280 + hh * 128; bf16_t* dst = Vb + (((size_t)b * 2 + hh) * S + t) * 128;
            dst[lane] = f2bf(src[lane]); dst[64 + lane] = f2bf(src[64 + lane]); }
        float av[2]; av[0] = lane < 16 ? pr[4608 + lane] : 0.f; av[1] = lane < 16 ? pr[4624 + lane] : 0.f;
#pragma unroll
        for (int d = 0; d < 2; ++d) {
            float z[8];
#pragma unroll
            for (int j = 0; j < 8; ++j) z[j] = wa[2 * 16 * 512 + d * 512 + j * 64 + lane];
#pragma unroll
            for (int i = 0; i < 16; ++i) { const float ai = __shfl(av[d], i);
#pragma unroll
                for (int j = 0; j < 8; ++j) z[j] += ai * wa[(d * 16 + i) * 512 + j * 64 + lane]; }
#pragma unroll
            for (int j = 0; j < 8; ++j) { const float zz = z[j]; const float ls = fminf(zz, 0.f) - log1pf(expf(-fabsf(zz)));
                glag[((size_t)d * R + r) * 512 + j * 64 + lane] = ls * (1.f / 16.f); }
        }
    }
}

template <int MODE>
DEV void scan_naive_phase(const Args& a, char* smem) {
    const int tid = tid_opaque(), vloc = tid >> 2, dg = tid & 3;
    float* qs = (float*)smem; float* ks = qs + 16 * 128; float* as = ks + 16 * 128; float* vs = as + 16 * 128;
    const float* P = (const float*)(a.ws + WS_P); const float* lb = (const float*)(a.ws + WS_LB); const float* glag = (const float*)(a.ws + WS_GLAG);
    float* odir = (float*)(a.ws + WS_ODIR);
    constexpr int NH = MODE == 0 ? 8 : 4, NVS = MODE == 0 ? 1 : 2, LDP = MODE == 0 ? AB_INP : CD_INP, DV = MODE == 0 ? 128 : 256;
    const float qscale = 0.08838834764831845f;
    for (int item = blockIdx.x; item < NB * NH * 2 * NVS; item += gridDim.x) {
        const int vsl = item % NVS, dir = (item / NVS) & 1, hd = (item / (NVS * 2)) % NH, b = item / (NVS * 2 * NH);
        float st[32];
#pragma unroll
        for (int i = 0; i < 32; ++i) st[i] = 0.f;
        for (int c0 = 0; c0 < S; c0 += 16) {
            __syncthreads();
#pragma unroll
            for (int e = 0; e < 4; ++e) { const int idx = tid + e * NT, j = idx >> 7, d = idx & 127, pos = c0 + j;
                int tt; if (dir == 0) tt = pos; else tt = pos < TC ? (TC - 1 - pos) : (S - 1 - (pos - TC));
                const int r = b * S + tt; const float* pr = P + (size_t)r * LDP;
                float q, k, av, v;
                if (MODE == 0) { q = siluf_(pr[hd * 128 + d]) * qscale; const float z = pr[1024 * (1 + dir) + hd * 128 + d]; const float l_ = lb[dir * 1024 + hd * 128 + d];
                    const float f = l_ + (1.f - l_) * sigmoidf_(z); k = 1.f - f; av = f; v = pr[3072 + hd * 128 + d]; }
                else { q = pr[1536 + hd * 128 + d] * qscale; k = pr[2048 + hd * 128 + d]; av = expf(glag[((size_t)dir * R + r) * 512 + hd * 128 + d]); v = pr[2560 + hd * 256 + vsl * 128 + d]; }
                qs[idx] = q; ks[idx] = k; as[idx] = av; vs[idx] = v; }
            __syncthreads();
            for (int j = 0; j < 16; ++j) {
                const float v = vs[j * 128 + vloc]; float part = 0.f;
#pragma unroll
                for (int i4 = 0; i4 < 8; ++i4) { const f32x4 av = *(const f32x4*)(as + j * 128 + dg * 32 + i4 * 4), kv = *(const f32x4*)(ks + j * 128 + dg * 32 + i4 * 4), qv = *(const f32x4*)(qs + j * 128 + dg * 32 + i4 * 4);
#pragma unroll
                    for (int i = 0; i < 4; ++i) { float s_ = st[i4 * 4 + i]; s_ = av[i] * s_ + kv[i] * v; st[i4 * 4 + i] = s_; part += s_ * qv[i]; } }
                part += __shfl_xor(part, 1); part += __shfl_xor(part, 2);
                if (dg == 0) { const int pos = c0 + j; int tt; if (dir == 0) tt = pos; else tt = pos < TC ? (TC - 1 - pos) : (S - 1 - (pos - TC));
                    odir[((size_t)dir * R + b * S + tt) * 1024 + hd * DV + vsl * 128 + vloc] = part; }
            }
        }
    }
}

template <int DQ, int HKV>
DEV void attn_naive_phase(const Args& a, float scale, int colbase, bool latent_only, char* smem) {
    const int tid = tid_opaque(), w = tid >> 6, lane = tid & 63;
    float* qsh = (float*)smem + w * DQ;
    const bf16_t* Qb = (const bf16_t*)(a.ws + WS_QB); const bf16_t* Kb = (const bf16_t*)(a.ws + WS_KB); const bf16_t* Vb = (const bf16_t*)(a.ws + WS_VB);
    bf16_t* A2 = (bf16_t*)(a.ws + WS_A2);
    const int total = NB * 8 * S;
    for (int it = blockIdx.x * 8 + w; it < total; it += gridDim.x * 8) {
        const int t = it % S, hh = (it / S) & 7, b = it / (S * 8);
        if (latent_only && t < TC) continue;
        const int hk = hh / (8 / HKV), nk = t < TC ? TC : S;
        const bf16_t* q = Qb + (((size_t)b * 8 + hh) * S + t) * DQ;
#pragma unroll
        for (int j = 0; j < DQ / 64; ++j) qsh[j * 64 + lane] = bf2f(q[j * 64 + lane]);
        const bf16_t* Kp = Kb + ((size_t)b * HKV + hk) * S * DQ; const bf16_t* Vp = Vb + ((size_t)b * HKV + hk) * S * 128;
        float m = -1e30f, l = 0.f, o0 = 0.f, o1 = 0.f;
        for (int k0 = 0; k0 < nk; k0 += 64) {
            const bf16_t* kr = Kp + (size_t)(k0 + lane) * DQ; float s_ = 0.f;
#pragma unroll 4
            for (int d8 = 0; d8 < DQ / 8; ++d8) { const u32x4 kv = *(const u32x4*)(kr + d8 * 8); const f32x4 qa = *(const f32x4*)(qsh + d8 * 8), qb = *(const f32x4*)(qsh + d8 * 8 + 4);
                s_ += qa[0] * __uint_as_float(kv.x << 16) + qa[1] * __uint_as_float(kv.x & 0xffff0000u) + qa[2] * __uint_as_float(kv.y << 16) + qa[3] * __uint_as_float(kv.y & 0xffff0000u)
                    + qb[0] * __uint_as_float(kv.z << 16) + qb[1] * __uint_as_float(kv.z & 0xffff0000u) + qb[2] * __uint_as_float(kv.w << 16) + qb[3] * __uint_as_float(kv.w & 0xffff0000u); }
            s_ *= scale;
            const float mn = fmaxf(m, wave_max(s_)); const float al = __expf(m - mn); const float p = __expf(s_ - mn);
            l = l * al + wave_sum(p); o0 *= al; o1 *= al; m = mn;
#pragma unroll 4
            for (int j = 0; j < 64; ++j) { const float pj = __shfl(p, j); const bf16_t* vr = Vp + (size_t)(k0 + j) * 128;
                o0 += pj * bf2f(vr[lane]); o1 += pj * bf2f(vr[64 + lane]); }
        }
        const float inv = 1.f / l; const int r = b * S + t;
        A2[(size_t)r * D + colbase + hh * 128 + lane] = f2bf(o0 * inv); A2[(size_t)r * D + colbase + hh * 128 + 64 + lane] = f2bf(o1 * inv);
    }
}

template <int MODE>
DEV void mixout_phase(const Args& a, bool latent_only) {
    const int tid = tid_opaque(), w = tid >> 6, lane = tid & 63;
    constexpr int NH = MODE == 0 ? 8 : 4, DV = MODE == 0 ? 128 : 256, LDP = MODE == 0 ? AB_INP : CD_INP, GC = MODE == 0 ? 4096 : 3584, CB = MODE == 0 ? 0 : 1024, PER = DV / 64;
    const float* P = (const float*)(a.ws + WS_P); const float* odir = (const float*)(a.ws + WS_ODIR); bf16_t* A2 = (bf16_t*)(a.ws + WS_A2);
    const float* g = MODE == 0 ? a.in[12] : a.in[23];
    for (int it = blockIdx.x * 8 + w; it < R * NH; it += gridDim.x * 8) {
        const int r = it / NH, hd = it - r * NH; const int t = r % S; if (latent_only && t < TC) continue;
        float o[PER]; float ss = 0.f;
#pragma unroll
        for (int j = 0; j < PER; ++j) { const int c = hd * DV + j * 64 + lane; o[j] = odir[(size_t)r * 1024 + c] + odir[((size_t)R + r) * 1024 + c]; ss += o[j] * o[j]; }
        ss = wave_sum(ss); const float rs = rsqrtf(ss * (1.f / DV) + EPS);
#pragma unroll
        for (int j = 0; j < PER; ++j) { const int c = hd * DV + j * 64 + lane; const float gt = P[(size_t)r * LDP + GC + c];
            const float act = MODE == 0 ? sigmoidf_(gt) : siluf_(gt);
            A2[(size_t)r * D + CB + c] = f2bf(o[j] * rs * g[j * 64 + lane] * act); }
    }
}

DEV void moe_phase_up(const Args& a, int l, char* smem) {
    const unsigned* cnt = (const unsigned*)(a.ws + WS_CTL) + CW_CNT + l * 16;
    const int* list = (const int*)(a.ws + WS_LIST);
    const bf16_t* h = (const bf16_t*)(a.ws + WS_H); const bf16_t* w13 = (const bf16_t*)(a.ws + WS_W13); bf16_t* hid = (bf16_t*)(a.ws + WS_QB);
    int u = blockIdx.x, base = 0, off = 0;
    for (int e = 0; e < NE; ++e) { const int n = (int)cnt[e], nt_ = (n + 255) >> 8, nu = nt_ * 4;
        for (; u < base + nu; u += gridDim.x) { const int t = u - base, i = t % nt_, pn = t / nt_; const int nv = min(256, n - i * 256);
            EpiMoeUp epi{hid, off + i * 256, nv};
            gemm_tile<true>(h, w13 + (size_t)e * 1024 * D, D, D, 0, pn * 256, list + (size_t)e * R + i * 256, nv, smem, epi); }
        base += nu; off += n; }
}
DEV void moe_phase_down(const Args& a, int l, char* smem) {
    const unsigned* cnt = (const unsigned*)(a.ws + WS_CTL) + CW_CNT + l * 16;
    const int* list = (const int*)(a.ws + WS_LIST);
    const bf16_t* hid = (const bf16_t*)(a.ws + WS_QB); const bf16_t* w2 = (const bf16_t*)(a.ws + WS_W2); float* y = (float*)(a.ws + WS_P);
    int u = blockIdx.x, base = 0, off = 0;
    for (int e = 0; e < NE; ++e) { const int n = (int)cnt[e], nt_ = (n + 255) >> 8, nu = nt_ * 8;
        for (; u < base + nu; u += gridDim.x) { const int t = u - base, i = t % nt_, pn = t / nt_; const int nv = min(256, n - i * 256);
            EpiMoeDown epi{y, list + (size_t)e * R + i * 256, nv};
            gemm_tile<false>(hid, w2 + (size_t)e * D * EDIM, EDIM, EDIM, off + i * 256, pn * 256, nullptr, 0, smem, epi); }
        base += nu; off += n; }
}
template <bool FINAL>
DEV void combine_phase(const Args& a, int l, bool latent_only) {
    const int tid = tid_opaque(), w = tid >> 6, lane = tid & 63;
    float* xres = (float*)(a.ws + WS_XRES); const float* y = (const float*)(a.ws + WS_P); const int* tok = (const int*)(a.ws + WS_TOK);
    const float* modv = (const float*)(a.ws + WS_MODV) + (size_t)l * 5 * MODN;
    for (int r = blockIdx.x * 8 + w; r < R; r += gridDim.x * 8) {
        const int b = r / S, t = r - b * S; if (latent_only && t < TC) continue;
        const int v = t < TC ? 4 : b; const float w0 = ((const float*)tok)[r * 4 + 2], w1 = ((const float*)tok)[r * 4 + 3];
        const float* g2 = modv + (size_t)v * MODN + 5 * D; float* xp = xres + (size_t)r * D; const float* y0 = y + (size_t)(2 * r) * D; const float* y1 = y0 + D;
        f32x4 x[8]; float ss = 0.f;
#pragma unroll
        for (int j = 0; j < 8; ++j) { const int c = j * 256 + lane * 4;
            x[j] = *(const f32x4*)(xp + c) + *(const f32x4*)(g2 + c) * (w0 * *(const f32x4*)(y0 + c) + w1 * *(const f32x4*)(y1 + c));
            if (!FINAL) *(f32x4*)(xp + c) = x[j];
            ss += x[j][0] * x[j][0] + x[j][1] * x[j][1] + x[j][2] * x[j][2] + x[j][3] * x[j][3]; }
        if (FINAL) { ss = wave_sum(ss); const float rs = rsqrtf(ss * (1.f / D) + EPS); float* op = a.out + ((size_t)b * TL + (t - TC)) * D;
#pragma unroll
            for (int j = 0; j < 8; ++j) { const int c = j * 256 + lane * 4; *(f32x4*)(op + c) = x[j] * rs * *(const f32x4*)(a.in[8] + c); } }
    }
}

constexpr int LDS_BYTES = SHM_GEMM + 1024;
constexpr int NPHASES = 25;
__global__ void __launch_bounds__(NT, 2) fwd(Args a) {
    extern __shared__ __attribute__((aligned(16))) char smem[];
    unsigned char* ws = a.ws;
    const int lo = a.ph_lo, hi = a.ph_hi;
#ifndef PHASE_MASK
#define PHASE_MASK 0xFFFFFFFFu
#endif
#define IN(k) (((PHASE_MASK >> (k)) & 1u) && lo <= (k) && (k) < hi)
    const float* modv = (const float*)(ws + WS_MODV);
    bf16_t* H = (bf16_t*)(ws + WS_H); float* P = (float*)(ws + WS_P); bf16_t* A2 = (bf16_t*)(ws + WS_A2); float* XR = (float*)(ws + WS_XRES);
    if (IN(0)) {
        cvt_weight(a.in[9], (bf16_t*)(ws + WS_WABIN), D, AB_IN, AB_INP, 1, 0, 0, 128, 0, nullptr, smem);
        cvt_weight(a.in[10], (bf16_t*)(ws + WS_WABOUT), D, D, D, 1, 0, 0, 128, 0, nullptr, smem);
        cvt_weight(a.in[14], (bf16_t*)(ws + WS_WUQ), 512, 1536, 1536, 1, 0, 0, 128, 0, a.in[13], smem);
        cvt_weight(a.in[16], (bf16_t*)(ws + WS_WUKV), 256, 2048, 2048, 1, 0, 0, 128, 0, a.in[15], smem);
        cvt_weight(a.in[17], (bf16_t*)(ws + WS_WCDIN), D, CD_IN, CD_INP, 1, 0, 0, 128, 0, nullptr, smem);
        cvt_weight(a.in[18], (bf16_t*)(ws + WS_WCDOUT), D, D, D, 1, 0, 0, 128, 0, nullptr, smem);
        cvt_moe_layer(a, 0, smem);
        mod_phase(a, smem);
        misc_phase(a);
    }
    if (IN(1)) norm_phase<false>(a, 0, 0, a.in[6], false, smem);
    if (IN(2)) { int cur = 0; EpiStoreF32 e{P, AB_INP}; gemm_phase(H, (const bf16_t*)(ws + WS_WABIN), R, AB_INP, D, smem, e, cur); }
    if (IN(3)) prep_ab_phase(a);
    if (IN(4)) { int cur = 0; EpiStoreF32 e1{(float*)(ws + WS_A2), 1536}; gemm_phase((const bf16_t*)(ws + WS_P5N), (const bf16_t*)(ws + WS_WUQ), R, 1536, 512, smem, e1, cur);
                 EpiStoreF32 e2{(float*)(ws + WS_ODIR), 2048}; gemm_phase((const bf16_t*)(ws + WS_P6N), (const bf16_t*)(ws + WS_WUKV), R, 2048, 256, smem, e2, cur); }
    if (IN(5)) assemble_ab_phase(a);
    if (IN(6)) scan_naive_phase<0>(a, smem);
    if (IN(7)) attn_naive_phase<192, 8>(a, 0.07216878364870322f, 1024, false, smem);
    if (IN(8)) mixout_phase<0>(a, false);
    if (IN(9)) { int cur = 0; EpiResidGate e{XR, modv + 2 * D}; gemm_phase(A2, (const bf16_t*)(ws + WS_WABOUT), R, D, D, smem, e, cur); }
    if (IN(10)) norm_phase<true>(a, 0, 3, a.in[7], false, smem);
    if (IN(11)) moe_phase_up(a, 0, smem);
    if (IN(12)) moe_phase_down(a, 0, smem);
    if (IN(13)) { combine_phase<false>(a, 0, false); cvt_moe_layer(a, 1, smem); }
    if (IN(14)) norm_phase<false>(a, 1, 0, a.in[6] + D, false, smem);
    if (IN(15)) { int cur = 0; EpiStoreF32 e{P, CD_INP}; gemm_phase(H, (const bf16_t*)(ws + WS_WCDIN), R, CD_INP, D, smem, e, cur); }
    if (IN(16)) prep_cd_phase(a, smem);
    if (IN(17)) scan_naive_phase<1>(a, smem);
    if (IN(18)) attn_naive_phase<128, 2>(a, 0.08838834764831845f, 0, true, smem);
    if (IN(19)) mixout_phase<1>(a, true);
    if (IN(20)) { int cur = 0; EpiResidGate e{XR, modv + 5 * MODN + 2 * D}; gemm_phase(A2, (const bf16_t*)(ws + WS_WCDOUT), R, D, D, smem, e, cur); }
    if (IN(21)) norm_phase<true>(a, 1, 3, a.in[7] + D, true, smem);
    if (IN(22)) moe_phase_up(a, 1, smem);
    if (IN(23)) moe_phase_down(a, 1, smem);
    if (IN(24)) combine_phase<true>(a, 1, true);
#undef IN
}

extern "C" void kernel_launch(void* const* d_in, const int* in_sizes, int n_in, void* d_out, int out_size, void* d_ws, size_t ws_size, hipStream_t stream) {
    static int grid = 0;
    if (grid == 0) {
        if (n_in != 29 || out_size != NB * TL * D || ws_size < WS_END) { fprintf(stderr, "kernel_launch: shape/workspace mismatch: n_in %d out %d ws %zu (need %zu)\n", n_in, out_size, ws_size, (size_t)WS_END); grid = -1; return; }
        int dev = 0, cus = 0;
        if (hipGetDevice(&dev) != hipSuccess || hipDeviceGetAttribute(&cus, hipDeviceAttributeMultiprocessorCount, dev) != hipSuccess) { grid = -1; return; }
        if (hipFuncSetAttribute((const void*)fwd, hipFuncAttributeMaxDynamicSharedMemorySize, LDS_BYTES) != hipSuccess) { fprintf(stderr, "kernel_launch: hipFuncSetAttribute failed\n"); grid = -1; return; }
        grid = cus > 0 ? cus : 256;
    }
    if (grid < 0) return;
    (void)hipMemsetAsync((char*)d_ws + WS_CTL, 0, CTL_BYTES, stream);
    Args a{};
    for (int i = 0; i < 29; ++i) a.in[i] = (const float*)d_in[i];
    a.out = (float*)d_out; a.ws = (unsigned char*)d_ws;
    for (int ph = 0; ph < NPHASES; ++ph) { a.ph_lo = ph; a.ph_hi = ph + 1; hipLaunchKernelGGL(fwd, dim3(grid), dim3(NT), LDS_BYTES, stream, a); }
}
```

```cpp
#include <hip/hip_runtime.h>
#include <cstdio>
#include <cstdint>

#define DEV __device__ __forceinline__
typedef unsigned short bf16_t;
typedef short bf16x8 __attribute__((ext_vector_type(8)));
typedef float f32x4 __attribute__((ext_vector_type(4)));
typedef unsigned u32x4 __attribute__((ext_vector_type(4)));
typedef unsigned u32x2 __attribute__((ext_vector_type(2)));

constexpr int NB = 4, TL = 2048, TC = 256, S = TL + TC, R = NB * S, D = 2048;
constexpr int NT = 512;
constexpr float EPS = 1e-6f;
constexpr int AB_IN = 5952, AB_INP = 6144, CD_IN = 4640, CD_INP = 4864;
constexpr int NE = 16, EDIM = 512;
constexpr int MODN = 6 * D;

constexpr size_t al256(size_t x) { return (x + 255) & ~(size_t)255; }
constexpr size_t WS_CTL = 0;
constexpr int    CW_CNT = 4096;
constexpr int    CW_CVT = 4224;
constexpr size_t CTL_BYTES = 131072;
constexpr int    CW_MOEQ = 4608;
constexpr int    CW_RDY = 8192;
constexpr size_t WS_MODV = WS_CTL + CTL_BYTES;
constexpr size_t WS_LB   = al256(WS_MODV + (size_t)2 * 5 * MODN * 4);
constexpr size_t WS_TABB = al256(WS_LB + 2 * 1024 * 4);
constexpr size_t WS_TABC = al256(WS_TABB + (size_t)TL * 32 * 8);
constexpr size_t WS_TOK  = al256(WS_TABC + (size_t)TL * 64 * 8);
constexpr size_t WS_LIST = al256(WS_TOK + (size_t)R * 16);
constexpr size_t WS_WABIN = al256(WS_LIST + (size_t)NE * R * 4);
constexpr size_t WS_WABOUT = al256(WS_WABIN + (size_t)AB_INP * D * 2);
constexpr size_t WS_WUQ  = al256(WS_WABOUT + (size_t)D * D * 2);
constexpr size_t WS_WUKV = al256(WS_WUQ + (size_t)1536 * 512 * 2);
constexpr size_t WS_WCDIN = al256(WS_WUKV + (size_t)2048 * 256 * 2);
constexpr size_t WS_WCDOUT = al256(WS_WCDIN + (size_t)CD_INP * D * 2);
constexpr size_t WS_W13  = al256(WS_WCDOUT + (size_t)D * D * 2);
constexpr size_t WS_W2   = al256(WS_W13 + (size_t)NE * 1024 * D * 2);
constexpr size_t WS_XRES = al256(WS_W2 + (size_t)NE * D * EDIM * 2);
constexpr size_t WS_H    = al256(WS_XRES + (size_t)R * D * 2);
constexpr size_t WS_P    = al256(WS_H + (size_t)R * D * 2);
constexpr size_t WS_ODIR = al256(WS_P + (size_t)R * AB_INP * 2);
constexpr size_t WS_QF   = WS_ODIR;
constexpr size_t WS_KVF  = al256(WS_QF + (size_t)R * 1536 * 2);
static_assert(WS_KVF + (size_t)R * 2048 * 2 <= WS_ODIR + (size_t)2 * R * 1024 * 4, "QF/KVF alias ODIR");
constexpr size_t WS_A2   = al256(WS_ODIR + (size_t)2 * R * 1024 * 4);
constexpr size_t WS_QB   = al256(WS_A2 + (size_t)R * D * 2);
constexpr size_t WS_KB   = al256(WS_QB + (size_t)NB * 8 * S * 192 * 2);
constexpr size_t WS_VB   = al256(WS_KB + (size_t)NB * 8 * S * 192 * 2);
constexpr size_t WS_SSQ  = al256(WS_VB + (size_t)NB * 8 * S * 128 * 2);
constexpr size_t WS_P5N_UNUSED = al256(WS_VB + (size_t)NB * 8 * S * 128 * 2);
constexpr size_t WS_P6N  = al256(WS_SSQ + (size_t)R * 16);
constexpr size_t WS_SVT  = WS_P6N;
constexpr size_t WS_SREC = al256(WS_SVT + (size_t)NB * 8 * 2 * 36 * 128 * 144);
constexpr int PA = 144, PQ = 272;
constexpr int REC_A = 0, REC_QH = 64 * PA, REC_KHT = REC_QH + 64 * PQ, REC_AL = REC_KHT + 128 * PA, REC_BYTES = REC_AL + 512;
constexpr size_t WS_END  = al256(WS_SREC + (size_t)NB * 8 * 2 * 36 * REC_BYTES);
constexpr size_t WS_SVT1 = WS_W13;
constexpr size_t WS_SREC1 = al256(WS_SVT1 + (size_t)NB * 4 * 2 * 36 * 256 * 144);
static_assert(WS_SREC1 + (size_t)NB * 4 * 2 * 36 * REC_BYTES <= WS_XRES, "layer-1 scan images alias");
static_assert(WS_SVT + (size_t)NE * 1024 * D * 2 + (size_t)NE * D * EDIM * 2 <= WS_END, "layer-1 MoE weights alias");
static_assert((size_t)(2 * R + 256) * 512 * 2 <= WS_KB - WS_QB, "HIDDEN alias");
static_assert((size_t)R * 2 * D * 2 <= WS_ODIR - WS_P, "YSLOTS alias");

struct Args { const float* in[29]; float* out; unsigned char* ws; int ph_lo, ph_hi; };

typedef __bf16 bf16v2_t __attribute__((ext_vector_type(2)));
DEV unsigned cvtpk(float lo, float hi) { bf16v2_t v; v.x = (__bf16)lo; v.y = (__bf16)hi; return __builtin_bit_cast(unsigned, v); }
DEV bf16_t f2bf(float x) { return (bf16_t)(cvtpk(x, 0.f) & 0xffffu); }
DEV float bf2f(bf16_t x) { return __uint_as_float(((unsigned)x) << 16); }
DEV float bflo(unsigned w) { return __uint_as_float(w << 16); }
DEV float bfhi(unsigned w) { return __uint_as_float(w & 0xffff0000u); }
DEV float sigmoidf_(float x) { return 1.f / (1.f + __expf(-x)); }
DEV float siluf_(float x) { return x / (1.f + __expf(-x)); }
DEV float wave_sum(float v) {
#pragma unroll
    for (int o = 32; o >= 1; o >>= 1) v += __shfl_xor(v, o);
    return v;
}
DEV float wave_max(float v) {
#pragma unroll
    for (int o = 32; o >= 1; o >>= 1) v = fmaxf(v, __shfl_xor(v, o));
    return v;
}
DEV int tid_opaque() { int t = threadIdx.x; asm volatile("" : "+v"(t)); return t; }
DEV int modvec_of_row(int r) { const int b = r / S, t = r - b * S; return t < TC ? 4 : b; }

#define XB_TMO      128
#define XB_XCNT(j)  (256  + 64 * (j))
#define XB_XSUB(j)  (1280 + 64 * (j))
#define XB_XGEN(j)  (2304 + 64 * (j))
#define XB_TOP      3328
#define XB_TOPGEN   3392
#define XCD_BAR_WORDS 3456
#define XB_SPIN_CAP (1u << 18)
#define LAS __attribute__((address_space(3)))

__device__ __forceinline__ unsigned xb_ld(unsigned* p)              { return __hip_atomic_load(p, __ATOMIC_RELAXED, __HIP_MEMORY_SCOPE_AGENT); }
__device__ __forceinline__ unsigned xb_add(unsigned* p, unsigned v) { return __hip_atomic_fetch_add(p, v, __ATOMIC_RELAXED, __HIP_MEMORY_SCOPE_AGENT); }
__device__ __forceinline__ unsigned xb_xcc_id() { return (unsigned)__builtin_amdgcn_s_getreg((3 << 11) | 20) & 0xFu; }
#define XB_SPIN(cond, bar) do { unsigned _sp = 0; while (cond) { __builtin_amdgcn_s_sleep(1); \
    if ((++_sp & 255u) == 0u) { if (xb_ld(&(bar)[XB_TMO])) break; if (_sp > XB_SPIN_CAP) { atomicAdd(&(bar)[XB_TMO], 1u); break; } } } } while (0)

struct XcdBarrier {
    unsigned* bar; unsigned x;
    volatile LAS unsigned* st;
};

__device__ __forceinline__ XcdBarrier xcd_barrier_post(unsigned* bar, volatile LAS unsigned* st) {
    XcdBarrier b; b.bar = bar; b.x = xb_xcc_id(); b.st = st;
    if (threadIdx.x == 0) (void)xb_add(&bar[XB_XCNT(b.x)], 1u);
    return b;
}
__device__ __forceinline__ void xcd_barrier_complete(unsigned* bar, unsigned x, unsigned& nloc, unsigned& nx) {
    const unsigned G = gridDim.x * gridDim.y * gridDim.z;
    unsigned sum, cnt, mine, sp = 0u;
    for (;;) {
        sum = 0u; cnt = 0u; mine = 0u;
#pragma unroll
        for (unsigned j = 0; j < 16; ++j) { const unsigned c = xb_ld(&bar[XB_XCNT(j)]); sum += c; cnt += (c > 0u) ? 1u : 0u; mine = (j == x) ? c : mine; }
        if (sum == G) break;
        __builtin_amdgcn_s_sleep(1);
        if ((++sp & 255u) == 0u) { if (xb_ld(&bar[XB_TMO])) break; if (sp > XB_SPIN_CAP) { atomicAdd(&bar[XB_TMO], 1u); break; } }
    }
    nloc = mine > 0u ? mine : 1u; nx = cnt > 0u ? cnt : 1u;
}

__device__ __forceinline__ void xcd_barrier(const XcdBarrier& b) {
    asm volatile("s_waitcnt vmcnt(0)" ::: "memory");
    __syncthreads();
    if (threadIdx.x == 0) {
        unsigned* bar = b.bar;
        __builtin_amdgcn_s_waitcnt(0);
        unsigned nloc = b.st[0], nx = b.st[1];
        if (nloc == 0u) { xcd_barrier_complete(bar, b.x, nloc, nx); b.st[0] = nloc; b.st[1] = nx; }
        const unsigned old = xb_add(&bar[XB_XSUB(b.x)], 1u);
        const unsigned gen = old / nloc;
        if (old + 1u == (gen + 1u) * nloc) {
            __builtin_amdgcn_fence(__ATOMIC_RELEASE, "agent");
            asm volatile("s_waitcnt vmcnt(0)" ::: "memory");
            const unsigned og = xb_add(&bar[XB_TOP], 1u);
            const unsigned tg = og / nx;
            if (og + 1u == (tg + 1u) * nx) xb_add(&bar[XB_TOPGEN], 1u);
            else XB_SPIN(xb_ld(&bar[XB_TOPGEN]) == tg, bar);
            __builtin_amdgcn_fence(__ATOMIC_ACQUIRE, "agent");
            xb_add(&bar[XB_XGEN(b.x)], 1u);
            asm volatile("s_waitcnt vmcnt(0)" ::: "memory");
        } else {
            XB_SPIN(xb_ld(&bar[XB_XGEN(b.x)]) == gen, bar);
            __builtin_amdgcn_fence(__ATOMIC_ACQUIRE, "agent");
            asm volatile("s_waitcnt vmcnt(0)" ::: "memory");
        }
    }
    __syncthreads();
}


constexpr int BM = 256, BK = 64, HALF = 128, HT = HALF * BK, SHM_GEMM = 8 * HT * 2;
DEV int lds_byte(int r, int c) { int st = (r >> 4) * 2 + (c >> 5), rr = r & 15, cc = c & 31, ob = rr * 64 + cc * 2; return st * 1024 + (ob ^ (((ob >> 9) & 1) << 5)); }
DEV void stage_rc(int b, int& Rr, int& Cc) { int st = b / 1024, sb = b % 1024, swz = sb ^ (((sb >> 9) & 1) << 5); Rr = (st >> 1) * 16 + swz / 64; Cc = (st & 1) * 32 + (swz % 64) / 2; }

template <bool GATHER, int LDA_ = 0, class Epi>
DEV void gemm_tile(const bf16_t* __restrict__ A, const bf16_t* __restrict__ Bt, int ld, int K, int brow, int bcol,
                   const int* __restrict__ rowmap, int nvalid, char* smem, const Epi& epi) {
    bf16_t* shm = (bf16_t*)smem;
#define SA(b, h) (shm + ((b) * 2 + (h)) * HT)
#define SB(b, h) (shm + (4 + (b) * 2 + (h)) * HT)
#define GLDS(gp, lp) __builtin_amdgcn_global_load_lds((const unsigned*)(gp), (unsigned*)(lp), 16, 0, 0)
#define STAGE_A(P, h, kt) do { _Pragma("unroll") for (int _i = 0; _i < 2; ++_i) { \
        const char* _sb = GATHER ? (const char*)A + (size_t)(kt) * (BK * 2) : (const char*)A + ((size_t)(brow + (h) * HALF + _i * 64) * (LDA_ ? LDA_ : ld) + (size_t)(kt) * BK) * 2; \
        GLDS(_sb + (GATHER ? voffa[h][_i] : voffA), (char*)(P) + tid16 + _i * 8192); } } while (0)
#define STAGE_B(P, h, kt) do { _Pragma("unroll") for (int _i = 0; _i < 2; ++_i) { \
        const char* _sb = (const char*)Bt + ((size_t)(bcol + (h) * HALF + _i * 64) * ld + (size_t)(kt) * BK) * 2; \
        GLDS(_sb + voff, (char*)(P) + tid16 + _i * 8192); } } while (0)
#define LDA(dst, b, h) _Pragma("unroll") for (int m = 0; m < 4; ++m) _Pragma("unroll") for (int k = 0; k < 2; ++k) \
        dst[m][k] = *reinterpret_cast<const bf16x8*>((char*)SA(b, h) + lds_byte(wr * 64 + m * 16 + fr, k * 32 + fq * 8))
#define LDB(dst, b, h) _Pragma("unroll") for (int n = 0; n < 2; ++n) _Pragma("unroll") for (int k = 0; k < 2; ++k) \
        dst[n][k] = *reinterpret_cast<const bf16x8*>((char*)SB(b, h) + lds_byte(wc * 32 + n * 16 + fr, k * 32 + fq * 8))
#define MMA(ai, bj, At_, Bt_) do { __builtin_amdgcn_s_setprio(1); \
        _Pragma("unroll") for (int m = 0; m < 4; ++m) _Pragma("unroll") for (int n = 0; n < 2; ++n) _Pragma("unroll") for (int k = 0; k < 2; ++k) \
            acc[ai][bj][m][n] = __builtin_amdgcn_mfma_f32_16x16x32_bf16(Bt_[n][k], At_[m][k], acc[ai][bj][m][n], 0, 0, 0); \
        __builtin_amdgcn_s_setprio(0); } while (0)
#define WAIT_V(n) asm volatile("s_waitcnt vmcnt(" #n ")" ::: "memory")
#define WAIT_L(n) asm volatile("s_waitcnt lgkmcnt(" #n ")" ::: "memory")
#define BAR __builtin_amdgcn_s_barrier()
#define SCHED __builtin_amdgcn_sched_barrier(0)
    int tid = threadIdx.x; asm volatile("" : "+v"(tid));
    int wid = tid >> 6, lane = tid & 63, wr = wid >> 2, wc = wid & 3, fr = lane & 15, fq = lane >> 4;
    const int tid16 = tid * 16;
    unsigned voff, voffA; unsigned voffa[2][2];
    {
        int r0, c0; stage_rc(tid16, r0, c0);
        voff = (unsigned)(r0 * ld + c0) * 2u; voffA = LDA_ ? (unsigned)(r0 * LDA_ + c0) * 2u : voff;
#pragma unroll
        for (int h = 0; h < 2; ++h)
#pragma unroll
            for (int i = 0; i < 2; ++i) {
                if (GATHER) { int l0 = h * HALF + i * 64 + r0; l0 = l0 < nvalid ? l0 : nvalid - 1; voffa[h][i] = (unsigned)((rowmap[l0] >> 1) * ld + c0) * 2u; }
                else voffa[h][i] = 0u;
            }
    }
    f32x4 acc[2][2][4][2] = {};
    bf16x8 At[4][2], B0[2][2], B1[2][2];
    const int nt = K / BK;
    STAGE_B(SB(0, 0), 0, 0); STAGE_A(SA(0, 0), 0, 0);
    STAGE_B(SB(0, 1), 1, 0); STAGE_A(SA(0, 1), 1, 0);
    if (wr == 1) BAR;
    WAIT_V(4); BAR;
    STAGE_B(SB(1, 0), 0, 1); STAGE_A(SA(1, 0), 0, 1); STAGE_B(SB(1, 1), 1, 1);
    WAIT_V(6); BAR;
    for (int t = 0; t < nt - 2; t += 2) {
        LDB(B0, 0, 0); SCHED; LDA(At, 0, 0); STAGE_A(SA(1, 1), 1, t + 1);
        WAIT_L(8); BAR; WAIT_L(0); MMA(0, 0, At, B0); BAR; SCHED;
        LDB(B1, 0, 1); STAGE_B(SB(0, 0), 0, t + 2);
        BAR; WAIT_L(0); MMA(0, 1, At, B1); BAR;
        LDA(At, 0, 1); STAGE_A(SA(0, 0), 0, t + 2);
        BAR; WAIT_L(0); MMA(1, 0, At, B0); BAR; SCHED;
        STAGE_B(SB(0, 1), 1, t + 2);
        WAIT_V(6); BAR; MMA(1, 1, At, B1); BAR;
        LDB(B0, 1, 0); SCHED; LDA(At, 1, 0); STAGE_A(SA(0, 1), 1, t + 2);
        WAIT_L(8); BAR; WAIT_L(0); MMA(0, 0, At, B0); BAR; SCHED;
        LDB(B1, 1, 1); STAGE_B(SB(1, 0), 0, t + 3);
        BAR; WAIT_L(0); MMA(0, 1, At, B1); BAR;
        LDA(At, 1, 1); STAGE_A(SA(1, 0), 0, t + 3);
        BAR; WAIT_L(0); MMA(1, 0, At, B0); BAR; SCHED;
        STAGE_B(SB(1, 1), 1, t + 3);
        WAIT_V(6); BAR; MMA(1, 1, At, B1); BAR;
    }
    { LDB(B0, 0, 0); WAIT_V(0); LDA(At, 0, 0); STAGE_A(SA(1, 1), 1, nt - 1);
      BAR; WAIT_L(0); MMA(0, 0, At, B0); BAR;
      LDB(B1, 0, 1); BAR; WAIT_L(0); MMA(0, 1, At, B1); BAR;
      LDA(At, 0, 1); WAIT_V(4); BAR; WAIT_L(0); MMA(1, 0, At, B0); MMA(1, 1, At, B1); BAR; }
    { LDB(B0, 1, 0); LDA(At, 1, 0); WAIT_V(2); BAR; WAIT_L(0); MMA(0, 0, At, B0); BAR;
      LDB(B1, 1, 1); WAIT_V(0); BAR; WAIT_L(0); MMA(0, 1, At, B1); BAR;
      LDA(At, 1, 1); BAR; WAIT_L(0); MMA(1, 0, At, B0); MMA(1, 1, At, B1); BAR; }
    if (wr == 0) BAR;
    int tz = threadIdx.x; asm volatile("" : "+v"(tz)); wid = tz >> 6; lane = tz & 63; wr = wid >> 2; wc = wid & 3; fr = lane & 15; fq = lane >> 4;
    epi(acc, brow, bcol, wr, wc, fr, fq);
#undef SA
#undef SB
#undef STAGE_A
#undef STAGE_B
#undef GLDS
#undef LDA
#undef LDB
#undef MMA
}

#define LAS3 __attribute__((address_space(3)))
template <bool LATENT = false, int LDA_ = 0, class Epi>
DEV void gemm_stream(const bf16_t* __restrict__ A, const bf16_t* __restrict__ Bt, int M, int N, int K, char* smem, const Epi& epi) {
    LAS3 unsigned char* lds = (LAS3 unsigned char*)smem;
    int tid = threadIdx.x; asm volatile("" : "+v"(tid));
    const int wid = __builtin_amdgcn_readfirstlane(tid >> 6), lane = tid & 63, wr = wid >> 2, wc = wid & 3, fr = lane & 15, fq = lane >> 4;
    const int nM = M / BM, nN = N / BM, ntile = nM * nN, G = gridDim.x, nt = K / BK, lda = LDA_ ? LDA_ : K;
    int t0 = blockIdx.x; if (t0 >= ntile) return;
    unsigned voffA[2], voffB[2];
#pragma unroll
    for (int i = 0; i < 2; ++i) { int Rr, Cc; stage_rc(tid * 16 + i * 8192, Rr, Cc); voffA[i] = (unsigned)(Rr * lda + Cc) * 2u; voffB[i] = (unsigned)(Rr * K + Cc) * 2u; }
    const size_t kstep = (size_t)(BK * 2), hstepA = (size_t)HALF * lda * 2, hstepB = (size_t)HALF * K * 2;
    const unsigned ldsw = (unsigned)wid * 1024u;
    const int aoff = lds_byte(wr * 64 + fr, fq * 8), boff = lds_byte(wc * 32 + fr, fq * 8);
    constexpr int HTB_ = HT * 2;
#define GS_SA(b, h) (((b) * 2 + (h)) * HTB_)
#define GS_SB(b, h) ((4 + (b) * 2 + (h)) * HTB_)
#define GS_STAGE(bufoff, gbase, voff) do { _Pragma("unroll") for (int _i = 0; _i < 2; ++_i) \
        __builtin_amdgcn_global_load_lds((const unsigned*)((const char*)(gbase) + (voff)[_i]), (LAS3 unsigned*)(lds + (bufoff) + ldsw + _i * 8192), 16, 0, 0); } while (0)
#define GS_LDA(dst, b, h) do { _Pragma("unroll") for (int m = 0; m < 4; ++m) _Pragma("unroll") for (int k = 0; k < 2; ++k) dst[m][k] = *(const LAS3 bf16x8*)(lds + GS_SA(b, h) + aoff + m * 2048 + k * 1024); } while (0)
#define GS_LDB(dst, b, h) do { _Pragma("unroll") for (int n = 0; n < 2; ++n) _Pragma("unroll") for (int k = 0; k < 2; ++k) dst[n][k] = *(const LAS3 bf16x8*)(lds + GS_SB(b, h) + boff + n * 2048 + k * 1024); } while (0)
#define GS_MMA(ai, bj, At_, Bt_) do { __builtin_amdgcn_s_setprio(1); _Pragma("unroll") for (int m = 0; m < 4; ++m) _Pragma("unroll") for (int n = 0; n < 2; ++n) _Pragma("unroll") for (int k = 0; k < 2; ++k) \
        acc[ai][bj][m][n] = __builtin_amdgcn_mfma_f32_16x16x32_bf16(Bt_[n][k], At_[m][k], acc[ai][bj][m][n], 0, 0, 0); __builtin_amdgcn_s_setprio(0); } while (0)
#define GS_ROW(tt) ((LATENT ? (((tt) % nM) >> 3) * 9 + 1 + (((tt) % nM) & 7) : ((tt) % nM)))
    f32x4 acc[2][2][4][2];
#pragma unroll
    for (int a_ = 0; a_ < 2; ++a_)
#pragma unroll
        for (int b_ = 0; b_ < 2; ++b_)
#pragma unroll
            for (int m = 0; m < 4; ++m)
#pragma unroll
                for (int n = 0; n < 2; ++n) acc[a_][b_][m][n] = (f32x4){0.f, 0.f, 0.f, 0.f};
    bf16x8 At[4][2], B0[2][2], B1[2][2];
    int tcur = t0;
    const char* cA = (const char*)A + (size_t)GS_ROW(tcur) * BM * lda * 2; const char* cB = (const char*)Bt + (size_t)(tcur / nM) * BM * K * 2;
    GS_STAGE(GS_SB(0, 0), cB, voffB); GS_STAGE(GS_SA(0, 0), cA, voffA); GS_STAGE(GS_SB(0, 1), cB + hstepB, voffB); GS_STAGE(GS_SA(0, 1), cA + hstepA, voffA);
    if (wr == 1) BAR;
    WAIT_V(4); BAR;
    GS_STAGE(GS_SB(1, 0), cB + kstep, voffB); GS_STAGE(GS_SA(1, 0), cA + kstep, voffA); GS_STAGE(GS_SB(1, 1), cB + hstepB + kstep, voffB);
    WAIT_V(6); BAR;
    for (;;) {
        const int tnxt = tcur + G; const bool has_next = tnxt < ntile;
        const char* nA = has_next ? (const char*)A + (size_t)GS_ROW(tnxt) * BM * lda * 2 : cA; const char* nB = has_next ? (const char*)Bt + (size_t)(tnxt / nM) * BM * K * 2 : cB;
        for (int t = 0; t < nt; t += 2) {
            const bool last = (t == nt - 2);
            const char* a1 = cA + (size_t)(t + 1) * kstep;
            const char* a2 = last ? nA : cA + (size_t)(t + 2) * kstep; const char* b2 = last ? nB : cB + (size_t)(t + 2) * kstep;
            const char* a3 = a2 + kstep; const char* b3 = b2 + kstep;
            GS_LDB(B0, 0, 0); SCHED; GS_LDA(At, 0, 0); GS_STAGE(GS_SA(1, 1), a1 + hstepA, voffA);
            WAIT_L(8); BAR; WAIT_L(0); GS_MMA(0, 0, At, B0); BAR; SCHED;
            GS_LDB(B1, 0, 1); GS_STAGE(GS_SB(0, 0), b2, voffB);
            BAR; WAIT_L(0); GS_MMA(0, 1, At, B1); BAR;
            GS_LDA(At, 0, 1); GS_STAGE(GS_SA(0, 0), a2, voffA);
            BAR; WAIT_L(0); GS_MMA(1, 0, At, B0); BAR; SCHED;
            GS_STAGE(GS_SB(0, 1), b2 + hstepB, voffB);
            WAIT_V(6); BAR; GS_MMA(1, 1, At, B1); BAR;
            GS_LDB(B0, 1, 0); SCHED; GS_LDA(At, 1, 0); GS_STAGE(GS_SA(0, 1), a2 + hstepA, voffA);
            WAIT_L(8); BAR; WAIT_L(0); GS_MMA(0, 0, At, B0); BAR; SCHED;
            GS_LDB(B1, 1, 1); GS_STAGE(GS_SB(1, 0), b3, voffB);
            BAR; WAIT_L(0); GS_MMA(0, 1, At, B1); BAR;
            GS_LDA(At, 1, 1); GS_STAGE(GS_SA(1, 0), a3, voffA);
            BAR; WAIT_L(0); GS_MMA(1, 0, At, B0); BAR; SCHED;
            GS_STAGE(GS_SB(1, 1), b3 + hstepB, voffB);
            WAIT_V(6); BAR; GS_MMA(1, 1, At, B1); BAR;
        }
        epi(acc, GS_ROW(tcur) * BM, (tcur / nM) * BM, wr, wc, fr, fq);
        if (!has_next) break;
#pragma unroll
        for (int a_ = 0; a_ < 2; ++a_)
#pragma unroll
            for (int b_ = 0; b_ < 2; ++b_)
#pragma unroll
                for (int m = 0; m < 4; ++m)
#pragma unroll
                    for (int n = 0; n < 2; ++n) acc[a_][b_][m][n] = (f32x4){0.f, 0.f, 0.f, 0.f};
        tcur = tnxt; cA = nA; cB = nB;
    }
    WAIT_V(0);
    if (wr == 0) BAR;
    BAR;
#undef GS_SA
#undef GS_SB
#undef GS_STAGE
#undef GS_LDA
#undef GS_LDB
#undef GS_MMA
#undef GS_ROW
}

struct EpiStoreF32 { float* C; int ldc;
    DEV void operator()(const f32x4 (&acc)[2][2][4][2], int brow, int bcol, int wr, int wc, int fr, int fq) const {
#pragma unroll
        for (int ai = 0; ai < 2; ++ai)
#pragma unroll
            for (int m = 0; m < 4; ++m) { float* rowp = C + (size_t)(brow + ai * HALF + wr * 64 + m * 16 + fr) * ldc + bcol + wc * 32 + fq * 4;
#pragma unroll
                for (int bj = 0; bj < 2; ++bj)
#pragma unroll
                    for (int n = 0; n < 2; ++n) *(f32x4*)(rowp + bj * HALF + n * 16) = acc[ai][bj][m][n]; }
    } };
struct EpiStoreBf16 { bf16_t* C; int ldc;
    DEV void operator()(const f32x4 (&acc)[2][2][4][2], int brow, int bcol, int wr, int wc, int fr, int fq) const {
#pragma unroll
        for (int ai = 0; ai < 2; ++ai)
#pragma unroll
            for (int m = 0; m < 4; ++m) { bf16_t* rowp = C + (size_t)(brow + ai * HALF + wr * 64 + m * 16 + fr) * ldc + bcol + wc * 32 + fq * 4;
#pragma unroll
                for (int bj = 0; bj < 2; ++bj)
#pragma unroll
                    for (int n = 0; n < 2; ++n) { const f32x4 v = acc[ai][bj][m][n]; u32x2 w; w.x = cvtpk(v[0], v[1]); w.y = cvtpk(v[2], v[3]); *(u32x2*)(rowp + bj * HALF + n * 16) = w; } }
    } };
struct EpiResidGate { bf16_t* X; const float* gate; bool dry; const float* xin; const float* cin;
    DEV void operator()(const f32x4 (&acc)[2][2][4][2], int brow, int bcol, int wr, int wc, int fr, int fq) const {
        const float* g = gate + (size_t)modvec_of_row(brow) * MODN + bcol + wc * 32 + fq * 4;
        f32x4 gv[2][2];
#pragma unroll
        for (int bj = 0; bj < 2; ++bj)
#pragma unroll
            for (int n = 0; n < 2; ++n) gv[bj][n] = *(const f32x4*)(g + bj * HALF + n * 16);
#pragma unroll
        for (int ai = 0; ai < 2; ++ai)
#pragma unroll
            for (int m = 0; m < 4; ++m) { const int lrow = ai * HALF + wr * 64 + m * 16 + fr; bf16_t* rowp = X + (size_t)(brow + lrow) * D + bcol + wc * 32 + fq * 4;
                const float* srcp = nullptr;
                if (xin) { const int b = brow / S, t0 = brow - b * S; srcp = (t0 < TC ? cin + ((size_t)b * TC + t0 + lrow) * D : xin + ((size_t)b * TL + (t0 - TC) + lrow) * D) + bcol + wc * 32 + fq * 4; }
#pragma unroll
                for (int bj = 0; bj < 2; ++bj)
#pragma unroll
                    for (int n = 0; n < 2; ++n) { f32x4 x;
                        if (xin) x = *(const f32x4*)(srcp + bj * HALF + n * 16); else { const u32x2 p = *(const u32x2*)(rowp + bj * HALF + n * 16); x = (f32x4){bflo(p.x), bfhi(p.x), bflo(p.y), bfhi(p.y)}; }
                        if (!dry) x += gv[bj][n] * acc[ai][bj][m][n];
                        u32x2 w; w.x = cvtpk(x[0], x[1]); w.y = cvtpk(x[2], x[3]); *(u32x2*)(rowp + bj * HALF + n * 16) = w; }
                if (m == 3) asm volatile("" ::: "memory"); }
    } };
struct EpiMoeUp { bf16_t* hid; int rowbase, nvalid;
    DEV void operator()(const f32x4 (&acc)[2][2][4][2], int brow, int bcol, int wr, int wc, int fr, int fq) const {
        const int hc = (bcol >> 1) + wc * 32 + fq * 4;
#pragma unroll
        for (int ai = 0; ai < 2; ++ai)
#pragma unroll
            for (int m = 0; m < 4; ++m) { const int lr = ai * HALF + wr * 64 + m * 16 + fr;
                if (lr < nvalid) { bf16_t* rowp = hid + (size_t)(rowbase + lr) * EDIM + hc;
#pragma unroll
                    for (int n = 0; n < 2; ++n) { const f32x4 a = acc[ai][0][m][n], b = acc[ai][1][m][n];
                        u32x2 w; w.x = cvtpk(siluf_(a[0]) * b[0], siluf_(a[1]) * b[1]); w.y = cvtpk(siluf_(a[2]) * b[2], siluf_(a[3]) * b[3]);
                        *(u32x2*)(rowp + n * 16) = w; } } }
    } };
struct EpiMoeDown { bf16_t* y; const int* list; int nvalid;
    DEV void operator()(const f32x4 (&acc)[2][2][4][2], int brow, int bcol, int wr, int wc, int fr, int fq) const {
#pragma unroll
        for (int ai = 0; ai < 2; ++ai)
#pragma unroll
            for (int m = 0; m < 4; ++m) { const int lr = ai * HALF + wr * 64 + m * 16 + fr;
                if (lr < nvalid) { bf16_t* rowp = y + (size_t)list[lr] * D + bcol + wc * 32 + fq * 4;
#pragma unroll
                    for (int bj = 0; bj < 2; ++bj)
#pragma unroll
                        for (int n = 0; n < 2; ++n) { const f32x4 v = acc[ai][bj][m][n]; u32x2 w; w.x = cvtpk(v[0], v[1]); w.y = cvtpk(v[2], v[3]); *(u32x2*)(rowp + bj * HALF + n * 16) = w; } } }
    } };

DEV void row_bt(int r, int& b, int& t) { b = r / S; t = r - b * S; }
struct EpiInAB { bf16_t* P; float* ssq; bf16_t* Kb; const float2* tb; char* smem;
    DEV void operator()(const f32x4 (&acc)[2][2][4][2], int brow, int bcol, int wr, int wc, int fr, int fq) const {
        const int pn = bcol >> 8;
        if (pn < 23) {
#pragma unroll
            for (int ai = 0; ai < 2; ++ai)
#pragma unroll
                for (int m = 0; m < 4; ++m) { bf16_t* rowp = P + (size_t)(brow + ai * HALF + wr * 64 + m * 16 + fr) * AB_INP + bcol + wc * 32 + fq * 4;
#pragma unroll
                    for (int bj = 0; bj < 2; ++bj)
#pragma unroll
                        for (int n = 0; n < 2; ++n) { const f32x4 v = acc[ai][bj][m][n]; u32x2 w; w.x = cvtpk(v[0], v[1]); w.y = cvtpk(v[2], v[3]); *(u32x2*)(rowp + bj * HALF + n * 16) = w; } }
            if (pn >= 20) {
                float* red = (float*)(smem + SHM_GEMM);
#pragma unroll
                for (int ai = 0; ai < 2; ++ai)
#pragma unroll
                    for (int m = 0; m < 4; ++m) { float sq = 0.f;
#pragma unroll
                        for (int bj = 0; bj < 2; ++bj)
#pragma unroll
                            for (int n = 0; n < 2; ++n) { const f32x4 v = acc[ai][bj][m][n]; sq += v[0] * v[0] + v[1] * v[1] + v[2] * v[2] + v[3] * v[3]; }
                        sq += __shfl_xor(sq, 16); sq += __shfl_xor(sq, 32);
                        if (fq == 0) red[(ai * HALF + wr * 64 + m * 16 + fr) * 4 + wc] = sq; }
                asm volatile("s_waitcnt lgkmcnt(0)" ::: "memory"); __builtin_amdgcn_s_barrier(); asm volatile("" ::: "memory");
                const int t_ = tid_opaque() & 255;
                if (t_ < 128) { const int lr = (t_ >> 6) * HALF + wr * 64 + (t_ & 63); const f32x4 q = *(const f32x4*)(red + lr * 4); ssq[(size_t)(pn - 20) * R + brow + lr] = (q[0] + q[1]) + (q[2] + q[3]); }
            }
        } else if (wc < 2) {
#pragma unroll
            for (int ai = 0; ai < 2; ++ai)
#pragma unroll
                for (int m = 0; m < 4; ++m) { int b, t; row_bt(brow + ai * HALF + wr * 64 + m * 16 + fr, b, t);
#pragma unroll
                    for (int n = 0; n < 2; ++n) { const f32x4 v = acc[ai][0][m][n]; const int p0 = 16 * wc + 8 * n + 2 * fq;
                        float2 c0 = make_float2(1.f, 0.f), c1 = c0; if (t >= TC) { c0 = tb[(t - TC) * 32 + p0]; c1 = tb[(t - TC) * 32 + p0 + 1]; }
                        const unsigned lo = cvtpk(v[0] * c0.x - v[1] * c0.y, v[2] * c1.x - v[3] * c1.y), hi = cvtpk(v[1] * c0.x + v[0] * c0.y, v[3] * c1.x + v[2] * c1.y);
#pragma unroll
                        for (int hh = 0; hh < 8; ++hh) { bf16_t* kp = Kb + (((size_t)b * 8 + hh) * S + t) * 192 + 128 + p0; *(unsigned*)kp = lo; *(unsigned*)(kp + 32) = hi; } } }
        }
    } };
struct EpiInCD { bf16_t* P; bf16_t* Qb; bf16_t* Kb; bf16_t* Vb; const float2* tc; const float* gq; const float* gk; char* smem;
    DEV void operator()(const f32x4 (&acc)[2][2][4][2], int brow, int bcol, int wr, int wc, int fr, int fq) const {
        const int pn = bcol >> 8;
        if (pn <= 4) {
            float* red = (float*)(smem + SHM_GEMM);
#pragma unroll
            for (int ai = 0; ai < 2; ++ai)
#pragma unroll
                for (int m = 0; m < 4; ++m)
#pragma unroll
                    for (int bj = 0; bj < 2; ++bj) { float sq = 0.f;
#pragma unroll
                        for (int n = 0; n < 2; ++n) { const f32x4 v = acc[ai][bj][m][n]; sq += v[0] * v[0] + v[1] * v[1] + v[2] * v[2] + v[3] * v[3]; }
                        sq += __shfl_xor(sq, 16); sq += __shfl_xor(sq, 32);
                        if (fq == 0) red[((ai * HALF + wr * 64 + m * 16 + fr) * 2 + bj) * 4 + wc] = sq; }
            asm volatile("s_waitcnt lgkmcnt(0)" ::: "memory"); __builtin_amdgcn_s_barrier(); asm volatile("" ::: "memory");
            const float* gp = pn < 4 ? gq : gk;
            float g1[2][2], g2[2][2];
#pragma unroll
            for (int n = 0; n < 2; ++n) { const int p0 = 16 * wc + 8 * n + 2 * fq; g1[n][0] = gp[p0]; g1[n][1] = gp[p0 + 1]; g2[n][0] = gp[p0 + 64]; g2[n][1] = gp[p0 + 65]; }
#pragma unroll
            for (int ai = 0; ai < 2; ++ai)
#pragma unroll
                for (int m = 0; m < 4; ++m) { const int lr = ai * HALF + wr * 64 + m * 16 + fr; int b, t; row_bt(brow + lr, b, t);
#pragma unroll
                    for (int bj = 0; bj < 2; ++bj) { const f32x4 q4 = *(const f32x4*)(red + (lr * 2 + bj) * 4); const float rs = rsqrtf(((q4[0] + q4[1]) + (q4[2] + q4[3])) * (1.f / 128.f) + EPS);
                        bf16_t* dst = pn < 4 ? Qb + (((size_t)b * 8 + pn * 2 + bj) * S + t) * 128 : Kb + (((size_t)b * 2 + bj) * S + t) * 128;
#pragma unroll
                        for (int n = 0; n < 2; ++n) { const f32x4 v = acc[ai][bj][m][n]; const int p0 = 16 * wc + 8 * n + 2 * fq;
                            float2 c0 = make_float2(1.f, 0.f), c1 = c0; if (t >= TC) { c0 = tc[(t - TC) * 64 + p0]; c1 = tc[(t - TC) * 64 + p0 + 1]; }
                            const float x1a = v[0] * rs * g1[n][0], x2a = v[1] * rs * g2[n][0], x1b = v[2] * rs * g1[n][1], x2b = v[3] * rs * g2[n][1];
                            *(unsigned*)(dst + p0) = cvtpk(x1a * c0.x - x2a * c0.y, x1b * c1.x - x2b * c1.y);
                            *(unsigned*)(dst + 64 + p0) = cvtpk(x2a * c0.x + x1a * c0.y, x2b * c1.x + x1b * c1.y); } } }
        } else if (pn == 5) {
#pragma unroll
            for (int ai = 0; ai < 2; ++ai)
#pragma unroll
                for (int m = 0; m < 4; ++m) { int b, t; row_bt(brow + ai * HALF + wr * 64 + m * 16 + fr, b, t);
#pragma unroll
                    for (int bj = 0; bj < 2; ++bj)
#pragma unroll
                        for (int n = 0; n < 2; ++n) { const f32x4 v = acc[ai][bj][m][n]; u32x2 w; w.x = cvtpk(v[0], v[1]); w.y = cvtpk(v[2], v[3]);
                            *(u32x2*)(Vb + (((size_t)b * 2 + bj) * S + t) * 128 + wc * 32 + n * 16 + fq * 4) = w; } }
        } else {
#pragma unroll
            for (int ai = 0; ai < 2; ++ai)
#pragma unroll
                for (int m = 0; m < 4; ++m) { bf16_t* rowp = P + (size_t)(brow + ai * HALF + wr * 64 + m * 16 + fr) * CD_INP + bcol + wc * 32 + fq * 4;
#pragma unroll
                    for (int bj = 0; bj < 2; ++bj)
#pragma unroll
                        for (int n = 0; n < 2; ++n) { const f32x4 v = acc[ai][bj][m][n]; u32x2 w; w.x = cvtpk(v[0], v[1]); w.y = cvtpk(v[2], v[3]); *(u32x2*)(rowp + bj * HALF + n * 16) = w; } }
        }
    } };
struct EpiUQ { bf16_t* Qb; const float* ssq; const float2* tb;
    DEV void operator()(const f32x4 (&acc)[2][2][4][2], int brow, int bcol, int wr, int wc, int fr, int fq) const {
        const int pn = bcol >> 8;
#pragma unroll
        for (int ai = 0; ai < 2; ++ai)
#pragma unroll
            for (int m = 0; m < 4; ++m) { const int r = brow + ai * HALF + wr * 64 + m * 16 + fr; int b, t; row_bt(r, b, t);
                const float rs = rsqrtf((ssq[r] + ssq[R + r]) * (1.f / 512.f) + EPS);
#pragma unroll
                for (int bj = 0; bj < 2; ++bj)
#pragma unroll
                    for (int n = 0; n < 2; ++n) { const f32x4 v = acc[ai][bj][m][n] * rs;
                        if (pn < 4) { const int hh = pn * 2 + bj; bf16_t* qp = Qb + (((size_t)b * 8 + hh) * S + t) * 192 + wc * 32 + n * 16 + fq * 4;
                            u32x2 w; w.x = cvtpk(v[0], v[1]); w.y = cvtpk(v[2], v[3]); *(u32x2*)qp = w; }
                        else { const int cr = (pn - 4) * 256 + bj * HALF + wc * 32 + n * 16 + fq * 4, hh = cr >> 6, p0 = (cr & 63) >> 1;
                            float2 c0 = make_float2(1.f, 0.f), c1 = c0; if (t >= TC) { c0 = tb[(t - TC) * 32 + p0]; c1 = tb[(t - TC) * 32 + p0 + 1]; }
                            bf16_t* qp = Qb + (((size_t)b * 8 + hh) * S + t) * 192 + 128 + p0;
                            *(unsigned*)qp = cvtpk(v[0] * c0.x - v[1] * c0.y, v[2] * c1.x - v[3] * c1.y); *(unsigned*)(qp + 32) = cvtpk(v[1] * c0.x + v[0] * c0.y, v[3] * c1.x + v[2] * c1.y); } } }
    } };
struct EpiUKV { bf16_t* Kb; bf16_t* Vb; const float* ssq;
    DEV void operator()(const f32x4 (&acc)[2][2][4][2], int brow, int bcol, int wr, int wc, int fr, int fq) const {
        const int hh = bcol >> 8;
#pragma unroll
        for (int ai = 0; ai < 2; ++ai)
#pragma unroll
            for (int m = 0; m < 4; ++m) { const int r = brow + ai * HALF + wr * 64 + m * 16 + fr; int b, t; row_bt(r, b, t);
                const float rs = rsqrtf(ssq[2 * R + r] * (1.f / 256.f) + EPS); const size_t rowi = ((size_t)b * 8 + hh) * S + t;
#pragma unroll
                for (int n = 0; n < 2; ++n) { const f32x4 kv = acc[ai][0][m][n] * rs, vv = acc[ai][1][m][n] * rs; const int c = wc * 32 + n * 16 + fq * 4;
                    u32x2 w; w.x = cvtpk(kv[0], kv[1]); w.y = cvtpk(kv[2], kv[3]); *(u32x2*)(Kb + rowi * 192 + c) = w;
                    w.x = cvtpk(vv[0], vv[1]); w.y = cvtpk(vv[2], vv[3]); *(u32x2*)(Vb + rowi * 128 + c) = w; } }
    } };

template <bool LATENT = false, int LDA_ = 0, class Epi>
DEV void gemm_phase(const bf16_t* A, const bf16_t* Bt, int M, int N, int K, char* smem, const Epi& epi, int& cursor, int tlo = 0, int thi = 1 << 30) {
    const int nM = M / BM, nN = N / BM, n = nM * nN;
    int first = cursor; cursor += n;
    int u = blockIdx.x; while (u < first) u += gridDim.x;
    for (; u < first + n; u += gridDim.x) { const int t = u - first; if (t < tlo || t >= thi) continue; const int pm = t % nM, pn = t / nM;
        const int prow = LATENT ? (pm >> 3) * 9 + 1 + (pm & 7) : pm;
        gemm_tile<false, LDA_>(A, Bt, K, K, prow * BM, pn * BM, nullptr, 0, smem, epi); }
}

struct CvtJob { const float* src; bf16_t* dst; int K, N, Nout, nb; size_t src_bs, dst_bs; int blk_rs, blk_base; const float* kscale; int perm = 0; };
DEV void cvt_do_tile(const CvtJob& j, int u, int lane) {
    const int tN = j.Nout / 64, per = (j.K / 64) * tN;
    const int bt = u / per, rem = u - bt * per, kt = rem / tN, ntl = rem - kt * tN;
    const int n = ntl * 64 + lane; const bool valid = n < j.N;
    const float* sp = j.src + (size_t)bt * j.src_bs + (size_t)(kt * 64) * j.N + (valid ? n : 0);
    float e[64];
#pragma unroll
    for (int i = 0; i < 64; ++i) e[i] = sp[(size_t)i * j.N];
    __builtin_amdgcn_sched_barrier(0);
    u32x4 ov[8];
#pragma unroll
    for (int kb = 0; kb < 8; ++kb) {
#pragma unroll
        for (int i = 0; i < 8; ++i) { float x = e[kb * 8 + i]; if (j.kscale) x *= j.kscale[kt * 64 + kb * 8 + i]; e[kb * 8 + i] = valid ? x : 0.f; }
        ov[kb] = (u32x4){cvtpk(e[kb * 8], e[kb * 8 + 1]), cvtpk(e[kb * 8 + 2], e[kb * 8 + 3]), cvtpk(e[kb * 8 + 4], e[kb * 8 + 5]), cvtpk(e[kb * 8 + 6], e[kb * 8 + 7])}; }
    int drow = (n >> 7) * j.blk_rs + j.blk_base + (n & 127);
    if (j.perm == 1) { const int hh = n / 192, c = n - hh * 192, i = c - 128; drow = c < 128 ? hh * 128 + c : 1024 + hh * 64 + (i < 32 ? 2 * i : 2 * (i - 32) + 1); }
    if (j.perm == 3 && n < 1280) { const int c = n & 127; drow = (n & ~127) + (c < 64 ? 2 * c : 2 * (c - 64) + 1); }
    if (j.perm == 2 && n >= 5888) { const int i = n - 5888; drow = i < 64 ? 5888 + (i < 32 ? 2 * i : 2 * (i - 32) + 1) : n; }
    bf16_t* dp = j.dst + (size_t)bt * j.dst_bs + (size_t)drow * j.K + kt * 64;
#pragma unroll
    for (int kb = 0; kb < 8; ++kb) *(u32x4*)(dp + kb * 8) = ov[kb];
}
DEV void cvt_weight(const float* __restrict__ src, bf16_t* __restrict__ dst, int K, int N, int Nout, int nb, size_t src_bs, size_t dst_bs,
                    int blk_rs, int blk_base, const float* __restrict__ kscale, char* smem, int perm = 0) {
    (void)smem;
    const CvtJob j{src, dst, K, N, Nout, nb, src_bs, dst_bs, blk_rs, blk_base, kscale, perm};
    const int tid = tid_opaque(), lane = tid & 63, w = tid >> 6, total = nb * (K / 64) * (Nout / 64);
    for (int u = blockIdx.x * 8 + w; u < total; u += gridDim.x * 8) cvt_do_tile(j, u, lane);
}
DEV bf16_t* moe_w13(const Args& a, int l) { return (bf16_t*)(a.ws + (l == 0 ? WS_W13 : WS_SVT)); }
DEV bf16_t* moe_w2(const Args& a, int l) { return (bf16_t*)(a.ws + (l == 0 ? WS_W2 : WS_SVT + (size_t)NE * 1024 * D * 2)); }
DEV void cvt_moe_dynamic(const Args& a, int l, char* smem) {
    const int tid = tid_opaque(), lane = tid & 63, w = tid >> 6;
    unsigned* counter = (unsigned*)(a.ws + WS_CTL) + CW_CVT + l * 64;
    volatile int* slot = (volatile int*)smem;
    const CvtJob j1{a.in[26] + (size_t)l * NE * D * EDIM, moe_w13(a, l), D, EDIM, EDIM, NE, (size_t)D * EDIM, (size_t)1024 * D, 256, 0, nullptr};
    const CvtJob j3{a.in[27] + (size_t)l * NE * D * EDIM, moe_w13(a, l), D, EDIM, EDIM, NE, (size_t)D * EDIM, (size_t)1024 * D, 256, 128, nullptr};
    const CvtJob j2{a.in[28] + (size_t)l * NE * EDIM * D, moe_w2(a, l), EDIM, D, D, NE, (size_t)EDIM * D, (size_t)D * EDIM, 128, 0, nullptr};
    constexpr int NCHUNK = 3 * 4096 / 64;
    for (;;) {
        __syncthreads();
        if (tid == 0) *slot = (int)atomicAdd(counter, 1u);
        __syncthreads();
        const int chunk = *slot;
        if (chunk >= NCHUNK) break;
        const int job = chunk >> 6;
#pragma unroll 1
        for (int i = 0; i < 8; ++i) { const int u = ((chunk & 63) << 6) + w * 8 + i;
            if (job == 0) cvt_do_tile(j1, u, lane); else if (job == 1) cvt_do_tile(j3, u, lane); else cvt_do_tile(j2, u, lane); }
    }
    __syncthreads();
}

DEV void cvt_cd_dynamic(const Args& a, char* smem) {
    const int tid = tid_opaque(), lane = tid & 63, w = tid >> 6;
    unsigned* counter = (unsigned*)(a.ws + WS_CTL) + CW_CVT + 3 * 64;
    volatile int* slot = (volatile int*)smem;
    const CvtJob jin{a.in[17], (bf16_t*)(a.ws + WS_WCDIN), D, CD_IN, CD_INP, 1, 0, 0, 128, 0, nullptr, 3};
    const CvtJob jout{a.in[18], (bf16_t*)(a.ws + WS_WCDOUT), D, D, D, 1, 0, 0, 128, 0, nullptr};
    const CvtJob jabo{a.in[10], (bf16_t*)(a.ws + WS_WABOUT), D, D, D, 1, 0, 0, 128, 0, nullptr};
    const CvtJob juq{a.in[14], (bf16_t*)(a.ws + WS_WUQ), 512, 1536, 1536, 1, 0, 0, 128, 0, a.in[13], 1};
    const CvtJob jukv{a.in[16], (bf16_t*)(a.ws + WS_WUKV), 256, 2048, 2048, 1, 0, 0, 128, 0, a.in[15]};
    constexpr int TIN = 32 * (CD_INP / 64), T1 = TIN + 32 * 32, T2 = T1 + 32 * 32, T3 = T2 + 8 * 24, T4 = T3 + 4 * 32, NCHUNK = T4 / 64;
    static_assert(TIN % 64 == 0 && T4 % 64 == 0, "chunk boundary");
    for (;;) {
        __syncthreads();
        if (tid == 0) *slot = (int)atomicAdd(counter, 1u);
        __syncthreads();
        const int chunk = *slot;
        if (chunk >= NCHUNK) break;
#pragma unroll 1
        for (int i = 0; i < 8; ++i) { const int g = chunk * 64 + w * 8 + i;
            if (g < TIN) cvt_do_tile(jin, g, lane); else if (g < T1) cvt_do_tile(jout, g - TIN, lane); else if (g < T2) cvt_do_tile(jabo, g - T1, lane);
            else if (g < T3) cvt_do_tile(juq, g - T2, lane); else cvt_do_tile(jukv, g - T3, lane); }
    }
    __syncthreads();
}

template <bool DYN>
DEV void mod_phase(const Args& a, int l, char* smem) {
    float* sc = (float*)smem;
    float* red = sc + 5 * D;
    const int tid = tid_opaque(), w = tid >> 6, lane = tid & 63, cg = lane & 7, rr = lane >> 3;
    for (int i = tid; i < 5 * D; i += NT) { const int v = i / D, k = i - v * D; const float x = v < 4 ? a.in[1][v * D + k] : a.in[3][k]; sc[i] = siluf_(x); }
    __syncthreads();
    float* modv = (float*)(a.ws + WS_MODV);
    unsigned* counter = (unsigned*)(a.ws + WS_CTL) + CW_CVT + 2 * 64; volatile int* slot = (volatile int*)(red + 8 * 5 * 32);
    for (int u = blockIdx.x;; u += gridDim.x) {
        if (DYN) { __syncthreads(); if (tid == 0) *slot = (int)atomicAdd(counter, 1u); __syncthreads(); u = *slot; }
        if (u >= MODN / 32) break;
        const int c0 = u * 32;
        const float* wp = a.in[4] + (size_t)l * D * MODN + c0 + cg * 4;
        f32x4 acc[5] = {};
        for (int it0 = 0; it0 < D / 64; it0 += 8) { f32x4 wv[8];
#pragma unroll
            for (int q = 0; q < 8; ++q) wv[q] = *(const f32x4*)(wp + (size_t)((it0 + q) * 64 + w * 8 + rr) * MODN);
#pragma unroll
            for (int q = 0; q < 8; ++q) { const int k = (it0 + q) * 64 + w * 8 + rr;
#pragma unroll
                for (int v = 0; v < 5; ++v) acc[v] += wv[q] * sc[v * D + k]; } }
#pragma unroll
        for (int v = 0; v < 5; ++v)
#pragma unroll
            for (int j = 0; j < 4; ++j) { float x = acc[v][j]; x += __shfl_xor(x, 8); x += __shfl_xor(x, 16); x += __shfl_xor(x, 32); acc[v][j] = x; }
        if (rr == 0) {
#pragma unroll
            for (int v = 0; v < 5; ++v)
#pragma unroll
                for (int j = 0; j < 4; ++j) red[(w * 5 + v) * 32 + cg * 4 + j] = acc[v][j]; }
        __syncthreads();
        if (tid < 160) { const int v = tid >> 5, c = tid & 31; float s = 0.f;
#pragma unroll
            for (int ww = 0; ww < 8; ++ww) s += red[(ww * 5 + v) * 32 + c];
            modv[((size_t)l * 5 + v) * MODN + c0 + c] = s + a.in[5][l * MODN + c0 + c]; }
        __syncthreads();
    }
}

DEV void misc_phase(const Args& a) {
    const int gt = blockIdx.x * NT + tid_opaque(), gs = gridDim.x * NT;
    float* lb = (float*)(a.ws + WS_LB);
    for (int i = gt; i < 2 * 1024; i += gs) { const int d = i >> 10, c = i & 1023; const float* p = a.in[11] + (size_t)d * 3 * 1024 + c;
        const float x0 = p[0], x1 = p[1024], x2 = p[2048], m = fmaxf(x0, fmaxf(x1, x2));
        const float e0 = expf(x0 - m), e1 = expf(x1 - m), e2 = expf(x2 - m); lb[i] = e0 / (e0 + e1 + e2); }
    float2* tb = (float2*)(a.ws + WS_TABB); float2* tc = (float2*)(a.ws + WS_TABC);
    for (int i = gt; i < TL * 32; i += gs) { const int t = i >> 5, j = i & 31, q = j & 15; const float fr = powf(10000.f, -(float)q / 16.f);
        const float pos = (j < 16) ? (float)(t >> 6) : (float)(t & 63); const float an = pos * fr; tb[i] = make_float2(cosf(an), sinf(an)); }
    for (int i = gt; i < TL * 64; i += gs) { const int t = i >> 6, j = i & 63, q = j & 31; const float fr = powf(10000.f, -(float)q / 32.f);
        const float pos = (j < 32) ? (float)(t >> 6) : (float)(t & 63); const float an = pos * fr; tc[i] = make_float2(cosf(an), sinf(an)); }
}

template <bool ROUTER, bool FROM_IN = false>
DEV void norm_phase(const Args& a, int l, int chunk_shift, const float* gain, bool latent_only, char* smem, bool dry = false) {
    const int tid = tid_opaque(), w = tid >> 6, lane = tid & 63;
    const bf16_t* xres = (const bf16_t*)(a.ws + WS_XRES); bf16_t* h = (bf16_t*)(a.ws + WS_H);
    const float* modv = (const float*)(a.ws + WS_MODV) + (size_t)l * 5 * MODN;
    unsigned* cnt = (unsigned*)(a.ws + WS_CTL) + CW_CNT + l * 16;
    int* tok = (int*)(a.ws + WS_TOK); int* list = (int*)(a.ws + WS_LIST);
    float* rw = (float*)smem;
    if (ROUTER) { for (int i = tid; i < D * 16 / 4; i += NT) { const int c = i >> 2, q = i & 3; *(f32x4*)(rw + c * 16 + (c >> 2) * 4 + q * 4) = ((const f32x4*)a.in[24])[i]; } __syncthreads(); }
    for (int r = blockIdx.x * 8 + w; r < R; r += gridDim.x * 8) {
        const int b = r / S, t = r - b * S; if (latent_only && t < TC) continue;
        const int v = t < TC ? 4 : b;
        const float* xp = t < TC ? a.in[2] + ((size_t)b * TC + t) * D : a.in[0] + ((size_t)b * TL + (t - TC)) * D; const bf16_t* xb = xres + (size_t)r * D; const float* sh = modv + (size_t)v * MODN + chunk_shift * D; const float* sc = sh + D;
        f32x4 x[8]; float ss = 0.f;
#pragma unroll
        for (int j = 0; j < 8; ++j) { if (FROM_IN) x[j] = *(const f32x4*)(xp + j * 256 + lane * 4); else { const u32x2 p = *(const u32x2*)(xb + j * 256 + lane * 4); x[j] = (f32x4){bflo(p.x), bfhi(p.x), bflo(p.y), bfhi(p.y)}; }
            ss += x[j][0] * x[j][0] + x[j][1] * x[j][1] + x[j][2] * x[j][2] + x[j][3] * x[j][3]; }
        ss = wave_sum(ss); const float rstd = rsqrtf(ss * (1.f / D) + EPS);
        float lg[16];
        if (ROUTER) {
#pragma unroll
            for (int e = 0; e < 16; ++e) lg[e] = 0.f; }
        f32x4 gv[8], s1v[8], s0v[8];
#pragma unroll
        for (int j = 0; j < 8; ++j) { const int c = j * 256 + lane * 4; gv[j] = *(const f32x4*)(gain + c); s1v[j] = *(const f32x4*)(sc + c); s0v[j] = *(const f32x4*)(sh + c); }
#pragma unroll
        for (int j = 0; j < 8; ++j) { const int c = j * 256 + lane * 4;
            const f32x4 g = gv[j], s1 = s1v[j], s0 = s0v[j];
            f32x4 y = (x[j] * rstd * g) * (1.f + s1) + s0;
            u32x2 pk; pk.x = cvtpk(y[0], y[1]); pk.y = cvtpk(y[2], y[3]); *(u32x2*)(h + (size_t)r * D + c) = pk;
            if (ROUTER) {
#pragma unroll
                for (int i = 0; i < 4; ++i) { const f32x4* wrow = (const f32x4*)(rw + (c + i) * 16 + (c >> 2) * 4);
#pragma unroll
                    for (int q = 0; q < 4; ++q) { const f32x4 wv = wrow[q]; lg[q * 4 + 0] += y[i] * wv[0]; lg[q * 4 + 1] += y[i] * wv[1]; lg[q * 4 + 2] += y[i] * wv[2]; lg[q * 4 + 3] += y[i] * wv[3]; } }
                __builtin_amdgcn_sched_barrier(0); }
        }
        if (ROUTER) {
#pragma unroll
            for (int e = 0; e < 16; ++e) lg[e] = wave_sum(lg[e]);
            if (lane == 0 && !dry) {
                float scv[16], sel[16];
#pragma unroll
                for (int e = 0; e < 16; ++e) { scv[e] = 1.f / (1.f + expf(-lg[e])); sel[e] = scv[e] + a.in[25][e]; }
                int gbest = 0; float gbv = -1e30f;
#pragma unroll
                for (int g = 0; g < 4; ++g) { float m1 = -1e30f, m2 = -1e30f;
#pragma unroll
                    for (int i = 0; i < 4; ++i) { const float s_ = sel[g * 4 + i]; if (s_ > m1) { m2 = m1; m1 = s_; } else if (s_ > m2) m2 = s_; }
                    const float gs = m1 + m2; if (gs > gbv) { gbv = gs; gbest = g; } }
                int e0 = 0, e1 = 0; float m1 = -1e30f, m2 = -1e30f; float w0 = 0.f, w1 = 0.f;
#pragma unroll
                for (int g = 0; g < 4; ++g) if (g == gbest) {
#pragma unroll
                    for (int i = 0; i < 4; ++i) { const float s_ = sel[g * 4 + i]; const int e = g * 4 + i;
                        if (s_ > m1) { m2 = m1; e1 = e0; w1 = w0; m1 = s_; e0 = e; w0 = scv[e]; } else if (s_ > m2) { m2 = s_; e1 = e; w1 = scv[e]; } } }
                const float inv = 1.f / (w0 + w1);
                const unsigned s0 = atomicAdd(&cnt[e0], 1u), s1 = atomicAdd(&cnt[e1], 1u);
                __hip_atomic_store((__attribute__((address_space(1))) int*)(list + (size_t)e0 * R + s0), r * 2, __ATOMIC_RELAXED, __HIP_MEMORY_SCOPE_AGENT);
                __hip_atomic_store((__attribute__((address_space(1))) int*)(list + (size_t)e1 * R + s1), r * 2 + 1, __ATOMIC_RELAXED, __HIP_MEMORY_SCOPE_AGENT);
                tok[r * 4 + 0] = e0; tok[r * 4 + 1] = e1; ((float*)tok)[r * 4 + 2] = w0 * inv; ((float*)tok)[r * 4 + 3] = w1 * inv;
            }
        }
    }
}

DEV int scan_tok(int dir, int pos) { return dir == 0 ? pos : (pos < TC ? (TC - 1 - pos) : (S - 1 - (pos - TC))); }
template <int MODE>
DEV void scan_prep_phase(const Args& a, char* smem) {
    constexpr int NH = MODE == 0 ? 8 : 4, DV = MODE == 0 ? 128 : 256, LDP = MODE == 0 ? AB_INP : CD_INP, NVP = DV / 128;
    const int tid = tid_opaque(), dp = tid & 63, pg = tid >> 6, wid = tid >> 6, lane = tid & 63, l15 = lane & 15, l4 = lane >> 4;
    char* QT = smem; char* KT = smem + 64 * PQ; float* tot = (float*)(smem + 2 * 64 * PQ);
    float* aT = tot + 8 * 128;
    const bf16_t* P = (const bf16_t*)(a.ws + WS_P); const float* lb = (const float*)(a.ws + WS_LB);
    const float qscale = 0.08838834764831845f;
    const int nitems = NB * NH * 2 * 36;
    for (int item = blockIdx.x; item < nitems; item += gridDim.x) {
        const int c = item % 36, dir = (item / 36) & 1, hd = (item / 72) % NH, b = item / (72 * NH);
        char* rec = (char*)(a.ws + (MODE == 0 ? WS_SREC : WS_SREC1)) + (size_t)item * REC_BYTES;
        char* vt = (char*)(a.ws + (MODE == 0 ? WS_SVT : WS_SVT1)) + (size_t)item * (DV * PA);
        unsigned zq[8], qq[8], kq[8], vq[NVP][8];
        const int qcol = (MODE == 0 ? hd * 128 : 1536 + hd * 128) + 2 * dp, zcol = (MODE == 0 ? 1024 * (1 + dir) + hd * 128 : 2048 + hd * 128) + 2 * dp;
        const int vcol = (MODE == 0 ? 3072 + hd * 128 : 2560 + hd * 256) + 2 * dp;
#pragma unroll
        for (int j = 0; j < 8; ++j) { const bf16_t* pr = P + (size_t)(b * S + scan_tok(dir, c * 64 + pg * 8 + j)) * LDP;
            qq[j] = *(const unsigned*)(pr + qcol); const unsigned zk = *(const unsigned*)(pr + zcol); zq[j] = zk; kq[j] = zk;
#pragma unroll
            for (int vv = 0; vv < NVP; ++vv) vq[vv][j] = *(const unsigned*)(pr + vcol + vv * 128); }
        if (MODE == 1) { if (tid < 256) { const int pos = tid >> 2, qd = tid & 3; const int r = b * S + scan_tok(dir, c * 64 + pos);
                const u32x2 av = *(const u32x2*)(P + (size_t)r * LDP + 4608 + dir * 16 + qd * 4); *(f32x4*)(aT + pos * 16 + qd * 4) = (f32x4){bflo(av.x), bfhi(av.x), bflo(av.y), bfhi(av.y)}; }
            __syncthreads(); }
        float g0[8], g1[8], k0[8], k1[8];
        if (MODE == 0) { const float lb0 = lb[dir * 1024 + hd * 128 + 2 * dp], lb1 = lb[dir * 1024 + hd * 128 + 2 * dp + 1];
#pragma unroll
            for (int j = 0; j < 8; ++j) { const float f0 = lb0 + (1.f - lb0) * sigmoidf_(bflo(zq[j])), f1 = lb1 + (1.f - lb1) * sigmoidf_(bfhi(zq[j]));
                g0[j] = __logf(f0); g1[j] = __logf(f1); k0[j] = 1.f - f0; k1[j] = 1.f - f1; } }
        else { float w0[16], w1[16]; const int wc_ = hd * 128 + 2 * dp; const float gb0 = a.in[22][dir * 512 + wc_], gb1 = a.in[22][dir * 512 + wc_ + 1];
#pragma unroll
            for (int i = 0; i < 16; ++i) { const float2 wv = *(const float2*)(a.in[21] + (size_t)(dir * 16 + i) * 512 + wc_); w0[i] = wv.x; w1[i] = wv.y; }
#pragma unroll
            for (int j = 0; j < 8; ++j) { float z0 = gb0, z1 = gb1;
#pragma unroll
                for (int i4 = 0; i4 < 4; ++i4) { const f32x4 av = *(const f32x4*)(aT + (pg * 8 + j) * 16 + i4 * 4);
#pragma unroll
                    for (int e = 0; e < 4; ++e) { z0 += av[e] * w0[i4 * 4 + e]; z1 += av[e] * w1[i4 * 4 + e]; } }
                g0[j] = (fminf(z0, 0.f) - __logf(1.f + __expf(-fabsf(z0)))) * (1.f / 16.f); g1[j] = (fminf(z1, 0.f) - __logf(1.f + __expf(-fabsf(z1)))) * (1.f / 16.f);
                k0[j] = bflo(kq[j]); k1[j] = bfhi(kq[j]); } }
#pragma unroll
        for (int j = 1; j < 8; ++j) { g0[j] += g0[j - 1]; g1[j] += g1[j - 1]; }
        *(float2*)(tot + pg * 128 + 2 * dp) = make_float2(g0[7], g1[7]);
        __syncthreads();
        float off0 = 0.f, off1 = 0.f, ref0 = 0.f, ref1 = 0.f, last0 = 0.f, last1 = 0.f;
#pragma unroll
        for (int p = 0; p < 8; ++p) { const float2 tp = *(const float2*)(tot + p * 128 + 2 * dp);
            if (p < pg) { off0 += tp.x; off1 += tp.y; } if (p < 4) { ref0 += tp.x; ref1 += tp.y; } last0 += tp.x; last1 += tp.y; }
        unsigned kh0[4], kh1[4];
        const float eref0 = __expf(ref0), eref1 = __expf(ref1), elr0 = __expf(last0 - ref0), elr1 = __expf(last1 - ref1);
#pragma unroll
        for (int j = 0; j < 8; j += 2) { float kha[2], khb[2];
#pragma unroll
            for (int e = 0; e < 2; ++e) { const int i = pg * 8 + j + e; const float G0 = off0 + g0[j + e], G1 = off1 + g1[j + e];
                float q0 = bflo(qq[j + e]), q1 = bfhi(qq[j + e]); if (MODE == 0) { q0 = siluf_(q0); q1 = siluf_(q1); } q0 *= qscale; q1 *= qscale;
                const float kk0 = k0[j + e], kk1 = k1[j + e];
                const float qt0 = q0 * __expf(G0 - ref0), qt1 = q1 * __expf(G1 - ref1), kt0 = kk0 * __expf(ref0 - G0), kt1 = kk1 * __expf(ref1 - G1);
                *(unsigned*)(QT + i * PQ + dp * 4) = cvtpk(qt0, qt1);
                *(unsigned*)(KT + i * PQ + dp * 4) = cvtpk(kt0, kt1);
                *(unsigned*)(rec + REC_QH + i * PQ + dp * 4) = cvtpk(qt0 * eref0, qt1 * eref1);
                kha[e] = kt0 * elr0; khb[e] = kt1 * elr1; }
            kh0[j >> 1] = cvtpk(kha[0], kha[1]); kh1[j >> 1] = cvtpk(khb[0], khb[1]); }
        *(u32x4*)(rec + REC_KHT + (2 * dp) * PA + pg * 16) = (u32x4){kh0[0], kh0[1], kh0[2], kh0[3]};
        *(u32x4*)(rec + REC_KHT + (2 * dp + 1) * PA + pg * 16) = (u32x4){kh1[0], kh1[1], kh1[2], kh1[3]};
        if (pg == 0) *(float2*)(rec + REC_AL + dp * 8) = make_float2(__expf(last0), __expf(last1));
#pragma unroll
        for (int vv = 0; vv < NVP; ++vv) { const int v0 = vv * 128 + 2 * dp; unsigned lo[4], hi[4];
#pragma unroll
            for (int j = 0; j < 8; j += 2) { lo[j >> 1] = (vq[vv][j] & 0xffffu) | (vq[vv][j + 1] << 16); hi[j >> 1] = (vq[vv][j] >> 16) | (vq[vv][j + 1] & 0xffff0000u); }
            *(u32x4*)(vt + v0 * PA + pg * 16) = (u32x4){lo[0], lo[1], lo[2], lo[3]};
            *(u32x4*)(vt + (v0 + 1) * PA + pg * 16) = (u32x4){hi[0], hi[1], hi[2], hi[3]}; }
        __syncthreads();
        { const int ti = wid >> 1; f32x4 acc[2] = {};
#pragma unroll
          for (int kk = 0; kk < 4; ++kk) { const int i = ti * 16 + l15;
              const bf16x8 bq = *(const bf16x8*)(QT + i * PQ + (kk * 32 + l4 * 8) * 2);
#pragma unroll
              for (int t2_ = 0; t2_ < 2; ++t2_) { const int sidx = ((wid & 1) * 2 + t2_) * 16 + l15;
                  const bf16x8 ak = *(const bf16x8*)(KT + sidx * PQ + (kk * 32 + l4 * 8) * 2);
                  acc[t2_] = __builtin_amdgcn_mfma_f32_16x16x32_bf16(ak, bq, acc[t2_], 0, 0, 0); } }
#pragma unroll
          for (int t2_ = 0; t2_ < 2; ++t2_) { const int tj = (wid & 1) * 2 + t2_, i = ti * 16 + l15, s0 = tj * 16 + 4 * l4;
              float x0 = (s0 + 0 <= i) ? acc[t2_][0] : 0.f, x1 = (s0 + 1 <= i) ? acc[t2_][1] : 0.f, x2 = (s0 + 2 <= i) ? acc[t2_][2] : 0.f, x3 = (s0 + 3 <= i) ? acc[t2_][3] : 0.f;
              u32x2 w_; w_.x = cvtpk(x0, x1); w_.y = cvtpk(x2, x3);
              *(u32x2*)(rec + REC_A + i * PA + s0 * 2) = w_; } }
        __syncthreads();
    }
}
template <int MODE>
DEV void scan_seq_phase(const Args& a, char* smem) {
    constexpr int NH = MODE == 0 ? 8 : 4, DV = MODE == 0 ? 128 : 256, NVS = DV / 32;
    constexpr int B_A = REC_A, B_QH = REC_QH, B_KHT = REC_KHT, B_AL = REC_AL, B_VT = REC_BYTES, VTS = 32 * PA, BUFB = REC_BYTES + VTS;
    constexpr int NPIECE = BUFB / 16, NREC = REC_BYTES / 16, STB = 32 * PQ;
    const int tid = tid_opaque(), wid = tid >> 6, lane = tid & 63, l15 = lane & 15, l4 = lane >> 4;
    char* ST = smem + 2 * BUFB;
    float* odir = (float*)(a.ws + WS_ODIR);
    for (int item = blockIdx.x; item < NB * NH * 2 * NVS; item += gridDim.x) {
        const int vs = (item >> 3) % NVS, rest = (item & 7) + 8 * ((item >> 3) / NVS);
        const int dir = rest & 1, hd = (rest >> 1) % NH, b = (rest >> 1) / NH;
        const char* rec0 = (const char*)(a.ws + (MODE == 0 ? WS_SREC : WS_SREC1)) + (size_t)rest * 36 * REC_BYTES;
        const char* vt0 = (const char*)(a.ws + (MODE == 0 ? WS_SVT : WS_SVT1)) + (size_t)rest * 36 * (DV * PA) + vs * VTS;
#define SC_LOAD(cc, bb) do { const char* _r = rec0 + (size_t)(cc) * REC_BYTES; const char* _v = vt0 + (size_t)(cc) * (DV * PA) - REC_BYTES; char* _l = smem + (bb) * BUFB; \
        for (int _p = tid; _p < NPIECE; _p += NT) __builtin_amdgcn_global_load_lds((const unsigned*)((_p < NREC ? _r : _v) + _p * 16), (unsigned*)(_l + _p * 16), 16, 0, 0); } while (0)
        for (int i = tid; i < STB / 16; i += NT) ((u32x4*)ST)[i] = (u32x4){0u, 0u, 0u, 0u};
        f32x4 Sacc[2] = {};
        SC_LOAD(0, 0);
        asm volatile("s_waitcnt vmcnt(0)" ::: "memory"); __syncthreads();
        for (int c = 0; c < 36; ++c) {
            const char* buf = smem + (c & 1) * BUFB; const char* STr = ST + (c & 1) * STB; char* STw = ST + ((c + 1) & 1) * STB;
            if (c + 1 < 36) SC_LOAD(c + 1, (c + 1) & 1);
            { const int ti = wid >> 1, tj = wid & 1, i = ti * 16 + l15, v = tj * 16 + l15; f32x4 acc = {};
#pragma unroll
              for (int kk = 0; kk < 2; ++kk) {
                  const bf16x8 av = *(const bf16x8*)(buf + B_VT + v * PA + (kk * 32 + l4 * 8) * 2);
                  const bf16x8 ba = *(const bf16x8*)(buf + B_A + i * PA + (kk * 32 + l4 * 8) * 2);
                  acc = __builtin_amdgcn_mfma_f32_16x16x32_bf16(av, ba, acc, 0, 0, 0); }
#pragma unroll
              for (int kk = 0; kk < 4; ++kk) {
                  const bf16x8 as_ = *(const bf16x8*)(STr + v * PQ + (kk * 32 + l4 * 8) * 2);
                  const bf16x8 bq = *(const bf16x8*)(buf + B_QH + i * PQ + (kk * 32 + l4 * 8) * 2);
                  acc = __builtin_amdgcn_mfma_f32_16x16x32_bf16(as_, bq, acc, 0, 0, 0); }
              const int r = b * S + scan_tok(dir, c * 64 + i);
              *(f32x4*)(odir + ((size_t)dir * R + r) * 1024 + hd * DV + vs * 32 + tj * 16 + 4 * l4) = acc; }
            { const int dr = wid * 16 + l15; const f32x4 al = *(const f32x4*)(buf + B_AL + (wid * 16 + 4 * l4) * 4);
#pragma unroll
              for (int tv = 0; tv < 2; ++tv) { Sacc[tv] *= al; const int v = tv * 16 + l15;
#pragma unroll
                  for (int kk = 0; kk < 2; ++kk) {
                      const bf16x8 ak = *(const bf16x8*)(buf + B_KHT + dr * PA + (kk * 32 + l4 * 8) * 2);
                      const bf16x8 bv = *(const bf16x8*)(buf + B_VT + v * PA + (kk * 32 + l4 * 8) * 2);
                      Sacc[tv] = __builtin_amdgcn_mfma_f32_16x16x32_bf16(ak, bv, Sacc[tv], 0, 0, 0); }
                  u32x2 w_; w_.x = cvtpk(Sacc[tv][0], Sacc[tv][1]); w_.y = cvtpk(Sacc[tv][2], Sacc[tv][3]);
                  *(u32x2*)(STw + v * PQ + (wid * 16 + 4 * l4) * 2) = w_; } }
            asm volatile("s_waitcnt vmcnt(0)" ::: "memory"); __syncthreads();
        }
#undef SC_LOAD
    }
}

namespace fa {
typedef short s16x4 __attribute__((ext_vector_type(4)));
typedef float f32x16 __attribute__((ext_vector_type(16)));
constexpr int QBLK = 32, KVBLK = 64, NW = 8;
constexpr float THR = 8.f;
#define FA_SBAR() __builtin_amdgcn_sched_barrier(0)
DEV int crow(int r, int hi) { return (r & 3) + 8 * (r >> 2) + 4 * hi; }
template <int DQ> DEV int kswz(int row, int colB) { return row * (DQ * 2) + (colB ^ ((row & 7) << 4)); }
template <int DQ> DEV void partialSM(f32x16& p0, f32x16& p1, float& m_reg, float& mn, float& alpha) {
    constexpr float SCALE = DQ == 128 ? 0.08838834764831845f : 0.07216878364870322f;
    constexpr float C = SCALE * 1.4426950408889634f;
    float pmax = p0[0];
#pragma unroll
    for (int r = 1; r < 16; ++r) pmax = fmaxf(pmax, p0[r]);
#pragma unroll
    for (int r = 0; r < 16; ++r) pmax = fmaxf(pmax, p1[r]);
    { auto rr = __builtin_amdgcn_permlane32_swap(__float_as_uint(pmax), __float_as_uint(pmax), false, false);
      pmax = fmaxf(__uint_as_float(rr[0]), __uint_as_float(rr[1])); }
    if (__builtin_expect(__all(pmax - m_reg <= THR / SCALE), 1)) { mn = m_reg; alpha = 1.f; }
    else { mn = fmaxf(m_reg, pmax); alpha = __builtin_amdgcn_exp2f((m_reg - mn) * C); m_reg = mn; }
    const float mnC = -mn * C;
#pragma unroll
    for (int r = 0; r < 16; ++r) p0[r] = fmaf(p0[r], C, mnC);
#pragma unroll
    for (int r = 0; r < 16; ++r) p1[r] = fmaf(p1[r], C, mnC);
#pragma unroll
    for (int r = 0; r < 16; ++r) p0[r] = __builtin_amdgcn_exp2f(p0[r]);
}
DEV void finishSM(f32x16& p0, f32x16& p1, float alpha, float& l_reg, bf16x8& pa0, bf16x8& pa1, bf16x8& pa2, bf16x8& pa3) {
#pragma unroll
    for (int r = 0; r < 16; ++r) p1[r] = __builtin_amdgcn_exp2f(p1[r]);
    float ps = 0;
#pragma unroll
    for (int r = 0; r < 16; ++r) ps += p0[r];
#pragma unroll
    for (int r = 0; r < 16; ++r) ps += p1[r];
    { auto rr = __builtin_amdgcn_permlane32_swap(__float_as_uint(ps), __float_as_uint(ps), false, false);
      ps = __uint_as_float(rr[0]) + __uint_as_float(rr[1]); }
    l_reg = l_reg * alpha + ps;
#define FA_PK4(P, BASE, OUT) do { unsigned a0 = cvtpk(P[BASE + 0], P[BASE + 1]), a1 = cvtpk(P[BASE + 2], P[BASE + 3]);   \
    unsigned b0 = cvtpk(P[BASE + 4], P[BASE + 5]), b1 = cvtpk(P[BASE + 6], P[BASE + 7]);                              \
    auto r0 = __builtin_amdgcn_permlane32_swap(a0, b0, false, false); auto r1 = __builtin_amdgcn_permlane32_swap(a1, b1, false, false); \
    u32x4 w = {r0[0], r1[0], r0[1], r1[1]}; OUT = *reinterpret_cast<bf16x8*>(&w); } while (0)
    FA_PK4(p0, 0, pa0); FA_PK4(p0, 8, pa1); FA_PK4(p1, 0, pa2); FA_PK4(p1, 8, pa3);
#undef FA_PK4
}
template <int DQ> DEV void qkt(f32x16& p0, f32x16& p1, const char* Ks, const bf16x8* qr, int r32, int hi) {
    p0 = f32x16{}; p1 = f32x16{};
#pragma unroll
    for (int d0 = 0; d0 < DQ / 16; ++d0) { const int cb = (d0 * 16 + hi * 8) * 2;
        const bf16x8 b0 = *reinterpret_cast<const bf16x8*>(Ks + kswz<DQ>(r32, cb));
        const bf16x8 b1 = *reinterpret_cast<const bf16x8*>(Ks + kswz<DQ>(32 + r32, cb));
        p0 = __builtin_amdgcn_mfma_f32_32x32x16_bf16(b0, qr[d0], p0, 0, 0, 0);
        p1 = __builtin_amdgcn_mfma_f32_32x32x16_bf16(b1, qr[d0], p1, 0, 0, 0); }
}
DEV int v_st(int k, int c) { const int kk = (k & ~0xC) | ((k & 4) << 1) | ((k & 8) >> 1); return ((kk >> 3) * 4 + (c >> 5)) * 512 + ((kk & 7) * 32 + (c & 31)) * 2; }
DEV int v_rd_base(int lane) { return ((lane & 3) << 3) | (((lane >> 2) & 3) << 6) | (((lane >> 4) & 1) << 5) | (((lane >> 5) & 1) << 8); }
constexpr int v_rd_off(int d0, int ks, int half) { return d0 * 512 + ks * 4096 + half * 2048; }
template <int OFF> DEV s16x4 tr_read(int vb) { s16x4 r; asm volatile("ds_read_b64_tr_b16 %0, %1 offset:%2" : "=&v"(r) : "v"(vb), "i"(OFF) : "memory"); return r; }
template <int D0> DEV void pv_one(f32x16& od, int vb, bf16x8 pa0, bf16x8 pa1, bf16x8 pa2, bf16x8 pa3) {
    const s16x4 l0 = tr_read<v_rd_off(D0, 0, 0)>(vb), h0 = tr_read<v_rd_off(D0, 0, 1)>(vb), l1 = tr_read<v_rd_off(D0, 1, 0)>(vb), h1 = tr_read<v_rd_off(D0, 1, 1)>(vb);
    const s16x4 l2 = tr_read<v_rd_off(D0, 2, 0)>(vb), h2 = tr_read<v_rd_off(D0, 2, 1)>(vb), l3 = tr_read<v_rd_off(D0, 3, 0)>(vb), h3 = tr_read<v_rd_off(D0, 3, 1)>(vb);
    asm volatile("s_waitcnt lgkmcnt(0)" ::: "memory"); FA_SBAR();
#define FA_PK(L, H) (bf16x8){L[0], L[1], L[2], L[3], H[0], H[1], H[2], H[3]}
    od = __builtin_amdgcn_mfma_f32_32x32x16_bf16(pa0, FA_PK(l0, h0), od, 0, 0, 0);
    od = __builtin_amdgcn_mfma_f32_32x32x16_bf16(pa1, FA_PK(l1, h1), od, 0, 0, 0);
    od = __builtin_amdgcn_mfma_f32_32x32x16_bf16(pa2, FA_PK(l2, h2), od, 0, 0, 0);
    od = __builtin_amdgcn_mfma_f32_32x32x16_bf16(pa3, FA_PK(l3, h3), od, 0, 0, 0);
#undef FA_PK
}
DEV void pv_d0(f32x16* o, int vb, bf16x8 pa0, bf16x8 pa1, bf16x8 pa2, bf16x8 pa3) {
    pv_one<0>(o[0], vb, pa0, pa1, pa2, pa3); pv_one<1>(o[1], vb, pa0, pa1, pa2, pa3); pv_one<2>(o[2], vb, pa0, pa1, pa2, pa3); pv_one<3>(o[3], vb, pa0, pa1, pa2, pa3);
}
template <int DQ>
DEV void attn_body(const bf16_t* __restrict__ Qb, const bf16_t* __restrict__ Kh, const bf16_t* __restrict__ Vh, bf16_t* __restrict__ Ob, int LDO_, int seq_, char* lds) {
    constexpr int LDO = D, seq = S; (void)LDO_; (void)seq_;
    constexpr int NKC = DQ / 64, KC8 = DQ / 8;
    constexpr int SHM_V = KVBLK * 128 * 2, SHM_K = KVBLK * DQ * 2;
    const int tid = tid_opaque(), wid = tid >> 6, lane = tid & 63, r32 = lane & 31, hi = lane >> 5;
    char* V_lds = lds; char* K_lds = lds + 2 * SHM_V;
    float* wsx = (float*)(lds + 2 * SHM_V + 2 * SHM_K) + wid * 64; float* li_l = wsx; float* al_l = wsx + 32;
    float m_reg = -1e30f, l_reg = 0; f32x16 o[4] = {}; bf16x8 qr[DQ / 16];
    const bf16_t* Qw = Qb + (size_t)(wid * QBLK + r32) * DQ + hi * 8;
#pragma unroll
    for (int d0 = 0; d0 < DQ / 16; ++d0) qr[d0] = *reinterpret_cast<const bf16x8*>(Qw + d0 * 16);
    const int sr = tid >> 4, sc = (tid & 15) * 8;
    const int vb0 = (int)(uintptr_t)V_lds + v_rd_base(lane);
    struct { bf16x8 vs0, vs1, ks[NKC]; } sr_[2];
#define SLOAD(i, k0) do { sr_[i].vs0 = *reinterpret_cast<const bf16x8*>(&Vh[(size_t)((k0) + sr) * 128 + sc]); sr_[i].vs1 = *reinterpret_cast<const bf16x8*>(&Vh[(size_t)((k0) + 32 + sr) * 128 + sc]); \
    _Pragma("unroll") for (int _c = 0; _c < NKC; ++_c) { const int ch = tid + _c * 512, kr = ch / KC8, kc = ch - kr * KC8; sr_[i].ks[_c] = *reinterpret_cast<const bf16x8*>(&Kh[(size_t)((k0) + kr) * DQ + kc * 8]); } } while (0)
#define SWRITE(b, i) do { const int t2_ = tid_opaque(), sr2_ = t2_ >> 4, sc2_ = (t2_ & 15) * 8; *(bf16x8*)(V_lds + (b) * SHM_V + v_st(sr2_, sc2_)) = sr_[i].vs0; *(bf16x8*)(V_lds + (b) * SHM_V + v_st(32 + sr2_, sc2_)) = sr_[i].vs1; \
    _Pragma("unroll") for (int _c = 0; _c < NKC; ++_c) { const int ch = tid + _c * 512, kr = ch / KC8, kc = ch - kr * KC8; *(bf16x8*)(K_lds + (b) * SHM_K + kswz<DQ>(kr, kc * 16)) = sr_[i].ks[_c]; } } while (0)
#define SWAIT() do { if constexpr (NKC == 2) asm volatile("s_waitcnt vmcnt(4)" ::: "memory"); else asm volatile("s_waitcnt vmcnt(5)" ::: "memory"); } while (0)
#define RESC(a_) do { if (__any((a_) < 1.f)) { if (hi == 0) al_l[r32] = (a_); asm volatile("s_waitcnt lgkmcnt(0)" ::: "memory"); \
    _Pragma("unroll") for (int d = 0; d < 4; ++d) _Pragma("unroll") for (int r = 0; r < 16; ++r) o[d][r] *= al_l[crow(r, hi)]; } } while (0)
    f32x16 pA0, pA1, pB0, pB1; float mnA, mnB, alA, alB; bf16x8 pa0, pa1, pa2, pa3; const int NTL = seq / KVBLK;
    constexpr int SE = 0, SO = 1;
    SLOAD(SE, 0); asm volatile("s_waitcnt vmcnt(0)" ::: "memory"); SWRITE(0, SE); __syncthreads();
    qkt<DQ>(pA0, pA1, K_lds, qr, r32, hi); partialSM<DQ>(pA0, pA1, m_reg, mnA, alA);
    SLOAD(SO, KVBLK); if (2 < NTL) SLOAD(SE, 2 * KVBLK);
    SWAIT(); SWRITE(1, SO); __syncthreads();
    for (int j = 1; j + 1 < NTL; j += 2) {
        FA_SBAR(); qkt<DQ>(pB0, pB1, K_lds + SHM_K, qr, r32, hi);
        finishSM(pA0, pA1, alA, l_reg, pa0, pa1, pa2, pa3); FA_SBAR();
        SLOAD(SO, (j + 2) * KVBLK); FA_SBAR();
        pv_d0(o, vb0, pa0, pa1, pa2, pa3); partialSM<DQ>(pB0, pB1, m_reg, mnB, alB);
        __syncthreads(); SWAIT(); SWRITE(0, SE);
        RESC(alB); __syncthreads();
        FA_SBAR(); qkt<DQ>(pA0, pA1, K_lds, qr, r32, hi);
        finishSM(pB0, pB1, alB, l_reg, pa0, pa1, pa2, pa3); FA_SBAR();
        if (j + 3 < NTL) SLOAD(SE, (j + 3) * KVBLK); FA_SBAR();
        pv_d0(o, vb0 + SHM_V, pa0, pa1, pa2, pa3); partialSM<DQ>(pA0, pA1, m_reg, mnA, alA);
        __syncthreads(); SWAIT(); SWRITE(1, SO);
        RESC(alA); __syncthreads();
    }
    FA_SBAR(); qkt<DQ>(pB0, pB1, K_lds + SHM_K, qr, r32, hi);
    finishSM(pA0, pA1, alA, l_reg, pa0, pa1, pa2, pa3); FA_SBAR();
    pv_d0(o, vb0, pa0, pa1, pa2, pa3); partialSM<DQ>(pB0, pB1, m_reg, mnB, alB);
    __syncthreads(); RESC(alB);
    finishSM(pB0, pB1, alB, l_reg, pa0, pa1, pa2, pa3); FA_SBAR();
    pv_d0(o, vb0 + SHM_V, pa0, pa1, pa2, pa3);
    if (hi == 0) li_l[r32] = l_reg; asm volatile("s_waitcnt lgkmcnt(0)" ::: "memory");
    float rli[16];
#pragma unroll
    for (int r = 0; r < 16; ++r) rli[r] = __builtin_amdgcn_rcpf(li_l[crow(r, hi)]);
    bf16_t* Ow = Ob + (size_t)(wid * QBLK) * LDO;
#pragma unroll
    for (int r = 0; r < 16; ++r) { const int orow = crow(r, hi);
#pragma unroll
        for (int d0 = 0; d0 < 4; ++d0) Ow[(size_t)orow * LDO + d0 * 32 + r32] = f2bf(o[d0][r] * rli[r]); }
    __syncthreads();
#undef SLOAD
#undef SWRITE
#undef SWAIT
#undef RESC
}

template <int DQ>
DEV void attn_body_simple(const bf16_t* __restrict__ Qb, const bf16_t* __restrict__ Kh, const bf16_t* __restrict__ Vh, bf16_t* __restrict__ Ob, int LDO, int seq, char* lds) {
    constexpr int NKC = DQ / 64, KC8 = DQ / 8;
    constexpr int SHM_V = KVBLK * 128 * 2, SHM_K = KVBLK * DQ * 2;
    const int tid = tid_opaque(), wid = tid >> 6, lane = tid & 63, r32 = lane & 31, hi = lane >> 5;
    char* V_lds = lds; char* K_lds = lds + 2 * SHM_V;
    float* wsx = (float*)(lds + 2 * SHM_V + 2 * SHM_K) + wid * 64; float* li_l = wsx; float* al_l = wsx + 32;
    float m_reg = -1e30f, l_reg = 0; f32x16 o[4] = {}; bf16x8 qr[DQ / 16];
    const bf16_t* Qw = Qb + (size_t)(wid * QBLK + r32) * DQ + hi * 8;
#pragma unroll
    for (int d0 = 0; d0 < DQ / 16; ++d0) qr[d0] = *reinterpret_cast<const bf16x8*>(Qw + d0 * 16);
    const int sr = tid >> 4, sc = (tid & 15) * 8, vst0 = v_st(sr, sc), vst1 = v_st(32 + sr, sc);
    const int vb0 = (int)(uintptr_t)V_lds + v_rd_base(lane);
    bf16x8 vs0, vs1, ks[NKC];
#define SLOAD(k0) do { vs0 = *reinterpret_cast<const bf16x8*>(&Vh[(size_t)((k0) + sr) * 128 + sc]); vs1 = *reinterpret_cast<const bf16x8*>(&Vh[(size_t)((k0) + 32 + sr) * 128 + sc]); \
    _Pragma("unroll") for (int _c = 0; _c < NKC; ++_c) { const int ch = tid + _c * 512, kr = ch / KC8, kc = ch - kr * KC8; ks[_c] = *reinterpret_cast<const bf16x8*>(&Kh[(size_t)((k0) + kr) * DQ + kc * 8]); } } while (0)
#define SWRITE(b) do { *(bf16x8*)(V_lds + (b) * SHM_V + vst0) = vs0; *(bf16x8*)(V_lds + (b) * SHM_V + vst1) = vs1; \
    _Pragma("unroll") for (int _c = 0; _c < NKC; ++_c) { const int ch = tid + _c * 512, kr = ch / KC8, kc = ch - kr * KC8; *(bf16x8*)(K_lds + (b) * SHM_K + kswz<DQ>(kr, kc * 16)) = ks[_c]; } } while (0)
    f32x16 p0, p1; float mn, al; bf16x8 pa0, pa1, pa2, pa3; const int NTL = seq / KVBLK;
    SLOAD(0); SWRITE(0); __syncthreads();
    for (int j = 0; j < NTL; ++j) {
        const int bsel = j & 1;
        if (j + 1 < NTL) SLOAD((j + 1) * KVBLK);
        FA_SBAR(); qkt<DQ>(p0, p1, K_lds + bsel * SHM_K, qr, r32, hi);
        partialSM<DQ>(p0, p1, m_reg, mn, al);
        if (__any(al < 1.f)) { if (hi == 0) al_l[r32] = al; asm volatile("s_waitcnt lgkmcnt(0)" ::: "memory");
#pragma unroll
            for (int d = 0; d < 4; ++d)
#pragma unroll
                for (int r = 0; r < 16; ++r) o[d][r] *= al_l[crow(r, hi)]; }
        finishSM(p0, p1, al, l_reg, pa0, pa1, pa2, pa3); FA_SBAR();
        pv_d0(o, vb0 + bsel * SHM_V, pa0, pa1, pa2, pa3);
        if (j + 1 < NTL) SWRITE(bsel ^ 1);
        __syncthreads();
    }
    if (hi == 0) li_l[r32] = l_reg; asm volatile("s_waitcnt lgkmcnt(0)" ::: "memory");
    float rli[16];
#pragma unroll
    for (int r = 0; r < 16; ++r) rli[r] = __builtin_amdgcn_rcpf(li_l[crow(r, hi)]);
    bf16_t* Ow = Ob + (size_t)(wid * QBLK) * LDO;
#pragma unroll
    for (int r = 0; r < 16; ++r) { const int orow = crow(r, hi);
#pragma unroll
        for (int d0 = 0; d0 < 4; ++d0) Ow[(size_t)orow * LDO + d0 * 32 + r32] = f2bf(o[d0][r] * rli[r]); }
    __syncthreads();
#undef SLOAD
#undef SWRITE
}
}

template <int DQ, int HKV, bool WITH_CTX>
DEV void attn_phase(const Args& a, int colbase, char* smem) {
    const bf16_t* Qb = (const bf16_t*)(a.ws + WS_QB); const bf16_t* Kb = (const bf16_t*)(a.ws + WS_KB); const bf16_t* Vb = (const bf16_t*)(a.ws + WS_VB);
    bf16_t* A2 = (bf16_t*)(a.ws + WS_A2);
    const int nunits = 256 + (WITH_CTX ? 32 : 0);
    for (int u = blockIdx.x; u < nunits; u += gridDim.x) {
        int b, hh, qb, nk;
        if (u < 256) { if (HKV == 8) { const int bh = u & 31; b = bh >> 3; hh = bh & 7; qb = 1 + (u >> 5); }
                       else { const int pr = u & 7, rest = u >> 3; b = pr >> 1; hh = (pr & 1) * 4 + (rest & 3); qb = 1 + (rest >> 2); }
                       nk = S; }
        else { const int bh = u - 256; b = bh >> 3; hh = bh & 7; qb = 0; nk = TC; }
        const int hk = hh / (8 / HKV);
        if constexpr (DQ == 192) fa::attn_body_simple<DQ>(Qb + (((size_t)b * 8 + hh) * S + qb * 256) * DQ, Kb + ((size_t)b * HKV + hk) * S * DQ, Vb + ((size_t)b * HKV + hk) * S * 128,
                          A2 + ((size_t)b * S + qb * 256) * D + colbase + hh * 128, D, nk, smem);
        else fa::attn_body<DQ>(Qb + (((size_t)b * 8 + hh) * S + qb * 256) * DQ, Kb + ((size_t)b * HKV + hk) * S * DQ, Vb + ((size_t)b * HKV + hk) * S * 128,
                          A2 + ((size_t)b * S + qb * 256) * D + colbase + hh * 128, D, nk, smem);
    }
}

template <int MODE>
DEV void mixout_phase(const Args& a, bool latent_only) {
    const int tid = tid_opaque(), w = tid >> 6, lane = tid & 63;
    constexpr int NH = MODE == 0 ? 8 : 4, DV = MODE == 0 ? 128 : 256, LDP = MODE == 0 ? AB_INP : CD_INP, GC = MODE == 0 ? 4096 : 3584, CB = MODE == 0 ? 0 : 1024, PER = DV / 64;
    const bf16_t* P = (const bf16_t*)(a.ws + WS_P); const float* odir = (const float*)(a.ws + WS_ODIR); bf16_t* A2 = (bf16_t*)(a.ws + WS_A2);
    const float* g = MODE == 0 ? a.in[12] : a.in[23];
    for (int it = blockIdx.x * 8 + w; it < R * NH; it += gridDim.x * 8) {
        const int r = it / NH, hd = it - r * NH; const int t = r % S; if (latent_only && t < TC) continue;
        float o[PER]; float ss = 0.f;
#pragma unroll
        for (int j = 0; j < PER; ++j) { const int c = hd * DV + j * 64 + lane; o[j] = odir[(size_t)r * 1024 + c] + odir[((size_t)R + r) * 1024 + c]; ss += o[j] * o[j]; }
        ss = wave_sum(ss); const float rs = rsqrtf(ss * (1.f / DV) + EPS);
#pragma unroll
        for (int j = 0; j < PER; ++j) { const int c = hd * DV + j * 64 + lane; const float gt = bf2f(P[(size_t)r * LDP + GC + c]);
            const float act = MODE == 0 ? sigmoidf_(gt) : siluf_(gt);
            A2[(size_t)r * D + CB + c] = f2bf(o[j] * rs * g[j * 64 + lane] * act); }
    }
}

#define GAS __attribute__((address_space(1)))
typedef GAS unsigned gu32; typedef GAS unsigned long long gu64;
#define RLX_AGENT __ATOMIC_RELAXED, __HIP_MEMORY_SCOPE_AGENT
struct EpiMoeUpSc1 { bf16_t* hid; int rowbase, nvalid;
    DEV void operator()(const f32x4 (&acc)[2][2][4][2], int brow, int bcol, int wr, int wc, int fr, int fq) const {
        const int hc = (bcol >> 1) + wc * 32 + fq * 4;
#pragma unroll
        for (int ai = 0; ai < 2; ++ai)
#pragma unroll
            for (int m = 0; m < 4; ++m) { const int lr = ai * HALF + wr * 64 + m * 16 + fr;
                if (lr < nvalid) { bf16_t* rowp = hid + (size_t)(rowbase + lr) * EDIM + hc;
#pragma unroll
                    for (int n = 0; n < 2; ++n) { const f32x4 a_ = acc[ai][0][m][n], b_ = acc[ai][1][m][n];
                        const unsigned lo = cvtpk(siluf_(a_[0]) * b_[0], siluf_(a_[1]) * b_[1]), hi = cvtpk(siluf_(a_[2]) * b_[2], siluf_(a_[3]) * b_[3]);
                        __hip_atomic_store((gu64*)(rowp + n * 16), (unsigned long long)lo | ((unsigned long long)hi << 32), RLX_AGENT); } } }
    } };
DEV void moe_phase_fused(const Args& a, int l, char* smem) {
    const int tid = tid_opaque();
    unsigned* ctl = (unsigned*)(a.ws + WS_CTL);
    unsigned* cnt = ctl + CW_CNT + l * 16; unsigned* head = ctl + CW_MOEQ + l * 64; unsigned* ready = ctl + CW_RDY + l * (NE * 36 * 16);
    const int* list = (const int*)(a.ws + WS_LIST);
    const bf16_t* h = (const bf16_t*)(a.ws + WS_H); const bf16_t* w13 = moe_w13(a, l); const bf16_t* w2 = moe_w2(a, l);
    bf16_t* hid = (bf16_t*)(a.ws + WS_QB); bf16_t* y = (bf16_t*)(a.ws + WS_P);
    volatile int* tab = (volatile int*)(smem + SHM_GEMM);
    if (tid == 0) { int ub = 0, of = 0, nts[NE];
        for (int e = 0; e < NE; ++e) { const int n = (int)__hip_atomic_load((gu32*)(cnt + e), RLX_AGENT); nts[e] = (n + 255) >> 8; tab[e] = n; tab[16 + e] = ub; tab[50 + e] = of; ub += nts[e] * 4; of += n; }
        tab[32] = ub; int db = ub;
        for (int e = 0; e < NE; ++e) { tab[33 + e] = db; db += nts[e] * 8; }
        tab[49] = db; }
    for (;;) {
        __syncthreads();
        if (tid == 0) tab[66] = (int)__hip_atomic_fetch_add((gu32*)head, 1u, RLX_AGENT);
        __syncthreads();
        const int item = __builtin_amdgcn_readfirstlane(tab[66]), nup = __builtin_amdgcn_readfirstlane(tab[32]), ntot = __builtin_amdgcn_readfirstlane(tab[49]);
        if (item >= ntot) break;
        const bool up = item < nup; const int tb0 = up ? 16 : 33;
        int e = 0;
#pragma unroll 1
        for (int q = 1; q < NE; ++q) if (item >= __builtin_amdgcn_readfirstlane(tab[tb0 + q])) e = q;
        const int n = __builtin_amdgcn_readfirstlane(tab[e]), nt_ = (n + 255) >> 8, t = item - __builtin_amdgcn_readfirstlane(tab[tb0 + e]), off = __builtin_amdgcn_readfirstlane(tab[50 + e]);
        const int i = t % nt_, pn = t / nt_, nv = min(256, n - i * 256);
        gu32* flag = (gu32*)(ready + (e * 36 + i) * 16);
        if (up) {
            EpiMoeUpSc1 epi{hid, off + i * 256, nv};
            gemm_tile<true>(h, w13 + (size_t)e * 1024 * D, D, D, 0, pn * 256, list + (size_t)e * R + i * 256, nv, smem, epi);
            asm volatile("s_waitcnt vmcnt(0)" ::: "memory");
            __syncthreads();
            if (tid == 0) __hip_atomic_fetch_add(flag, 1u, RLX_AGENT);
        } else {
            if (tid < 64) { unsigned spins = 0;
                while ((unsigned)__builtin_amdgcn_readfirstlane(__hip_atomic_load(flag, RLX_AGENT)) < 4u) { __builtin_amdgcn_s_sleep(2); if (++spins > (1u << 22)) break; }
                __builtin_amdgcn_fence(__ATOMIC_ACQUIRE, "agent");
                asm volatile("s_waitcnt vmcnt(0)" ::: "memory"); }
            __syncthreads();
            EpiMoeDown epi{y, list + (size_t)e * R + i * 256, nv};
            gemm_tile<false>(hid, w2 + (size_t)e * D * EDIM, EDIM, EDIM, off + i * 256, pn * 256, nullptr, 0, smem, epi);
        }
    }
    __syncthreads();
}

DEV void moe_phase_up(const Args& a, int l, char* smem) {
    unsigned* cnt = (unsigned*)(a.ws + WS_CTL) + CW_CNT + l * 16;
    const int* list = (const int*)(a.ws + WS_LIST);
    const bf16_t* h = (const bf16_t*)(a.ws + WS_H); const bf16_t* w13 = moe_w13(a, l); bf16_t* hid = (bf16_t*)(a.ws + WS_QB);
    int u = blockIdx.x, base = 0, off = 0;
    for (int e = 0; e < NE; ++e) { const int n = (int)__builtin_amdgcn_readfirstlane(__hip_atomic_load(cnt + e, __ATOMIC_RELAXED, __HIP_MEMORY_SCOPE_AGENT)), nt_ = (n + 255) >> 8, nu = nt_ * 4;
        for (; u < base + nu; u += gridDim.x) { const int t = u - base, i = t % nt_, pn = t / nt_; const int nv = min(256, n - i * 256);
            EpiMoeUp epi{hid, off + i * 256, nv};
            gemm_tile<true>(h, w13 + (size_t)e * 1024 * D, D, D, 0, pn * 256, list + (size_t)e * R + i * 256, nv, smem, epi); }
        base += nu; off += n; }
}
DEV void moe_phase_down(const Args& a, int l, char* smem) {
    unsigned* cnt = (unsigned*)(a.ws + WS_CTL) + CW_CNT + l * 16;
    const int* list = (const int*)(a.ws + WS_LIST);
    const bf16_t* hid = (const bf16_t*)(a.ws + WS_QB); const bf16_t* w2 = moe_w2(a, l); bf16_t* y = (bf16_t*)(a.ws + WS_P);
    int u = blockIdx.x, base = 0, off = 0;
    for (int e = 0; e < NE; ++e) { const int n = (int)__builtin_amdgcn_readfirstlane(__hip_atomic_load(cnt + e, __ATOMIC_RELAXED, __HIP_MEMORY_SCOPE_AGENT)), nt_ = (n + 255) >> 8, nu = nt_ * 8;
        for (; u < base + nu; u += gridDim.x) { const int t = u - base, i = t % nt_, pn = t / nt_; const int nv = min(256, n - i * 256);
            EpiMoeDown epi{y, list + (size_t)e * R + i * 256, nv};
            gemm_tile<false>(hid, w2 + (size_t)e * D * EDIM, EDIM, EDIM, off + i * 256, pn * 256, nullptr, 0, smem, epi); }
        base += nu; off += n; }
}
template <bool FINAL>
DEV void combine_phase(const Args& a, int l, bool latent_only, bool dry = false) {
    const int tid = tid_opaque(), w = tid >> 6, lane = tid & 63;
    bf16_t* xres = (bf16_t*)(a.ws + WS_XRES); const bf16_t* y = (const bf16_t*)(a.ws + WS_P); const int* tok = (const int*)(a.ws + WS_TOK);
    const float* modv = (const float*)(a.ws + WS_MODV) + (size_t)l * 5 * MODN; bf16_t* h = (bf16_t*)(a.ws + WS_H);
    const float* gain = FINAL ? a.in[8] : a.in[6] + (size_t)(l + 1) * D;
    for (int r = blockIdx.x * 8 + w; r < R; r += gridDim.x * 8) {
        const int b = r / S, t = r - b * S; if (latent_only && t < TC) continue;
        const int v = t < TC ? 4 : b; const float w0 = ((const float*)tok)[r * 4 + 2], w1 = ((const float*)tok)[r * 4 + 3];
        const float* g2 = modv + (size_t)v * MODN + 5 * D; bf16_t* xp = xres + (size_t)r * D; const bf16_t* y0 = y + (size_t)(2 * r) * D; const bf16_t* y1 = y0 + D;
        f32x4 x[8]; float ss = 0.f;
#pragma unroll
        for (int j = 0; j < 8; ++j) { const int c = j * 256 + lane * 4;
            const u32x2 a0 = *(const u32x2*)(y0 + c), a1 = *(const u32x2*)(y1 + c);
            const f32x4 yy = {w0 * bflo(a0.x) + w1 * bflo(a1.x), w0 * bfhi(a0.x) + w1 * bfhi(a1.x), w0 * bflo(a0.y) + w1 * bflo(a1.y), w0 * bfhi(a0.y) + w1 * bfhi(a1.y)};
            const u32x2 xq = *(const u32x2*)(xp + c);
            x[j] = (f32x4){bflo(xq.x), bfhi(xq.x), bflo(xq.y), bfhi(xq.y)} + *(const f32x4*)(g2 + c) * yy;
            if (!FINAL && !dry) { u32x2 xw; xw.x = cvtpk(x[j][0], x[j][1]); xw.y = cvtpk(x[j][2], x[j][3]); *(u32x2*)(xp + c) = xw; }
            ss += x[j][0] * x[j][0] + x[j][1] * x[j][1] + x[j][2] * x[j][2] + x[j][3] * x[j][3]; }
        ss = wave_sum(ss); const float rs = rsqrtf(ss * (1.f / D) + EPS);
        if (FINAL) { float* op = a.out + ((size_t)b * TL + (t - TC)) * D;
#pragma unroll
            for (int j = 0; j < 8; ++j) { const int c = j * 256 + lane * 4; *(f32x4*)(op + c) = x[j] * rs * *(const f32x4*)(gain + c); } }
        else { const float* sh = modv + 5 * MODN + (size_t)v * MODN; const float* sc = sh + D;
#pragma unroll
            for (int j = 0; j < 8; ++j) { const int c = j * 256 + lane * 4;
                const f32x4 yv = (x[j] * rs * *(const f32x4*)(gain + c)) * (1.f + *(const f32x4*)(sc + c)) + *(const f32x4*)(sh + c);
                u32x2 pk; pk.x = cvtpk(yv[0], yv[1]); pk.y = cvtpk(yv[2], yv[3]); if (!dry) *(u32x2*)(h + (size_t)r * D + c) = pk; } }
    }
}

constexpr int LDS_BYTES = 140 * 1024;
constexpr int NPHASES = 25;
__global__ void __launch_bounds__(NT, 2) fwd(Args a) {
    extern __shared__ __attribute__((aligned(16))) char smem[];
    unsigned char* ws = a.ws;
    const int lo = a.ph_lo, hi = a.ph_hi;
    volatile LAS unsigned* xbw = (volatile LAS unsigned*)(smem + LDS_BYTES - 16);
    if (threadIdx.x < 4) xbw[threadIdx.x] = 0u;
    __syncthreads();
    XcdBarrier bar; bar.bar = (unsigned*)(ws + WS_CTL); bar.x = 0; bar.st = xbw;
    if (hi - lo > 1) bar = xcd_barrier_post((unsigned*)(ws + WS_CTL), xbw);
#ifndef BARRIER_REP
#define BARRIER_REP 1
#endif
#define SEAM(k) do { if (IN(k) && IN((k) + 1)) { for (int br_ = 0; br_ < BARRIER_REP; ++br_) xcd_barrier(bar); } } while (0)
#ifndef PHASE_MASK
#define PHASE_MASK 0xFFFFFFFFu
#endif
#define IN(k) (((PHASE_MASK >> (k)) & 1u) && lo <= (k) && (k) < hi)
#ifndef REPEAT_MASK
#define REPEAT_MASK 0u
#endif
#ifndef SUBREP
#define SUBREP 0
#endif
#define PHASE(k) if (IN(k)) for (int rep_ = 0; rep_ < ((((REPEAT_MASK) >> (k)) & 1u) ? 2 : 1); ++rep_, ((((REPEAT_MASK) >> (k)) & 1u) ? __syncthreads() : (void)0))
    const float* modv = (const float*)(ws + WS_MODV);
    bf16_t* H = (bf16_t*)(ws + WS_H); bf16_t* P = (bf16_t*)(ws + WS_P); bf16_t* A2 = (bf16_t*)(ws + WS_A2); bf16_t* XR = (bf16_t*)(ws + WS_XRES);
    PHASE(0) {
        cvt_weight(a.in[9], (bf16_t*)(ws + WS_WABIN), D, AB_IN, AB_INP, 1, 0, 0, 128, 0, nullptr, smem, 2);
        mod_phase<false>(a, 0, smem);
        misc_phase(a);
    }
    SEAM(0);
    PHASE(1) norm_phase<false, true>(a, 0, 0, a.in[6], false, smem);
    SEAM(1);
    PHASE(2) { int cur = 0; EpiInAB e{P, (float*)(ws + WS_SSQ), (bf16_t*)(ws + WS_KB), (const float2*)(ws + WS_TABB), smem};
                 (void)cur; gemm_stream(H, (const bf16_t*)(ws + WS_WABIN), R, AB_INP, D, smem, e);
                 if (rep_ == 0) { cvt_cd_dynamic(a, smem); mod_phase<true>(a, 1, smem); } }
    SEAM(2);
    PHASE(3) { int cur = 0; EpiUQ e1{(bf16_t*)(ws + WS_QB), (const float*)(ws + WS_SSQ), (const float2*)(ws + WS_TABB)};
                 (void)cur; gemm_stream<false, AB_INP>(P + 5120, (const bf16_t*)(ws + WS_WUQ), R, 1536, 512, smem, e1);
                 EpiUKV e2{(bf16_t*)(ws + WS_KB), (bf16_t*)(ws + WS_VB), (const float*)(ws + WS_SSQ)};
                 gemm_stream<false, AB_INP>(P + 5632, (const bf16_t*)(ws + WS_WUKV), R, 2048, 256, smem, e2);
                 scan_prep_phase<0>(a, smem); if (SUBREP & 1) scan_prep_phase<0>(a, smem); }
    SEAM(3);
    PHASE(6) scan_seq_phase<0>(a, smem);
    PHASE(7) attn_phase<192, 8, true>(a, 1024, smem);
    SEAM(7);
    PHASE(8) { mixout_phase<0>(a, false); if (SUBREP & 2) mixout_phase<0>(a, false); }
    SEAM(8);
    PHASE(9) { int cur = 0; EpiResidGate e{XR, modv + 2 * D, rep_ > 0, rep_ > 0 ? nullptr : a.in[0], a.in[2]}; (void)cur; gemm_stream(A2, (const bf16_t*)(ws + WS_WABOUT), R, D, D, smem, e); cvt_moe_dynamic(a, 0, smem); }
    SEAM(9);
    PHASE(10) norm_phase<true>(a, 0, 3, a.in[7], false, smem, rep_ > 0);
    SEAM(10);
#ifndef MOE_SPLIT
    PHASE(11) { moe_phase_fused(a, 0, smem); cvt_moe_dynamic(a, 1, smem); }
    SEAM(11);
#else
    PHASE(11) { moe_phase_up(a, 0, smem); cvt_moe_dynamic(a, 1, smem); }
    SEAM(11);
    PHASE(12) { moe_phase_down(a, 0, smem); cvt_moe_dynamic(a, 1, smem); }
    SEAM(12);
#endif
    PHASE(13) { combine_phase<false>(a, 0, false, rep_ > 0); cvt_moe_dynamic(a, 1, smem); }
    SEAM(13);
    PHASE(15) { int cur = 0; EpiInCD e{P, (bf16_t*)(ws + WS_QB), (bf16_t*)(ws + WS_KB), (bf16_t*)(ws + WS_VB), (const float2*)(ws + WS_TABC), a.in[19], a.in[20], smem}; (void)cur; gemm_stream(H, (const bf16_t*)(ws + WS_WCDIN), R, CD_INP, D, smem, e); }
    SEAM(15);
    PHASE(16) { scan_prep_phase<1>(a, smem); if (SUBREP & 1) scan_prep_phase<1>(a, smem); }
    SEAM(16);
    PHASE(17) scan_seq_phase<1>(a, smem);
    PHASE(18) attn_phase<128, 2, false>(a, 0, smem);
    SEAM(18);
    PHASE(19) { mixout_phase<1>(a, true); if (SUBREP & 2) mixout_phase<1>(a, true); }
    SEAM(19);
    PHASE(20) { int cur = 0; EpiResidGate e{XR, modv + 5 * MODN + 2 * D, rep_ > 0, nullptr, nullptr}; (void)cur; gemm_stream<true>(A2, (const bf16_t*)(ws + WS_WCDOUT), NB * TL, D, D, smem, e); }
    SEAM(20);
    PHASE(21) norm_phase<true>(a, 1, 3, a.in[7] + D, true, smem, rep_ > 0);
    SEAM(21);
#ifndef MOE_SPLIT
    PHASE(22) moe_phase_fused(a, 1, smem);
    SEAM(22);
#else
    PHASE(22) moe_phase_up(a, 1, smem);
    SEAM(22);
    PHASE(23) moe_phase_down(a, 1, smem);
    SEAM(23);
#endif
    PHASE(24) combine_phase<true>(a, 1, true);
#undef IN
#undef PHASE
#undef SEAM
}

extern "C" void kernel_launch(void* const* d_in, const int* in_sizes, int n_in, void* d_out, int out_size, void* d_ws, size_t ws_size, hipStream_t stream) {
    static int grid = 0;
    if (grid == 0) {
        if (n_in != 29 || out_size != NB * TL * D || ws_size < WS_END) { fprintf(stderr, "kernel_launch: shape/workspace mismatch: n_in %d out %d ws %zu (need %zu)\n", n_in, out_size, ws_size, (size_t)WS_END); grid = -1; return; }
        int dev = 0, cus = 0;
        if (hipGetDevice(&dev) != hipSuccess || hipDeviceGetAttribute(&cus, hipDeviceAttributeMultiprocessorCount, dev) != hipSuccess) { grid = -1; return; }
        if (hipFuncSetAttribute((const void*)fwd, hipFuncAttributeMaxDynamicSharedMemorySize, LDS_BYTES) != hipSuccess) { fprintf(stderr, "kernel_launch: hipFuncSetAttribute failed\n"); grid = -1; return; }
        grid = cus > 0 ? cus : 256;
    }
    if (grid < 0) return;
    (void)hipMemsetAsync((char*)d_ws + WS_CTL, 0, CTL_BYTES, stream);
    Args a{};
    for (int i = 0; i < 29; ++i) a.in[i] = (const float*)d_in[i];
    a.out = (float*)d_out; a.ws = (unsigned char*)d_ws;
#ifndef MK_PER_PHASE
    a.ph_lo = 0; a.ph_hi = NPHASES; hipLaunchKernelGGL(fwd, dim3(grid), dim3(NT), LDS_BYTES, stream, a);
#else
    for (int ph = 0; ph < NPHASES; ++ph) { a.ph_lo = ph; a.ph_hi = ph + 1; hipLaunchKernelGGL(fwd, dim3(grid), dim3(NT), LDS_BYTES, stream, a); }
#endif
}
```

```cpp
#include <hip/hip_runtime.h>
#include <cstdio>
#include <cstdint>

#define DEV __device__ __forceinline__
typedef unsigned short bf16_t;
typedef short bf16x8 __attribute__((ext_vector_type(8)));
typedef float f32x4 __attribute__((ext_vector_type(4)));
typedef unsigned u32x4 __attribute__((ext_vector_type(4)));
typedef unsigned u32x2 __attribute__((ext_vector_type(2)));

constexpr int NB = 4, TL = 2048, TC = 256, S = TL + TC, R = NB * S, D = 2048;
constexpr int NT = 512;
constexpr float EPS = 1e-6f;
constexpr int AB_IN = 5952, AB_INP = 6144, CD_IN = 4640, CD_INP = 4864;
constexpr int NE = 16, EDIM = 512;
constexpr int MODN = 6 * D;

constexpr size_t al256(size_t x) { return (x + 255) & ~(size_t)255; }
constexpr size_t WS_CTL = 0;
constexpr int    CW_CNT = 26624;
constexpr int    CNT_STRIDE = 64;
constexpr int    CW_CVT = 4224;
constexpr size_t CTL_BYTES = 131072;
constexpr int    CW_MOEQ = 4608;
constexpr int    CW_RDY = 8192;
constexpr size_t WS_MODV = WS_CTL + CTL_BYTES;
constexpr size_t WS_LB   = al256(WS_MODV + (size_t)2 * 5 * MODN * 4);
constexpr size_t WS_TABB = al256(WS_LB + 2 * 1024 * 4);
constexpr size_t WS_TABC = al256(WS_TABB + (size_t)TL * 32 * 8);
constexpr size_t WS_TOK  = al256(WS_TABC + (size_t)TL * 64 * 8);
constexpr size_t WS_LIST = al256(WS_TOK + (size_t)R * 16);
constexpr size_t WS_WABIN = al256(WS_LIST + (size_t)NE * R * 4);
constexpr size_t WS_WABOUT = al256(WS_WABIN + (size_t)AB_INP * D * 2);
constexpr size_t WS_WUQ  = al256(WS_WABOUT + (size_t)D * D * 2);
constexpr size_t WS_WUKV = al256(WS_WUQ + (size_t)1536 * 512 * 2);
constexpr size_t WS_WCDIN = al256(WS_WUKV + (size_t)2048 * 256 * 2);
constexpr size_t WS_WCDOUT = al256(WS_WCDIN + (size_t)CD_INP * D * 2);
constexpr size_t WS_W13  = al256(WS_WCDOUT + (size_t)D * D * 2);
constexpr size_t WS_W2   = al256(WS_W13 + (size_t)NE * 1024 * D * 2);
constexpr size_t WS_XRES = al256(WS_W2 + (size_t)NE * D * EDIM * 2);
constexpr size_t WS_H    = al256(WS_XRES + (size_t)R * D * 2);
constexpr size_t WS_P    = al256(WS_H + (size_t)R * D * 2);
constexpr size_t WS_ODIR = al256(WS_P + (size_t)R * AB_INP * 2);
constexpr size_t WS_QF   = WS_ODIR;
constexpr size_t WS_KVF  = al256(WS_QF + (size_t)R * 1536 * 2);
static_assert(WS_KVF + (size_t)R * 2048 * 2 <= WS_ODIR + (size_t)2 * R * 1024 * 4, "QF/KVF alias ODIR");
constexpr size_t WS_A2   = al256(WS_ODIR + (size_t)2 * R * 1024 * 4);
constexpr size_t WS_QB   = al256(WS_A2 + (size_t)R * D * 2);
constexpr size_t WS_KB   = al256(WS_QB + (size_t)NB * 8 * S * 192 * 2);
constexpr size_t WS_VB   = al256(WS_KB + (size_t)NB * 8 * S * 192 * 2);
constexpr size_t WS_SSQ  = al256(WS_VB + (size_t)NB * 8 * S * 128 * 2);
constexpr size_t WS_P5N_UNUSED = al256(WS_VB + (size_t)NB * 8 * S * 128 * 2);
constexpr size_t WS_P6N  = al256(WS_SSQ + (size_t)R * 16);
constexpr size_t WS_SVT  = WS_P6N;
constexpr size_t WS_SREC = al256(WS_SVT + (size_t)NB * 8 * 2 * 36 * 128 * 144);
constexpr int PA = 144, PQ = 272;
constexpr int REC_A = 0, REC_QH = 64 * PA, REC_KHT = REC_QH + 64 * PQ, REC_AL = REC_KHT + 128 * PA, REC_BYTES = REC_AL + 512;
constexpr size_t WS_END  = al256(WS_SREC + (size_t)NB * 8 * 2 * 36 * REC_BYTES);
constexpr size_t WS_SVT1 = WS_W13;
constexpr size_t WS_SREC1 = al256(WS_SVT1 + (size_t)NB * 4 * 2 * 36 * 256 * 144);
static_assert(WS_SREC1 + (size_t)NB * 4 * 2 * 36 * REC_BYTES <= WS_XRES, "layer-1 scan images alias");
static_assert(WS_SVT + (size_t)NE * 1024 * D * 2 + (size_t)NE * D * EDIM * 2 <= WS_END, "layer-1 MoE weights alias");
static_assert((size_t)(2 * R + 256) * 512 * 2 <= WS_KB - WS_QB, "HIDDEN alias");
static_assert((size_t)R * 2 * D * 2 <= WS_ODIR - WS_P, "YSLOTS alias");

struct Args { const float* in[29]; float* out; unsigned char* ws; int ph_lo, ph_hi; };

typedef __bf16 bf16v2_t __attribute__((ext_vector_type(2)));
DEV unsigned cvtpk(float lo, float hi) { bf16v2_t v; v.x = (__bf16)lo; v.y = (__bf16)hi; return __builtin_bit_cast(unsigned, v); }
DEV bf16_t f2bf(float x) { return (bf16_t)(cvtpk(x, 0.f) & 0xffffu); }
DEV float bf2f(bf16_t x) { return __uint_as_float(((unsigned)x) << 16); }
DEV float bflo(unsigned w) { return __uint_as_float(w << 16); }
DEV float bfhi(unsigned w) { return __uint_as_float(w & 0xffff0000u); }
DEV float sigmoidf_(float x) { return 1.f / (1.f + __expf(-x)); }
DEV float siluf_(float x) { return x / (1.f + __expf(-x)); }
DEV float wave_sum(float v) {
#pragma unroll
    for (int o = 32; o >= 1; o >>= 1) v += __shfl_xor(v, o);
    return v;
}
DEV float wave_max(float v) {
#pragma unroll
    for (int o = 32; o >= 1; o >>= 1) v = fmaxf(v, __shfl_xor(v, o));
    return v;
}
DEV int tid_opaque() { int t = threadIdx.x; asm volatile("" : "+v"(t)); return t; }
DEV int modvec_of_row(int r) { const int b = r / S, t = r - b * S; return t < TC ? 4 : b; }

#define XB_TMO      128
#define XB_XCNT(j)  (256  + 64 * (j))
#define XB_XSUB(j)  (1280 + 64 * (j))
#define XB_XGEN(j)  (2304 + 64 * (j))
#define XB_TOP      3328
#define XB_TOPGEN   3392
#define XCD_BAR_WORDS 3456
#define XB_SPIN_CAP (1u << 18)
#define LAS __attribute__((address_space(3)))

__device__ __forceinline__ unsigned xb_ld(unsigned* p)              { return __hip_atomic_load(p, __ATOMIC_RELAXED, __HIP_MEMORY_SCOPE_AGENT); }
__device__ __forceinline__ unsigned xb_add(unsigned* p, unsigned v) { return __hip_atomic_fetch_add(p, v, __ATOMIC_RELAXED, __HIP_MEMORY_SCOPE_AGENT); }
__device__ __forceinline__ unsigned xb_xcc_id() { return (unsigned)__builtin_amdgcn_s_getreg((3 << 11) | 20) & 0xFu; }
#define XB_SPIN(cond, bar) do { unsigned _sp = 0; while (cond) { __builtin_amdgcn_s_sleep(1); \
    if ((++_sp & 255u) == 0u) { if (xb_ld(&(bar)[XB_TMO])) break; if (_sp > XB_SPIN_CAP) { atomicAdd(&(bar)[XB_TMO], 1u); break; } } } } while (0)

struct XcdBarrier {
    unsigned* bar; unsigned x;
    volatile LAS unsigned* st;
};

__device__ __forceinline__ XcdBarrier xcd_barrier_post(unsigned* bar, volatile LAS unsigned* st) {
    XcdBarrier b; b.bar = bar; b.x = xb_xcc_id(); b.st = st;
    if (threadIdx.x == 0) (void)xb_add(&bar[XB_XCNT(b.x)], 1u);
    return b;
}
__device__ __forceinline__ void xcd_barrier_complete(unsigned* bar, unsigned x, unsigned& nloc, unsigned& nx) {
    const unsigned G = gridDim.x * gridDim.y * gridDim.z;
    unsigned sum, cnt, mine, sp = 0u;
    for (;;) {
        sum = 0u; cnt = 0u; mine = 0u;
#pragma unroll
        for (unsigned j = 0; j < 16; ++j) { const unsigned c = xb_ld(&bar[XB_XCNT(j)]); sum += c; cnt += (c > 0u) ? 1u : 0u; mine = (j == x) ? c : mine; }
        if (sum == G) break;
        __builtin_amdgcn_s_sleep(1);
        if ((++sp & 255u) == 0u) { if (xb_ld(&bar[XB_TMO])) break; if (sp > XB_SPIN_CAP) { atomicAdd(&bar[XB_TMO], 1u); break; } }
    }
    nloc = mine > 0u ? mine : 1u; nx = cnt > 0u ? cnt : 1u;
}

__device__ __forceinline__ void xcd_barrier(const XcdBarrier& b) {
    asm volatile("s_waitcnt vmcnt(0)" ::: "memory");
    __syncthreads();
    if (threadIdx.x == 0) {
        unsigned* bar = b.bar;
        __builtin_amdgcn_s_waitcnt(0);
        unsigned nloc = b.st[0], nx = b.st[1];
        if (nloc == 0u) { xcd_barrier_complete(bar, b.x, nloc, nx); b.st[0] = nloc; b.st[1] = nx; }
        const unsigned old = xb_add(&bar[XB_XSUB(b.x)], 1u);
        const unsigned gen = old / nloc;
        if (old + 1u == (gen + 1u) * nloc) {
            __builtin_amdgcn_fence(__ATOMIC_RELEASE, "agent");
            asm volatile("s_waitcnt vmcnt(0)" ::: "memory");
            const unsigned og = xb_add(&bar[XB_TOP], 1u);
            const unsigned tg = og / nx;
            if (og + 1u == (tg + 1u) * nx) xb_add(&bar[XB_TOPGEN], 1u);
            else XB_SPIN(xb_ld(&bar[XB_TOPGEN]) == tg, bar);
            __builtin_amdgcn_fence(__ATOMIC_ACQUIRE, "agent");
            xb_add(&bar[XB_XGEN(b.x)], 1u);
            asm volatile("s_waitcnt vmcnt(0)" ::: "memory");
        } else {
            XB_SPIN(xb_ld(&bar[XB_XGEN(b.x)]) == gen, bar);
            __builtin_amdgcn_fence(__ATOMIC_ACQUIRE, "agent");
            asm volatile("s_waitcnt vmcnt(0)" ::: "memory");
        }
    }
    __syncthreads();
}


constexpr int BM = 256, BK = 64, HALF = 128, HT = HALF * BK, SHM_GEMM = 8 * HT * 2;
DEV int lds_byte(int r, int c) { int st = (r >> 4) * 2 + (c >> 5), rr = r & 15, cc = c & 31, ob = rr * 64 + cc * 2; return st * 1024 + (ob ^ (((ob >> 9) & 1) << 5)); }
DEV void stage_rc(int b, int& Rr, int& Cc) { int st = b / 1024, sb = b % 1024, swz = sb ^ (((sb >> 9) & 1) << 5); Rr = (st >> 1) * 16 + swz / 64; Cc = (st & 1) * 32 + (swz % 64) / 2; }

template <bool GATHER, int LDA_ = 0, class Epi>
DEV void gemm_tile(const bf16_t* __restrict__ A, const bf16_t* __restrict__ Bt, int ld, int K, int brow, int bcol,
                   const int* __restrict__ rowmap, int nvalid, char* smem, const Epi& epi) {
    bf16_t* shm = (bf16_t*)smem;
#define SA(b, h) (shm + ((b) * 2 + (h)) * HT)
#define SB(b, h) (shm + (4 + (b) * 2 + (h)) * HT)
#define GLDS(gp, lp) __builtin_amdgcn_global_load_lds((const unsigned*)(gp), (unsigned*)(lp), 16, 0, 0)
#define STAGE_A(P, h, kt) do { _Pragma("unroll") for (int _i = 0; _i < 2; ++_i) { \
        const char* _sb = GATHER ? (const char*)A + (size_t)(kt) * (BK * 2) : (const char*)A + ((size_t)(brow + (h) * HALF + _i * 64) * (LDA_ ? LDA_ : ld) + (size_t)(kt) * BK) * 2; \
        GLDS(_sb + (GATHER ? voffa[h][_i] : voffA), (char*)(P) + tid16 + _i * 8192); } } while (0)
#define STAGE_B(P, h, kt) do { _Pragma("unroll") for (int _i = 0; _i < 2; ++_i) { \
        const char* _sb = (const char*)Bt + ((size_t)(bcol + (h) * HALF + _i * 64) * ld + (size_t)(kt) * BK) * 2; \
        GLDS(_sb + voff, (char*)(P) + tid16 + _i * 8192); } } while (0)
#define LDA(dst, b, h) _Pragma("unroll") for (int m = 0; m < 4; ++m) _Pragma("unroll") for (int k = 0; k < 2; ++k) \
        dst[m][k] = *reinterpret_cast<const bf16x8*>((char*)SA(b, h) + lds_byte(wr * 64 + m * 16 + fr, k * 32 + fq * 8))
#define LDB(dst, b, h) _Pragma("unroll") for (int n = 0; n < 2; ++n) _Pragma("unroll") for (int k = 0; k < 2; ++k) \
        dst[n][k] = *reinterpret_cast<const bf16x8*>((char*)SB(b, h) + lds_byte(wc * 32 + n * 16 + fr, k * 32 + fq * 8))
#define MMA(ai, bj, At_, Bt_) do { __builtin_amdgcn_s_setprio(1); \
        _Pragma("unroll") for (int m = 0; m < 4; ++m) _Pragma("unroll") for (int n = 0; n < 2; ++n) _Pragma("unroll") for (int k = 0; k < 2; ++k) \
            acc[ai][bj][m][n] = __builtin_amdgcn_mfma_f32_16x16x32_bf16(Bt_[n][k], At_[m][k], acc[ai][bj][m][n], 0, 0, 0); \
        __builtin_amdgcn_s_setprio(0); } while (0)
#define WAIT_V(n) asm volatile("s_waitcnt vmcnt(" #n ")" ::: "memory")
#define WAIT_L(n) asm volatile("s_waitcnt lgkmcnt(" #n ")" ::: "memory")
#define BAR __builtin_amdgcn_s_barrier()
#define SCHED __builtin_amdgcn_sched_barrier(0)
    int tid = threadIdx.x; asm volatile("" : "+v"(tid));
    int wid = tid >> 6, lane = tid & 63, wr = wid >> 2, wc = wid & 3, fr = lane & 15, fq = lane >> 4;
    const int tid16 = tid * 16;
    unsigned voff, voffA; unsigned voffa[2][2];
    {
        int r0, c0; stage_rc(tid16, r0, c0);
        voff = (unsigned)(r0 * ld + c0) * 2u; voffA = LDA_ ? (unsigned)(r0 * LDA_ + c0) * 2u : voff;
#pragma unroll
        for (int h = 0; h < 2; ++h)
#pragma unroll
            for (int i = 0; i < 2; ++i) {
                if (GATHER) { int l0 = h * HALF + i * 64 + r0; l0 = l0 < nvalid ? l0 : nvalid - 1; voffa[h][i] = (unsigned)((rowmap[l0] >> 1) * ld + c0) * 2u; }
                else voffa[h][i] = 0u;
            }
    }
    f32x4 acc[2][2][4][2] = {};
    bf16x8 At[4][2], B0[2][2], B1[2][2];
    const int nt = K / BK;
    STAGE_B(SB(0, 0), 0, 0); STAGE_A(SA(0, 0), 0, 0);
    STAGE_B(SB(0, 1), 1, 0); STAGE_A(SA(0, 1), 1, 0);
    if (wr == 1) BAR;
    WAIT_V(4); BAR;
    STAGE_B(SB(1, 0), 0, 1); STAGE_A(SA(1, 0), 0, 1); STAGE_B(SB(1, 1), 1, 1);
    WAIT_V(6); BAR;
    for (int t = 0; t < nt - 2; t += 2) {
        LDB(B0, 0, 0); SCHED; LDA(At, 0, 0); STAGE_A(SA(1, 1), 1, t + 1);
        WAIT_L(8); BAR; WAIT_L(0); MMA(0, 0, At, B0); BAR; SCHED;
        LDB(B1, 0, 1); STAGE_B(SB(0, 0), 0, t + 2);
        BAR; WAIT_L(0); MMA(0, 1, At, B1); BAR;
        LDA(At, 0, 1); STAGE_A(SA(0, 0), 0, t + 2);
        BAR; WAIT_L(0); MMA(1, 0, At, B0); BAR; SCHED;
        STAGE_B(SB(0, 1), 1, t + 2);
        WAIT_V(6); BAR; MMA(1, 1, At, B1); BAR;
        LDB(B0, 1, 0); SCHED; LDA(At, 1, 0); STAGE_A(SA(0, 1), 1, t + 2);
        WAIT_L(8); BAR; WAIT_L(0); MMA(0, 0, At, B0); BAR; SCHED;
        LDB(B1, 1, 1); STAGE_B(SB(1, 0), 0, t + 3);
        BAR; WAIT_L(0); MMA(0, 1, At, B1); BAR;
        LDA(At, 1, 1); STAGE_A(SA(1, 0), 0, t + 3);
        BAR; WAIT_L(0); MMA(1, 0, At, B0); BAR; SCHED;
        STAGE_B(SB(1, 1), 1, t + 3);
        WAIT_V(6); BAR; MMA(1, 1, At, B1); BAR;
    }
    { LDB(B0, 0, 0); WAIT_V(0); LDA(At, 0, 0); STAGE_A(SA(1, 1), 1, nt - 1);
      BAR; WAIT_L(0); MMA(0, 0, At, B0); BAR;
      LDB(B1, 0, 1); BAR; WAIT_L(0); MMA(0, 1, At, B1); BAR;
      LDA(At, 0, 1); WAIT_V(4); BAR; WAIT_L(0); MMA(1, 0, At, B0); MMA(1, 1, At, B1); BAR; }
    { LDB(B0, 1, 0); LDA(At, 1, 0); WAIT_V(2); BAR; WAIT_L(0); MMA(0, 0, At, B0); BAR;
      LDB(B1, 1, 1); WAIT_V(0); BAR; WAIT_L(0); MMA(0, 1, At, B1); BAR;
      LDA(At, 1, 1); BAR; WAIT_L(0); MMA(1, 0, At, B0); MMA(1, 1, At, B1); BAR; }
    if (wr == 0) BAR;
    int tz = threadIdx.x; asm volatile("" : "+v"(tz)); wid = tz >> 6; lane = tz & 63; wr = wid >> 2; wc = wid & 3; fr = lane & 15; fq = lane >> 4;
    epi(acc, brow, bcol, wr, wc, fr, fq);
#undef SA
#undef SB
#undef STAGE_A
#undef STAGE_B
#undef GLDS
#undef LDA
#undef LDB
#undef MMA
}

struct EpiStoreF32 { float* C; int ldc;
    DEV void operator()(const f32x4 (&acc)[2][2][4][2], int brow, int bcol, int wr, int wc, int fr, int fq) const {
#pragma unroll
        for (int ai = 0; ai < 2; ++ai)
#pragma unroll
            for (int m = 0; m < 4; ++m) { float* rowp = C + (size_t)(brow + ai * HALF + wr * 64 + m * 16 + fr) * ldc + bcol + wc * 32 + fq * 4;
#pragma unroll
                for (int bj = 0; bj < 2; ++bj)
#pragma unroll
                    for (int n = 0; n < 2; ++n) *(f32x4*)(rowp + bj * HALF + n * 16) = acc[ai][bj][m][n]; }
    } };
struct EpiStoreBf16 { bf16_t* C; int ldc;
    DEV void operator()(const f32x4 (&acc)[2][2][4][2], int brow, int bcol, int wr, int wc, int fr, int fq) const {
#pragma unroll
        for (int ai = 0; ai < 2; ++ai)
#pragma unroll
            for (int m = 0; m < 4; ++m) { bf16_t* rowp = C + (size_t)(brow + ai * HALF + wr * 64 + m * 16 + fr) * ldc + bcol + wc * 32 + fq * 4;
#pragma unroll
                for (int bj = 0; bj < 2; ++bj)
#pragma unroll
                    for (int n = 0; n < 2; ++n) { const f32x4 v = acc[ai][bj][m][n]; u32x2 w; w.x = cvtpk(v[0], v[1]); w.y = cvtpk(v[2], v[3]); *(u32x2*)(rowp + bj * HALF + n * 16) = w; } }
    } };
struct EpiResidGate { bf16_t* X; const float* gate; bool dry; const float* xin; const float* cin;
    DEV void operator()(const f32x4 (&acc)[2][2][4][2], int brow, int bcol, int wr, int wc, int fr, int fq) const {
        const float* g = gate + (size_t)modvec_of_row(brow) * MODN + bcol + wc * 32 + fq * 4;
        f32x4 gv[2][2];
#pragma unroll
        for (int bj = 0; bj < 2; ++bj)
#pragma unroll
            for (int n = 0; n < 2; ++n) gv[bj][n] = *(const f32x4*)(g + bj * HALF + n * 16);
#pragma unroll
        for (int ai = 0; ai < 2; ++ai)
#pragma unroll
            for (int m = 0; m < 4; ++m) { const int lrow = ai * HALF + wr * 64 + m * 16 + fr; bf16_t* rowp = X + (size_t)(brow + lrow) * D + bcol + wc * 32 + fq * 4;
                const float* srcp = nullptr;
                if (xin) { const int b = brow / S, t0 = brow - b * S; srcp = (t0 < TC ? cin + ((size_t)b * TC + t0 + lrow) * D : xin + ((size_t)b * TL + (t0 - TC) + lrow) * D) + bcol + wc * 32 + fq * 4; }
#pragma unroll
                for (int bj = 0; bj < 2; ++bj)
#pragma unroll
                    for (int n = 0; n < 2; ++n) { f32x4 x;
                        if (xin) x = *(const f32x4*)(srcp + bj * HALF + n * 16); else { const u32x2 p = *(const u32x2*)(rowp + bj * HALF + n * 16); x = (f32x4){bflo(p.x), bfhi(p.x), bflo(p.y), bfhi(p.y)}; }
                        if (!dry) x += gv[bj][n] * acc[ai][bj][m][n];
                        u32x2 w; w.x = cvtpk(x[0], x[1]); w.y = cvtpk(x[2], x[3]); *(u32x2*)(rowp + bj * HALF + n * 16) = w; }
                if (m == 3) asm volatile("" ::: "memory"); }
    } };
struct EpiMoeUp { bf16_t* hid; int rowbase, nvalid;
    DEV void operator()(const f32x4 (&acc)[2][2][4][2], int brow, int bcol, int wr, int wc, int fr, int fq) const {
        const int hc = (bcol >> 1) + wc * 32 + fq * 4;
#pragma unroll
        for (int ai = 0; ai < 2; ++ai)
#pragma unroll
            for (int m = 0; m < 4; ++m) { const int lr = ai * HALF + wr * 64 + m * 16 + fr;
                if (lr < nvalid) { bf16_t* rowp = hid + (size_t)(rowbase + lr) * EDIM + hc;
#pragma unroll
                    for (int n = 0; n < 2; ++n) { const f32x4 a = acc[ai][0][m][n], b = acc[ai][1][m][n];
                        u32x2 w; w.x = cvtpk(siluf_(a[0]) * b[0], siluf_(a[1]) * b[1]); w.y = cvtpk(siluf_(a[2]) * b[2], siluf_(a[3]) * b[3]);
                        *(u32x2*)(rowp + n * 16) = w; } } }
    } };
struct EpiMoeDown { bf16_t* y; const int* list; int nvalid;
    DEV void operator()(const f32x4 (&acc)[2][2][4][2], int brow, int bcol, int wr, int wc, int fr, int fq) const {
#pragma unroll
        for (int ai = 0; ai < 2; ++ai)
#pragma unroll
            for (int m = 0; m < 4; ++m) { const int lr = ai * HALF + wr * 64 + m * 16 + fr;
                if (lr < nvalid) { bf16_t* rowp = y + (size_t)list[lr] * D + bcol + wc * 32 + fq * 4;
#pragma unroll
                    for (int bj = 0; bj < 2; ++bj)
#pragma unroll
                        for (int n = 0; n < 2; ++n) { const f32x4 v = acc[ai][bj][m][n]; u32x2 w; w.x = cvtpk(v[0], v[1]); w.y = cvtpk(v[2], v[3]); *(u32x2*)(rowp + bj * HALF + n * 16) = w; } } }
    } };

DEV void row_bt(int r, int& b, int& t) { b = r / S; t = r - b * S; }
struct EpiInAB { bf16_t* P; float* ssq; bf16_t* Kb; const float2* tb; char* smem;
    DEV void operator()(const f32x4 (&acc)[2][2][4][2], int brow, int bcol, int wr, int wc, int fr, int fq) const {
        const int pn = bcol >> 8;
        if (pn < 23) {
#pragma unroll
            for (int ai = 0; ai < 2; ++ai)
#pragma unroll
                for (int m = 0; m < 4; ++m) { bf16_t* rowp = P + (size_t)(brow + ai * HALF + wr * 64 + m * 16 + fr) * AB_INP + bcol + wc * 32 + fq * 4;
#pragma unroll
                    for (int bj = 0; bj < 2; ++bj)
#pragma unroll
                        for (int n = 0; n < 2; ++n) { const f32x4 v = acc[ai][bj][m][n]; u32x2 w; w.x = cvtpk(v[0], v[1]); w.y = cvtpk(v[2], v[3]); *(u32x2*)(rowp + bj * HALF + n * 16) = w; } }
            if (pn >= 20) {
                float* red = (float*)smem;
#pragma unroll
                for (int ai = 0; ai < 2; ++ai)
#pragma unroll
                    for (int m = 0; m < 4; ++m) { float sq = 0.f;
#pragma unroll
                        for (int bj = 0; bj < 2; ++bj)
#pragma unroll
                            for (int n = 0; n < 2; ++n) { const f32x4 v = acc[ai][bj][m][n]; sq += v[0] * v[0] + v[1] * v[1] + v[2] * v[2] + v[3] * v[3]; }
                        sq += __shfl_xor(sq, 16); sq += __shfl_xor(sq, 32);
                        if (fq == 0) red[(ai * HALF + wr * 64 + m * 16 + fr) * 4 + wc] = sq; }
                __syncthreads();
                const int t_ = tid_opaque();
                if (t_ < 256) { const f32x4 q = *(const f32x4*)(red + t_ * 4); ssq[(size_t)(pn - 20) * R + brow + t_] = (q[0] + q[1]) + (q[2] + q[3]); }
                __syncthreads();
            }
        } else if (wc < 2) {
#pragma unroll
            for (int ai = 0; ai < 2; ++ai)
#pragma unroll
                for (int m = 0; m < 4; ++m) { int b, t; row_bt(brow + ai * HALF + wr * 64 + m * 16 + fr, b, t);
#pragma unroll
                    for (int n = 0; n < 2; ++n) { const f32x4 v = acc[ai][0][m][n]; const int p0 = 16 * wc + 8 * n + 2 * fq;
                        float2 c0 = make_float2(1.f, 0.f), c1 = c0; if (t >= TC) { c0 = tb[(t - TC) * 32 + p0]; c1 = tb[(t - TC) * 32 + p0 + 1]; }
                        const unsigned lo = cvtpk(v[0] * c0.x - v[1] * c0.y, v[2] * c1.x - v[3] * c1.y), hi = cvtpk(v[1] * c0.x + v[0] * c0.y, v[3] * c1.x + v[2] * c1.y);
#pragma unroll
                        for (int hh = 0; hh < 8; ++hh) { bf16_t* kp = Kb + (((size_t)b * 8 + hh) * S + t) * 192 + 128 + p0; *(unsigned*)kp = lo; *(unsigned*)(kp + 32) = hi; } } }
        }
    } };
struct EpiInCD { bf16_t* P; bf16_t* Qb; bf16_t* Kb; bf16_t* Vb; const float2* tc; const float* gq; const float* gk; char* smem;
    DEV void operator()(const f32x4 (&acc)[2][2][4][2], int brow, int bcol, int wr, int wc, int fr, int fq) const {
        const int pn = bcol >> 8;
        if (pn <= 4) {
            float* red = (float*)smem;
#pragma unroll
            for (int ai = 0; ai < 2; ++ai)
#pragma unroll
                for (int m = 0; m < 4; ++m)
#pragma unroll
                    for (int bj = 0; bj < 2; ++bj) { float sq = 0.f;
#pragma unroll
                        for (int n = 0; n < 2; ++n) { const f32x4 v = acc[ai][bj][m][n]; sq += v[0] * v[0] + v[1] * v[1] + v[2] * v[2] + v[3] * v[3]; }
                        sq += __shfl_xor(sq, 16); sq += __shfl_xor(sq, 32);
                        if (fq == 0) red[((ai * HALF + wr * 64 + m * 16 + fr) * 2 + bj) * 4 + wc] = sq; }
            __syncthreads();
            const float* gp = pn < 4 ? gq : gk;
            float g1[2][2], g2[2][2];
#pragma unroll
            for (int n = 0; n < 2; ++n) { const int p0 = 16 * wc + 8 * n + 2 * fq; g1[n][0] = gp[p0]; g1[n][1] = gp[p0 + 1]; g2[n][0] = gp[p0 + 64]; g2[n][1] = gp[p0 + 65]; }
#pragma unroll
            for (int ai = 0; ai < 2; ++ai)
#pragma unroll
                for (int m = 0; m < 4; ++m) { const int lr = ai * HALF + wr * 64 + m * 16 + fr; int b, t; row_bt(brow + lr, b, t);
#pragma unroll
                    for (int bj = 0; bj < 2; ++bj) { const f32x4 q4 = *(const f32x4*)(red + (lr * 2 + bj) * 4); const float rs = rsqrtf(((q4[0] + q4[1]) + (q4[2] + q4[3])) * (1.f / 128.f) + EPS);
                        bf16_t* dst = pn < 4 ? Qb + (((size_t)b * 8 + pn * 2 + bj) * S + t) * 128 : Kb + (((size_t)b * 2 + bj) * S + t) * 128;
#pragma unroll
                        for (int n = 0; n < 2; ++n) { const f32x4 v = acc[ai][bj][m][n]; const int p0 = 16 * wc + 8 * n + 2 * fq;
                            float2 c0 = make_float2(1.f, 0.f), c1 = c0; if (t >= TC) { c0 = tc[(t - TC) * 64 + p0]; c1 = tc[(t - TC) * 64 + p0 + 1]; }
                            const float x1a = v[0] * rs * g1[n][0], x2a = v[1] * rs * g2[n][0], x1b = v[2] * rs * g1[n][1], x2b = v[3] * rs * g2[n][1];
                            *(unsigned*)(dst + p0) = cvtpk(x1a * c0.x - x2a * c0.y, x1b * c1.x - x2b * c1.y);
                            *(unsigned*)(dst + 64 + p0) = cvtpk(x2a * c0.x + x1a * c0.y, x2b * c1.x + x1b * c1.y); } } }
            __syncthreads();
        } else if (pn == 5) {
#pragma unroll
            for (int ai = 0; ai < 2; ++ai)
#pragma unroll
                for (int m = 0; m < 4; ++m) { int b, t; row_bt(brow + ai * HALF + wr * 64 + m * 16 + fr, b, t);
#pragma unroll
                    for (int bj = 0; bj < 2; ++bj)
#pragma unroll
                        for (int n = 0; n < 2; ++n) { const f32x4 v = acc[ai][bj][m][n]; u32x2 w; w.x = cvtpk(v[0], v[1]); w.y = cvtpk(v[2], v[3]);
                            *(u32x2*)(Vb + (((size_t)b * 2 + bj) * S + t) * 128 + wc * 32 + n * 16 + fq * 4) = w; } }
        } else {
#pragma unroll
            for (int ai = 0; ai < 2; ++ai)
#pragma unroll
                for (int m = 0; m < 4; ++m) { bf16_t* rowp = P + (size_t)(brow + ai * HALF + wr * 64 + m * 16 + fr) * CD_INP + bcol + wc * 32 + fq * 4;
#pragma unroll
                    for (int bj = 0; bj < 2; ++bj)
#pragma unroll
                        for (int n = 0; n < 2; ++n) { const f32x4 v = acc[ai][bj][m][n]; u32x2 w; w.x = cvtpk(v[0], v[1]); w.y = cvtpk(v[2], v[3]); *(u32x2*)(rowp + bj * HALF + n * 16) = w; } }
        }
    } };
struct EpiUQ { bf16_t* Qb; const float* ssq; const float2* tb;
    DEV void operator()(const f32x4 (&acc)[2][2][4][2], int brow, int bcol, int wr, int wc, int fr, int fq) const {
        const int pn = bcol >> 8;
#pragma unroll
        for (int ai = 0; ai < 2; ++ai)
#pragma unroll
            for (int m = 0; m < 4; ++m) { const int r = brow + ai * HALF + wr * 64 + m * 16 + fr; int b, t; row_bt(r, b, t);
                const float rs = rsqrtf((ssq[r] + ssq[R + r]) * (1.f / 512.f) + EPS);
#pragma unroll
                for (int bj = 0; bj < 2; ++bj)
#pragma unroll
                    for (int n = 0; n < 2; ++n) { const f32x4 v = acc[ai][bj][m][n] * rs;
                        if (pn < 4) { const int hh = pn * 2 + bj; bf16_t* qp = Qb + (((size_t)b * 8 + hh) * S + t) * 192 + wc * 32 + n * 16 + fq * 4;
                            u32x2 w; w.x = cvtpk(v[0], v[1]); w.y = cvtpk(v[2], v[3]); *(u32x2*)qp = w; }
                        else { const int cr = (pn - 4) * 256 + bj * HALF + wc * 32 + n * 16 + fq * 4, hh = cr >> 6, p0 = (cr & 63) >> 1;
                            float2 c0 = make_float2(1.f, 0.f), c1 = c0; if (t >= TC) { c0 = tb[(t - TC) * 32 + p0]; c1 = tb[(t - TC) * 32 + p0 + 1]; }
                            bf16_t* qp = Qb + (((size_t)b * 8 + hh) * S + t) * 192 + 128 + p0;
                            *(unsigned*)qp = cvtpk(v[0] * c0.x - v[1] * c0.y, v[2] * c1.x - v[3] * c1.y); *(unsigned*)(qp + 32) = cvtpk(v[1] * c0.x + v[0] * c0.y, v[3] * c1.x + v[2] * c1.y); } } }
    } };
struct EpiUKV { bf16_t* Kb; bf16_t* Vb; const float* ssq;
    DEV void operator()(const f32x4 (&acc)[2][2][4][2], int brow, int bcol, int wr, int wc, int fr, int fq) const {
        const int hh = bcol >> 8;
#pragma unroll
        for (int ai = 0; ai < 2; ++ai)
#pragma unroll
            for (int m = 0; m < 4; ++m) { const int r = brow + ai * HALF + wr * 64 + m * 16 + fr; int b, t; row_bt(r, b, t);
                const float rs = rsqrtf(ssq[2 * R + r] * (1.f / 256.f) + EPS); const size_t rowi = ((size_t)b * 8 + hh) * S + t;
#pragma unroll
                for (int n = 0; n < 2; ++n) { const f32x4 kv = acc[ai][0][m][n] * rs, vv = acc[ai][1][m][n] * rs; const int c = wc * 32 + n * 16 + fq * 4;
                    u32x2 w; w.x = cvtpk(kv[0], kv[1]); w.y = cvtpk(kv[2], kv[3]); *(u32x2*)(Kb + rowi * 192 + c) = w;
                    w.x = cvtpk(vv[0], vv[1]); w.y = cvtpk(vv[2], vv[3]); *(u32x2*)(Vb + rowi * 128 + c) = w; } }
    } };

template <bool LATENT = false, int LDA_ = 0, class Epi>
DEV void gemm_phase(const bf16_t* A, const bf16_t* Bt, int M, int N, int K, char* smem, const Epi& epi, int& cursor, int tlo = 0, int thi = 1 << 30) {
    const int nM = M / BM, nN = N / BM, n = nM * nN;
    int first = cursor; cursor += n;
    int u = blockIdx.x; while (u < first) u += gridDim.x;
    for (; u < first + n; u += gridDim.x) { const int t = u - first; if (t < tlo || t >= thi) continue; const int pm = t % nM, pn = t / nM;
        const int prow = LATENT ? (pm >> 3) * 9 + 1 + (pm & 7) : pm;
        gemm_tile<false, LDA_>(A, Bt, K, K, prow * BM, pn * BM, nullptr, 0, smem, epi); }
}

struct CvtJob { const float* src; bf16_t* dst; int K, N, Nout, nb; size_t src_bs, dst_bs; int blk_rs, blk_base; const float* kscale; int perm = 0; };
DEV void cvt_do_tile(const CvtJob& j, int u, int lane) {
    const int tN = j.Nout / 64, per = (j.K / 64) * tN;
    const int bt = u / per, rem = u - bt * per, kt = rem / tN, ntl = rem - kt * tN;
    const int n = ntl * 64 + lane; const bool valid = n < j.N;
    const float* sp = j.src + (size_t)bt * j.src_bs + (size_t)(kt * 64) * j.N + (valid ? n : 0);
    float e[64];
#pragma unroll
    for (int i = 0; i < 64; ++i) e[i] = sp[(size_t)i * j.N];
    __builtin_amdgcn_sched_barrier(0);
    u32x4 ov[8];
#pragma unroll
    for (int kb = 0; kb < 8; ++kb) {
#pragma unroll
        for (int i = 0; i < 8; ++i) { float x = e[kb * 8 + i]; if (j.kscale) x *= j.kscale[kt * 64 + kb * 8 + i]; e[kb * 8 + i] = valid ? x : 0.f; }
        ov[kb] = (u32x4){cvtpk(e[kb * 8], e[kb * 8 + 1]), cvtpk(e[kb * 8 + 2], e[kb * 8 + 3]), cvtpk(e[kb * 8 + 4], e[kb * 8 + 5]), cvtpk(e[kb * 8 + 6], e[kb * 8 + 7])}; }
    int drow = (n >> 7) * j.blk_rs + j.blk_base + (n & 127);
    if (j.perm == 1) { const int hh = n / 192, c = n - hh * 192, i = c - 128; drow = c < 128 ? hh * 128 + c : 1024 + hh * 64 + (i < 32 ? 2 * i : 2 * (i - 32) + 1); }
    if (j.perm == 3 && n < 1280) { const int c = n & 127; drow = (n & ~127) + (c < 64 ? 2 * c : 2 * (c - 64) + 1); }
    if (j.perm == 2 && n >= 5888) { const int i = n - 5888; drow = i < 64 ? 5888 + (i < 32 ? 2 * i : 2 * (i - 32) + 1) : n; }
    bf16_t* dp = j.dst + (size_t)bt * j.dst_bs + (size_t)drow * j.K + kt * 64;
#pragma unroll
    for (int kb = 0; kb < 8; ++kb) *(u32x4*)(dp + kb * 8) = ov[kb];
}
DEV void cvt_weight(const float* __restrict__ src, bf16_t* __restrict__ dst, int K, int N, int Nout, int nb, size_t src_bs, size_t dst_bs,
                    int blk_rs, int blk_base, const float* __restrict__ kscale, char* smem, int perm = 0) {
    (void)smem;
    const CvtJob j{src, dst, K, N, Nout, nb, src_bs, dst_bs, blk_rs, blk_base, kscale, perm};
    const int tid = tid_opaque(), lane = tid & 63, w = tid >> 6, total = nb * (K / 64) * (Nout / 64);
    for (int u = blockIdx.x * 8 + w; u < total; u += gridDim.x * 8) cvt_do_tile(j, u, lane);
}
DEV bf16_t* moe_w13(const Args& a, int l) { return (bf16_t*)(a.ws + (l == 0 ? WS_W13 : WS_SVT)); }
DEV bf16_t* moe_w2(const Args& a, int l) { return (bf16_t*)(a.ws + (l == 0 ? WS_W2 : WS_SVT + (size_t)NE * 1024 * D * 2)); }
DEV void cvt_moe_dynamic(const Args& a, int l, char* smem) {
    const int tid = tid_opaque(), lane = tid & 63, w = tid >> 6;
    unsigned* counter = (unsigned*)(a.ws + WS_CTL) + CW_CVT + l * 64;
    volatile int* slot = (volatile int*)smem;
    const CvtJob j1{a.in[26] + (size_t)l * NE * D * EDIM, moe_w13(a, l), D, EDIM, EDIM, NE, (size_t)D * EDIM, (size_t)1024 * D, 256, 0, nullptr};
    const CvtJob j3{a.in[27] + (size_t)l * NE * D * EDIM, moe_w13(a, l), D, EDIM, EDIM, NE, (size_t)D * EDIM, (size_t)1024 * D, 256, 128, nullptr};
    const CvtJob j2{a.in[28] + (size_t)l * NE * EDIM * D, moe_w2(a, l), EDIM, D, D, NE, (size_t)EDIM * D, (size_t)D * EDIM, 128, 0, nullptr};
    constexpr int NCHUNK = 3 * 4096 / 64;
    for (;;) {
        __syncthreads();
        if (tid == 0) *slot = (int)atomicAdd(counter, 1u);
        __syncthreads();
        const int chunk = *slot;
        if (chunk >= NCHUNK) break;
        const int job = chunk >> 6;
#pragma unroll 1
        for (int i = 0; i < 8; ++i) { const int u = ((chunk & 63) << 6) + w * 8 + i;
            if (job == 0) cvt_do_tile(j1, u, lane); else if (job == 1) cvt_do_tile(j3, u, lane); else cvt_do_tile(j2, u, lane); }
    }
    __syncthreads();
}

DEV void cvt_cd_dynamic(const Args& a, char* smem) {
    const int tid = tid_opaque(), lane = tid & 63, w = tid >> 6;
    unsigned* counter = (unsigned*)(a.ws + WS_CTL) + CW_CVT + 3 * 64;
    volatile int* slot = (volatile int*)smem;
    const CvtJob jin{a.in[17], (bf16_t*)(a.ws + WS_WCDIN), D, CD_IN, CD_INP, 1, 0, 0, 128, 0, nullptr, 3};
    const CvtJob jout{a.in[18], (bf16_t*)(a.ws + WS_WCDOUT), D, D, D, 1, 0, 0, 128, 0, nullptr};
    const CvtJob jabo{a.in[10], (bf16_t*)(a.ws + WS_WABOUT), D, D, D, 1, 0, 0, 128, 0, nullptr};
    const CvtJob juq{a.in[14], (bf16_t*)(a.ws + WS_WUQ), 512, 1536, 1536, 1, 0, 0, 128, 0, a.in[13], 1};
    const CvtJob jukv{a.in[16], (bf16_t*)(a.ws + WS_WUKV), 256, 2048, 2048, 1, 0, 0, 128, 0, a.in[15]};
    constexpr int TIN = 32 * (CD_INP / 64), T1 = TIN + 32 * 32, T2 = T1 + 32 * 32, T3 = T2 + 8 * 24, T4 = T3 + 4 * 32, NCHUNK = T4 / 64;
    static_assert(TIN % 64 == 0 && T4 % 64 == 0, "chunk boundary");
    for (;;) {
        __syncthreads();
        if (tid == 0) *slot = (int)atomicAdd(counter, 1u);
        __syncthreads();
        const int chunk = *slot;
        if (chunk >= NCHUNK) break;
#pragma unroll 1
        for (int i = 0; i < 8; ++i) { const int g = chunk * 64 + w * 8 + i;
            if (g < TIN) cvt_do_tile(jin, g, lane); else if (g < T1) cvt_do_tile(jout, g - TIN, lane); else if (g < T2) cvt_do_tile(jabo, g - T1, lane);
            else if (g < T3) cvt_do_tile(juq, g - T2, lane); else cvt_do_tile(jukv, g - T3, lane); }
    }
    __syncthreads();
}

template <bool DYN>
DEV void mod_phase(const Args& a, int l, char* smem) {
    float* sc = (float*)smem;
    float* red = sc + 5 * D;
    const int tid = tid_opaque(), w = tid >> 6, lane = tid & 63, cg = lane & 7, rr = lane >> 3;
    for (int i = tid; i < 5 * D; i += NT) { const int v = i / D, k = i - v * D; const float x = v < 4 ? a.in[1][v * D + k] : a.in[3][k]; sc[i] = siluf_(x); }
    __syncthreads();
    float* modv = (float*)(a.ws + WS_MODV);
    unsigned* counter = (unsigned*)(a.ws + WS_CTL) + CW_CVT + 2 * 64; volatile int* slot = (volatile int*)(red + 8 * 5 * 32);
    for (int u = blockIdx.x;; u += gridDim.x) {
        if (DYN) { __syncthreads(); if (tid == 0) *slot = (int)atomicAdd(counter, 1u); __syncthreads(); u = *slot; }
        if (u >= MODN / 32) break;
        const int c0 = u * 32;
        const float* wp = a.in[4] + (size_t)l * D * MODN + c0 + cg * 4;
        f32x4 acc[5] = {};
        for (int it0 = 0; it0 < D / 64; it0 += 8) { f32x4 wv[8];
#pragma unroll
            for (int q = 0; q < 8; ++q) wv[q] = *(const f32x4*)(wp + (size_t)((it0 + q) * 64 + w * 8 + rr) * MODN);
#pragma unroll
            for (int q = 0; q < 8; ++q) { const int k = (it0 + q) * 64 + w * 8 + rr;
#pragma unroll
                for (int v = 0; v < 5; ++v) acc[v] += wv[q] * sc[v * D + k]; } }
#pragma unroll
        for (int v = 0; v < 5; ++v)
#pragma unroll
            for (int j = 0; j < 4; ++j) { float x = acc[v][j]; x += __shfl_xor(x, 8); x += __shfl_xor(x, 16); x += __shfl_xor(x, 32); acc[v][j] = x; }
        if (rr == 0) {
#pragma unroll
            for (int v = 0; v < 5; ++v)
#pragma unroll
                for (int j = 0; j < 4; ++j) red[(w * 5 + v) * 32 + cg * 4 + j] = acc[v][j]; }
        __syncthreads();
        if (tid < 160) { const int v = tid >> 5, c = tid & 31; float s = 0.f;
#pragma unroll
            for (int ww = 0; ww < 8; ++ww) s += red[(ww * 5 + v) * 32 + c];
            modv[((size_t)l * 5 + v) * MODN + c0 + c] = s + a.in[5][l * MODN + c0 + c]; }
        __syncthreads();
    }
}

DEV void misc_phase(const Args& a) {
    const int gt = blockIdx.x * NT + tid_opaque(), gs = gridDim.x * NT;
    float* lb = (float*)(a.ws + WS_LB);
    for (int i = gt; i < 2 * 1024; i += gs) { const int d = i >> 10, c = i & 1023; const float* p = a.in[11] + (size_t)d * 3 * 1024 + c;
        const float x0 = p[0], x1 = p[1024], x2 = p[2048], m = fmaxf(x0, fmaxf(x1, x2));
        const float e0 = expf(x0 - m), e1 = expf(x1 - m), e2 = expf(x2 - m); lb[i] = e0 / (e0 + e1 + e2); }
    float2* tb = (float2*)(a.ws + WS_TABB); float2* tc = (float2*)(a.ws + WS_TABC);
    for (int i = gt; i < TL * 32; i += gs) { const int t = i >> 5, j = i & 31, q = j & 15; const float fr = powf(10000.f, -(float)q / 16.f);
        const float pos = (j < 16) ? (float)(t >> 6) : (float)(t & 63); const float an = pos * fr; tb[i] = make_float2(cosf(an), sinf(an)); }
    for (int i = gt; i < TL * 64; i += gs) { const int t = i >> 6, j = i & 63, q = j & 31; const float fr = powf(10000.f, -(float)q / 32.f);
        const float pos = (j < 32) ? (float)(t >> 6) : (float)(t & 63); const float an = pos * fr; tc[i] = make_float2(cosf(an), sinf(an)); }
}

template <bool ROUTER, bool FROM_IN = false>
DEV void norm_phase(const Args& a, int l, int chunk_shift, const float* gain, bool latent_only, char* smem, bool dry = false) {
    const int tid = tid_opaque(), w = tid >> 6, lane = tid & 63;
    const bf16_t* xres = (const bf16_t*)(a.ws + WS_XRES); bf16_t* h = (bf16_t*)(a.ws + WS_H);
    const float* modv = (const float*)(a.ws + WS_MODV) + (size_t)l * 5 * MODN;
    unsigned* cnt = (unsigned*)(a.ws + WS_CTL) + CW_CNT + l * 16 * CNT_STRIDE;
    int* tok = (int*)(a.ws + WS_TOK); int* list = (int*)(a.ws + WS_LIST);
    float* rw = (float*)smem;
    if (ROUTER) { for (int i = tid; i < D * 16 / 4; i += NT) { const int c = i >> 2, q = i & 3; *(f32x4*)(rw + c * 16 + (c >> 2) * 4 + q * 4) = ((const f32x4*)a.in[24])[i]; } __syncthreads(); }
    for (int r = blockIdx.x * 8 + w; r < R; r += gridDim.x * 8) {
        const int b = r / S, t = r - b * S; if (latent_only && t < TC) continue;
        const int v = t < TC ? 4 : b;
        const float* xp = t < TC ? a.in[2] + ((size_t)b * TC + t) * D : a.in[0] + ((size_t)b * TL + (t - TC)) * D; const bf16_t* xb = xres + (size_t)r * D; const float* sh = modv + (size_t)v * MODN + chunk_shift * D; const float* sc = sh + D;
        f32x4 x[8]; float ss = 0.f;
#pragma unroll
        for (int j = 0; j < 8; ++j) { if (FROM_IN) x[j] = *(const f32x4*)(xp + j * 256 + lane * 4); else { const u32x2 p = *(const u32x2*)(xb + j * 256 + lane * 4); x[j] = (f32x4){bflo(p.x), bfhi(p.x), bflo(p.y), bfhi(p.y)}; }
            ss += x[j][0] * x[j][0] + x[j][1] * x[j][1] + x[j][2] * x[j][2] + x[j][3] * x[j][3]; }
        ss = wave_sum(ss); const float rstd = rsqrtf(ss * (1.f / D) + EPS);
        float lg[16];
        if (ROUTER) {
#pragma unroll
            for (int e = 0; e < 16; ++e) lg[e] = 0.f; }
        f32x4 gv[8], s1v[8], s0v[8];
#pragma unroll
        for (int j = 0; j < 8; ++j) { const int c = j * 256 + lane * 4; gv[j] = *(const f32x4*)(gain + c); s1v[j] = *(const f32x4*)(sc + c); s0v[j] = *(const f32x4*)(sh + c); }
#pragma unroll
        for (int j = 0; j < 8; ++j) { const int c = j * 256 + lane * 4;
            const f32x4 g = gv[j], s1 = s1v[j], s0 = s0v[j];
            f32x4 y = (x[j] * rstd * g) * (1.f + s1) + s0;
            u32x2 pk; pk.x = cvtpk(y[0], y[1]); pk.y = cvtpk(y[2], y[3]); *(u32x2*)(h + (size_t)r * D + c) = pk;
            if (ROUTER) {
#pragma unroll
                for (int i = 0; i < 4; ++i) { const f32x4* wrow = (const f32x4*)(rw + (c + i) * 16 + (c >> 2) * 4);
#pragma unroll
                    for (int q = 0; q < 4; ++q) { const f32x4 wv = wrow[q]; lg[q * 4 + 0] += y[i] * wv[0]; lg[q * 4 + 1] += y[i] * wv[1]; lg[q * 4 + 2] += y[i] * wv[2]; lg[q * 4 + 3] += y[i] * wv[3]; } }
                __builtin_amdgcn_sched_barrier(0); }
        }
        if (ROUTER) {
#pragma unroll
            for (int e = 0; e < 16; ++e) lg[e] = wave_sum(lg[e]);
            if (lane == 0 && !dry) {
                float scv[16], sel[16];
#pragma unroll
                for (int e = 0; e < 16; ++e) { scv[e] = 1.f / (1.f + expf(-lg[e])); sel[e] = scv[e] + a.in[25][e]; }
                int gbest = 0; float gbv = -1e30f;
#pragma unroll
                for (int g = 0; g < 4; ++g) { float m1 = -1e30f, m2 = -1e30f;
#pragma unroll
                    for (int i = 0; i < 4; ++i) { const float s_ = sel[g * 4 + i]; if (s_ > m1) { m2 = m1; m1 = s_; } else if (s_ > m2) m2 = s_; }
                    const float gs = m1 + m2; if (gs > gbv) { gbv = gs; gbest = g; } }
                int e0 = 0, e1 = 0; float m1 = -1e30f, m2 = -1e30f; float w0 = 0.f, w1 = 0.f;
#pragma unroll
                for (int g = 0; g < 4; ++g) if (g == gbest) {
#pragma unroll
                    for (int i = 0; i < 4; ++i) { const float s_ = sel[g * 4 + i]; const int e = g * 4 + i;
                        if (s_ > m1) { m2 = m1; e1 = e0; w1 = w0; m1 = s_; e0 = e; w0 = scv[e]; } else if (s_ > m2) { m2 = s_; e1 = e; w1 = scv[e]; } } }
                const float inv = 1.f / (w0 + w1);
                const unsigned s0 = atomicAdd(&cnt[e0 * CNT_STRIDE], 1u), s1 = atomicAdd(&cnt[e1 * CNT_STRIDE], 1u);
                __hip_atomic_store((__attribute__((address_space(1))) int*)(list + (size_t)e0 * R + s0), r * 2, __ATOMIC_RELAXED, __HIP_MEMORY_SCOPE_AGENT);
                __hip_atomic_store((__attribute__((address_space(1))) int*)(list + (size_t)e1 * R + s1), r * 2 + 1, __ATOMIC_RELAXED, __HIP_MEMORY_SCOPE_AGENT);
                tok[r * 4 + 0] = e0; tok[r * 4 + 1] = e1; ((float*)tok)[r * 4 + 2] = w0 * inv; ((float*)tok)[r * 4 + 3] = w1 * inv;
            }
        }
    }
}

DEV int scan_tok(int dir, int pos) { return dir == 0 ? pos : (pos < TC ? (TC - 1 - pos) : (S - 1 - (pos - TC))); }
template <int MODE>
DEV void scan_prep_phase(const Args& a, char* smem) {
    constexpr int NH = MODE == 0 ? 8 : 4, DV = MODE == 0 ? 128 : 256, LDP = MODE == 0 ? AB_INP : CD_INP, NVP = DV / 128;
    const int tid = tid_opaque(), dp = tid & 63, pg = tid >> 6, wid = tid >> 6, lane = tid & 63, l15 = lane & 15, l4 = lane >> 4;
    char* QT = smem; char* KT = smem + 64 * PQ; float* tot = (float*)(smem + 2 * 64 * PQ);
    float* aT = tot + 8 * 128;
    const bf16_t* P = (const bf16_t*)(a.ws + WS_P); const float* lb = (const float*)(a.ws + WS_LB);
    const float qscale = 0.08838834764831845f;
    const int nitems = NB * NH * 2 * 36;
    for (int item = blockIdx.x; item < nitems; item += gridDim.x) {
        const int c = item % 36, dir = (item / 36) & 1, hd = (item / 72) % NH, b = item / (72 * NH);
        char* rec = (char*)(a.ws + (MODE == 0 ? WS_SREC : WS_SREC1)) + (size_t)item * REC_BYTES;
        char* vt = (char*)(a.ws + (MODE == 0 ? WS_SVT : WS_SVT1)) + (size_t)item * (DV * PA);
        unsigned zq[8], qq[8], kq[8], vq[NVP][8];
        const int qcol = (MODE == 0 ? hd * 128 : 1536 + hd * 128) + 2 * dp, zcol = (MODE == 0 ? 1024 * (1 + dir) + hd * 128 : 2048 + hd * 128) + 2 * dp;
        const int vcol = (MODE == 0 ? 3072 + hd * 128 : 2560 + hd * 256) + 2 * dp;
#pragma unroll
        for (int j = 0; j < 8; ++j) { const bf16_t* pr = P + (size_t)(b * S + scan_tok(dir, c * 64 + pg * 8 + j)) * LDP;
            qq[j] = *(const unsigned*)(pr + qcol); const unsigned zk = *(const unsigned*)(pr + zcol); zq[j] = zk; kq[j] = zk;
#pragma unroll
            for (int vv = 0; vv < NVP; ++vv) vq[vv][j] = *(const unsigned*)(pr + vcol + vv * 128); }
        if (MODE == 1) { if (tid < 256) { const int pos = tid >> 2, qd = tid & 3; const int r = b * S + scan_tok(dir, c * 64 + pos);
                const u32x2 av = *(const u32x2*)(P + (size_t)r * LDP + 4608 + dir * 16 + qd * 4); *(f32x4*)(aT + pos * 16 + qd * 4) = (f32x4){bflo(av.x), bfhi(av.x), bflo(av.y), bfhi(av.y)}; }
            __syncthreads(); }
        float g0[8], g1[8], k0[8], k1[8];
        if (MODE == 0) { const float lb0 = lb[dir * 1024 + hd * 128 + 2 * dp], lb1 = lb[dir * 1024 + hd * 128 + 2 * dp + 1];
#pragma unroll
            for (int j = 0; j < 8; ++j) { const float f0 = lb0 + (1.f - lb0) * sigmoidf_(bflo(zq[j])), f1 = lb1 + (1.f - lb1) * sigmoidf_(bfhi(zq[j]));
                g0[j] = __logf(f0); g1[j] = __logf(f1); k0[j] = 1.f - f0; k1[j] = 1.f - f1; } }
        else { float w0[16], w1[16]; const int wc_ = hd * 128 + 2 * dp; const float gb0 = a.in[22][dir * 512 + wc_], gb1 = a.in[22][dir * 512 + wc_ + 1];
#pragma unroll
            for (int i = 0; i < 16; ++i) { const float2 wv = *(const float2*)(a.in[21] + (size_t)(dir * 16 + i) * 512 + wc_); w0[i] = wv.x; w1[i] = wv.y; }
#pragma unroll
            for (int j = 0; j < 8; ++j) { float z0 = gb0, z1 = gb1;
#pragma unroll
                for (int i4 = 0; i4 < 4; ++i4) { const f32x4 av = *(const f32x4*)(aT + (pg * 8 + j) * 16 + i4 * 4);
#pragma unroll
                    for (int e = 0; e < 4; ++e) { z0 += av[e] * w0[i4 * 4 + e]; z1 += av[e] * w1[i4 * 4 + e]; } }
                g0[j] = (fminf(z0, 0.f) - __logf(1.f + __expf(-fabsf(z0)))) * (1.f / 16.f); g1[j] = (fminf(z1, 0.f) - __logf(1.f + __expf(-fabsf(z1)))) * (1.f / 16.f);
                k0[j] = bflo(kq[j]); k1[j] = bfhi(kq[j]); } }
#pragma unroll
        for (int j = 1; j < 8; ++j) { g0[j] += g0[j - 1]; g1[j] += g1[j - 1]; }
        *(float2*)(tot + pg * 128 + 2 * dp) = make_float2(g0[7], g1[7]);
        __syncthreads();
        float off0 = 0.f, off1 = 0.f, ref0 = 0.f, ref1 = 0.f, last0 = 0.f, last1 = 0.f;
#pragma unroll
        for (int p = 0; p < 8; ++p) { const float2 tp = *(const float2*)(tot + p * 128 + 2 * dp);
            if (p < pg) { off0 += tp.x; off1 += tp.y; } if (p < 4) { ref0 += tp.x; ref1 += tp.y; } last0 += tp.x; last1 += tp.y; }
        unsigned kh0[4], kh1[4];
        const float eref0 = __expf(ref0), eref1 = __expf(ref1), elr0 = __expf(last0 - ref0), elr1 = __expf(last1 - ref1);
#pragma unroll
        for (int j = 0; j < 8; j += 2) { float kha[2], khb[2];
#pragma unroll
            for (int e = 0; e < 2; ++e) { const int i = pg * 8 + j + e; const float G0 = off0 + g0[j + e], G1 = off1 + g1[j + e];
                float q0 = bflo(qq[j + e]), q1 = bfhi(qq[j + e]); if (MODE == 0) { q0 = siluf_(q0); q1 = siluf_(q1); } q0 *= qscale; q1 *= qscale;
                const float kk0 = k0[j + e], kk1 = k1[j + e];
                const float qt0 = q0 * __expf(G0 - ref0), qt1 = q1 * __expf(G1 - ref1), kt0 = kk0 * __expf(ref0 - G0), kt1 = kk1 * __expf(ref1 - G1);
                *(unsigned*)(QT + i * PQ + dp * 4) = cvtpk(qt0, qt1);
                *(unsigned*)(KT + i * PQ + dp * 4) = cvtpk(kt0, kt1);
                *(unsigned*)(rec + REC_QH + i * PQ + dp * 4) = cvtpk(qt0 * eref0, qt1 * eref1);
                kha[e] = kt0 * elr0; khb[e] = kt1 * elr1; }
            kh0[j >> 1] = cvtpk(kha[0], kha[1]); kh1[j >> 1] = cvtpk(khb[0], khb[1]); }
        *(u32x4*)(rec + REC_KHT + (2 * dp) * PA + pg * 16) = (u32x4){kh0[0], kh0[1], kh0[2], kh0[3]};
        *(u32x4*)(rec + REC_KHT + (2 * dp + 1) * PA + pg * 16) = (u32x4){kh1[0], kh1[1], kh1[2], kh1[3]};
        if (pg == 0) *(float2*)(rec + REC_AL + dp * 8) = make_float2(__expf(last0), __expf(last1));
#pragma unroll
        for (int vv = 0; vv < NVP; ++vv) { const int v0 = vv * 128 + 2 * dp; unsigned lo[4], hi[4];
#pragma unroll
            for (int j = 0; j < 8; j += 2) { lo[j >> 1] = (vq[vv][j] & 0xffffu) | (vq[vv][j + 1] << 16); hi[j >> 1] = (vq[vv][j] >> 16) | (vq[vv][j + 1] & 0xffff0000u); }
            *(u32x4*)(vt + v0 * PA + pg * 16) = (u32x4){lo[0], lo[1], lo[2], lo[3]};
            *(u32x4*)(vt + (v0 + 1) * PA + pg * 16) = (u32x4){hi[0], hi[1], hi[2], hi[3]}; }
        __syncthreads();
        { const int ti = wid >> 1; f32x4 acc[2] = {};
#pragma unroll
          for (int kk = 0; kk < 4; ++kk) { const int i = ti * 16 + l15;
              const bf16x8 bq = *(const bf16x8*)(QT + i * PQ + (kk * 32 + l4 * 8) * 2);
#pragma unroll
              for (int t2_ = 0; t2_ < 2; ++t2_) { const int sidx = ((wid & 1) * 2 + t2_) * 16 + l15;
                  const bf16x8 ak = *(const bf16x8*)(KT + sidx * PQ + (kk * 32 + l4 * 8) * 2);
                  acc[t2_] = __builtin_amdgcn_mfma_f32_16x16x32_bf16(ak, bq, acc[t2_], 0, 0, 0); } }
#pragma unroll
          for (int t2_ = 0; t2_ < 2; ++t2_) { const int tj = (wid & 1) * 2 + t2_, i = ti * 16 + l15, s0 = tj * 16 + 4 * l4;
              float x0 = (s0 + 0 <= i) ? acc[t2_][0] : 0.f, x1 = (s0 + 1 <= i) ? acc[t2_][1] : 0.f, x2 = (s0 + 2 <= i) ? acc[t2_][2] : 0.f, x3 = (s0 + 3 <= i) ? acc[t2_][3] : 0.f;
              u32x2 w_; w_.x = cvtpk(x0, x1); w_.y = cvtpk(x2, x3);
              *(u32x2*)(rec + REC_A + i * PA + s0 * 2) = w_; } }
        __syncthreads();
    }
}
template <int MODE>
DEV void scan_seq_phase(const Args& a, char* smem) {
    constexpr int NH = MODE == 0 ? 8 : 4, DV = MODE == 0 ? 128 : 256, NVS = DV / 32;
    constexpr int B_A = REC_A, B_QH = REC_QH, B_KHT = REC_KHT, B_AL = REC_AL, B_VT = REC_BYTES, VTS = 32 * PA, BUFB = REC_BYTES + VTS;
    constexpr int NPIECE = BUFB / 16, NREC = REC_BYTES / 16, STB = 32 * PQ;
    const int tid = tid_opaque(), wid = tid >> 6, lane = tid & 63, l15 = lane & 15, l4 = lane >> 4;
    char* ST = smem + 2 * BUFB;
    float* odir = (float*)(a.ws + WS_ODIR);
    for (int item = blockIdx.x; item < NB * NH * 2 * NVS; item += gridDim.x) {
        const int vs = (item >> 3) % NVS, rest = (item & 7) + 8 * ((item >> 3) / NVS);
        const int dir = rest & 1, hd = (rest >> 1) % NH, b = (rest >> 1) / NH;
        const char* rec0 = (const char*)(a.ws + (MODE == 0 ? WS_SREC : WS_SREC1)) + (size_t)rest * 36 * REC_BYTES;
        const char* vt0 = (const char*)(a.ws + (MODE == 0 ? WS_SVT : WS_SVT1)) + (size_t)rest * 36 * (DV * PA) + vs * VTS;
#define SC_LOAD(cc, bb) do { const char* _r = rec0 + (size_t)(cc) * REC_BYTES; const char* _v = vt0 + (size_t)(cc) * (DV * PA) - REC_BYTES; char* _l = smem + (bb) * BUFB; \
        for (int _p = tid; _p < NPIECE; _p += NT) __builtin_amdgcn_global_load_lds((const unsigned*)((_p < NREC ? _r : _v) + _p * 16), (unsigned*)(_l + _p * 16), 16, 0, 0); } while (0)
        for (int i = tid; i < STB / 16; i += NT) ((u32x4*)ST)[i] = (u32x4){0u, 0u, 0u, 0u};
        f32x4 Sacc[2] = {};
        SC_LOAD(0, 0);
        asm volatile("s_waitcnt vmcnt(0)" ::: "memory"); __syncthreads();
        for (int c = 0; c < 36; ++c) {
            const char* buf = smem + (c & 1) * BUFB; const char* STr = ST + (c & 1) * STB; char* STw = ST + ((c + 1) & 1) * STB;
            if (c + 1 < 36) SC_LOAD(c + 1, (c + 1) & 1);
            { const int ti = wid >> 1, tj = wid & 1, i = ti * 16 + l15, v = tj * 16 + l15; f32x4 acc = {};
#pragma unroll
              for (int kk = 0; kk < 2; ++kk) {
                  const bf16x8 av = *(const bf16x8*)(buf + B_VT + v * PA + (kk * 32 + l4 * 8) * 2);
                  const bf16x8 ba = *(const bf16x8*)(buf + B_A + i * PA + (kk * 32 + l4 * 8) * 2);
                  acc = __builtin_amdgcn_mfma_f32_16x16x32_bf16(av, ba, acc, 0, 0, 0); }
#pragma unroll
              for (int kk = 0; kk < 4; ++kk) {
                  const bf16x8 as_ = *(const bf16x8*)(STr + v * PQ + (kk * 32 + l4 * 8) * 2);
                  const bf16x8 bq = *(const bf16x8*)(buf + B_QH + i * PQ + (kk * 32 + l4 * 8) * 2);
                  acc = __builtin_amdgcn_mfma_f32_16x16x32_bf16(as_, bq, acc, 0, 0, 0); }
              const int r = b * S + scan_tok(dir, c * 64 + i);
              *(f32x4*)(odir + ((size_t)dir * R + r) * 1024 + hd * DV + vs * 32 + tj * 16 + 4 * l4) = acc; }
            { const int dr = wid * 16 + l15; const f32x4 al = *(const f32x4*)(buf + B_AL + (wid * 16 + 4 * l4) * 4);
#pragma unroll
              for (int tv = 0; tv < 2; ++tv) { Sacc[tv] *= al; const int v = tv * 16 + l15;
#pragma unroll
                  for (int kk = 0; kk < 2; ++kk) {
                      const bf16x8 ak = *(const bf16x8*)(buf + B_KHT + dr * PA + (kk * 32 + l4 * 8) * 2);
                      const bf16x8 bv = *(const bf16x8*)(buf + B_VT + v * PA + (kk * 32 + l4 * 8) * 2);
                      Sacc[tv] = __builtin_amdgcn_mfma_f32_16x16x32_bf16(ak, bv, Sacc[tv], 0, 0, 0); }
                  u32x2 w_; w_.x = cvtpk(Sacc[tv][0], Sacc[tv][1]); w_.y = cvtpk(Sacc[tv][2], Sacc[tv][3]);
                  *(u32x2*)(STw + v * PQ + (wid * 16 + 4 * l4) * 2) = w_; } }
            asm volatile("s_waitcnt vmcnt(0)" ::: "memory"); __syncthreads();
        }
#undef SC_LOAD
    }
}

namespace fa {
typedef short s16x4 __attribute__((ext_vector_type(4)));
typedef float f32x16 __attribute__((ext_vector_type(16)));
constexpr int QBLK = 32, KVBLK = 64, NW = 8;
constexpr float THR = 8.f;
#define FA_SBAR() __builtin_amdgcn_sched_barrier(0)
DEV int crow(int r, int hi) { return (r & 3) + 8 * (r >> 2) + 4 * hi; }
template <int DQ> DEV int kswz(int row, int colB) { return row * (DQ * 2) + (colB ^ ((row & 7) << 4)); }
template <int DQ> DEV void partialSM(f32x16& p0, f32x16& p1, float& m_reg, float& mn, float& alpha) {
    constexpr float SCALE = DQ == 128 ? 0.08838834764831845f : 0.07216878364870322f;
    constexpr float C = SCALE * 1.4426950408889634f;
    float pmax = p0[0];
#pragma unroll
    for (int r = 1; r < 16; ++r) pmax = fmaxf(pmax, p0[r]);
#pragma unroll
    for (int r = 0; r < 16; ++r) pmax = fmaxf(pmax, p1[r]);
    { auto rr = __builtin_amdgcn_permlane32_swap(__float_as_uint(pmax), __float_as_uint(pmax), false, false);
      pmax = fmaxf(__uint_as_float(rr[0]), __uint_as_float(rr[1])); }
    if (__builtin_expect(__all(pmax - m_reg <= THR / SCALE), 1)) { mn = m_reg; alpha = 1.f; }
    else { mn = fmaxf(m_reg, pmax); alpha = __builtin_amdgcn_exp2f((m_reg - mn) * C); m_reg = mn; }
    const float mnC = -mn * C;
#pragma unroll
    for (int r = 0; r < 16; ++r) p0[r] = fmaf(p0[r], C, mnC);
#pragma unroll
    for (int r = 0; r < 16; ++r) p1[r] = fmaf(p1[r], C, mnC);
#pragma unroll
    for (int r = 0; r < 16; ++r) p0[r] = __builtin_amdgcn_exp2f(p0[r]);
}
DEV void finishSM(f32x16& p0, f32x16& p1, float alpha, float& l_reg, bf16x8& pa0, bf16x8& pa1, bf16x8& pa2, bf16x8& pa3) {
#pragma unroll
    for (int r = 0; r < 16; ++r) p1[r] = __builtin_amdgcn_exp2f(p1[r]);
    float ps = 0;
#pragma unroll
    for (int r = 0; r < 16; ++r) ps += p0[r];
#pragma unroll
    for (int r = 0; r < 16; ++r) ps += p1[r];
    { auto rr = __builtin_amdgcn_permlane32_swap(__float_as_uint(ps), __float_as_uint(ps), false, false);
      ps = __uint_as_float(rr[0]) + __uint_as_float(rr[1]); }
    l_reg = l_reg * alpha + ps;
#define FA_PK4(P, BASE, OUT) do { unsigned a0 = cvtpk(P[BASE + 0], P[BASE + 1]), a1 = cvtpk(P[BASE + 2], P[BASE + 3]);   \
    unsigned b0 = cvtpk(P[BASE + 4], P[BASE + 5]), b1 = cvtpk(P[BASE + 6], P[BASE + 7]);                              \
    auto r0 = __builtin_amdgcn_permlane32_swap(a0, b0, false, false); auto r1 = __builtin_amdgcn_permlane32_swap(a1, b1, false, false); \
    u32x4 w = {r0[0], r1[0], r0[1], r1[1]}; OUT = *reinterpret_cast<bf16x8*>(&w); } while (0)
    FA_PK4(p0, 0, pa0); FA_PK4(p0, 8, pa1); FA_PK4(p1, 0, pa2); FA_PK4(p1, 8, pa3);
#undef FA_PK4
}
template <int DQ> DEV void qkt(f32x16& p0, f32x16& p1, const char* Ks, const bf16x8* qr, int r32, int hi) {
    p0 = f32x16{}; p1 = f32x16{};
#pragma unroll
    for (int d0 = 0; d0 < DQ / 16; ++d0) { const int cb = (d0 * 16 + hi * 8) * 2;
        const bf16x8 b0 = *reinterpret_cast<const bf16x8*>(Ks + kswz<DQ>(r32, cb));
        const bf16x8 b1 = *reinterpret_cast<const bf16x8*>(Ks + kswz<DQ>(32 + r32, cb));
        p0 = __builtin_amdgcn_mfma_f32_32x32x16_bf16(b0, qr[d0], p0, 0, 0, 0);
        p1 = __builtin_amdgcn_mfma_f32_32x32x16_bf16(b1, qr[d0], p1, 0, 0, 0); }
}
DEV int v_st(int k, int c) { const int kk = (k & ~0xC) | ((k & 4) << 1) | ((k & 8) >> 1); return ((kk >> 3) * 4 + (c >> 5)) * 512 + ((kk & 7) * 32 + (c & 31)) * 2; }
DEV int v_rd_base(int lane) { return ((lane & 3) << 3) | (((lane >> 2) & 3) << 6) | (((lane >> 4) & 1) << 5) | (((lane >> 5) & 1) << 8); }
constexpr int v_rd_off(int d0, int ks, int half) { return d0 * 512 + ks * 4096 + half * 2048; }
template <int OFF> DEV s16x4 tr_read(int vb) { s16x4 r; asm volatile("ds_read_b64_tr_b16 %0, %1 offset:%2" : "=&v"(r) : "v"(vb), "i"(OFF) : "memory"); return r; }
template <int D0> DEV void pv_one(f32x16& od, int vb, bf16x8 pa0, bf16x8 pa1, bf16x8 pa2, bf16x8 pa3) {
    const s16x4 l0 = tr_read<v_rd_off(D0, 0, 0)>(vb), h0 = tr_read<v_rd_off(D0, 0, 1)>(vb), l1 = tr_read<v_rd_off(D0, 1, 0)>(vb), h1 = tr_read<v_rd_off(D0, 1, 1)>(vb);
    const s16x4 l2 = tr_read<v_rd_off(D0, 2, 0)>(vb), h2 = tr_read<v_rd_off(D0, 2, 1)>(vb), l3 = tr_read<v_rd_off(D0, 3, 0)>(vb), h3 = tr_read<v_rd_off(D0, 3, 1)>(vb);
    asm volatile("s_waitcnt lgkmcnt(0)" ::: "memory"); FA_SBAR();
#define FA_PK(L, H) (bf16x8){L[0], L[1], L[2], L[3], H[0], H[1], H[2], H[3]}
    od = __builtin_amdgcn_mfma_f32_32x32x16_bf16(pa0, FA_PK(l0, h0), od, 0, 0, 0);
    od = __builtin_amdgcn_mfma_f32_32x32x16_bf16(pa1, FA_PK(l1, h1), od, 0, 0, 0);
    od = __builtin_amdgcn_mfma_f32_32x32x16_bf16(pa2, FA_PK(l2, h2), od, 0, 0, 0);
    od = __builtin_amdgcn_mfma_f32_32x32x16_bf16(pa3, FA_PK(l3, h3), od, 0, 0, 0);
#undef FA_PK
}
DEV void pv_d0(f32x16* o, int vb, bf16x8 pa0, bf16x8 pa1, bf16x8 pa2, bf16x8 pa3) {
    pv_one<0>(o[0], vb, pa0, pa1, pa2, pa3); pv_one<1>(o[1], vb, pa0, pa1, pa2, pa3); pv_one<2>(o[2], vb, pa0, pa1, pa2, pa3); pv_one<3>(o[3], vb, pa0, pa1, pa2, pa3);
}
template <int DQ>
DEV void attn_body(const bf16_t* __restrict__ Qb, const bf16_t* __restrict__ Kh, const bf16_t* __restrict__ Vh, bf16_t* __restrict__ Ob, int LDO_, int seq_, char* lds) {
    constexpr int LDO = D, seq = S; (void)LDO_; (void)seq_;
    constexpr int NKC = DQ / 64, KC8 = DQ / 8;
    constexpr int SHM_V = KVBLK * 128 * 2, SHM_K = KVBLK * DQ * 2;
    const int tid = tid_opaque(), wid = tid >> 6, lane = tid & 63, r32 = lane & 31, hi = lane >> 5;
    char* V_lds = lds; char* K_lds = lds + 2 * SHM_V;
    float* wsx = (float*)(lds + 2 * SHM_V + 2 * SHM_K) + wid * 64; float* li_l = wsx; float* al_l = wsx + 32;
    float m_reg = -1e30f, l_reg = 0; f32x16 o[4] = {}; bf16x8 qr[DQ / 16];
    const bf16_t* Qw = Qb + (size_t)(wid * QBLK + r32) * DQ + hi * 8;
#pragma unroll
    for (int d0 = 0; d0 < DQ / 16; ++d0) qr[d0] = *reinterpret_cast<const bf16x8*>(Qw + d0 * 16);
    const int sr = tid >> 4, sc = (tid & 15) * 8;
    const int vb0 = (int)(uintptr_t)V_lds + v_rd_base(lane);
    struct { bf16x8 vs0, vs1, ks[NKC]; } sr_[2];
#define SLOAD(i, k0) do { sr_[i].vs0 = *reinterpret_cast<const bf16x8*>(&Vh[(size_t)((k0) + sr) * 128 + sc]); sr_[i].vs1 = *reinterpret_cast<const bf16x8*>(&Vh[(size_t)((k0) + 32 + sr) * 128 + sc]); \
    _Pragma("unroll") for (int _c = 0; _c < NKC; ++_c) { const int ch = tid + _c * 512, kr = ch / KC8, kc = ch - kr * KC8; sr_[i].ks[_c] = *reinterpret_cast<const bf16x8*>(&Kh[(size_t)((k0) + kr) * DQ + kc * 8]); } } while (0)
#define SWRITE(b, i) do { const int t2_ = tid_opaque(), sr2_ = t2_ >> 4, sc2_ = (t2_ & 15) * 8; *(bf16x8*)(V_lds + (b) * SHM_V + v_st(sr2_, sc2_)) = sr_[i].vs0; *(bf16x8*)(V_lds + (b) * SHM_V + v_st(32 + sr2_, sc2_)) = sr_[i].vs1; \
    _Pragma("unroll") for (int _c = 0; _c < NKC; ++_c) { const int ch = tid + _c * 512, kr = ch / KC8, kc = ch - kr * KC8; *(bf16x8*)(K_lds + (b) * SHM_K + kswz<DQ>(kr, kc * 16)) = sr_[i].ks[_c]; } } while (0)
#define SWAIT() do { if constexpr (NKC == 2) asm volatile("s_waitcnt vmcnt(4)" ::: "memory"); else asm volatile("s_waitcnt vmcnt(5)" ::: "memory"); } while (0)
#define RESC(a_) do { if (__any((a_) < 1.f)) { if (hi == 0) al_l[r32] = (a_); asm volatile("s_waitcnt lgkmcnt(0)" ::: "memory"); \
    _Pragma("unroll") for (int d = 0; d < 4; ++d) _Pragma("unroll") for (int r = 0; r < 16; ++r) o[d][r] *= al_l[crow(r, hi)]; } } while (0)
    f32x16 pA0, pA1, pB0, pB1; float mnA, mnB, alA, alB; bf16x8 pa0, pa1, pa2, pa3; const int NTL = seq / KVBLK;
    constexpr int SE = 0, SO = 1;
    SLOAD(SE, 0); asm volatile("s_waitcnt vmcnt(0)" ::: "memory"); SWRITE(0, SE); __syncthreads();
    qkt<DQ>(pA0, pA1, K_lds, qr, r32, hi); partialSM<DQ>(pA0, pA1, m_reg, mnA, alA);
    SLOAD(SO, KVBLK); if (2 < NTL) SLOAD(SE, 2 * KVBLK);
    SWAIT(); SWRITE(1, SO); __syncthreads();
    for (int j = 1; j + 1 < NTL; j += 2) {
        FA_SBAR(); qkt<DQ>(pB0, pB1, K_lds + SHM_K, qr, r32, hi);
        finishSM(pA0, pA1, alA, l_reg, pa0, pa1, pa2, pa3); FA_SBAR();
        SLOAD(SO, (j + 2) * KVBLK); FA_SBAR();
        pv_d0(o, vb0, pa0, pa1, pa2, pa3); partialSM<DQ>(pB0, pB1, m_reg, mnB, alB);
        __syncthreads(); SWAIT(); SWRITE(0, SE);
        RESC(alB); __syncthreads();
        FA_SBAR(); qkt<DQ>(pA0, pA1, K_lds, qr, r32, hi);
        finishSM(pB0, pB1, alB, l_reg, pa0, pa1, pa2, pa3); FA_SBAR();
        if (j + 3 < NTL) SLOAD(SE, (j + 3) * KVBLK); FA_SBAR();
        pv_d0(o, vb0 + SHM_V, pa0, pa1, pa2, pa3); partialSM<DQ>(pA0, pA1, m_reg, mnA, alA);
        __syncthreads(); SWAIT(); SWRITE(1, SO);
        RESC(alA); __syncthreads();
    }
    FA_SBAR(); qkt<DQ>(pB0, pB1, K_lds + SHM_K, qr, r32, hi);
    finishSM(pA0, pA1, alA, l_reg, pa0, pa1, pa2, pa3); FA_SBAR();
    pv_d0(o, vb0, pa0, pa1, pa2, pa3); partialSM<DQ>(pB0, pB1, m_reg, mnB, alB);
    __syncthreads(); RESC(alB);
    finishSM(pB0, pB1, alB, l_reg, pa0, pa1, pa2, pa3); FA_SBAR();
    pv_d0(o, vb0 + SHM_V, pa0, pa1, pa2, pa3);
    if (hi == 0) li_l[r32] = l_reg; asm volatile("s_waitcnt lgkmcnt(0)" ::: "memory");
    float rli[16];
#pragma unroll
    for (int r = 0; r < 16; ++r) rli[r] = __builtin_amdgcn_rcpf(li_l[crow(r, hi)]);
    bf16_t* Ow = Ob + (size_t)(wid * QBLK) * LDO;
#pragma unroll
    for (int r = 0; r < 16; ++r) { const int orow = crow(r, hi);
#pragma unroll
        for (int d0 = 0; d0 < 4; ++d0) Ow[(size_t)orow * LDO + d0 * 32 + r32] = f2bf(o[d0][r] * rli[r]); }
    __syncthreads();
#undef SLOAD
#undef SWRITE
#undef SWAIT
#undef RESC
}

template <int DQ>
DEV void attn_body_simple(const bf16_t* __restrict__ Qb, const bf16_t* __restrict__ Kh, const bf16_t* __restrict__ Vh, bf16_t* __restrict__ Ob, int LDO, int seq, char* lds) {
    constexpr int NKC = DQ / 64, KC8 = DQ / 8;
    constexpr int SHM_V = KVBLK * 128 * 2, SHM_K = KVBLK * DQ * 2;
    const int tid = tid_opaque(), wid = tid >> 6, lane = tid & 63, r32 = lane & 31, hi = lane >> 5;
    char* V_lds = lds; char* K_lds = lds + 2 * SHM_V;
    float* wsx = (float*)(lds + 2 * SHM_V + 2 * SHM_K) + wid * 64; float* li_l = wsx; float* al_l = wsx + 32;
    float m_reg = -1e30f, l_reg = 0; f32x16 o[4] = {}; bf16x8 qr[DQ / 16];
    const bf16_t* Qw = Qb + (size_t)(wid * QBLK + r32) * DQ + hi * 8;
#pragma unroll
    for (int d0 = 0; d0 < DQ / 16; ++d0) qr[d0] = *reinterpret_cast<const bf16x8*>(Qw + d0 * 16);
    const int sr = tid >> 4, sc = (tid & 15) * 8, vst0 = v_st(sr, sc), vst1 = v_st(32 + sr, sc);
    const int vb0 = (int)(uintptr_t)V_lds + v_rd_base(lane);
    bf16x8 vs0, vs1, ks[NKC];
#define SLOAD(k0) do { vs0 = *reinterpret_cast<const bf16x8*>(&Vh[(size_t)((k0) + sr) * 128 + sc]); vs1 = *reinterpret_cast<const bf16x8*>(&Vh[(size_t)((k0) + 32 + sr) * 128 + sc]); \
    _Pragma("unroll") for (int _c = 0; _c < NKC; ++_c) { const int ch = tid + _c * 512, kr = ch / KC8, kc = ch - kr * KC8; ks[_c] = *reinterpret_cast<const bf16x8*>(&Kh[(size_t)((k0) + kr) * DQ + kc * 8]); } } while (0)
#define SWRITE(b) do { *(bf16x8*)(V_lds + (b) * SHM_V + vst0) = vs0; *(bf16x8*)(V_lds + (b) * SHM_V + vst1) = vs1; \
    _Pragma("unroll") for (int _c = 0; _c < NKC; ++_c) { const int ch = tid + _c * 512, kr = ch / KC8, kc = ch - kr * KC8; *(bf16x8*)(K_lds + (b) * SHM_K + kswz<DQ>(kr, kc * 16)) = ks[_c]; } } while (0)
    f32x16 p0, p1; float mn, al; bf16x8 pa0, pa1, pa2, pa3; const int NTL = seq / KVBLK;
    SLOAD(0); SWRITE(0); __syncthreads();
    for (int j = 0; j < NTL; ++j) {
        const int bsel = j & 1;
        if (j + 1 < NTL) SLOAD((j + 1) * KVBLK);
        FA_SBAR(); qkt<DQ>(p0, p1, K_lds + bsel * SHM_K, qr, r32, hi);
        partialSM<DQ>(p0, p1, m_reg, mn, al);
        if (__any(al < 1.f)) { if (hi == 0) al_l[r32] = al; asm volatile("s_waitcnt lgkmcnt(0)" ::: "memory");
#pragma unroll
            for (int d = 0; d < 4; ++d)
#pragma unroll
                for (int r = 0; r < 16; ++r) o[d][r] *= al_l[crow(r, hi)]; }
        finishSM(p0, p1, al, l_reg, pa0, pa1, pa2, pa3); FA_SBAR();
        pv_d0(o, vb0 + bsel * SHM_V, pa0, pa1, pa2, pa3);
        if (j + 1 < NTL) SWRITE(bsel ^ 1);
        __syncthreads();
    }
    if (hi == 0) li_l[r32] = l_reg; asm volatile("s_waitcnt lgkmcnt(0)" ::: "memory");
    float rli[16];
#pragma unroll
    for (int r = 0; r < 16; ++r) rli[r] = __builtin_amdgcn_rcpf(li_l[crow(r, hi)]);
    bf16_t* Ow = Ob + (size_t)(wid * QBLK) * LDO;
#pragma unroll
    for (int r = 0; r < 16; ++r) { const int orow = crow(r, hi);
#pragma unroll
        for (int d0 = 0; d0 < 4; ++d0) Ow[(size_t)orow * LDO + d0 * 32 + r32] = f2bf(o[d0][r] * rli[r]); }
    __syncthreads();
#undef SLOAD
#undef SWRITE
}
}

template <int DQ, int HKV, bool WITH_CTX>
DEV void attn_phase(const Args& a, int colbase, char* smem) {
    const bf16_t* Qb = (const bf16_t*)(a.ws + WS_QB); const bf16_t* Kb = (const bf16_t*)(a.ws + WS_KB); const bf16_t* Vb = (const bf16_t*)(a.ws + WS_VB);
    bf16_t* A2 = (bf16_t*)(a.ws + WS_A2);
    const int nunits = 256 + (WITH_CTX ? 32 : 0);
    for (int u = blockIdx.x; u < nunits; u += gridDim.x) {
        int b, hh, qb, nk;
        if (u < 256) { if (HKV == 8) { const int bh = u & 31; b = bh >> 3; hh = bh & 7; qb = 1 + (u >> 5); }
                       else { const int pr = u & 7, rest = u >> 3; b = pr >> 1; hh = (pr & 1) * 4 + (rest & 3); qb = 1 + (rest >> 2); }
                       nk = S; }
        else { const int bh = u - 256; b = bh >> 3; hh = bh & 7; qb = 0; nk = TC; }
        const int hk = hh / (8 / HKV);
        if constexpr (DQ == 192) fa::attn_body_simple<DQ>(Qb + (((size_t)b * 8 + hh) * S + qb * 256) * DQ, Kb + ((size_t)b * HKV + hk) * S * DQ, Vb + ((size_t)b * HKV + hk) * S * 128,
                          A2 + ((size_t)b * S + qb * 256) * D + colbase + hh * 128, D, nk, smem);
        else fa::attn_body<DQ>(Qb + (((size_t)b * 8 + hh) * S + qb * 256) * DQ, Kb + ((size_t)b * HKV + hk) * S * DQ, Vb + ((size_t)b * HKV + hk) * S * 128,
                          A2 + ((size_t)b * S + qb * 256) * D + colbase + hh * 128, D, nk, smem);
    }
}

template <int MODE>
DEV void mixout_phase(const Args& a, bool latent_only) {
    const int tid = tid_opaque(), w = tid >> 6, lane = tid & 63;
    constexpr int NH = MODE == 0 ? 8 : 4, DV = MODE == 0 ? 128 : 256, LDP = MODE == 0 ? AB_INP : CD_INP, GC = MODE == 0 ? 4096 : 3584, CB = MODE == 0 ? 0 : 1024, PER = DV / 64;
    const bf16_t* P = (const bf16_t*)(a.ws + WS_P); const float* odir = (const float*)(a.ws + WS_ODIR); bf16_t* A2 = (bf16_t*)(a.ws + WS_A2);
    const float* g = MODE == 0 ? a.in[12] : a.in[23];
    for (int it = blockIdx.x * 8 + w; it < R * NH; it += gridDim.x * 8) {
        const int r = it / NH, hd = it - r * NH; const int t = r % S; if (latent_only && t < TC) continue;
        float o[PER]; float ss = 0.f;
#pragma unroll
        for (int j = 0; j < PER; ++j) { const int c = hd * DV + j * 64 + lane; o[j] = odir[(size_t)r * 1024 + c] + odir[((size_t)R + r) * 1024 + c]; ss += o[j] * o[j]; }
        ss = wave_sum(ss); const float rs = rsqrtf(ss * (1.f / DV) + EPS);
#pragma unroll
        for (int j = 0; j < PER; ++j) { const int c = hd * DV + j * 64 + lane; const float gt = bf2f(P[(size_t)r * LDP + GC + c]);
            const float act = MODE == 0 ? sigmoidf_(gt) : siluf_(gt);
            A2[(size_t)r * D + CB + c] = f2bf(o[j] * rs * g[j * 64 + lane] * act); }
    }
}

#define GAS __attribute__((address_space(1)))
typedef GAS unsigned gu32; typedef GAS unsigned long long gu64;
#define RLX_AGENT __ATOMIC_RELAXED, __HIP_MEMORY_SCOPE_AGENT
struct EpiMoeUpSc1 { bf16_t* hid; int rowbase, nvalid;
    DEV void operator()(const f32x4 (&acc)[2][2][4][2], int brow, int bcol, int wr, int wc, int fr, int fq) const {
        const int hc = (bcol >> 1) + wc * 32 + fq * 4;
#pragma unroll
        for (int ai = 0; ai < 2; ++ai)
#pragma unroll
            for (int m = 0; m < 4; ++m) { const int lr = ai * HALF + wr * 64 + m * 16 + fr;
                if (lr < nvalid) { bf16_t* rowp = hid + (size_t)(rowbase + lr) * EDIM + hc;
#pragma unroll
                    for (int n = 0; n < 2; ++n) { const f32x4 a_ = acc[ai][0][m][n], b_ = acc[ai][1][m][n];
                        const unsigned lo = cvtpk(siluf_(a_[0]) * b_[0], siluf_(a_[1]) * b_[1]), hi = cvtpk(siluf_(a_[2]) * b_[2], siluf_(a_[3]) * b_[3]);
                        __hip_atomic_store((gu64*)(rowp + n * 16), (unsigned long long)lo | ((unsigned long long)hi << 32), RLX_AGENT); } } }
    } };
DEV void moe_phase_fused(const Args& a, int l, char* smem) {
    const int tid = tid_opaque();
    unsigned* ctl = (unsigned*)(a.ws + WS_CTL);
    unsigned* cnt = ctl + CW_CNT + l * 16 * CNT_STRIDE; unsigned* head = ctl + CW_MOEQ + l * 64; unsigned* ready = ctl + CW_RDY + l * (NE * 36 * 16);
    const int* list = (const int*)(a.ws + WS_LIST);
    const bf16_t* h = (const bf16_t*)(a.ws + WS_H); const bf16_t* w13 = moe_w13(a, l); const bf16_t* w2 = moe_w2(a, l);
    bf16_t* hid = (bf16_t*)(a.ws + WS_QB); bf16_t* y = (bf16_t*)(a.ws + WS_P);
    volatile int* tab = (volatile int*)(smem + SHM_GEMM);
    if (tid == 0) { int ub = 0, of = 0, nts[NE];
        for (int e = 0; e < NE; ++e) { const int n = (int)__hip_atomic_load((gu32*)(cnt + e * CNT_STRIDE), RLX_AGENT); nts[e] = (n + 255) >> 8; tab[e] = n; tab[16 + e] = ub; tab[50 + e] = of; ub += nts[e] * 4; of += n; }
        tab[32] = ub; int db = ub;
        for (int e = 0; e < NE; ++e) { tab[33 + e] = db; db += nts[e] * 8; }
        tab[49] = db; }
    for (;;) {
        __syncthreads();
        if (tid == 0) tab[66] = (int)__hip_atomic_fetch_add((gu32*)head, 1u, RLX_AGENT);
        __syncthreads();
        const int item = __builtin_amdgcn_readfirstlane(tab[66]), nup = __builtin_amdgcn_readfirstlane(tab[32]), ntot = __builtin_amdgcn_readfirstlane(tab[49]);
        if (item >= ntot) break;
        const bool up = item < nup; const int tb0 = up ? 16 : 33;
        int e = 0;
#pragma unroll 1
        for (int q = 1; q < NE; ++q) if (item >= __builtin_amdgcn_readfirstlane(tab[tb0 + q])) e = q;
        const int n = __builtin_amdgcn_readfirstlane(tab[e]), nt_ = (n + 255) >> 8, t = item - __builtin_amdgcn_readfirstlane(tab[tb0 + e]), off = __builtin_amdgcn_readfirstlane(tab[50 + e]);
        const int i = t % nt_, pn = t / nt_, nv = min(256, n - i * 256);
        gu32* flag = (gu32*)(ready + (e * 36 + i) * 16);
        if (up) {
            EpiMoeUpSc1 epi{hid, off + i * 256, nv};
            gemm_tile<true>(h, w13 + (size_t)e * 1024 * D, D, D, 0, pn * 256, list + (size_t)e * R + i * 256, nv, smem, epi);
            asm volatile("s_waitcnt vmcnt(0)" ::: "memory");
            __syncthreads();
            if (tid == 0) __hip_atomic_fetch_add(flag, 1u, RLX_AGENT);
        } else {
            if (tid < 64) { unsigned spins = 0;
                while ((unsigned)__builtin_amdgcn_readfirstlane(__hip_atomic_load(flag, RLX_AGENT)) < 4u) { __builtin_amdgcn_s_sleep(2); if (++spins > (1u << 22)) break; }
                __builtin_amdgcn_fence(__ATOMIC_ACQUIRE, "agent");
                asm volatile("s_waitcnt vmcnt(0)" ::: "memory"); }
            __syncthreads();
            EpiMoeDown epi{y, list + (size_t)e * R + i * 256, nv};
            gemm_tile<false>(hid, w2 + (size_t)e * D * EDIM, EDIM, EDIM, off + i * 256, pn * 256, nullptr, 0, smem, epi);
        }
    }
    __syncthreads();
}

DEV void moe_phase_up(const Args& a, int l, char* smem) {
    unsigned* cnt = (unsigned*)(a.ws + WS_CTL) + CW_CNT + l * 16 * CNT_STRIDE;
    const int* list = (const int*)(a.ws + WS_LIST);
    const bf16_t* h = (const bf16_t*)(a.ws + WS_H); const bf16_t* w13 = moe_w13(a, l); bf16_t* hid = (bf16_t*)(a.ws + WS_QB);
    int u = blockIdx.x, base = 0, off = 0;
    for (int e = 0; e < NE; ++e) { const int n = (int)__builtin_amdgcn_readfirstlane(__hip_atomic_load(cnt + e * CNT_STRIDE, __ATOMIC_RELAXED, __HIP_MEMORY_SCOPE_AGENT)), nt_ = (n + 255) >> 8, nu = nt_ * 4;
        for (; u < base + nu; u += gridDim.x) { const int t = u - base, i = t % nt_, pn = t / nt_; const int nv = min(256, n - i * 256);
            EpiMoeUp epi{hid, off + i * 256, nv};
            gemm_tile<true>(h, w13 + (size_t)e * 1024 * D, D, D, 0, pn * 256, list + (size_t)e * R + i * 256, nv, smem, epi); }
        base += nu; off += n; }
}
DEV void moe_phase_down(const Args& a, int l, char* smem) {
    unsigned* cnt = (unsigned*)(a.ws + WS_CTL) + CW_CNT + l * 16 * CNT_STRIDE;
    const int* list = (const int*)(a.ws + WS_LIST);
    const bf16_t* hid = (const bf16_t*)(a.ws + WS_QB); const bf16_t* w2 = moe_w2(a, l); bf16_t* y = (bf16_t*)(a.ws + WS_P);
    int u = blockIdx.x, base = 0, off = 0;
    for (int e = 0; e < NE; ++e) { const int n = (int)__builtin_amdgcn_readfirstlane(__hip_atomic_load(cnt + e * CNT_STRIDE, __ATOMIC_RELAXED, __HIP_MEMORY_SCOPE_AGENT)), nt_ = (n + 255) >> 8, nu = nt_ * 8;
        for (; u < base + nu; u += gridDim.x) { const int t = u - base, i = t % nt_, pn = t / nt_; const int nv = min(256, n - i * 256);
            EpiMoeDown epi{y, list + (size_t)e * R + i * 256, nv};
            gemm_tile<false>(hid, w2 + (size_t)e * D * EDIM, EDIM, EDIM, off + i * 256, pn * 256, nullptr, 0, smem, epi); }
        base += nu; off += n; }
}
template <bool FINAL>
DEV void combine_phase(const Args& a, int l, bool latent_only, bool dry = false) {
    const int tid = tid_opaque(), w = tid >> 6, lane = tid & 63;
    bf16_t* xres = (bf16_t*)(a.ws + WS_XRES); const bf16_t* y = (const bf16_t*)(a.ws + WS_P); const int* tok = (const int*)(a.ws + WS_TOK);
    const float* modv = (const float*)(a.ws + WS_MODV) + (size_t)l * 5 * MODN; bf16_t* h = (bf16_t*)(a.ws + WS_H);
    const float* gain = FINAL ? a.in[8] : a.in[6] + (size_t)(l + 1) * D;
    for (int r = blockIdx.x * 8 + w; r < R; r += gridDim.x * 8) {
        const int b = r / S, t = r - b * S; if (latent_only && t < TC) continue;
        const int v = t < TC ? 4 : b; const float w0 = ((const float*)tok)[r * 4 + 2], w1 = ((const float*)tok)[r * 4 + 3];
        const float* g2 = modv + (size_t)v * MODN + 5 * D; bf16_t* xp = xres + (size_t)r * D; const bf16_t* y0 = y + (size_t)(2 * r) * D; const bf16_t* y1 = y0 + D;
        f32x4 x[8]; float ss = 0.f;
#pragma unroll
        for (int j = 0; j < 8; ++j) { const int c = j * 256 + lane * 4;
            const u32x2 a0 = *(const u32x2*)(y0 + c), a1 = *(const u32x2*)(y1 + c);
            const f32x4 yy = {w0 * bflo(a0.x) + w1 * bflo(a1.x), w0 * bfhi(a0.x) + w1 * bfhi(a1.x), w0 * bflo(a0.y) + w1 * bflo(a1.y), w0 * bfhi(a0.y) + w1 * bfhi(a1.y)};
            const u32x2 xq = *(const u32x2*)(xp + c);
            x[j] = (f32x4){bflo(xq.x), bfhi(xq.x), bflo(xq.y), bfhi(xq.y)} + *(const f32x4*)(g2 + c) * yy;
            if (!FINAL && !dry) { u32x2 xw; xw.x = cvtpk(x[j][0], x[j][1]); xw.y = cvtpk(x[j][2], x[j][3]); *(u32x2*)(xp + c) = xw; }
            ss += x[j][0] * x[j][0] + x[j][1] * x[j][1] + x[j][2] * x[j][2] + x[j][3] * x[j][3]; }
        ss = wave_sum(ss); const float rs = rsqrtf(ss * (1.f / D) + EPS);
        if (FINAL) { float* op = a.out + ((size_t)b * TL + (t - TC)) * D;
#pragma unroll
            for (int j = 0; j < 8; ++j) { const int c = j * 256 + lane * 4; *(f32x4*)(op + c) = x[j] * rs * *(const f32x4*)(gain + c); } }
        else { const float* sh = modv + 5 * MODN + (size_t)v * MODN; const float* sc = sh + D;
#pragma unroll
            for (int j = 0; j < 8; ++j) { const int c = j * 256 + lane * 4;
                const f32x4 yv = (x[j] * rs * *(const f32x4*)(gain + c)) * (1.f + *(const f32x4*)(sc + c)) + *(const f32x4*)(sh + c);
                u32x2 pk; pk.x = cvtpk(yv[0], yv[1]); pk.y = cvtpk(yv[2], yv[3]); if (!dry) *(u32x2*)(h + (size_t)r * D + c) = pk; } }
    }
}

constexpr int LDS_BYTES = 140 * 1024;
constexpr int NPHASES = 25;
__global__ void __launch_bounds__(NT, 2) fwd(Args a) {
    extern __shared__ __attribute__((aligned(16))) char smem[];
    unsigned char* ws = a.ws;
    const int lo = a.ph_lo, hi = a.ph_hi;
    volatile LAS unsigned* xbw = (volatile LAS unsigned*)(smem + LDS_BYTES - 16);
    if (threadIdx.x < 4) xbw[threadIdx.x] = 0u;
    __syncthreads();
    XcdBarrier bar; bar.bar = (unsigned*)(ws + WS_CTL); bar.x = 0; bar.st = xbw;
    if (hi - lo > 1) bar = xcd_barrier_post((unsigned*)(ws + WS_CTL), xbw);
#ifndef BARRIER_REP
#define BARRIER_REP 1
#endif
#define SEAM(k) do { if (IN(k) && IN((k) + 1)) { for (int br_ = 0; br_ < BARRIER_REP; ++br_) xcd_barrier(bar); } } while (0)
#ifndef PHASE_MASK
#define PHASE_MASK 0xFFFFFFFFu
#endif
#define IN(k) (((PHASE_MASK >> (k)) & 1u) && lo <= (k) && (k) < hi)
#ifndef REPEAT_MASK
#define REPEAT_MASK 0u
#endif
#ifndef SUBREP
#define SUBREP 0
#endif
#define PHASE(k) if (IN(k)) for (int rep_ = 0; rep_ < ((((REPEAT_MASK) >> (k)) & 1u) ? 2 : 1); ++rep_, ((((REPEAT_MASK) >> (k)) & 1u) ? __syncthreads() : (void)0))
    const float* modv = (const float*)(ws + WS_MODV);
    bf16_t* H = (bf16_t*)(ws + WS_H); bf16_t* P = (bf16_t*)(ws + WS_P); bf16_t* A2 = (bf16_t*)(ws + WS_A2); bf16_t* XR = (bf16_t*)(ws + WS_XRES);
    PHASE(0) {
        cvt_weight(a.in[9], (bf16_t*)(ws + WS_WABIN), D, AB_IN, AB_INP, 1, 0, 0, 128, 0, nullptr, smem, 2);
        mod_phase<false>(a, 0, smem);
        misc_phase(a);
    }
    SEAM(0);
    PHASE(1) norm_phase<false, true>(a, 0, 0, a.in[6], false, smem);
    SEAM(1);
    PHASE(2) { int cur = 0; EpiInAB e{P, (float*)(ws + WS_SSQ), (bf16_t*)(ws + WS_KB), (const float2*)(ws + WS_TABB), smem};
#ifdef SEAM_PROBE
                 gemm_phase(H, (const bf16_t*)(ws + WS_WABIN), R, AB_INP, D, smem, e, cur, 0, 512); xcd_barrier(bar); cur = 0; gemm_phase(H, (const bf16_t*)(ws + WS_WABIN), R, AB_INP, D, smem, e, cur, 512, 864);
#else
                 gemm_phase(H, (const bf16_t*)(ws + WS_WABIN), R, AB_INP, D, smem, e, cur);
#endif
                 if (rep_ == 0) { cvt_cd_dynamic(a, smem); mod_phase<true>(a, 1, smem); } }
    SEAM(2);
    PHASE(3) { int cur = 0; EpiUQ e1{(bf16_t*)(ws + WS_QB), (const float*)(ws + WS_SSQ), (const float2*)(ws + WS_TABB)};
                 gemm_phase<false, AB_INP>(P + 5120, (const bf16_t*)(ws + WS_WUQ), R, 1536, 512, smem, e1, cur);
                 EpiUKV e2{(bf16_t*)(ws + WS_KB), (bf16_t*)(ws + WS_VB), (const float*)(ws + WS_SSQ)};
                 gemm_phase<false, AB_INP>(P + 5632, (const bf16_t*)(ws + WS_WUKV), R, 2048, 256, smem, e2, cur);
                 scan_prep_phase<0>(a, smem); if (SUBREP & 1) scan_prep_phase<0>(a, smem); }
    SEAM(3);
    PHASE(6) scan_seq_phase<0>(a, smem);
    PHASE(7) attn_phase<192, 8, true>(a, 1024, smem);
    SEAM(7);
    PHASE(8) { mixout_phase<0>(a, false); if (SUBREP & 2) mixout_phase<0>(a, false); }
    SEAM(8);
    PHASE(9) { int cur = 0; EpiResidGate e{XR, modv + 2 * D, rep_ > 0, rep_ > 0 ? nullptr : a.in[0], a.in[2]}; gemm_phase(A2, (const bf16_t*)(ws + WS_WABOUT), R, D, D, smem, e, cur); cvt_moe_dynamic(a, 0, smem); }
    SEAM(9);
    PHASE(10) norm_phase<true>(a, 0, 3, a.in[7], false, smem, rep_ > 0);
    SEAM(10);
#ifndef MOE_SPLIT
    PHASE(11) { moe_phase_fused(a, 0, smem); cvt_moe_dynamic(a, 1, smem); }
    SEAM(11);
#else
    PHASE(11) { moe_phase_up(a, 0, smem); cvt_moe_dynamic(a, 1, smem); }
    SEAM(11);
    PHASE(12) { moe_phase_down(a, 0, smem); cvt_moe_dynamic(a, 1, smem); }
    SEAM(12);
#endif
    PHASE(13) { combine_phase<false>(a, 0, false, rep_ > 0); cvt_moe_dynamic(a, 1, smem); }
    SEAM(13);
    PHASE(15) { int cur = 0; EpiInCD e{P, (bf16_t*)(ws + WS_QB), (bf16_t*)(ws + WS_KB), (bf16_t*)(ws + WS_VB), (const float2*)(ws + WS_TABC), a.in[19], a.in[20], smem}; gemm_phase(H, (const bf16_t*)(ws + WS_WCDIN), R, CD_INP, D, smem, e, cur); }
    SEAM(15);
    PHASE(16) { scan_prep_phase<1>(a, smem); if (SUBREP & 1) scan_prep_phase<1>(a, smem); }
    SEAM(16);
    PHASE(17) scan_seq_phase<1>(a, smem);
    PHASE(18) attn_phase<128, 2, false>(a, 0, smem);
    SEAM(18);
    PHASE(19) { mixout_phase<1>(a, true); if (SUBREP & 2) mixout_phase<1>(a, true); }
    SEAM(19);
    PHASE(20) { int cur = 0; EpiResidGate e{XR, modv + 5 * MODN + 2 * D, rep_ > 0, nullptr, nullptr}; gemm_phase<true>(A2, (const bf16_t*)(ws + WS_WCDOUT), NB * TL, D, D, smem, e, cur); }
    SEAM(20);
    PHASE(21) norm_phase<true>(a, 1, 3, a.in[7] + D, true, smem, rep_ > 0);
    SEAM(21);
#ifndef MOE_SPLIT
    PHASE(22) moe_phase_fused(a, 1, smem);
    SEAM(22);
#else
    PHASE(22) moe_phase_up(a, 1, smem);
    SEAM(22);
    PHASE(23) moe_phase_down(a, 1, smem);
    SEAM(23);
#endif
    PHASE(24) combine_phase<true>(a, 1, true);
#undef IN
#undef PHASE
#undef SEAM
}

extern "C" void kernel_launch(void* const* d_in, const int* in_sizes, int n_in, void* d_out, int out_size, void* d_ws, size_t ws_size, hipStream_t stream) {
    static int grid = 0;
    if (grid == 0) {
        if (n_in != 29 || out_size != NB * TL * D || ws_size < WS_END) { fprintf(stderr, "kernel_launch: shape/workspace mismatch: n_in %d out %d ws %zu (need %zu)\n", n_in, out_size, ws_size, (size_t)WS_END); grid = -1; return; }
        int dev = 0, cus = 0;
        if (hipGetDevice(&dev) != hipSuccess || hipDeviceGetAttribute(&cus, hipDeviceAttributeMultiprocessorCount, dev) != hipSuccess) { grid = -1; return; }
        if (hipFuncSetAttribute((const void*)fwd, hipFuncAttributeMaxDynamicSharedMemorySize, LDS_BYTES) != hipSuccess) { fprintf(stderr, "kernel_launch: hipFuncSetAttribute failed\n"); grid = -1; return; }
        grid = cus > 0 ? cus : 256;
    }
    if (grid < 0) return;
    (void)hipMemsetAsync((char*)d_ws + WS_CTL, 0, CTL_BYTES, stream);
    Args a{};
    for (int i = 0; i < 29; ++i) a.in[i] = (const float*)d_in[i];
    a.out = (float*)d_out; a.ws = (unsigned char*)d_ws;
#ifndef MK_PER_PHASE
    a.ph_lo = 0; a.ph_hi = NPHASES; hipLaunchKernelGGL(fwd, dim3(grid), dim3(NT), LDS_BYTES, stream, a);
#else
    for (int ph = 0; ph < NPHASES; ++ph) { a.ph_lo = ph; a.ph_hi = ph + 1; hipLaunchKernelGGL(fwd, dim3(grid), dim3(NT), LDS_BYTES, stream, a); }
#endif
}
```

```cpp
#include <hip/hip_runtime.h>
#include <cstdio>
#include <cstdint>

#define DEV __device__ __forceinline__
typedef unsigned short bf16_t;
typedef short bf16x8 __attribute__((ext_vector_type(8)));
typedef float f32x4 __attribute__((ext_vector_type(4)));
typedef float f32x2 __attribute__((ext_vector_type(2)));
typedef unsigned u32x4 __attribute__((ext_vector_type(4)));
typedef unsigned u32x2 __attribute__((ext_vector_type(2)));

constexpr int NB = 4, TL = 2048, TC = 256, S = TL + TC, R = NB * S, D = 2048;
constexpr int NT = 512;
constexpr float EPS = 1e-6f;
constexpr int AB_IN = 5952, AB_INP = 6144, CD_IN = 4640, CD_INP = 4864;
constexpr int NE = 16, EDIM = 512;
constexpr int MODN = 6 * D;

constexpr size_t al256(size_t x) { return (x + 255) & ~(size_t)255; }
constexpr size_t WS_CTL = 0;
constexpr int    CW_CNT = 26624;
constexpr int    CNT_STRIDE = 64;
constexpr int    CW_CVT = 4224;
constexpr size_t CTL_BYTES = 131072;
constexpr int    CW_MOEQ = 4608;
constexpr int    CW_RDY = 8192;
constexpr size_t WS_MODV = WS_CTL + CTL_BYTES;
constexpr size_t WS_LB   = al256(WS_MODV + (size_t)2 * 5 * MODN * 4);
constexpr size_t WS_TABB = al256(WS_LB + 2 * 1024 * 4);
constexpr size_t WS_TABC = al256(WS_TABB + (size_t)S * 32 * 8);
constexpr size_t WS_TOK  = al256(WS_TABC + (size_t)S * 64 * 8);
constexpr size_t WS_LIST = al256(WS_TOK + (size_t)R * 16);
constexpr size_t WS_WABIN = al256(WS_LIST + (size_t)NE * R * 4);
constexpr size_t WS_WABOUT = al256(WS_WABIN + (size_t)AB_INP * D * 2);
constexpr size_t WS_WUQ  = al256(WS_WABOUT + (size_t)D * D * 2);
constexpr size_t WS_WUKV = al256(WS_WUQ + (size_t)1536 * 512 * 2);
constexpr size_t WS_WCDIN = al256(WS_WUKV + (size_t)2048 * 256 * 2);
constexpr size_t WS_WCDOUT = al256(WS_WCDIN + (size_t)CD_INP * D * 2);
constexpr size_t WS_W13  = al256(WS_WCDOUT + (size_t)D * D * 2);
constexpr size_t WS_W2   = al256(WS_W13 + (size_t)NE * 1024 * D * 2);
constexpr size_t WS_XRES = al256(WS_W2 + (size_t)NE * D * EDIM * 2);
constexpr size_t WS_H    = al256(WS_XRES + (size_t)R * D * 2);
constexpr size_t WS_P    = al256(WS_H + (size_t)R * D * 2);
constexpr size_t WS_ODIR = al256(WS_P + (size_t)R * AB_INP * 2);
constexpr size_t WS_QF   = WS_ODIR;
constexpr size_t WS_KVF  = al256(WS_QF + (size_t)R * 1536 * 2);
static_assert(WS_KVF + (size_t)R * 2048 * 2 <= WS_ODIR + (size_t)2 * R * 1024 * 4, "QF/KVF alias ODIR");
constexpr size_t WS_A2   = al256(WS_ODIR + (size_t)2 * R * 1024 * 4);
constexpr size_t WS_QB   = al256(WS_A2 + (size_t)R * D * 2);
constexpr size_t WS_KB   = al256(WS_QB + (size_t)NB * 8 * S * 192 * 2);
constexpr size_t WS_VB   = al256(WS_KB + (size_t)NB * 8 * S * 192 * 2);
constexpr size_t WS_SSQ  = al256(WS_VB + (size_t)NB * 8 * S * 128 * 2);
constexpr size_t WS_P5N_UNUSED = al256(WS_VB + (size_t)NB * 8 * S * 128 * 2);
constexpr size_t WS_P6N  = al256(WS_SSQ + (size_t)R * 16);
constexpr size_t WS_SVT  = WS_P6N;
constexpr size_t WS_SREC = al256(WS_SVT + (size_t)NB * 8 * 2 * 36 * 128 * 144);
constexpr int LDS_BYTES_C = 160 * 1024;
constexpr int PA = 144, PQ = 272;
constexpr int REC_A = 0, REC_QH = 64 * PA, REC_KHT = REC_QH + 64 * PQ, REC_AL = REC_KHT + 128 * PA, REC_BYTES = REC_AL + 512;
constexpr size_t WS_END  = al256(WS_SREC + (size_t)NB * 8 * 2 * 36 * REC_BYTES);
constexpr size_t WS_SVT1 = WS_W13;
constexpr size_t WS_SREC1 = al256(WS_SVT1 + (size_t)NB * 4 * 2 * 36 * 256 * 144);
static_assert(WS_SREC1 + (size_t)NB * 4 * 2 * 36 * REC_BYTES <= WS_XRES, "layer-1 scan images alias");
static_assert(WS_SVT + (size_t)NE * 1024 * D * 2 + (size_t)NE * D * EDIM * 2 <= WS_END, "layer-1 MoE weights alias");
static_assert((size_t)(2 * R + 256) * 512 * 2 <= WS_KB - WS_QB, "HIDDEN alias");
static_assert((size_t)R * 2 * D * 2 <= WS_ODIR - WS_P, "YSLOTS alias");

struct Args { const float* in[29]; float* out; unsigned char* ws; int ph_lo, ph_hi; };

typedef __bf16 bf16v2_t __attribute__((ext_vector_type(2)));
DEV unsigned cvtpk(float lo, float hi) { bf16v2_t v; v.x = (__bf16)lo; v.y = (__bf16)hi; return __builtin_bit_cast(unsigned, v); }
DEV bf16_t f2bf(float x) { return (bf16_t)(cvtpk(x, 0.f) & 0xffffu); }
DEV float bf2f(bf16_t x) { return __uint_as_float(((unsigned)x) << 16); }
DEV float bflo(unsigned w) { return __uint_as_float(w << 16); }
DEV float bfhi(unsigned w) { return __uint_as_float(w & 0xffff0000u); }
DEV float sigmoidf_(float x) { return 1.f / (1.f + __expf(-x)); }
DEV float siluf_(float x) { return x / (1.f + __expf(-x)); }
DEV float wave_sum(float v) {
#pragma unroll
    for (int o = 32; o >= 1; o >>= 1) v += __shfl_xor(v, o);
    return v;
}
DEV float wave_max(float v) {
#pragma unroll
    for (int o = 32; o >= 1; o >>= 1) v = fmaxf(v, __shfl_xor(v, o));
    return v;
}
DEV int tid_opaque() { int t = threadIdx.x; asm volatile("" : "+v"(t)); return t; }
DEV int modvec_of_row(int r) { const int b = r / S, t = r - b * S; return t < TC ? 4 : b; }

#define XB_TMO      128
#define XB_XCNT(j)  (256  + 64 * (j))
#define XB_XSUB(j)  (1280 + 64 * (j))
#define XB_XGEN(j)  (2304 + 64 * (j))
#define XB_TOP      3328
#define XB_TOPGEN   3392
#define XCD_BAR_WORDS 3456
#define XB_SPIN_CAP (1u << 18)
#define LAS __attribute__((address_space(3)))

__device__ __forceinline__ unsigned xb_ld(unsigned* p)              { return __hip_atomic_load(p, __ATOMIC_RELAXED, __HIP_MEMORY_SCOPE_AGENT); }
__device__ __forceinline__ unsigned xb_add(unsigned* p, unsigned v) { return __hip_atomic_fetch_add(p, v, __ATOMIC_RELAXED, __HIP_MEMORY_SCOPE_AGENT); }
__device__ __forceinline__ unsigned xb_xcc_id() { return (unsigned)__builtin_amdgcn_s_getreg((3 << 11) | 20) & 0xFu; }
#define XB_SPIN(cond, bar) do { unsigned _sp = 0; while (cond) { __builtin_amdgcn_s_sleep(1); \
    if ((++_sp & 255u) == 0u) { if (xb_ld(&(bar)[XB_TMO])) break; if (_sp > XB_SPIN_CAP) { atomicAdd(&(bar)[XB_TMO], 1u); break; } } } } while (0)

struct XcdBarrier {
    unsigned* bar; unsigned x;
    volatile LAS unsigned* st;
};

__device__ __forceinline__ XcdBarrier xcd_barrier_post(unsigned* bar, volatile LAS unsigned* st) {
    XcdBarrier b; b.bar = bar; b.x = xb_xcc_id(); b.st = st;
    if (threadIdx.x == 0) (void)xb_add(&bar[XB_XCNT(b.x)], 1u);
    return b;
}
__device__ __forceinline__ void xcd_barrier_complete(unsigned* bar, unsigned x, unsigned& nloc, unsigned& nx) {
    const unsigned G = gridDim.x * gridDim.y * gridDim.z;
    unsigned sum, cnt, mine, sp = 0u;
    for (;;) {
        sum = 0u; cnt = 0u; mine = 0u;
#pragma unroll
        for (unsigned j = 0; j < 16; ++j) { const unsigned c = xb_ld(&bar[XB_XCNT(j)]); sum += c; cnt += (c > 0u) ? 1u : 0u; mine = (j == x) ? c : mine; }
        if (sum == G) break;
        __builtin_amdgcn_s_sleep(1);
        if ((++sp & 255u) == 0u) { if (xb_ld(&bar[XB_TMO])) break; if (sp > XB_SPIN_CAP) { atomicAdd(&bar[XB_TMO], 1u); break; } }
    }
    nloc = mine > 0u ? mine : 1u; nx = cnt > 0u ? cnt : 1u;
}

__device__ __forceinline__ void xcd_barrier(const XcdBarrier& b) {
    asm volatile("s_waitcnt vmcnt(0)" ::: "memory");
    __syncthreads();
    if (threadIdx.x == 0) {
        unsigned* bar = b.bar;
        __builtin_amdgcn_s_waitcnt(0);
        unsigned nloc = b.st[0], nx = b.st[1];
        if (nloc == 0u) { xcd_barrier_complete(bar, b.x, nloc, nx); b.st[0] = nloc; b.st[1] = nx; }
        const unsigned old = xb_add(&bar[XB_XSUB(b.x)], 1u);
        const unsigned gen = old / nloc;
        if (old + 1u == (gen + 1u) * nloc) {
            __builtin_amdgcn_fence(__ATOMIC_RELEASE, "agent");
            asm volatile("s_waitcnt vmcnt(0)" ::: "memory");
            const unsigned og = xb_add(&bar[XB_TOP], 1u);
            const unsigned tg = og / nx;
            if (og + 1u == (tg + 1u) * nx) xb_add(&bar[XB_TOPGEN], 1u);
            else XB_SPIN(xb_ld(&bar[XB_TOPGEN]) == tg, bar);
            __builtin_amdgcn_fence(__ATOMIC_ACQUIRE, "agent");
            xb_add(&bar[XB_XGEN(b.x)], 1u);
            asm volatile("s_waitcnt vmcnt(0)" ::: "memory");
        } else {
            XB_SPIN(xb_ld(&bar[XB_XGEN(b.x)]) == gen, bar);
            __builtin_amdgcn_fence(__ATOMIC_ACQUIRE, "agent");
            asm volatile("s_waitcnt vmcnt(0)" ::: "memory");
        }
    }
    __syncthreads();
}


constexpr int BM = 256, BK = 64, HALF = 128, HT = HALF * BK, SHM_GEMM = 8 * HT * 2;
DEV int lds_byte(int r, int c) { int st = (r >> 4) * 2 + (c >> 5), rr = r & 15, cc = c & 31, ob = rr * 64 + cc * 2; return st * 1024 + (ob ^ (((ob >> 9) & 1) << 5)); }
DEV void stage_rc(int b, int& Rr, int& Cc) { int st = b / 1024, sb = b % 1024, swz = sb ^ (((sb >> 9) & 1) << 5); Rr = (st >> 1) * 16 + swz / 64; Cc = (st & 1) * 32 + (swz % 64) / 2; }

template <bool GATHER, int LDA_ = 0, class Epi>
DEV void gemm_tile(const bf16_t* __restrict__ A, const bf16_t* __restrict__ Bt, int ld, int K, int brow, int bcol,
                   const int* __restrict__ rowmap, int nvalid, char* smem, const Epi& epi) {
    bf16_t* shm = (bf16_t*)smem;
#define SA(b, h) (shm + ((b) * 2 + (h)) * HT)
#define SB(b, h) (shm + (4 + (b) * 2 + (h)) * HT)
#define GLDS(gp, lp) __builtin_amdgcn_global_load_lds((const unsigned*)(gp), (unsigned*)(lp), 16, 0, 0)
#define STAGE_A(P, h, kt) do { _Pragma("unroll") for (int _i = 0; _i < 2; ++_i) { \
        const char* _sb = GATHER ? (const char*)A + (size_t)(kt) * (BK * 2) : (const char*)A + ((size_t)(brow + (h) * HALF + _i * 64) * (LDA_ ? LDA_ : ld) + (size_t)(kt) * BK) * 2; \
        GLDS(_sb + (GATHER ? voffa[h][_i] : voffA), (char*)(P) + tid16 + _i * 8192); } } while (0)
#define STAGE_B(P, h, kt) do { _Pragma("unroll") for (int _i = 0; _i < 2; ++_i) { \
        const char* _sb = (const char*)Bt + ((size_t)(bcol + (h) * HALF + _i * 64) * ld + (size_t)(kt) * BK) * 2; \
        GLDS(_sb + voff, (char*)(P) + tid16 + _i * 8192); } } while (0)
#define LDA(dst, b, h) _Pragma("unroll") for (int m = 0; m < 4; ++m) _Pragma("unroll") for (int k = 0; k < 2; ++k) \
        dst[m][k] = *reinterpret_cast<const bf16x8*>((char*)SA(b, h) + lds_byte(wr * 64 + m * 16 + fr, k * 32 + fq * 8))
#define LDB(dst, b, h) _Pragma("unroll") for (int n = 0; n < 2; ++n) _Pragma("unroll") for (int k = 0; k < 2; ++k) \
        dst[n][k] = *reinterpret_cast<const bf16x8*>((char*)SB(b, h) + lds_byte(wc * 32 + n * 16 + fr, k * 32 + fq * 8))
#define MMA(ai, bj, At_, Bt_) do { __builtin_amdgcn_s_setprio(1); \
        _Pragma("unroll") for (int m = 0; m < 4; ++m) _Pragma("unroll") for (int n = 0; n < 2; ++n) _Pragma("unroll") for (int k = 0; k < 2; ++k) \
            acc[ai][bj][m][n] = __builtin_amdgcn_mfma_f32_16x16x32_bf16(Bt_[n][k], At_[m][k], acc[ai][bj][m][n], 0, 0, 0); \
        __builtin_amdgcn_s_setprio(0); } while (0)
#define WAIT_V(n) asm volatile("s_waitcnt vmcnt(" #n ")" ::: "memory")
#define WAIT_L(n) asm volatile("s_waitcnt lgkmcnt(" #n ")" ::: "memory")
#define BAR __builtin_amdgcn_s_barrier()
#define SCHED __builtin_amdgcn_sched_barrier(0)
    int tid = threadIdx.x; asm volatile("" : "+v"(tid));
    int wid = tid >> 6, lane = tid & 63, wr = wid >> 2, wc = wid & 3, fr = lane & 15, fq = lane >> 4;
    const int tid16 = tid * 16;
    unsigned voff, voffA; unsigned voffa[2][2];
    {
        int r0, c0; stage_rc(tid16, r0, c0);
        voff = (unsigned)(r0 * ld + c0) * 2u; voffA = LDA_ ? (unsigned)(r0 * LDA_ + c0) * 2u : voff;
#pragma unroll
        for (int h = 0; h < 2; ++h)
#pragma unroll
            for (int i = 0; i < 2; ++i) {
                if (GATHER) { int l0 = h * HALF + i * 64 + r0; l0 = l0 < nvalid ? l0 : nvalid - 1; voffa[h][i] = (unsigned)((rowmap[l0] >> 1) * ld + c0) * 2u; }
                else voffa[h][i] = 0u;
            }
    }
    f32x4 acc[2][2][4][2] = {};
    bf16x8 At[4][2], B0[2][2], B1[2][2];
    const int nt = K / BK;
    STAGE_B(SB(0, 0), 0, 0); STAGE_A(SA(0, 0), 0, 0);
    STAGE_B(SB(0, 1), 1, 0); STAGE_A(SA(0, 1), 1, 0);
    if (wr == 1) BAR;
    WAIT_V(4); BAR;
    STAGE_B(SB(1, 0), 0, 1); STAGE_A(SA(1, 0), 0, 1); STAGE_B(SB(1, 1), 1, 1);
    WAIT_V(6); BAR;
    for (int t = 0; t < nt - 2; t += 2) {
        LDB(B0, 0, 0); SCHED; LDA(At, 0, 0); STAGE_A(SA(1, 1), 1, t + 1);
        WAIT_L(8); BAR; WAIT_L(0); MMA(0, 0, At, B0); BAR; SCHED;
        LDB(B1, 0, 1); STAGE_B(SB(0, 0), 0, t + 2);
        BAR; WAIT_L(0); MMA(0, 1, At, B1); BAR;
        LDA(At, 0, 1); STAGE_A(SA(0, 0), 0, t + 2);
        BAR; WAIT_L(0); MMA(1, 0, At, B0); BAR; SCHED;
        STAGE_B(SB(0, 1), 1, t + 2);
        WAIT_V(6); BAR; MMA(1, 1, At, B1); BAR;
        LDB(B0, 1, 0); SCHED; LDA(At, 1, 0); STAGE_A(SA(0, 1), 1, t + 2);
        WAIT_L(8); BAR; WAIT_L(0); MMA(0, 0, At, B0); BAR; SCHED;
        LDB(B1, 1, 1); STAGE_B(SB(1, 0), 0, t + 3);
        BAR; WAIT_L(0); MMA(0, 1, At, B1); BAR;
        LDA(At, 1, 1); STAGE_A(SA(1, 0), 0, t + 3);
        BAR; WAIT_L(0); MMA(1, 0, At, B0); BAR; SCHED;
        STAGE_B(SB(1, 1), 1, t + 3);
        WAIT_V(6); BAR; MMA(1, 1, At, B1); BAR;
    }
    { LDB(B0, 0, 0); WAIT_V(0); LDA(At, 0, 0); STAGE_A(SA(1, 1), 1, nt - 1);
      BAR; WAIT_L(0); MMA(0, 0, At, B0); BAR;
      LDB(B1, 0, 1); BAR; WAIT_L(0); MMA(0, 1, At, B1); BAR;
      LDA(At, 0, 1); WAIT_V(4); BAR; WAIT_L(0); MMA(1, 0, At, B0); MMA(1, 1, At, B1); BAR; }
    { LDB(B0, 1, 0); LDA(At, 1, 0); WAIT_V(2); BAR; WAIT_L(0); MMA(0, 0, At, B0); BAR;
      LDB(B1, 1, 1); WAIT_V(0); BAR; WAIT_L(0); MMA(0, 1, At, B1); BAR;
      LDA(At, 1, 1); BAR; WAIT_L(0); MMA(1, 0, At, B0); MMA(1, 1, At, B1); BAR; }
    if (wr == 0) BAR;
    int tz = threadIdx.x; asm volatile("" : "+v"(tz)); wid = tz >> 6; lane = tz & 63; wr = wid >> 2; wc = wid & 3; fr = lane & 15; fq = lane >> 4;
    epi(acc, brow, bcol, wr, wc, fr, fq);
#undef SA
#undef SB
#undef STAGE_A
#undef STAGE_B
#undef GLDS
#undef LDA
#undef LDB
#undef MMA
}

struct EpiStoreF32 { float* C; int ldc;
    DEV void operator()(const f32x4 (&acc)[2][2][4][2], int brow, int bcol, int wr, int wc, int fr, int fq) const {
#pragma unroll
        for (int ai = 0; ai < 2; ++ai)
#pragma unroll
            for (int m = 0; m < 4; ++m) { float* rowp = C + (size_t)(brow + ai * HALF + wr * 64 + m * 16 + fr) * ldc + bcol + wc * 32 + fq * 4;
#pragma unroll
                for (int bj = 0; bj < 2; ++bj)
#pragma unroll
                    for (int n = 0; n < 2; ++n) *(f32x4*)(rowp + bj * HALF + n * 16) = acc[ai][bj][m][n]; }
    } };
struct EpiStoreBf16 { bf16_t* C; int ldc;
    DEV void operator()(const f32x4 (&acc)[2][2][4][2], int brow, int bcol, int wr, int wc, int fr, int fq) const {
#pragma unroll
        for (int ai = 0; ai < 2; ++ai)
#pragma unroll
            for (int m = 0; m < 4; ++m) { bf16_t* rowp = C + (size_t)(brow + ai * HALF + wr * 64 + m * 16 + fr) * ldc + bcol + wc * 32 + fq * 4;
#pragma unroll
                for (int bj = 0; bj < 2; ++bj)
#pragma unroll
                    for (int n = 0; n < 2; ++n) { const f32x4 v = acc[ai][bj][m][n]; u32x2 w; w.x = cvtpk(v[0], v[1]); w.y = cvtpk(v[2], v[3]); *(u32x2*)(rowp + bj * HALF + n * 16) = w; } }
    } };
struct EpiResidGate { bf16_t* X; const float* gate; bool dry; const float* xin; const float* cin;
    DEV void operator()(const f32x4 (&acc)[2][2][4][2], int brow, int bcol, int wr, int wc, int fr, int fq) const {
        const float* g = gate + (size_t)modvec_of_row(brow) * MODN + bcol + wc * 32 + fq * 4;
        f32x4 gv[2][2];
#pragma unroll
        for (int bj = 0; bj < 2; ++bj)
#pragma unroll
            for (int n = 0; n < 2; ++n) gv[bj][n] = *(const f32x4*)(g + bj * HALF + n * 16);
#pragma unroll
        for (int ai = 0; ai < 2; ++ai)
#pragma unroll
            for (int m = 0; m < 4; ++m) { const int lrow = ai * HALF + wr * 64 + m * 16 + fr; bf16_t* rowp = X + (size_t)(brow + lrow) * D + bcol + wc * 32 + fq * 4;
                const float* srcp = nullptr;
                if (xin) { const int b = brow / S, t0 = brow - b * S; srcp = (t0 < TC ? cin + ((size_t)b * TC + t0 + lrow) * D : xin + ((size_t)b * TL + (t0 - TC) + lrow) * D) + bcol + wc * 32 + fq * 4; }
#pragma unroll
                for (int bj = 0; bj < 2; ++bj)
#pragma unroll
                    for (int n = 0; n < 2; ++n) { f32x4 x;
                        if (xin) x = *(const f32x4*)(srcp + bj * HALF + n * 16); else { const u32x2 p = *(const u32x2*)(rowp + bj * HALF + n * 16); x = (f32x4){bflo(p.x), bfhi(p.x), bflo(p.y), bfhi(p.y)}; }
                        if (!dry) x += gv[bj][n] * acc[ai][bj][m][n];
                        u32x2 w; w.x = cvtpk(x[0], x[1]); w.y = cvtpk(x[2], x[3]); *(u32x2*)(rowp + bj * HALF + n * 16) = w; }
                if (m == 3) asm volatile("" ::: "memory"); }
    } };
struct EpiMoeUp { bf16_t* hid; int rowbase, nvalid;
    DEV void operator()(const f32x4 (&acc)[2][2][4][2], int brow, int bcol, int wr, int wc, int fr, int fq) const {
        const int hc = (bcol >> 1) + wc * 32 + fq * 4;
#pragma unroll
        for (int ai = 0; ai < 2; ++ai)
#pragma unroll
            for (int m = 0; m < 4; ++m) { const int lr = ai * HALF + wr * 64 + m * 16 + fr;
                if (lr < nvalid) { bf16_t* rowp = hid + (size_t)(rowbase + lr) * EDIM + hc;
#pragma unroll
                    for (int n = 0; n < 2; ++n) { const f32x4 a = acc[ai][0][m][n], b = acc[ai][1][m][n];
                        u32x2 w; w.x = cvtpk(siluf_(a[0]) * b[0], siluf_(a[1]) * b[1]); w.y = cvtpk(siluf_(a[2]) * b[2], siluf_(a[3]) * b[3]);
                        *(u32x2*)(rowp + n * 16) = w; } } }
    } };
struct EpiMoeDown { bf16_t* y; const int* list; int nvalid;
    DEV void operator()(const f32x4 (&acc)[2][2][4][2], int brow, int bcol, int wr, int wc, int fr, int fq) const {
        int li[2][4];
#pragma unroll
        for (int ai = 0; ai < 2; ++ai)
#pragma unroll
            for (int m = 0; m < 4; ++m) { const int lr = ai * HALF + wr * 64 + m * 16 + fr; li[ai][m] = list[lr < nvalid ? lr : nvalid - 1]; }
#pragma unroll
        for (int ai = 0; ai < 2; ++ai)
#pragma unroll
            for (int m = 0; m < 4; ++m) { const int lr = ai * HALF + wr * 64 + m * 16 + fr;
                if (lr < nvalid) { bf16_t* rowp = y + (size_t)li[ai][m] * D + bcol + wc * 32 + fq * 4;
#pragma unroll
                    for (int bj = 0; bj < 2; ++bj)
#pragma unroll
                        for (int n = 0; n < 2; ++n) { const f32x4 v = acc[ai][bj][m][n]; u32x2 w; w.x = cvtpk(v[0], v[1]); w.y = cvtpk(v[2], v[3]); *(u32x2*)(rowp + bj * HALF + n * 16) = w; } } }
    } };

DEV void row_bt(int r, int& b, int& t) { b = r / S; t = r - b * S; }
#define LDS_BARRIER() do { asm volatile("s_waitcnt lgkmcnt(0)" ::: "memory"); __builtin_amdgcn_s_barrier(); asm volatile("" ::: "memory"); } while (0)
struct EpiInAB { bf16_t* P; float* ssq; bf16_t* Kb; const float2* tb; char* smem;
    DEV void operator()(const f32x4 (&acc)[2][2][4][2], int brow, int bcol, int wr, int wc, int fr, int fq) const {
        const int pn = bcol >> 8;
        if (pn < 23) {
#pragma unroll
            for (int ai = 0; ai < 2; ++ai)
#pragma unroll
                for (int m = 0; m < 4; ++m) { bf16_t* rowp = P + (size_t)(brow + ai * HALF + wr * 64 + m * 16 + fr) * AB_INP + bcol + wc * 32 + fq * 4;
#pragma unroll
                    for (int bj = 0; bj < 2; ++bj)
#pragma unroll
                        for (int n = 0; n < 2; ++n) { const f32x4 v = acc[ai][bj][m][n]; u32x2 w; w.x = cvtpk(v[0], v[1]); w.y = cvtpk(v[2], v[3]); *(u32x2*)(rowp + bj * HALF + n * 16) = w; } }
            if (pn >= 20) {
                float* red = (float*)smem;
#pragma unroll
                for (int ai = 0; ai < 2; ++ai)
#pragma unroll
                    for (int m = 0; m < 4; ++m) { float sq = 0.f;
#pragma unroll
                        for (int bj = 0; bj < 2; ++bj)
#pragma unroll
                            for (int n = 0; n < 2; ++n) { const f32x4 v = acc[ai][bj][m][n]; sq += v[0] * v[0] + v[1] * v[1] + v[2] * v[2] + v[3] * v[3]; }
                        sq += __shfl_xor(sq, 16); sq += __shfl_xor(sq, 32);
                        if (fq == 0) red[(ai * HALF + wr * 64 + m * 16 + fr) * 4 + wc] = sq; }
                LDS_BARRIER();
                const int t_ = tid_opaque();
                if (t_ < 256) { const f32x4 q = *(const f32x4*)(red + t_ * 4); ssq[(size_t)(pn - 20) * R + brow + t_] = (q[0] + q[1]) + (q[2] + q[3]); }
                LDS_BARRIER();
            }
        } else if (wc < 2) {
            f32x4 cc[2][4][2];
#pragma unroll
            for (int ai = 0; ai < 2; ++ai)
#pragma unroll
                for (int m = 0; m < 4; ++m) { int b, t; row_bt(brow + ai * HALF + wr * 64 + m * 16 + fr, b, t);
#pragma unroll
                    for (int n = 0; n < 2; ++n) cc[ai][m][n] = *(const f32x4*)(tb + t * 32 + 16 * wc + 8 * n + 2 * fq); }
#pragma unroll
            for (int ai = 0; ai < 2; ++ai)
#pragma unroll
                for (int m = 0; m < 4; ++m) { int b, t; row_bt(brow + ai * HALF + wr * 64 + m * 16 + fr, b, t);
#pragma unroll
                    for (int n = 0; n < 2; ++n) { const f32x4 v = acc[ai][0][m][n]; const int p0 = 16 * wc + 8 * n + 2 * fq;
                        const float2 c0 = make_float2(cc[ai][m][n][0], cc[ai][m][n][1]), c1 = make_float2(cc[ai][m][n][2], cc[ai][m][n][3]);
                        const unsigned lo = cvtpk(v[0] * c0.x - v[1] * c0.y, v[2] * c1.x - v[3] * c1.y), hi = cvtpk(v[1] * c0.x + v[0] * c0.y, v[3] * c1.x + v[2] * c1.y);
#pragma unroll
                        for (int hh = 0; hh < 8; ++hh) { bf16_t* kp = Kb + (((size_t)b * 8 + hh) * S + t) * 192 + 128 + p0; *(unsigned*)kp = lo; *(unsigned*)(kp + 32) = hi; } } }
        }
    } };
struct EpiInCD { bf16_t* P; bf16_t* Qb; bf16_t* Kb; bf16_t* Vb; const float2* tc; const float* gq; const float* gk; char* smem;
    DEV void operator()(const f32x4 (&acc)[2][2][4][2], int brow, int bcol, int wr, int wc, int fr, int fq) const {
        const int pn = bcol >> 8;
        if (pn <= 4) {
            float* red = (float*)smem;
            f32x4 cc[2][4][2];
#pragma unroll
            for (int ai = 0; ai < 2; ++ai)
#pragma unroll
                for (int m = 0; m < 4; ++m) { int b, t; row_bt(brow + ai * HALF + wr * 64 + m * 16 + fr, b, t);
#pragma unroll
                    for (int n = 0; n < 2; ++n) cc[ai][m][n] = *(const f32x4*)(tc + t * 64 + 16 * wc + 8 * n + 2 * fq); }
#pragma unroll
            for (int ai = 0; ai < 2; ++ai)
#pragma unroll
                for (int m = 0; m < 4; ++m)
#pragma unroll
                    for (int bj = 0; bj < 2; ++bj) { float sq = 0.f;
#pragma unroll
                        for (int n = 0; n < 2; ++n) { const f32x4 v = acc[ai][bj][m][n]; sq += v[0] * v[0] + v[1] * v[1] + v[2] * v[2] + v[3] * v[3]; }
                        sq += __shfl_xor(sq, 16); sq += __shfl_xor(sq, 32);
                        if (fq == 0) red[((ai * HALF + wr * 64 + m * 16 + fr) * 2 + bj) * 4 + wc] = sq; }
            LDS_BARRIER();
            const float* gp = pn < 4 ? gq : gk;
            float g1[2][2], g2[2][2];
#pragma unroll
            for (int n = 0; n < 2; ++n) { const int p0 = 16 * wc + 8 * n + 2 * fq; g1[n][0] = gp[p0]; g1[n][1] = gp[p0 + 1]; g2[n][0] = gp[p0 + 64]; g2[n][1] = gp[p0 + 65]; }
#pragma unroll
            for (int ai = 0; ai < 2; ++ai)
#pragma unroll
                for (int m = 0; m < 4; ++m) { const int lr = ai * HALF + wr * 64 + m * 16 + fr; int b, t; row_bt(brow + lr, b, t);
#pragma unroll
                    for (int bj = 0; bj < 2; ++bj) { const f32x4 q4 = *(const f32x4*)(red + (lr * 2 + bj) * 4); const float rs = rsqrtf(((q4[0] + q4[1]) + (q4[2] + q4[3])) * (1.f / 128.f) + EPS);
                        bf16_t* dst = pn < 4 ? Qb + (((size_t)b * 8 + pn * 2 + bj) * S + t) * 128 : Kb + (((size_t)b * 2 + bj) * S + t) * 128;
#pragma unroll
                        for (int n = 0; n < 2; ++n) { const f32x4 v = acc[ai][bj][m][n]; const int p0 = 16 * wc + 8 * n + 2 * fq;
                            const float2 c0 = make_float2(cc[ai][m][n][0], cc[ai][m][n][1]), c1 = make_float2(cc[ai][m][n][2], cc[ai][m][n][3]);
                            const float x1a = v[0] * rs * g1[n][0], x2a = v[1] * rs * g2[n][0], x1b = v[2] * rs * g1[n][1], x2b = v[3] * rs * g2[n][1];
                            *(unsigned*)(dst + p0) = cvtpk(x1a * c0.x - x2a * c0.y, x1b * c1.x - x2b * c1.y);
                            *(unsigned*)(dst + 64 + p0) = cvtpk(x2a * c0.x + x1a * c0.y, x2b * c1.x + x1b * c1.y); } } }
            LDS_BARRIER();
        } else if (pn == 5) {
#pragma unroll
            for (int ai = 0; ai < 2; ++ai)
#pragma unroll
                for (int m = 0; m < 4; ++m) { int b, t; row_bt(brow + ai * HALF + wr * 64 + m * 16 + fr, b, t);
#pragma unroll
                    for (int bj = 0; bj < 2; ++bj)
#pragma unroll
                        for (int n = 0; n < 2; ++n) { const f32x4 v = acc[ai][bj][m][n]; u32x2 w; w.x = cvtpk(v[0], v[1]); w.y = cvtpk(v[2], v[3]);
                            *(u32x2*)(Vb + (((size_t)b * 2 + bj) * S + t) * 128 + wc * 32 + n * 16 + fq * 4) = w; } }
        } else {
#pragma unroll
            for (int ai = 0; ai < 2; ++ai)
#pragma unroll
                for (int m = 0; m < 4; ++m) { bf16_t* rowp = P + (size_t)(brow + ai * HALF + wr * 64 + m * 16 + fr) * CD_INP + bcol + wc * 32 + fq * 4;
#pragma unroll
                    for (int bj = 0; bj < 2; ++bj)
#pragma unroll
                        for (int n = 0; n < 2; ++n) { const f32x4 v = acc[ai][bj][m][n]; u32x2 w; w.x = cvtpk(v[0], v[1]); w.y = cvtpk(v[2], v[3]); *(u32x2*)(rowp + bj * HALF + n * 16) = w; } }
        }
    } };
struct EpiUQ { bf16_t* Qb; const float* ssq; const float2* tb;
    DEV void operator()(const f32x4 (&acc)[2][2][4][2], int brow, int bcol, int wr, int wc, int fr, int fq) const {
        const int pn = bcol >> 8;
#pragma unroll
        for (int ai = 0; ai < 2; ++ai)
#pragma unroll
            for (int m = 0; m < 4; ++m) { const int r = brow + ai * HALF + wr * 64 + m * 16 + fr; int b, t; row_bt(r, b, t);
                const float rs = rsqrtf((ssq[r] + ssq[R + r]) * (1.f / 512.f) + EPS);
#pragma unroll
                for (int bj = 0; bj < 2; ++bj)
#pragma unroll
                    for (int n = 0; n < 2; ++n) { const f32x4 v = acc[ai][bj][m][n] * rs;
                        if (pn < 4) { const int hh = pn * 2 + bj; bf16_t* qp = Qb + (((size_t)b * 8 + hh) * S + t) * 192 + wc * 32 + n * 16 + fq * 4;
                            u32x2 w; w.x = cvtpk(v[0], v[1]); w.y = cvtpk(v[2], v[3]); *(u32x2*)qp = w; }
                        else { const int cr = (pn - 4) * 256 + bj * HALF + wc * 32 + n * 16 + fq * 4, hh = cr >> 6, p0 = (cr & 63) >> 1;
                            const f32x4 cc = *(const f32x4*)(tb + t * 32 + p0); const float2 c0 = make_float2(cc[0], cc[1]), c1 = make_float2(cc[2], cc[3]);
                            bf16_t* qp = Qb + (((size_t)b * 8 + hh) * S + t) * 192 + 128 + p0;
                            *(unsigned*)qp = cvtpk(v[0] * c0.x - v[1] * c0.y, v[2] * c1.x - v[3] * c1.y); *(unsigned*)(qp + 32) = cvtpk(v[1] * c0.x + v[0] * c0.y, v[3] * c1.x + v[2] * c1.y); } } }
    } };
struct EpiUKV { bf16_t* Kb; bf16_t* Vb; const float* ssq;
    DEV void operator()(const f32x4 (&acc)[2][2][4][2], int brow, int bcol, int wr, int wc, int fr, int fq) const {
        const int hh = bcol >> 8;
#pragma unroll
        for (int ai = 0; ai < 2; ++ai)
#pragma unroll
            for (int m = 0; m < 4; ++m) { const int r = brow + ai * HALF + wr * 64 + m * 16 + fr; int b, t; row_bt(r, b, t);
                const float rs = rsqrtf(ssq[2 * R + r] * (1.f / 256.f) + EPS); const size_t rowi = ((size_t)b * 8 + hh) * S + t;
#pragma unroll
                for (int n = 0; n < 2; ++n) { const f32x4 kv = acc[ai][0][m][n] * rs, vv = acc[ai][1][m][n] * rs; const int c = wc * 32 + n * 16 + fq * 4;
                    u32x2 w; w.x = cvtpk(kv[0], kv[1]); w.y = cvtpk(kv[2], kv[3]); *(u32x2*)(Kb + rowi * 192 + c) = w;
                    w.x = cvtpk(vv[0], vv[1]); w.y = cvtpk(vv[2], vv[3]); *(u32x2*)(Vb + rowi * 128 + c) = w; } }
    } };

template <bool LATENT = false, int LDA_ = 0, class Epi>
DEV void gemm_phase(const bf16_t* A, const bf16_t* Bt, int M, int N, int K, char* smem, const Epi& epi, int& cursor, int tlo = 0, int thi = 1 << 30) {
    const int nM = M / BM, nN = N / BM, n = nM * nN;
    int first = cursor; cursor += n;
    int u = blockIdx.x; while (u < first) u += gridDim.x;
    for (; u < first + n; u += gridDim.x) { const int t = u - first; if (t < tlo || t >= thi) continue; const int pm = t % nM, pn = t / nM;
        const int prow = LATENT ? (pm >> 3) * 9 + 1 + (pm & 7) : pm;
        gemm_tile<false, LDA_>(A, Bt, K, K, prow * BM, pn * BM, nullptr, 0, smem, epi); }
}

struct CvtJob { const float* src; bf16_t* dst; int K, N, Nout, nb; size_t src_bs, dst_bs; int blk_rs, blk_base; const float* kscale; int perm = 0; };
constexpr int CVT_LDS_WAVE = 64 * 65 * 4, CVT_SLOT_OFF = 8 * CVT_LDS_WAVE;
DEV void cvt_issue(const CvtJob& j, int u, int lane, f32x4 (&e)[16]) {
    const int tN = j.Nout / 64, per = (j.K / 64) * tN;
    const int bt = u / per, rem = u - bt * per, kt = rem / tN, ntl = rem - kt * tN;
    const int n0 = ntl * 64 + (lane & 15) * 4;
    const float* sp = j.src + (size_t)bt * j.src_bs + (size_t)(kt * 64 + (lane >> 4)) * j.N + (n0 < j.N ? n0 : 0);
#pragma unroll
    for (int q = 0; q < 16; ++q) e[q] = *(const f32x4*)(sp + (size_t)(q * 4) * j.N);
}
DEV void cvt_finish(const CvtJob& j, int u, int lane, float* tile, const f32x4 (&e)[16]) {
    const int tN = j.Nout / 64, per = (j.K / 64) * tN;
    const int bt = u / per, rem = u - bt * per, kt = rem / tN, ntl = rem - kt * tN;
    const int r0 = lane >> 4, c4 = lane & 15; const bool valid = ntl * 64 + c4 * 4 < j.N;
#pragma unroll
    for (int q = 0; q < 16; ++q) { f32x4 x = e[q]; const int k = r0 + 4 * q; if (j.kscale) x *= j.kscale[kt * 64 + k]; if (!valid) x = (f32x4){0.f, 0.f, 0.f, 0.f};
        float* tp = tile + k * 65 + c4 * 4; tp[0] = x[0]; tp[1] = x[1]; tp[2] = x[2]; tp[3] = x[3]; }
    const int nl0 = lane >> 3, kc = (lane & 7) * 8;
#pragma unroll
    for (int p = 0; p < 8; ++p) { const int nl = p * 8 + nl0, nn = ntl * 64 + nl; float v[8];
#pragma unroll
        for (int i = 0; i < 8; ++i) v[i] = tile[(kc + i) * 65 + nl];
        int drow = (nn >> 7) * j.blk_rs + j.blk_base + (nn & 127);
        if (j.perm == 1) { const int hh = nn / 192, c = nn - hh * 192, i = c - 128; drow = c < 128 ? hh * 128 + c : 1024 + hh * 64 + (i < 32 ? 2 * i : 2 * (i - 32) + 1); }
        if (j.perm == 3 && nn < 1280) { const int c = nn & 127; drow = (nn & ~127) + (c < 64 ? 2 * c : 2 * (c - 64) + 1); }
        if (j.perm == 2 && nn >= 5888) { const int i = nn - 5888; drow = i < 64 ? 5888 + (i < 32 ? 2 * i : 2 * (i - 32) + 1) : nn; }
        *(u32x4*)(j.dst + (size_t)bt * j.dst_bs + (size_t)drow * j.K + kt * 64 + kc) = (u32x4){cvtpk(v[0], v[1]), cvtpk(v[2], v[3]), cvtpk(v[4], v[5]), cvtpk(v[6], v[7])}; }
}
DEV void cvt_run(const CvtJob& j, int u0, int ustep, int n, int lane, float* tile) {
    f32x4 eA[16], eB[16];
    cvt_issue(j, u0, lane, eA);
    int i = 0;
#pragma unroll 1
    for (; i + 2 < n; i += 2) {
        cvt_issue(j, u0 + (i + 1) * ustep, lane, eB);
        __builtin_amdgcn_sched_barrier(0);
        cvt_finish(j, u0 + i * ustep, lane, tile, eA);
        __builtin_amdgcn_sched_barrier(0);
        cvt_issue(j, u0 + (i + 2) * ustep, lane, eA);
        __builtin_amdgcn_sched_barrier(0);
        cvt_finish(j, u0 + (i + 1) * ustep, lane, tile, eB);
        __builtin_amdgcn_sched_barrier(0);
    }
    if (i + 1 < n) {
        cvt_issue(j, u0 + (i + 1) * ustep, lane, eB);
        __builtin_amdgcn_sched_barrier(0);
        cvt_finish(j, u0 + i * ustep, lane, tile, eA);
        __builtin_amdgcn_sched_barrier(0);
        cvt_finish(j, u0 + (i + 1) * ustep, lane, tile, eB);
    } else cvt_finish(j, u0 + i * ustep, lane, tile, eA);
}
DEV void cvt_weight(const float* __restrict__ src, bf16_t* __restrict__ dst, int K, int N, int Nout, int nb, size_t src_bs, size_t dst_bs,
                    int blk_rs, int blk_base, const float* __restrict__ kscale, char* smem, int perm = 0) {
    const CvtJob j{src, dst, K, N, Nout, nb, src_bs, dst_bs, blk_rs, blk_base, kscale, perm};
    const int tid = tid_opaque(), lane = tid & 63, w = tid >> 6, total = nb * (K / 64) * (Nout / 64);
    float* tile = (float*)(smem + w * CVT_LDS_WAVE);
    const int u0 = blockIdx.x * 8 + w, ustep = gridDim.x * 8;
    if (u0 < total) cvt_run(j, u0, ustep, (total - u0 + ustep - 1) / ustep, lane, tile);
    __syncthreads();
}
DEV bf16_t* moe_w13(const Args& a, int l) { return (bf16_t*)(a.ws + (l == 0 ? WS_W13 : WS_SVT)); }
DEV bf16_t* moe_w2(const Args& a, int l) { return (bf16_t*)(a.ws + (l == 0 ? WS_W2 : WS_SVT + (size_t)NE * 1024 * D * 2)); }
constexpr int CVT_IT = 8;
DEV void cvt_moe_dynamic(const Args& a, int l, char* smem) {
    const int tid = tid_opaque(), lane = tid & 63, w = tid >> 6;
    unsigned* counter = (unsigned*)(a.ws + WS_CTL) + CW_CVT + l * 64;
    volatile int* slot = (volatile int*)(smem + CVT_SLOT_OFF); float* tile = (float*)(smem + w * CVT_LDS_WAVE);
    const CvtJob j1{a.in[26] + (size_t)l * NE * D * EDIM, moe_w13(a, l), D, EDIM, EDIM, NE, (size_t)D * EDIM, (size_t)1024 * D, 256, 0, nullptr};
    const CvtJob j3{a.in[27] + (size_t)l * NE * D * EDIM, moe_w13(a, l), D, EDIM, EDIM, NE, (size_t)D * EDIM, (size_t)1024 * D, 256, 128, nullptr};
    const CvtJob j2{a.in[28] + (size_t)l * NE * EDIM * D, moe_w2(a, l), EDIM, D, D, NE, (size_t)EDIM * D, (size_t)D * EDIM, 128, 0, nullptr};
    constexpr int CPJ = 4096 / (8 * CVT_IT), NCHUNK = 3 * CPJ;
    for (;;) {
        __syncthreads();
        if (tid == 0) *slot = (int)atomicAdd(counter, 1u);
        __syncthreads();
        const int chunk = *slot;
        if (chunk >= NCHUNK) break;
        const int job = chunk / CPJ, u0 = (chunk - job * CPJ) * (8 * CVT_IT) + w;
        if (job == 0) cvt_run(j1, u0, 8, CVT_IT, lane, tile); else if (job == 1) cvt_run(j3, u0, 8, CVT_IT, lane, tile); else cvt_run(j2, u0, 8, CVT_IT, lane, tile);
    }
    __syncthreads();
}

DEV void cvt_cd_dynamic(const Args& a, char* smem) {
    const int tid = tid_opaque(), lane = tid & 63, w = tid >> 6;
    unsigned* counter = (unsigned*)(a.ws + WS_CTL) + CW_CVT + 3 * 64;
    volatile int* slot = (volatile int*)(smem + CVT_SLOT_OFF); float* tile = (float*)(smem + w * CVT_LDS_WAVE);
    const CvtJob jin{a.in[17], (bf16_t*)(a.ws + WS_WCDIN), D, CD_IN, CD_INP, 1, 0, 0, 128, 0, nullptr, 3};
    const CvtJob jout{a.in[18], (bf16_t*)(a.ws + WS_WCDOUT), D, D, D, 1, 0, 0, 128, 0, nullptr};
    const CvtJob jabo{a.in[10], (bf16_t*)(a.ws + WS_WABOUT), D, D, D, 1, 0, 0, 128, 0, nullptr};
    const CvtJob juq{a.in[14], (bf16_t*)(a.ws + WS_WUQ), 512, 1536, 1536, 1, 0, 0, 128, 0, a.in[13], 1};
    const CvtJob jukv{a.in[16], (bf16_t*)(a.ws + WS_WUKV), 256, 2048, 2048, 1, 0, 0, 128, 0, a.in[15]};
    constexpr int TIN = 32 * (CD_INP / 64), T1 = TIN + 32 * 32, T2 = T1 + 32 * 32, T3 = T2 + 8 * 24, T4 = T3 + 4 * 32, NCHUNK = T4 / (8 * CVT_IT);
    static_assert(TIN % (8 * CVT_IT) == 0 && T1 % (8 * CVT_IT) == 0 && T2 % (8 * CVT_IT) == 0 && T3 % (8 * CVT_IT) == 0 && T4 % (8 * CVT_IT) == 0, "chunk boundary");
    for (;;) {
        __syncthreads();
        if (tid == 0) *slot = (int)atomicAdd(counter, 1u);
        __syncthreads();
        const int chunk = *slot;
        if (chunk >= NCHUNK) break;
        const int g = chunk * (8 * CVT_IT) + w;
        if (g < TIN) cvt_run(jin, g, 8, CVT_IT, lane, tile); else if (g < T1) cvt_run(jout, g - TIN, 8, CVT_IT, lane, tile); else if (g < T2) cvt_run(jabo, g - T1, 8, CVT_IT, lane, tile);
        else if (g < T3) cvt_run(juq, g - T2, 8, CVT_IT, lane, tile); else cvt_run(jukv, g - T3, 8, CVT_IT, lane, tile);
    }
    __syncthreads();
}

template <bool DYN>
DEV void mod_phase(const Args& a, int l, char* smem) {
    float* sc = (float*)smem;
    float* red = sc + 5 * D;
    const int tid = tid_opaque(), w = tid >> 6, lane = tid & 63, cg = lane & 7, rr = lane >> 3;
    { float xv[5 * D / NT];
#pragma unroll
      for (int q = 0; q < 5 * D / NT; ++q) { const int i = tid + q * NT, v = i / D, k = i - v * D; xv[q] = v < 4 ? a.in[1][v * D + k] : a.in[3][k]; }
#pragma unroll
      for (int q = 0; q < 5 * D / NT; ++q) sc[tid + q * NT] = siluf_(xv[q]); }
    __syncthreads();
    float* modv = (float*)(a.ws + WS_MODV);
    unsigned* counter = (unsigned*)(a.ws + WS_CTL) + CW_CVT + 2 * 64; volatile int* slot = (volatile int*)(red + 8 * 5 * 32);
    for (int u = gridDim.x - 1 - blockIdx.x;; u += gridDim.x) {
        if (DYN) { __syncthreads(); if (tid == 0) *slot = (int)atomicAdd(counter, 1u); __syncthreads(); u = *slot; }
        if (u >= MODN / 32) break;
        const int c0 = u * 32;
        const float* wp = a.in[4] + (size_t)l * D * MODN + c0 + cg * 4;
        f32x4 acc[5] = {};
        for (int it0 = 0; it0 < D / 64; it0 += 8) { f32x4 wv[8];
#pragma unroll
            for (int q = 0; q < 8; ++q) wv[q] = *(const f32x4*)(wp + (size_t)((it0 + q) * 64 + w * 8 + rr) * MODN);
#pragma unroll
            for (int q = 0; q < 8; ++q) { const int k = (it0 + q) * 64 + w * 8 + rr;
#pragma unroll
                for (int v = 0; v < 5; ++v) acc[v] += wv[q] * sc[v * D + k]; } }
#pragma unroll
        for (int v = 0; v < 5; ++v)
#pragma unroll
            for (int j = 0; j < 4; ++j) { float x = acc[v][j]; x += __shfl_xor(x, 8); x += __shfl_xor(x, 16); x += __shfl_xor(x, 32); acc[v][j] = x; }
        if (rr == 0) {
#pragma unroll
            for (int v = 0; v < 5; ++v)
#pragma unroll
                for (int j = 0; j < 4; ++j) red[(w * 5 + v) * 32 + cg * 4 + j] = acc[v][j]; }
        __syncthreads();
        if (tid < 160) { const int v = tid >> 5, c = tid & 31; float s = 0.f;
#pragma unroll
            for (int ww = 0; ww < 8; ++ww) s += red[(ww * 5 + v) * 32 + c];
            modv[((size_t)l * 5 + v) * MODN + c0 + c] = s + a.in[5][l * MODN + c0 + c]; }
        __syncthreads();
    }
}

DEV void misc_phase(const Args& a) {
    const int gt = blockIdx.x * NT + tid_opaque(), gs = gridDim.x * NT;
    float* lb = (float*)(a.ws + WS_LB);
    for (int i = gt; i < 2 * 1024; i += gs) { const int d = i >> 10, c = i & 1023; const float* p = a.in[11] + (size_t)d * 3 * 1024 + c;
        const float x0 = p[0], x1 = p[1024], x2 = p[2048], m = fmaxf(x0, fmaxf(x1, x2));
        const float e0 = expf(x0 - m), e1 = expf(x1 - m), e2 = expf(x2 - m); lb[i] = e0 / (e0 + e1 + e2); }
    float2* tb = (float2*)(a.ws + WS_TABB); float2* tc = (float2*)(a.ws + WS_TABC);
    for (int i = gt; i < S * 32; i += gs) { const int t = (i >> 5) - TC, j = i & 31, q = j & 15; const float fr = powf(10000.f, -(float)q / 16.f);
        const float pos = (j < 16) ? (float)(t >> 6) : (float)(t & 63); const float an = pos * fr; tb[i] = t < 0 ? make_float2(1.f, 0.f) : make_float2(cosf(an), sinf(an)); }
    for (int i = gt; i < S * 64; i += gs) { const int t = (i >> 6) - TC, j = i & 63, q = j & 31; const float fr = powf(10000.f, -(float)q / 32.f);
        const float pos = (j < 32) ? (float)(t >> 6) : (float)(t & 63); const float an = pos * fr; tc[i] = t < 0 ? make_float2(1.f, 0.f) : make_float2(cosf(an), sinf(an)); }
}

template <bool ROUTER, bool FROM_IN = false>
DEV void norm_phase(const Args& a, int l, int chunk_shift, const float* gain, bool latent_only, char* smem, bool dry = false) {
    const int tid = tid_opaque(), w = tid >> 6, lane = tid & 63;
    const bf16_t* xres = (const bf16_t*)(a.ws + WS_XRES); bf16_t* h = (bf16_t*)(a.ws + WS_H);
    const float* modv = (const float*)(a.ws + WS_MODV) + (size_t)l * 5 * MODN;
    unsigned* cnt = (unsigned*)(a.ws + WS_CTL) + CW_CNT + l * 16 * CNT_STRIDE;
    int* tok = (int*)(a.ws + WS_TOK); int* list = (int*)(a.ws + WS_LIST);
    float* rw = (float*)smem;
    int* ent = (int*)(smem + 139264);
    if (ROUTER) { for (int i = tid; i < D * 16 / 4; i += NT) { const int c = i >> 2, q = i & 3; *(f32x4*)(rw + c * 16 + (c >> 2) * 4 + q * 4) = ((const f32x4*)a.in[24])[i]; }
                  if (tid < 128) ent[tid] = -1; __syncthreads(); }
    const int stride = gridDim.x * 8, rfirst = blockIdx.x * 8 + w;
#define NP_SKIP(rr) while ((rr) < R && latent_only && ((rr) % S) < TC) (rr) += stride
#define NP_LOAD(rr, XF, XB) do { const int b_ = (rr) / S, t_ = (rr) - b_ * S; const float* xp_ = t_ < TC ? a.in[2] + ((size_t)b_ * TC + t_) * D : a.in[0] + ((size_t)b_ * TL + (t_ - TC)) * D; const bf16_t* xb_ = xres + (size_t)(rr) * D; \
        _Pragma("unroll") for (int j = 0; j < 8; ++j) { if (FROM_IN) XF[j] = *(const f32x4*)(xp_ + j * 256 + lane * 4); else XB[j] = *(const u32x2*)(xb_ + j * 256 + lane * 4); } } while (0)
    int r = rfirst; NP_SKIP(r);
    f32x4 nxf[8]; u32x2 nxb[8];
    if (r < R) NP_LOAD(r, nxf, nxb);
    while (r < R) {
        const int nent = (r - rfirst) / stride;
        f32x4 x[8]; float ss = 0.f;
#pragma unroll
        for (int j = 0; j < 8; ++j) { if (FROM_IN) x[j] = nxf[j]; else { const u32x2 p = nxb[j]; x[j] = (f32x4){bflo(p.x), bfhi(p.x), bflo(p.y), bfhi(p.y)}; } }
        int rn = r + stride; NP_SKIP(rn);
        if (rn < R) NP_LOAD(rn, nxf, nxb);
        const int b = r / S, t = r - b * S; const int v = t < TC ? 4 : b;
        const float* sh = modv + (size_t)v * MODN + chunk_shift * D; const float* sc = sh + D;
#pragma unroll
        for (int j = 0; j < 8; ++j) ss += x[j][0] * x[j][0] + x[j][1] * x[j][1] + x[j][2] * x[j][2] + x[j][3] * x[j][3];
        ss = wave_sum(ss); const float rstd = rsqrtf(ss * (1.f / D) + EPS);
        float lg[16]; f32x2 lgp[8];
        if (ROUTER) {
#pragma unroll
            for (int e = 0; e < 8; ++e) lgp[e] = (f32x2){0.f, 0.f}; }
#pragma unroll
        for (int j = 0; j < 8; ++j) { const int c = j * 256 + lane * 4;
            const f32x4 g = *(const f32x4*)(gain + c), s1 = *(const f32x4*)(sc + c), s0 = *(const f32x4*)(sh + c);
            f32x4 y = (x[j] * rstd * g) * (1.f + s1) + s0;
            u32x2 pk; pk.x = cvtpk(y[0], y[1]); pk.y = cvtpk(y[2], y[3]); *(u32x2*)(h + (size_t)r * D + c) = pk;
            if (ROUTER) {
#pragma unroll
                for (int i = 0; i < 4; ++i) { const f32x4* wrow = (const f32x4*)(rw + (c + i) * 16 + (c >> 2) * 4);
#pragma unroll
                    for (int q = 0; q < 4; ++q) { const f32x4 wv = wrow[q]; const f32x2 yy = (f32x2){y[i], y[i]};
                        lgp[q * 2 + 0] += yy * (f32x2){wv[0], wv[1]}; lgp[q * 2 + 1] += yy * (f32x2){wv[2], wv[3]}; } }
                __builtin_amdgcn_sched_barrier(0); }
        }
        if (ROUTER) {
#pragma unroll
            for (int e = 0; e < 16; ++e) lg[e] = wave_sum(lgp[e >> 1][e & 1]);
            if (lane == 0 && !dry) {
                float scv[16], sel[16];
#pragma unroll
                for (int e = 0; e < 16; ++e) { scv[e] = 1.f / (1.f + __expf(-lg[e])); sel[e] = scv[e] + a.in[25][e]; }
                int gbest = 0; float gbv = -1e30f;
#pragma unroll
                for (int g = 0; g < 4; ++g) { float m1 = -1e30f, m2 = -1e30f;
#pragma unroll
                    for (int i = 0; i < 4; ++i) { const float s_ = sel[g * 4 + i]; if (s_ > m1) { m2 = m1; m1 = s_; } else if (s_ > m2) m2 = s_; }
                    const float gs = m1 + m2; if (gs > gbv) { gbv = gs; gbest = g; } }
                int e0 = 0, e1 = 0; float m1 = -1e30f, m2 = -1e30f; float w0 = 0.f, w1 = 0.f;
#pragma unroll
                for (int g = 0; g < 4; ++g) if (g == gbest) {
#pragma unroll
                    for (int i = 0; i < 4; ++i) { const float s_ = sel[g * 4 + i]; const int e = g * 4 + i;
                        if (s_ > m1) { m2 = m1; e1 = e0; w1 = w0; m1 = s_; e0 = e; w0 = scv[e]; } else if (s_ > m2) { m2 = s_; e1 = e; w1 = scv[e]; } } }
                const float inv = 1.f / (w0 + w1);
                ent[nent * 16 + w * 2 + 0] = (e0 << 24) | (r * 2); ent[nent * 16 + w * 2 + 1] = (e1 << 24) | (r * 2 + 1);
                tok[r * 4 + 0] = e0; tok[r * 4 + 1] = e1; ((float*)tok)[r * 4 + 2] = w0 * inv; ((float*)tok)[r * 4 + 3] = w1 * inv;
            }
        }
        r = rn;
    }
#undef NP_LOAD
#undef NP_SKIP
    if (ROUTER) {
        __syncthreads();
        if (tid < NE) { int c_ = 0;
            for (int j = 0; j < 128; ++j) c_ += ((ent[j] >> 24) == tid) ? 1 : 0;
            if (c_) { unsigned pos = atomicAdd(&cnt[tid * CNT_STRIDE], (unsigned)c_);
                for (int j = 0; j < 128; ++j) { const int en = ent[j]; if ((en >> 24) == tid) { __hip_atomic_store((__attribute__((address_space(1))) int*)(list + (size_t)tid * R + pos), en & 0xffffff, __ATOMIC_RELAXED, __HIP_MEMORY_SCOPE_AGENT); ++pos; } } } }
        __syncthreads();
    }
}

DEV int scan_tok(int dir, int pos) { return dir == 0 ? pos : (pos < TC ? (TC - 1 - pos) : (S - 1 - (pos - TC))); }
template <int MODE>
DEV void scan_prep_phase(const Args& a, char* smem) {
    constexpr int NH = MODE == 0 ? 8 : 4, DV = MODE == 0 ? 128 : 256, LDP = MODE == 0 ? AB_INP : CD_INP, NVP = DV / 128;
    const int tid = tid_opaque(), dp = tid & 63, pg = tid >> 6, wid = tid >> 6, lane = tid & 63, l15 = lane & 15, l4 = lane >> 4;
    char* QT = smem; char* KT = smem + 64 * PQ; float* tot = (float*)(smem + 2 * 64 * PQ);
    float* aT = tot + 8 * 128;
    const bf16_t* P = (const bf16_t*)(a.ws + WS_P); const float* lb = (const float*)(a.ws + WS_LB);
    const float qscale = 0.08838834764831845f;
    const int nitems = NB * NH * 2 * 36;
#define SP_LOADS(it_, Q_, Z_, V_) do { const int c_ = (it_) % 36, dir_ = ((it_) / 36) & 1, hd_ = ((it_) / 72) % NH, b_ = (it_) / (72 * NH); \
        const int qcol_ = (MODE == 0 ? hd_ * 128 : 1536 + hd_ * 128) + 2 * dp, zcol_ = (MODE == 0 ? 1024 * (1 + dir_) + hd_ * 128 : 2048 + hd_ * 128) + 2 * dp, vcol_ = (MODE == 0 ? 3072 + hd_ * 128 : 2560 + hd_ * 256) + 2 * dp; \
        _Pragma("unroll") for (int j = 0; j < 8; ++j) { const bf16_t* pr = P + (size_t)(b_ * S + scan_tok(dir_, c_ * 64 + pg * 8 + j)) * LDP; \
            Q_[j] = *(const unsigned*)(pr + qcol_); Z_[j] = *(const unsigned*)(pr + zcol_); \
            _Pragma("unroll") for (int vv = 0; vv < NVP; ++vv) V_[vv][j] = *(const unsigned*)(pr + vcol_ + vv * 128); } } while (0)
    unsigned nz[8], nq[8], nv[NVP][8];
    if ((int)blockIdx.x < nitems) SP_LOADS((int)blockIdx.x, nq, nz, nv);
    for (int item = blockIdx.x; item < nitems; item += gridDim.x) {
        const int c = item % 36, dir = (item / 36) & 1, hd = (item / 72) % NH, b = item / (72 * NH);
        char* rec = (char*)(a.ws + (MODE == 0 ? WS_SREC : WS_SREC1)) + (size_t)item * REC_BYTES;
        char* vt = (char*)(a.ws + (MODE == 0 ? WS_SVT : WS_SVT1)) + (size_t)item * (DV * PA);
        unsigned zq[8], qq[8], kq[8], vq[NVP][8];
#pragma unroll
        for (int j = 0; j < 8; ++j) { qq[j] = nq[j]; zq[j] = nz[j]; kq[j] = nz[j];
#pragma unroll
            for (int vv = 0; vv < NVP; ++vv) vq[vv][j] = nv[vv][j]; }
        float lb0 = 0.f, lb1 = 0.f, gb0 = 0.f, gb1 = 0.f; float w0[16], w1[16]; u32x2 av = {0u, 0u};
        if (MODE == 0) { lb0 = lb[dir * 1024 + hd * 128 + 2 * dp]; lb1 = lb[dir * 1024 + hd * 128 + 2 * dp + 1]; }
        else { const int wc_ = hd * 128 + 2 * dp; gb0 = a.in[22][dir * 512 + wc_]; gb1 = a.in[22][dir * 512 + wc_ + 1];
#pragma unroll
            for (int i = 0; i < 16; ++i) { const float2 wv = *(const float2*)(a.in[21] + (size_t)(dir * 16 + i) * 512 + wc_); w0[i] = wv.x; w1[i] = wv.y; }
            const int pos = (tid & 255) >> 2, qd = tid & 3; const int r = b * S + scan_tok(dir, c * 64 + pos);
            av = *(const u32x2*)(P + (size_t)r * LDP + 4608 + dir * 16 + qd * 4); }
        __builtin_amdgcn_sched_barrier(0);
        { const int nxt = item + (int)gridDim.x < nitems ? item + (int)gridDim.x : item; SP_LOADS(nxt, nq, nz, nv); }
        __builtin_amdgcn_sched_barrier(0);
        if (MODE == 1) { if (tid < 256) { const int pos = tid >> 2, qd = tid & 3; *(f32x4*)(aT + pos * 16 + qd * 4) = (f32x4){bflo(av.x), bfhi(av.x), bflo(av.y), bfhi(av.y)}; }
            LDS_BARRIER(); }
        float g0[8], g1[8], k0[8], k1[8];
        if (MODE == 0) {
#pragma unroll
            for (int j = 0; j < 8; ++j) { const float f0 = lb0 + (1.f - lb0) * sigmoidf_(bflo(zq[j])), f1 = lb1 + (1.f - lb1) * sigmoidf_(bfhi(zq[j]));
                g0[j] = __logf(f0); g1[j] = __logf(f1); k0[j] = 1.f - f0; k1[j] = 1.f - f1; } }
        else {
#pragma unroll
            for (int j = 0; j < 8; ++j) { float z0 = gb0, z1 = gb1;
#pragma unroll
                for (int i4 = 0; i4 < 4; ++i4) { const f32x4 av = *(const f32x4*)(aT + (pg * 8 + j) * 16 + i4 * 4);
#pragma unroll
                    for (int e = 0; e < 4; ++e) { z0 += av[e] * w0[i4 * 4 + e]; z1 += av[e] * w1[i4 * 4 + e]; } }
                g0[j] = (fminf(z0, 0.f) - __logf(1.f + __expf(-fabsf(z0)))) * (1.f / 16.f); g1[j] = (fminf(z1, 0.f) - __logf(1.f + __expf(-fabsf(z1)))) * (1.f / 16.f);
                k0[j] = bflo(kq[j]); k1[j] = bfhi(kq[j]); } }
#pragma unroll
        for (int j = 1; j < 8; ++j) { g0[j] += g0[j - 1]; g1[j] += g1[j - 1]; }
        *(float2*)(tot + pg * 128 + 2 * dp) = make_float2(g0[7], g1[7]);
        LDS_BARRIER();
        float off0 = 0.f, off1 = 0.f, ref0 = 0.f, ref1 = 0.f, last0 = 0.f, last1 = 0.f;
#pragma unroll
        for (int p = 0; p < 8; ++p) { const float2 tp = *(const float2*)(tot + p * 128 + 2 * dp);
            if (p < pg) { off0 += tp.x; off1 += tp.y; } if (p < 4) { ref0 += tp.x; ref1 += tp.y; } last0 += tp.x; last1 += tp.y; }
        unsigned kh0[4], kh1[4];
        const float eref0 = __expf(ref0), eref1 = __expf(ref1), elr0 = __expf(last0 - ref0), elr1 = __expf(last1 - ref1);
#pragma unroll
        for (int j = 0; j < 8; j += 2) { float kha[2], khb[2];
#pragma unroll
            for (int e = 0; e < 2; ++e) { const int i = pg * 8 + j + e; const float G0 = off0 + g0[j + e], G1 = off1 + g1[j + e];
                float q0 = bflo(qq[j + e]), q1 = bfhi(qq[j + e]); if (MODE == 0) { q0 = siluf_(q0); q1 = siluf_(q1); } q0 *= qscale; q1 *= qscale;
                const float kk0 = k0[j + e], kk1 = k1[j + e];
                const float qt0 = q0 * __expf(G0 - ref0), qt1 = q1 * __expf(G1 - ref1), kt0 = kk0 * __expf(ref0 - G0), kt1 = kk1 * __expf(ref1 - G1);
                *(unsigned*)(QT + i * PQ + dp * 4) = cvtpk(qt0, qt1);
                *(unsigned*)(KT + i * PQ + dp * 4) = cvtpk(kt0, kt1);
                *(unsigned*)(rec + REC_QH + i * PQ + dp * 4) = cvtpk(qt0 * eref0, qt1 * eref1);
                kha[e] = kt0 * elr0; khb[e] = kt1 * elr1; }
            kh0[j >> 1] = cvtpk(kha[0], kha[1]); kh1[j >> 1] = cvtpk(khb[0], khb[1]); }
        *(u32x4*)(rec + REC_KHT + (2 * dp) * PA + pg * 16) = (u32x4){kh0[0], kh0[1], kh0[2], kh0[3]};
        *(u32x4*)(rec + REC_KHT + (2 * dp + 1) * PA + pg * 16) = (u32x4){kh1[0], kh1[1], kh1[2], kh1[3]};
        if (pg == 0) *(float2*)(rec + REC_AL + dp * 8) = make_float2(__expf(last0), __expf(last1));
#pragma unroll
        for (int vv = 0; vv < NVP; ++vv) { const int v0 = vv * 128 + 2 * dp; unsigned lo[4], hi[4];
#pragma unroll
            for (int j = 0; j < 8; j += 2) { lo[j >> 1] = (vq[vv][j] & 0xffffu) | (vq[vv][j + 1] << 16); hi[j >> 1] = (vq[vv][j] >> 16) | (vq[vv][j + 1] & 0xffff0000u); }
            *(u32x4*)(vt + v0 * PA + pg * 16) = (u32x4){lo[0], lo[1], lo[2], lo[3]};
            *(u32x4*)(vt + (v0 + 1) * PA + pg * 16) = (u32x4){hi[0], hi[1], hi[2], hi[3]}; }
        asm volatile("s_waitcnt lgkmcnt(0)" ::: "memory"); __builtin_amdgcn_s_barrier();
        { const int ti = wid >> 1; f32x4 acc[2] = {};
#pragma unroll
          for (int kk = 0; kk < 4; ++kk) { const int i = ti * 16 + l15;
              const bf16x8 bq = *(const bf16x8*)(QT + i * PQ + (kk * 32 + l4 * 8) * 2);
#pragma unroll
              for (int t2_ = 0; t2_ < 2; ++t2_) { const int sidx = ((wid & 1) * 2 + t2_) * 16 + l15;
                  const bf16x8 ak = *(const bf16x8*)(KT + sidx * PQ + (kk * 32 + l4 * 8) * 2);
                  acc[t2_] = __builtin_amdgcn_mfma_f32_16x16x32_bf16(ak, bq, acc[t2_], 0, 0, 0); } }
#pragma unroll
          for (int t2_ = 0; t2_ < 2; ++t2_) { const int tj = (wid & 1) * 2 + t2_, i = ti * 16 + l15, s0 = tj * 16 + 4 * l4;
              float x0 = (s0 + 0 <= i) ? acc[t2_][0] : 0.f, x1 = (s0 + 1 <= i) ? acc[t2_][1] : 0.f, x2 = (s0 + 2 <= i) ? acc[t2_][2] : 0.f, x3 = (s0 + 3 <= i) ? acc[t2_][3] : 0.f;
              u32x2 w_; w_.x = cvtpk(x0, x1); w_.y = cvtpk(x2, x3);
              *(u32x2*)(rec + REC_A + i * PA + s0 * 2) = w_; } }
    }
#undef SP_LOADS
    __syncthreads();
}
template <int MODE>
DEV void scan_seq_phase(const Args& a, char* smem) {
    constexpr int NH = MODE == 0 ? 8 : 4, DV = MODE == 0 ? 128 : 256, NVS = DV / 32;
    constexpr int B_A = REC_A, B_QH = REC_QH, B_KHT = REC_KHT, B_AL = REC_AL, B_VT = REC_BYTES, VTS = 32 * PA, BUFB = REC_BYTES + VTS;
    constexpr int NPIECE = BUFB / 16, NREC = REC_BYTES / 16, STB = 32 * PQ, NLD = 7 * 64;
    constexpr int NRL = (REC_BYTES / 128 + NVS - 1) / NVS, TOUCH_OFF = 3 * BUFB + STB;
    static_assert(NPIECE == 7 * NLD && REC_BYTES % 128 == 0 && VTS == 36 * 128 && NRL + 36 <= 128 && TOUCH_OFF + 256 <= LDS_BYTES_C - 16, "scan_seq layout");
    const int tid = tid_opaque(), wid = tid >> 6, lane = tid & 63, l15 = lane & 15, l4 = lane >> 4;
    char* ST = smem + 3 * BUFB;
    float* odir = (float*)(a.ws + WS_ODIR);
    for (int item = blockIdx.x; item < NB * NH * 2 * NVS; item += gridDim.x) {
        const int vs = (item >> 3) % NVS, rest = (item & 7) + 8 * ((item >> 3) / NVS);
        const int dir = rest & 1, hd = (rest >> 1) % NH, b = (rest >> 1) / NH;
        const char* rec0 = (const char*)(a.ws + (MODE == 0 ? WS_SREC : WS_SREC1)) + (size_t)rest * 36 * REC_BYTES;
        const char* vt0 = (const char*)(a.ws + (MODE == 0 ? WS_SVT : WS_SVT1)) + (size_t)rest * 36 * (DV * PA) + vs * VTS;
#define SC_LOAD(cc, bb) do { if (wid < 7) { const char* _r = rec0 + (size_t)(cc) * REC_BYTES; const char* _v = vt0 + (size_t)(cc) * (DV * PA) - REC_BYTES; char* _l = smem + (bb) * BUFB; \
        _Pragma("unroll") for (int _k = 0; _k < 7; ++_k) { const int _p = tid + _k * NLD; \
            __builtin_amdgcn_global_load_lds((const unsigned*)((_p < NREC ? _r : _v) + _p * 16), (unsigned*)(_l + _p * 16), 16, 0, 0); } } } while (0)
#define SC_TOUCH(cc) do { if (wid == 7) { _Pragma("unroll") for (int _q = 0; _q < 2; ++_q) { const int L_ = _q * 64 + lane; const char* tp_; \
        if (L_ < NRL) { int li_ = vs * NRL + L_; li_ = li_ < REC_BYTES / 128 - 1 ? li_ : REC_BYTES / 128 - 1; tp_ = rec0 + (size_t)(cc) * REC_BYTES + li_ * 128; } \
        else { int li_ = L_ - NRL; li_ = li_ < 35 ? li_ : 35; tp_ = vt0 + (size_t)(cc) * (DV * PA) + li_ * 128; } \
        __builtin_amdgcn_global_load_lds((const unsigned*)tp_, (unsigned*)(smem + TOUCH_OFF), 4, 0, 0); } } } while (0)
        for (int i = tid; i < STB / 16; i += NT) ((u32x4*)ST)[i] = (u32x4){0u, 0u, 0u, 0u};
        f32x4 Sacc[2] = {};
        SC_LOAD(0, 0); SC_LOAD(1, 1); SC_TOUCH(2); SC_TOUCH(3);
        asm volatile("s_waitcnt vmcnt(0) lgkmcnt(0)" ::: "memory"); __builtin_amdgcn_s_barrier(); asm volatile("" ::: "memory");
        int rb = 0;
#pragma unroll 1
        for (int c = 0; c < 36; ++c) {
            const char* buf = smem + rb * BUFB; const char* STr = ST; char* STw = ST;
            { const int nb2 = rb == 0 ? 2 : rb - 1;
              if (c + 2 < 36) SC_LOAD(c + 2, nb2); }
            rb = rb == 2 ? 0 : rb + 1;
            { const int ti = wid >> 1, tj = wid & 1, i = ti * 16 + l15, v = tj * 16 + l15, dr = wid * 16 + l15;
              bf16x8 ba[2], as_[4], bq[4], ak[2], bv[2][2];
#pragma unroll
              for (int kk = 0; kk < 2; ++kk) { ba[kk] = *(const bf16x8*)(buf + B_A + i * PA + (kk * 32 + l4 * 8) * 2); ak[kk] = *(const bf16x8*)(buf + B_KHT + dr * PA + (kk * 32 + l4 * 8) * 2);
                  bv[0][kk] = *(const bf16x8*)(buf + B_VT + l15 * PA + (kk * 32 + l4 * 8) * 2); bv[1][kk] = *(const bf16x8*)(buf + B_VT + (16 + l15) * PA + (kk * 32 + l4 * 8) * 2); }
              const f32x4 al = *(const f32x4*)(buf + B_AL + (wid * 16 + 4 * l4) * 4);
#pragma unroll
              for (int kk = 0; kk < 4; ++kk) { as_[kk] = *(const bf16x8*)(STr + v * PQ + (kk * 32 + l4 * 8) * 2); bq[kk] = *(const bf16x8*)(buf + B_QH + i * PQ + (kk * 32 + l4 * 8) * 2); }
              __builtin_amdgcn_sched_barrier(0);
              asm volatile("s_waitcnt lgkmcnt(0)" : "+v"(as_[0]), "+v"(as_[1]), "+v"(as_[2]), "+v"(as_[3]) :: "memory"); __builtin_amdgcn_s_barrier(); asm volatile("" ::: "memory");
              f32x4 acc = {}; Sacc[0] *= al; Sacc[1] *= al;
#pragma unroll
              for (int kk = 0; kk < 2; ++kk) {
                  acc = __builtin_amdgcn_mfma_f32_16x16x32_bf16(tj ? bv[1][kk] : bv[0][kk], ba[kk], acc, 0, 0, 0);
                  Sacc[0] = __builtin_amdgcn_mfma_f32_16x16x32_bf16(ak[kk], bv[0][kk], Sacc[0], 0, 0, 0);
                  Sacc[1] = __builtin_amdgcn_mfma_f32_16x16x32_bf16(ak[kk], bv[1][kk], Sacc[1], 0, 0, 0); }
#pragma unroll
              for (int kk = 0; kk < 4; ++kk) acc = __builtin_amdgcn_mfma_f32_16x16x32_bf16(as_[kk], bq[kk], acc, 0, 0, 0);
#pragma unroll
              for (int tv = 0; tv < 2; ++tv) { u32x2 w_; w_.x = cvtpk(Sacc[tv][0], Sacc[tv][1]); w_.y = cvtpk(Sacc[tv][2], Sacc[tv][3]);
                  *(u32x2*)(STw + (tv * 16 + l15) * PQ + (wid * 16 + 4 * l4) * 2) = w_; }
              const int r = b * S + scan_tok(dir, c * 64 + i);
              *(f32x4*)(odir + ((size_t)dir * R + r) * 1024 + hd * DV + vs * 32 + tj * 16 + 4 * l4) = acc; }
            SC_TOUCH(c + 4 < 36 ? c + 4 : 35);
            if (wid < 7) { if (c + 2 < 36) asm volatile("s_waitcnt vmcnt(8)" ::: "memory"); else asm volatile("s_waitcnt vmcnt(1)" ::: "memory"); } else asm volatile("s_waitcnt vmcnt(9)" ::: "memory");
            asm volatile("s_waitcnt lgkmcnt(0)" ::: "memory"); __builtin_amdgcn_s_barrier(); asm volatile("" ::: "memory");
        }
#undef SC_LOAD
#undef SC_TOUCH
    }
    asm volatile("s_waitcnt vmcnt(0)" ::: "memory"); __syncthreads();
}

namespace fa {
typedef short s16x4 __attribute__((ext_vector_type(4)));
typedef float f32x16 __attribute__((ext_vector_type(16)));
constexpr int QBLK = 32, KVBLK = 64, NW = 8;
constexpr float THR = 8.f;
#define FA_SBAR() __builtin_amdgcn_sched_barrier(0)
DEV int crow(int r, int hi) { return (r & 3) + 8 * (r >> 2) + 4 * hi; }
template <int DQ> DEV int kswz(int row, int colB) { return row * (DQ * 2) + (colB ^ ((row & 7) << 4)); }
template <int DQ> DEV void partialSM(f32x16& p0, f32x16& p1, float& m_reg, float& mn, float& alpha) {
    constexpr float SCALE = DQ == 128 ? 0.08838834764831845f : 0.07216878364870322f;
    constexpr float C = SCALE * 1.4426950408889634f;
    float pmax = p0[0];
#pragma unroll
    for (int r = 1; r < 16; ++r) pmax = fmaxf(pmax, p0[r]);
#pragma unroll
    for (int r = 0; r < 16; ++r) pmax = fmaxf(pmax, p1[r]);
    { auto rr = __builtin_amdgcn_permlane32_swap(__float_as_uint(pmax), __float_as_uint(pmax), false, false);
      pmax = fmaxf(__uint_as_float(rr[0]), __uint_as_float(rr[1])); }
    if (__builtin_expect(__all(pmax - m_reg <= THR / SCALE), 1)) { mn = m_reg; alpha = 1.f; }
    else { mn = fmaxf(m_reg, pmax); alpha = __builtin_amdgcn_exp2f((m_reg - mn) * C); m_reg = mn; }
    const float mnC = -mn * C;
#pragma unroll
    for (int r = 0; r < 16; ++r) p0[r] = fmaf(p0[r], C, mnC);
#pragma unroll
    for (int r = 0; r < 16; ++r) p1[r] = fmaf(p1[r], C, mnC);
#pragma unroll
    for (int r = 0; r < 16; ++r) p0[r] = __builtin_amdgcn_exp2f(p0[r]);
}
DEV void finishSM(f32x16& p0, f32x16& p1, float alpha, float& l_reg, bf16x8& pa0, bf16x8& pa1, bf16x8& pa2, bf16x8& pa3) {
#pragma unroll
    for (int r = 0; r < 16; ++r) p1[r] = __builtin_amdgcn_exp2f(p1[r]);
    float ps = 0;
#pragma unroll
    for (int r = 0; r < 16; ++r) ps += p0[r];
#pragma unroll
    for (int r = 0; r < 16; ++r) ps += p1[r];
    { auto rr = __builtin_amdgcn_permlane32_swap(__float_as_uint(ps), __float_as_uint(ps), false, false);
      ps = __uint_as_float(rr[0]) + __uint_as_float(rr[1]); }
    l_reg = l_reg * alpha + ps;
#define FA_PK4(P, BASE, OUT) do { unsigned a0 = cvtpk(P[BASE + 0], P[BASE + 1]), a1 = cvtpk(P[BASE + 2], P[BASE + 3]);   \
    unsigned b0 = cvtpk(P[BASE + 4], P[BASE + 5]), b1 = cvtpk(P[BASE + 6], P[BASE + 7]);                              \
    auto r0 = __builtin_amdgcn_permlane32_swap(a0, b0, false, false); auto r1 = __builtin_amdgcn_permlane32_swap(a1, b1, false, false); \
    u32x4 w = {r0[0], r1[0], r0[1], r1[1]}; OUT = *reinterpret_cast<bf16x8*>(&w); } while (0)
    FA_PK4(p0, 0, pa0); FA_PK4(p0, 8, pa1); FA_PK4(p1, 0, pa2); FA_PK4(p1, 8, pa3);
#undef FA_PK4
}
template <int DQ> DEV void qkt(f32x16& p0, f32x16& p1, const char* Ks, const bf16x8* qr, int r32, int hi) {
    p0 = f32x16{}; p1 = f32x16{};
#pragma unroll
    for (int d0 = 0; d0 < DQ / 16; ++d0) { const int cb = (d0 * 16 + hi * 8) * 2;
        const bf16x8 b0 = *reinterpret_cast<const bf16x8*>(Ks + kswz<DQ>(r32, cb));
        const bf16x8 b1 = *reinterpret_cast<const bf16x8*>(Ks + kswz<DQ>(32 + r32, cb));
        p0 = __builtin_amdgcn_mfma_f32_32x32x16_bf16(b0, qr[d0], p0, 0, 0, 0);
        p1 = __builtin_amdgcn_mfma_f32_32x32x16_bf16(b1, qr[d0], p1, 0, 0, 0); }
}
DEV int v_st(int k, int c) { const int kk = (k & ~0xC) | ((k & 4) << 1) | ((k & 8) >> 1); return ((kk >> 3) * 4 + (c >> 5)) * 512 + ((kk & 7) * 32 + (c & 31)) * 2; }
DEV int v_rd_base(int lane) { return ((lane & 3) << 3) | (((lane >> 2) & 3) << 6) | (((lane >> 4) & 1) << 5) | (((lane >> 5) & 1) << 8); }
constexpr int v_rd_off(int d0, int ks, int half) { return d0 * 512 + ks * 4096 + half * 2048; }
template <int OFF> DEV s16x4 tr_read(int vb) { s16x4 r; asm volatile("ds_read_b64_tr_b16 %0, %1 offset:%2" : "=&v"(r) : "v"(vb), "i"(OFF) : "memory"); return r; }
template <int D0> DEV void pv_one(f32x16& od, int vb, bf16x8 pa0, bf16x8 pa1, bf16x8 pa2, bf16x8 pa3) {
    const s16x4 l0 = tr_read<v_rd_off(D0, 0, 0)>(vb), h0 = tr_read<v_rd_off(D0, 0, 1)>(vb), l1 = tr_read<v_rd_off(D0, 1, 0)>(vb), h1 = tr_read<v_rd_off(D0, 1, 1)>(vb);
    const s16x4 l2 = tr_read<v_rd_off(D0, 2, 0)>(vb), h2 = tr_read<v_rd_off(D0, 2, 1)>(vb), l3 = tr_read<v_rd_off(D0, 3, 0)>(vb), h3 = tr_read<v_rd_off(D0, 3, 1)>(vb);
    asm volatile("s_waitcnt lgkmcnt(0)" ::: "memory"); FA_SBAR();
#define FA_PK(L, H) (bf16x8){L[0], L[1], L[2], L[3], H[0], H[1], H[2], H[3]}
    od = __builtin_amdgcn_mfma_f32_32x32x16_bf16(pa0, FA_PK(l0, h0), od, 0, 0, 0);
    od = __builtin_amdgcn_mfma_f32_32x32x16_bf16(pa1, FA_PK(l1, h1), od, 0, 0, 0);
    od = __builtin_amdgcn_mfma_f32_32x32x16_bf16(pa2, FA_PK(l2, h2), od, 0, 0, 0);
    od = __builtin_amdgcn_mfma_f32_32x32x16_bf16(pa3, FA_PK(l3, h3), od, 0, 0, 0);
#undef FA_PK
}
DEV void pv_d0(f32x16* o, int vb, bf16x8 pa0, bf16x8 pa1, bf16x8 pa2, bf16x8 pa3) {
    pv_one<0>(o[0], vb, pa0, pa1, pa2, pa3); pv_one<1>(o[1], vb, pa0, pa1, pa2, pa3); pv_one<2>(o[2], vb, pa0, pa1, pa2, pa3); pv_one<3>(o[3], vb, pa0, pa1, pa2, pa3);
}
template <int DQ>
DEV void attn_body(const bf16_t* __restrict__ Qb, const bf16_t* __restrict__ Kh, const bf16_t* __restrict__ Vh, bf16_t* __restrict__ Ob, int LDO_, int seq_, char* lds) {
    constexpr int LDO = D, seq = S; (void)LDO_; (void)seq_;
    constexpr int NKC = DQ / 64, KC8 = DQ / 8;
    constexpr int SHM_V = KVBLK * 128 * 2, SHM_K = KVBLK * DQ * 2;
    const int tid = tid_opaque(), wid = tid >> 6, lane = tid & 63, r32 = lane & 31, hi = lane >> 5;
    char* V_lds = lds; char* K_lds = lds + 2 * SHM_V;
    float* wsx = (float*)(lds + 2 * SHM_V + 2 * SHM_K) + wid * 64; float* li_l = wsx; float* al_l = wsx + 32;
    float m_reg = -1e30f, l_reg = 0; f32x16 o[4] = {}; bf16x8 qr[DQ / 16];
    const bf16_t* Qw = Qb + (size_t)(wid * QBLK + r32) * DQ + hi * 8;
#pragma unroll
    for (int d0 = 0; d0 < DQ / 16; ++d0) qr[d0] = *reinterpret_cast<const bf16x8*>(Qw + d0 * 16);
    const int sr = tid >> 4, sc = (tid & 15) * 8;
    const int vb0 = (int)(uintptr_t)V_lds + v_rd_base(lane);
    struct { bf16x8 vs0, vs1, ks[NKC]; } sr_[2];
#define SLOAD(i, k0) do { sr_[i].vs0 = *reinterpret_cast<const bf16x8*>(&Vh[(size_t)((k0) + sr) * 128 + sc]); sr_[i].vs1 = *reinterpret_cast<const bf16x8*>(&Vh[(size_t)((k0) + 32 + sr) * 128 + sc]); \
    _Pragma("unroll") for (int _c = 0; _c < NKC; ++_c) { const int ch = tid + _c * 512, kr = ch / KC8, kc = ch - kr * KC8; sr_[i].ks[_c] = *reinterpret_cast<const bf16x8*>(&Kh[(size_t)((k0) + kr) * DQ + kc * 8]); } } while (0)
#define SWRITE(b, i) do { const int t2_ = tid_opaque(), sr2_ = t2_ >> 4, sc2_ = (t2_ & 15) * 8; *(bf16x8*)(V_lds + (b) * SHM_V + v_st(sr2_, sc2_)) = sr_[i].vs0; *(bf16x8*)(V_lds + (b) * SHM_V + v_st(32 + sr2_, sc2_)) = sr_[i].vs1; \
    _Pragma("unroll") for (int _c = 0; _c < NKC; ++_c) { const int ch = tid + _c * 512, kr = ch / KC8, kc = ch - kr * KC8; *(bf16x8*)(K_lds + (b) * SHM_K + kswz<DQ>(kr, kc * 16)) = sr_[i].ks[_c]; } } while (0)
#define SWAIT() do { if constexpr (NKC == 2) asm volatile("s_waitcnt vmcnt(4)" ::: "memory"); else asm volatile("s_waitcnt vmcnt(5)" ::: "memory"); } while (0)
#define RESC(a_) do { if (__any((a_) < 1.f)) { if (hi == 0) al_l[r32] = (a_); asm volatile("s_waitcnt lgkmcnt(0)" ::: "memory"); \
    _Pragma("unroll") for (int d = 0; d < 4; ++d) _Pragma("unroll") for (int r = 0; r < 16; ++r) o[d][r] *= al_l[crow(r, hi)]; } } while (0)
    f32x16 pA0, pA1, pB0, pB1; float mnA, mnB, alA, alB; bf16x8 pa0, pa1, pa2, pa3; const int NTL = seq / KVBLK;
    constexpr int SE = 0, SO = 1;
    SLOAD(SE, 0); asm volatile("s_waitcnt vmcnt(0)" ::: "memory"); SWRITE(0, SE); __syncthreads();
    qkt<DQ>(pA0, pA1, K_lds, qr, r32, hi); partialSM<DQ>(pA0, pA1, m_reg, mnA, alA);
    SLOAD(SO, KVBLK); if (2 < NTL) SLOAD(SE, 2 * KVBLK);
    SWAIT(); SWRITE(1, SO); __syncthreads();
    for (int j = 1; j + 1 < NTL; j += 2) {
        FA_SBAR(); qkt<DQ>(pB0, pB1, K_lds + SHM_K, qr, r32, hi);
        finishSM(pA0, pA1, alA, l_reg, pa0, pa1, pa2, pa3); FA_SBAR();
        SLOAD(SO, (j + 2) * KVBLK); FA_SBAR();
        pv_d0(o, vb0, pa0, pa1, pa2, pa3); partialSM<DQ>(pB0, pB1, m_reg, mnB, alB);
        __syncthreads(); SWAIT(); SWRITE(0, SE);
        RESC(alB); __syncthreads();
        FA_SBAR(); qkt<DQ>(pA0, pA1, K_lds, qr, r32, hi);
        finishSM(pB0, pB1, alB, l_reg, pa0, pa1, pa2, pa3); FA_SBAR();
        if (j + 3 < NTL) SLOAD(SE, (j + 3) * KVBLK); FA_SBAR();
        pv_d0(o, vb0 + SHM_V, pa0, pa1, pa2, pa3); partialSM<DQ>(pA0, pA1, m_reg, mnA, alA);
        __syncthreads(); SWAIT(); SWRITE(1, SO);
        RESC(alA); __syncthreads();
    }
    FA_SBAR(); qkt<DQ>(pB0, pB1, K_lds + SHM_K, qr, r32, hi);
    finishSM(pA0, pA1, alA, l_reg, pa0, pa1, pa2, pa3); FA_SBAR();
    pv_d0(o, vb0, pa0, pa1, pa2, pa3); partialSM<DQ>(pB0, pB1, m_reg, mnB, alB);
    __syncthreads(); RESC(alB);
    finishSM(pB0, pB1, alB, l_reg, pa0, pa1, pa2, pa3); FA_SBAR();
    pv_d0(o, vb0 + SHM_V, pa0, pa1, pa2, pa3);
    if (hi == 0) li_l[r32] = l_reg; asm volatile("s_waitcnt lgkmcnt(0)" ::: "memory");
    float rli[16];
#pragma unroll
    for (int r = 0; r < 16; ++r) rli[r] = __builtin_amdgcn_rcpf(li_l[crow(r, hi)]);
    bf16_t* Ow = Ob + (size_t)(wid * QBLK) * LDO;
#pragma unroll
    for (int r = 0; r < 16; ++r) { const int orow = crow(r, hi);
#pragma unroll
        for (int d0 = 0; d0 < 4; ++d0) Ow[(size_t)orow * LDO + d0 * 32 + r32] = f2bf(o[d0][r] * rli[r]); }
    __syncthreads();
#undef SLOAD
#undef SWRITE
#undef SWAIT
#undef RESC
}

template <int DQ>
DEV void attn_body_simple(const bf16_t* __restrict__ Qb, const bf16_t* __restrict__ Kh, const bf16_t* __restrict__ Vh, bf16_t* __restrict__ Ob, int LDO, int seq, char* lds) {
    constexpr int NKC = DQ / 64, KC8 = DQ / 8;
    constexpr int SHM_V = KVBLK * 128 * 2, SHM_K = KVBLK * DQ * 2;
    const int tid = tid_opaque(), wid = tid >> 6, lane = tid & 63, r32 = lane & 31, hi = lane >> 5;
    char* V_lds = lds; char* K_lds = lds + 2 * SHM_V;
    float* wsx = (float*)(lds + 2 * SHM_V + 2 * SHM_K) + wid * 64; float* li_l = wsx; float* al_l = wsx + 32;
    float m_reg = -1e30f, l_reg = 0; f32x16 o[4] = {}; bf16x8 qr[DQ / 16];
    const bf16_t* Qw = Qb + (size_t)(wid * QBLK + r32) * DQ + hi * 8;
#pragma unroll
    for (int d0 = 0; d0 < DQ / 16; ++d0) qr[d0] = *reinterpret_cast<const bf16x8*>(Qw + d0 * 16);
    const int sr = tid >> 4, sc = (tid & 15) * 8, vst0 = v_st(sr, sc), vst1 = v_st(32 + sr, sc);
    const int vb0 = (int)(uintptr_t)V_lds + v_rd_base(lane);
    bf16x8 vs0, vs1, ks[NKC];
#define SLOAD(k0) do { vs0 = *reinterpret_cast<const bf16x8*>(&Vh[(size_t)((k0) + sr) * 128 + sc]); vs1 = *reinterpret_cast<const bf16x8*>(&Vh[(size_t)((k0) + 32 + sr) * 128 + sc]); \
    _Pragma("unroll") for (int _c = 0; _c < NKC; ++_c) { const int ch = tid + _c * 512, kr = ch / KC8, kc = ch - kr * KC8; ks[_c] = *reinterpret_cast<const bf16x8*>(&Kh[(size_t)((k0) + kr) * DQ + kc * 8]); } } while (0)
#define SWRITE(b) do { *(bf16x8*)(V_lds + (b) * SHM_V + vst0) = vs0; *(bf16x8*)(V_lds + (b) * SHM_V + vst1) = vs1; \
    _Pragma("unroll") for (int _c = 0; _c < NKC; ++_c) { const int ch = tid + _c * 512, kr = ch / KC8, kc = ch - kr * KC8; *(bf16x8*)(K_lds + (b) * SHM_K + kswz<DQ>(kr, kc * 16)) = ks[_c]; } } while (0)
    f32x16 p0, p1; float mn, al; bf16x8 pa0, pa1, pa2, pa3; const int NTL = seq / KVBLK;
    SLOAD(0); SWRITE(0); __syncthreads();
    for (int j = 0; j < NTL; ++j) {
        const int bsel = j & 1;
        if (j + 1 < NTL) SLOAD((j + 1) * KVBLK);
        FA_SBAR(); qkt<DQ>(p0, p1, K_lds + bsel * SHM_K, qr, r32, hi);
        partialSM<DQ>(p0, p1, m_reg, mn, al);
        if (__any(al < 1.f)) { if (hi == 0) al_l[r32] = al; asm volatile("s_waitcnt lgkmcnt(0)" ::: "memory");
#pragma unroll
            for (int d = 0; d < 4; ++d)
#pragma unroll
                for (int r = 0; r < 16; ++r) o[d][r] *= al_l[crow(r, hi)]; }
        finishSM(p0, p1, al, l_reg, pa0, pa1, pa2, pa3); FA_SBAR();
        pv_d0(o, vb0 + bsel * SHM_V, pa0, pa1, pa2, pa3);
        if (j + 1 < NTL) SWRITE(bsel ^ 1);
        __syncthreads();
    }
    if (hi == 0) li_l[r32] = l_reg; asm volatile("s_waitcnt lgkmcnt(0)" ::: "memory");
    float rli[16];
#pragma unroll
    for (int r = 0; r < 16; ++r) rli[r] = __builtin_amdgcn_rcpf(li_l[crow(r, hi)]);
    bf16_t* Ow = Ob + (size_t)(wid * QBLK) * LDO;
#pragma unroll
    for (int r = 0; r < 16; ++r) { const int orow = crow(r, hi);
#pragma unroll
        for (int d0 = 0; d0 < 4; ++d0) Ow[(size_t)orow * LDO + d0 * 32 + r32] = f2bf(o[d0][r] * rli[r]); }
    __syncthreads();
#undef SLOAD
#undef SWRITE
}
}

template <int DQ, int HKV, bool WITH_CTX>
DEV void attn_phase(const Args& a, int colbase, char* smem) {
    const bf16_t* Qb = (const bf16_t*)(a.ws + WS_QB); const bf16_t* Kb = (const bf16_t*)(a.ws + WS_KB); const bf16_t* Vb = (const bf16_t*)(a.ws + WS_VB);
    bf16_t* A2 = (bf16_t*)(a.ws + WS_A2);
    const int nunits = 256 + (WITH_CTX ? 32 : 0);
    for (int u = blockIdx.x; u < nunits; u += gridDim.x) {
        int b, hh, qb, nk;
        if (u < 256) { if (HKV == 8) { const int bh = u & 31; b = bh >> 3; hh = bh & 7; qb = 1 + (u >> 5); }
                       else { const int pr = u & 7, rest = u >> 3; b = pr >> 1; hh = (pr & 1) * 4 + (rest & 3); qb = 1 + (rest >> 2); }
                       nk = S; }
        else { const int bh = u - 256; b = bh >> 3; hh = bh & 7; qb = 0; nk = TC; }
        const int hk = hh / (8 / HKV);
        if constexpr (DQ == 192) fa::attn_body_simple<DQ>(Qb + (((size_t)b * 8 + hh) * S + qb * 256) * DQ, Kb + ((size_t)b * HKV + hk) * S * DQ, Vb + ((size_t)b * HKV + hk) * S * 128,
                          A2 + ((size_t)b * S + qb * 256) * D + colbase + hh * 128, D, nk, smem);
        else fa::attn_body<DQ>(Qb + (((size_t)b * 8 + hh) * S + qb * 256) * DQ, Kb + ((size_t)b * HKV + hk) * S * DQ, Vb + ((size_t)b * HKV + hk) * S * 128,
                          A2 + ((size_t)b * S + qb * 256) * D + colbase + hh * 128, D, nk, smem);
    }
}

template <int MODE>
DEV void mixout_phase(const Args& a, bool latent_only) {
    const int tid = tid_opaque(), w = tid >> 6, lane = tid & 63;
    constexpr int NH = MODE == 0 ? 8 : 4, DV = MODE == 0 ? 128 : 256, LDP = MODE == 0 ? AB_INP : CD_INP, GC = MODE == 0 ? 4096 : 3584, CB = MODE == 0 ? 0 : 1024, PER = DV / 64;
    const bf16_t* P = (const bf16_t*)(a.ws + WS_P); const float* odir = (const float*)(a.ws + WS_ODIR); bf16_t* A2 = (bf16_t*)(a.ws + WS_A2);
    const float* g = MODE == 0 ? a.in[12] : a.in[23];
    for (int it = blockIdx.x * 8 + w; it < R * NH; it += gridDim.x * 8) {
        const int r = it / NH, hd = it - r * NH; const int t = r % S; if (latent_only && t < TC) continue;
        float o[PER]; float ss = 0.f;
#pragma unroll
        for (int j = 0; j < PER; ++j) { const int c = hd * DV + j * 64 + lane; o[j] = odir[(size_t)r * 1024 + c] + odir[((size_t)R + r) * 1024 + c]; ss += o[j] * o[j]; }
        ss = wave_sum(ss); const float rs = rsqrtf(ss * (1.f / DV) + EPS);
#pragma unroll
        for (int j = 0; j < PER; ++j) { const int c = hd * DV + j * 64 + lane; const float gt = bf2f(P[(size_t)r * LDP + GC + c]);
            const float act = MODE == 0 ? sigmoidf_(gt) : siluf_(gt);
            A2[(size_t)r * D + CB + c] = f2bf(o[j] * rs * g[j * 64 + lane] * act); }
    }
}

#define GAS __attribute__((address_space(1)))
typedef GAS unsigned gu32; typedef GAS unsigned long long gu64;
#define RLX_AGENT __ATOMIC_RELAXED, __HIP_MEMORY_SCOPE_AGENT
struct EpiMoeUpSc1 { bf16_t* hid; int rowbase, nvalid;
    DEV void operator()(const f32x4 (&acc)[2][2][4][2], int brow, int bcol, int wr, int wc, int fr, int fq) const {
        const int hc = (bcol >> 1) + wc * 32 + fq * 4;
#pragma unroll
        for (int ai = 0; ai < 2; ++ai)
#pragma unroll
            for (int m = 0; m < 4; ++m) { const int lr = ai * HALF + wr * 64 + m * 16 + fr;
                if (lr < nvalid) { bf16_t* rowp = hid + (size_t)(rowbase + lr) * EDIM + hc;
#pragma unroll
                    for (int n = 0; n < 2; ++n) { const f32x4 a_ = acc[ai][0][m][n], b_ = acc[ai][1][m][n];
                        const unsigned lo = cvtpk(siluf_(a_[0]) * b_[0], siluf_(a_[1]) * b_[1]), hi = cvtpk(siluf_(a_[2]) * b_[2], siluf_(a_[3]) * b_[3]);
                        __hip_atomic_store((gu64*)(rowp + n * 16), (unsigned long long)lo | ((unsigned long long)hi << 32), RLX_AGENT); } } }
    } };
DEV void moe_phase_fused(const Args& a, int l, char* smem) {
    const int tid = tid_opaque();
    unsigned* ctl = (unsigned*)(a.ws + WS_CTL);
    unsigned* cnt = ctl + CW_CNT + l * 16 * CNT_STRIDE; unsigned* head = ctl + CW_MOEQ + l * 64; unsigned* ready = ctl + CW_RDY + l * (NE * 36 * 16);
    const int* list = (const int*)(a.ws + WS_LIST);
    const bf16_t* h = (const bf16_t*)(a.ws + WS_H); const bf16_t* w13 = moe_w13(a, l); const bf16_t* w2 = moe_w2(a, l);
    bf16_t* hid = (bf16_t*)(a.ws + WS_QB); bf16_t* y = (bf16_t*)(a.ws + WS_P);
    volatile int* tab = (volatile int*)(smem + SHM_GEMM);
    if (tid == 0) { int ub = 0, of = 0, nts[NE];
        for (int e = 0; e < NE; ++e) { const int n = (int)__hip_atomic_load((gu32*)(cnt + e * CNT_STRIDE), RLX_AGENT); nts[e] = (n + 255) >> 8; tab[e] = n; tab[16 + e] = ub; tab[50 + e] = of; ub += nts[e] * 4; of += n; }
        tab[32] = ub; int db = ub;
        for (int e = 0; e < NE; ++e) { tab[33 + e] = db; db += nts[e] * 8; }
        tab[49] = db; }
    for (;;) {
        __syncthreads();
        if (tid == 0) tab[66] = (int)__hip_atomic_fetch_add((gu32*)head, 1u, RLX_AGENT);
        __syncthreads();
        const int item = __builtin_amdgcn_readfirstlane(tab[66]), nup = __builtin_amdgcn_readfirstlane(tab[32]), ntot = __builtin_amdgcn_readfirstlane(tab[49]);
        if (item >= ntot) break;
        const bool up = item < nup; const int tb0 = up ? 16 : 33;
        int e = 0;
#pragma unroll 1
        for (int q = 1; q < NE; ++q) if (item >= __builtin_amdgcn_readfirstlane(tab[tb0 + q])) e = q;
        const int n = __builtin_amdgcn_readfirstlane(tab[e]), nt_ = (n + 255) >> 8, t = item - __builtin_amdgcn_readfirstlane(tab[tb0 + e]), off = __builtin_amdgcn_readfirstlane(tab[50 + e]);
        const int i = t % nt_, pn = t / nt_, nv = min(256, n - i * 256);
        gu32* flag = (gu32*)(ready + (e * 36 + i) * 16);
        if (up) {
            EpiMoeUpSc1 epi{hid, off + i * 256, nv};
            gemm_tile<true>(h, w13 + (size_t)e * 1024 * D, D, D, 0, pn * 256, list + (size_t)e * R + i * 256, nv, smem, epi);
            asm volatile("s_waitcnt vmcnt(0)" ::: "memory");
            __syncthreads();
            if (tid == 0) __hip_atomic_fetch_add(flag, 1u, RLX_AGENT);
        } else {
            if (tid < 64) { unsigned spins = 0;
                while ((unsigned)__builtin_amdgcn_readfirstlane(__hip_atomic_load(flag, RLX_AGENT)) < 4u) { __builtin_amdgcn_s_sleep(2); if (++spins > (1u << 22)) break; }
                __builtin_amdgcn_fence(__ATOMIC_ACQUIRE, "agent");
                asm volatile("s_waitcnt vmcnt(0)" ::: "memory"); }
            __syncthreads();
            EpiMoeDown epi{y, list + (size_t)e * R + i * 256, nv};
            gemm_tile<false>(hid, w2 + (size_t)e * D * EDIM, EDIM, EDIM, off + i * 256, pn * 256, nullptr, 0, smem, epi);
        }
    }
    __syncthreads();
}

DEV void moe_phase_up(const Args& a, int l, char* smem) {
    unsigned* cnt = (unsigned*)(a.ws + WS_CTL) + CW_CNT + l * 16 * CNT_STRIDE;
    const int* list = (const int*)(a.ws + WS_LIST);
    const bf16_t* h = (const bf16_t*)(a.ws + WS_H); const bf16_t* w13 = moe_w13(a, l); bf16_t* hid = (bf16_t*)(a.ws + WS_QB);
    int u = blockIdx.x, base = 0, off = 0;
    for (int e = 0; e < NE; ++e) { const int n = (int)__builtin_amdgcn_readfirstlane(__hip_atomic_load(cnt + e * CNT_STRIDE, __ATOMIC_RELAXED, __HIP_MEMORY_SCOPE_AGENT)), nt_ = (n + 255) >> 8, nu = nt_ * 4;
        for (; u < base + nu; u += gridDim.x) { const int t = u - base, i = t % nt_, pn = t / nt_; const int nv = min(256, n - i * 256);
            EpiMoeUp epi{hid, off + i * 256, nv};
            gemm_tile<true>(h, w13 + (size_t)e * 1024 * D, D, D, 0, pn * 256, list + (size_t)e * R + i * 256, nv, smem, epi); }
        base += nu; off += n; }
}
DEV void moe_phase_down(const Args& a, int l, char* smem) {
    unsigned* cnt = (unsigned*)(a.ws + WS_CTL) + CW_CNT + l * 16 * CNT_STRIDE;
    const int* list = (const int*)(a.ws + WS_LIST);
    const bf16_t* hid = (const bf16_t*)(a.ws + WS_QB); const bf16_t* w2 = moe_w2(a, l); bf16_t* y = (bf16_t*)(a.ws + WS_P);
    int u = blockIdx.x, base = 0, off = 0;
    for (int e = 0; e < NE; ++e) { const int n = (int)__builtin_amdgcn_readfirstlane(__hip_atomic_load(cnt + e * CNT_STRIDE, __ATOMIC_RELAXED, __HIP_MEMORY_SCOPE_AGENT)), nt_ = (n + 255) >> 8, nu = nt_ * 8;
        for (; u < base + nu; u += gridDim.x) { const int t = u - base, i = t % nt_, pn = t / nt_; const int nv = min(256, n - i * 256);
            EpiMoeDown epi{y, list + (size_t)e * R + i * 256, nv};
            gemm_tile<false>(hid, w2 + (size_t)e * D * EDIM, EDIM, EDIM, off + i * 256, pn * 256, nullptr, 0, smem, epi); }
        base += nu; off += n; }
}
template <bool FINAL>
DEV void combine_phase(const Args& a, int l, bool latent_only, bool dry = false) {
    const int tid = tid_opaque(), w = tid >> 6, lane = tid & 63;
    bf16_t* xres = (bf16_t*)(a.ws + WS_XRES); const bf16_t* y = (const bf16_t*)(a.ws + WS_P); const float* tokf = (const float*)(a.ws + WS_TOK);
    const float* modv = (const float*)(a.ws + WS_MODV) + (size_t)l * 5 * MODN; bf16_t* h = (bf16_t*)(a.ws + WS_H);
    const float* gain = FINAL ? a.in[8] : a.in[6] + (size_t)(l + 1) * D;
    const int stride = gridDim.x * 8;
#define CB_SKIP(rr) while ((rr) < R && latent_only && ((rr) % S) < TC) (rr) += stride
#define CB_LOAD(rr, Y0, Y1, XQ, W0, W1) do { const bf16_t* y0_ = y + (size_t)(2 * (rr)) * D; const bf16_t* xp_ = xres + (size_t)(rr) * D; W0 = tokf[(rr) * 4 + 2]; W1 = tokf[(rr) * 4 + 3]; \
        _Pragma("unroll") for (int j = 0; j < 8; ++j) { const int c = j * 256 + lane * 4; Y0[j] = *(const u32x2*)(y0_ + c); Y1[j] = *(const u32x2*)(y0_ + D + c); XQ[j] = *(const u32x2*)(xp_ + c); } } while (0)
    int r = blockIdx.x * 8 + w; CB_SKIP(r);
    u32x2 ny0[8], ny1[8], nxq[8]; float nw0 = 0.f, nw1 = 0.f;
    if (r < R) CB_LOAD(r, ny0, ny1, nxq, nw0, nw1);
    while (r < R) {
        u32x2 cy0[8], cy1[8], cxq[8]; const float w0 = nw0, w1 = nw1;
#pragma unroll
        for (int j = 0; j < 8; ++j) { cy0[j] = ny0[j]; cy1[j] = ny1[j]; cxq[j] = nxq[j]; }
        int rn = r + stride; CB_SKIP(rn);
        if (rn < R) CB_LOAD(rn, ny0, ny1, nxq, nw0, nw1);
        const int b = r / S, t = r - b * S; const int v = t < TC ? 4 : b;
        const float* g2 = modv + (size_t)v * MODN + 5 * D; bf16_t* xp = xres + (size_t)r * D;
        f32x4 x[8]; float ss = 0.f;
#pragma unroll
        for (int j = 0; j < 8; ++j) { const int c = j * 256 + lane * 4;
            const u32x2 a0 = cy0[j], a1 = cy1[j], xq = cxq[j];
            const f32x4 yy = {w0 * bflo(a0.x) + w1 * bflo(a1.x), w0 * bfhi(a0.x) + w1 * bfhi(a1.x), w0 * bflo(a0.y) + w1 * bflo(a1.y), w0 * bfhi(a0.y) + w1 * bfhi(a1.y)};
            x[j] = (f32x4){bflo(xq.x), bfhi(xq.x), bflo(xq.y), bfhi(xq.y)} + *(const f32x4*)(g2 + c) * yy;
            if (!FINAL && !dry) { u32x2 xw; xw.x = cvtpk(x[j][0], x[j][1]); xw.y = cvtpk(x[j][2], x[j][3]); *(u32x2*)(xp + c) = xw; }
            ss += x[j][0] * x[j][0] + x[j][1] * x[j][1] + x[j][2] * x[j][2] + x[j][3] * x[j][3]; }
        ss = wave_sum(ss); const float rs = rsqrtf(ss * (1.f / D) + EPS);
        if (FINAL) { float* op = a.out + ((size_t)b * TL + (t - TC)) * D;
#pragma unroll
            for (int j = 0; j < 8; ++j) { const int c = j * 256 + lane * 4; *(f32x4*)(op + c) = x[j] * rs * *(const f32x4*)(gain + c); } }
        else { const float* sh = modv + 5 * MODN + (size_t)v * MODN; const float* sc = sh + D;
#pragma unroll
            for (int j = 0; j < 8; ++j) { const int c = j * 256 + lane * 4;
                const f32x4 yv = (x[j] * rs * *(const f32x4*)(gain + c)) * (1.f + *(const f32x4*)(sc + c)) + *(const f32x4*)(sh + c);
                u32x2 pk; pk.x = cvtpk(yv[0], yv[1]); pk.y = cvtpk(yv[2], yv[3]); if (!dry) *(u32x2*)(h + (size_t)r * D + c) = pk; } }
        r = rn;
    }
#undef CB_LOAD
#undef CB_SKIP
}

constexpr int LDS_BYTES = LDS_BYTES_C;
constexpr int NPHASES = 25;
__global__ void __launch_bounds__(NT, 2) fwd(Args a) {
    extern __shared__ __attribute__((aligned(16))) char smem[];
    unsigned char* ws = a.ws;
    const int lo = a.ph_lo, hi = a.ph_hi;
    volatile LAS unsigned* xbw = (volatile LAS unsigned*)(smem + LDS_BYTES - 16);
    if (threadIdx.x < 4) xbw[threadIdx.x] = 0u;
    __syncthreads();
    XcdBarrier bar; bar.bar = (unsigned*)(ws + WS_CTL); bar.x = 0; bar.st = xbw;
    if (hi - lo > 1) bar = xcd_barrier_post((unsigned*)(ws + WS_CTL), xbw);
#ifndef BARRIER_REP
#define BARRIER_REP 1
#endif
#ifndef TPROBE_MASK
#define TPROBE_MASK 0u
#endif
#ifndef TPROBE_ALPHA
#define TPROBE_ALPHA 4
#endif
    unsigned long long tp_prev = TPROBE_MASK ? __builtin_amdgcn_s_memrealtime() : 0ull, tp_acc = 0ull;
#define TPROBE(k) do { if (TPROBE_MASK) { const unsigned long long tn_ = __builtin_amdgcn_s_memrealtime(); if ((TPROBE_MASK >> (k)) & 1u) tp_acc += tn_ - tp_prev; tp_prev = tn_; } } while (0)
#ifndef WPROBE_MASK
#define WPROBE_MASK 0u
#endif
    unsigned long long wp_acc = 0ull;
#define SEAM(k) do { if (IN(k) && IN((k) + 1)) { const unsigned long long wa_ = WPROBE_MASK ? __builtin_amdgcn_s_memrealtime() : 0ull; for (int br_ = 0; br_ < BARRIER_REP; ++br_) xcd_barrier(bar); \
        if (WPROBE_MASK && ((WPROBE_MASK >> (k)) & 1u)) wp_acc += __builtin_amdgcn_s_memrealtime() - wa_; TPROBE(k); } } while (0)
#ifndef PHASE_MASK
#define PHASE_MASK 0xFFFFFFFFu
#endif
#define IN(k) (((PHASE_MASK >> (k)) & 1u) && lo <= (k) && (k) < hi)
#ifndef REPEAT_MASK
#define REPEAT_MASK 0u
#endif
#ifndef SUBREP
#define SUBREP 0
#endif
#define PHASE(k) if (IN(k)) for (int rep_ = 0; rep_ < ((((REPEAT_MASK) >> (k)) & 1u) ? 2 : 1); ++rep_, ((((REPEAT_MASK) >> (k)) & 1u) ? __syncthreads() : (void)0))
    const float* modv = (const float*)(ws + WS_MODV);
    bf16_t* H = (bf16_t*)(ws + WS_H); bf16_t* P = (bf16_t*)(ws + WS_P); bf16_t* A2 = (bf16_t*)(ws + WS_A2); bf16_t* XR = (bf16_t*)(ws + WS_XRES);
    PHASE(0) {
        cvt_weight(a.in[9], (bf16_t*)(ws + WS_WABIN), D, AB_IN, AB_INP, 1, 0, 0, 128, 0, nullptr, smem, 2);
        mod_phase<false>(a, 0, smem);
        misc_phase(a);
    }
    SEAM(0);
    PHASE(1) norm_phase<false, true>(a, 0, 0, a.in[6], false, smem);
    SEAM(1);
    PHASE(2) { int cur = 0; EpiInAB e{P, (float*)(ws + WS_SSQ), (bf16_t*)(ws + WS_KB), (const float2*)(ws + WS_TABB), smem};
#ifdef SEAM_PROBE
                 gemm_phase(H, (const bf16_t*)(ws + WS_WABIN), R, AB_INP, D, smem, e, cur, 0, 512); xcd_barrier(bar); cur = 0; gemm_phase(H, (const bf16_t*)(ws + WS_WABIN), R, AB_INP, D, smem, e, cur, 512, 864);
#else
                 gemm_phase(H, (const bf16_t*)(ws + WS_WABIN), R, AB_INP, D, smem, e, cur);
#endif
                 if (rep_ == 0) { cvt_cd_dynamic(a, smem); mod_phase<true>(a, 1, smem); } }
    SEAM(2);
    PHASE(3) { int cur = 0; EpiUQ e1{(bf16_t*)(ws + WS_QB), (const float*)(ws + WS_SSQ), (const float2*)(ws + WS_TABB)};
                 gemm_phase<false, AB_INP>(P + 5120, (const bf16_t*)(ws + WS_WUQ), R, 1536, 512, smem, e1, cur);
                 EpiUKV e2{(bf16_t*)(ws + WS_KB), (bf16_t*)(ws + WS_VB), (const float*)(ws + WS_SSQ)};
                 gemm_phase<false, AB_INP>(P + 5632, (const bf16_t*)(ws + WS_WUKV), R, 2048, 256, smem, e2, cur);
                 scan_prep_phase<0>(a, smem); if (SUBREP & 1) scan_prep_phase<0>(a, smem); }
    SEAM(3);
    PHASE(6) scan_seq_phase<0>(a, smem);
    PHASE(7) attn_phase<192, 8, true>(a, 1024, smem);
    SEAM(7);
    PHASE(8) { mixout_phase<0>(a, false); if (SUBREP & 2) mixout_phase<0>(a, false); }
    SEAM(8);
    PHASE(9) { int cur = 0; EpiResidGate e{XR, modv + 2 * D, rep_ > 0, rep_ > 0 ? nullptr : a.in[0], a.in[2]}; gemm_phase(A2, (const bf16_t*)(ws + WS_WABOUT), R, D, D, smem, e, cur); cvt_moe_dynamic(a, 0, smem); }
    SEAM(9);
    PHASE(10) norm_phase<true>(a, 0, 3, a.in[7], false, smem, rep_ > 0);
    SEAM(10);
#ifndef MOE_SPLIT
    PHASE(11) { moe_phase_fused(a, 0, smem); cvt_moe_dynamic(a, 1, smem); }
    SEAM(11);
#else
    PHASE(11) { moe_phase_up(a, 0, smem); cvt_moe_dynamic(a, 1, smem); }
    SEAM(11);
    PHASE(12) { moe_phase_down(a, 0, smem); cvt_moe_dynamic(a, 1, smem); }
    SEAM(12);
#endif
    PHASE(13) { combine_phase<false>(a, 0, false, rep_ > 0); cvt_moe_dynamic(a, 1, smem); }
    SEAM(13);
    PHASE(15) { int cur = 0; EpiInCD e{P, (bf16_t*)(ws + WS_QB), (bf16_t*)(ws + WS_KB), (bf16_t*)(ws + WS_VB), (const float2*)(ws + WS_TABC), a.in[19], a.in[20], smem}; gemm_phase(H, (const bf16_t*)(ws + WS_WCDIN), R, CD_INP, D, smem, e, cur); }
    SEAM(15);
    PHASE(16) { scan_prep_phase<1>(a, smem); if (SUBREP & 1) scan_prep_phase<1>(a, smem); }
    SEAM(16);
    PHASE(17) scan_seq_phase<1>(a, smem);
    PHASE(18) attn_phase<128, 2, false>(a, 0, smem);
    SEAM(18);
    PHASE(19) { mixout_phase<1>(a, true); if (SUBREP & 2) mixout_phase<1>(a, true); }
    SEAM(19);
    PHASE(20) { int cur = 0; EpiResidGate e{XR, modv + 5 * MODN + 2 * D, rep_ > 0, nullptr, nullptr}; gemm_phase<true>(A2, (const bf16_t*)(ws + WS_WCDOUT), NB * TL, D, D, smem, e, cur); }
    SEAM(20);
    PHASE(21) norm_phase<true>(a, 1, 3, a.in[7] + D, true, smem, rep_ > 0);
    SEAM(21);
#ifndef MOE_SPLIT
    PHASE(22) moe_phase_fused(a, 1, smem);
    SEAM(22);
#else
    PHASE(22) moe_phase_up(a, 1, smem);
    SEAM(22);
    PHASE(23) moe_phase_down(a, 1, smem);
    SEAM(23);
#endif
    PHASE(24) combine_phase<true>(a, 1, true);
    if (TPROBE_MASK) { TPROBE(24);
        if (blockIdx.x == 0) { const unsigned long long t0_ = __builtin_amdgcn_s_memrealtime(); while (__builtin_amdgcn_s_memrealtime() - t0_ < (unsigned long long)TPROBE_ALPHA * tp_acc) __builtin_amdgcn_s_sleep(8); } }
    if (WPROBE_MASK) { unsigned* wsum = (unsigned*)(ws + WS_CTL) + 30000;
        if (threadIdx.x == 0) atomicAdd(wsum, (unsigned)wp_acc);
        xcd_barrier(bar);
        if (blockIdx.x == 0) { const unsigned long long tot_ = __hip_atomic_load(wsum, __ATOMIC_RELAXED, __HIP_MEMORY_SCOPE_AGENT) / gridDim.x;
            const unsigned long long t0_ = __builtin_amdgcn_s_memrealtime(); while (__builtin_amdgcn_s_memrealtime() - t0_ < (unsigned long long)TPROBE_ALPHA * tot_) __builtin_amdgcn_s_sleep(8); } }
#undef IN
#undef PHASE
#undef SEAM
}

extern "C" void kernel_launch(void* const* d_in, const int* in_sizes, int n_in, void* d_out, int out_size, void* d_ws, size_t ws_size, hipStream_t stream) {
    static int grid = 0;
    if (grid == 0) {
        if (n_in != 29 || out_size != NB * TL * D || ws_size < WS_END) { fprintf(stderr, "kernel_launch: shape/workspace mismatch: n_in %d out %d ws %zu (need %zu)\n", n_in, out_size, ws_size, (size_t)WS_END); grid = -1; return; }
        int dev = 0, cus = 0;
        if (hipGetDevice(&dev) != hipSuccess || hipDeviceGetAttribute(&cus, hipDeviceAttributeMultiprocessorCount, dev) != hipSuccess) { grid = -1; return; }
        if (hipFuncSetAttribute((const void*)fwd, hipFuncAttributeMaxDynamicSharedMemorySize, LDS_BYTES) != hipSuccess) { fprintf(stderr, "kernel_launch: hipFuncSetAttribute failed\n"); grid = -1; return; }
        grid = cus > 0 ? cus : 256;
    }
    if (grid < 0) return;
    (void)hipMemsetAsync((char*)d_ws + WS_CTL, 0, CTL_BYTES, stream);
    Args a{};
    for (int i = 0; i < 29; ++i) a.in[i] = (const float*)d_in[i];
    a.out = (float*)d_out; a.ws = (unsigned char*)d_ws;
#ifndef MK_PER_PHASE
    a.ph_lo = 0; a.ph_hi = NPHASES; hipLaunchKernelGGL(fwd, dim3(grid), dim3(NT), LDS_BYTES, stream, a);
#else
    for (int ph = 0; ph < NPHASES; ++ph) { a.ph_lo = ph; a.ph_hi = ph + 1; hipLaunchKernelGGL(fwd, dim3(grid), dim3(NT), LDS_BYTES, stream, a); }
#endif
}
```

```cpp
#include <hip/hip_runtime.h>
#include <cstdio>
#include <cstdint>

#define DEV __device__ __forceinline__
typedef unsigned short bf16_t;
typedef short bf16x8 __attribute__((ext_vector_type(8)));
typedef float f32x4 __attribute__((ext_vector_type(4)));
typedef float f32x2 __attribute__((ext_vector_type(2)));
typedef unsigned u32x4 __attribute__((ext_vector_type(4)));
typedef unsigned u32x2 __attribute__((ext_vector_type(2)));

constexpr int NB = 4, TL = 2048, TC = 256, S = TL + TC, R = NB * S, D = 2048;
constexpr int NT = 512;
constexpr float EPS = 1e-6f;
constexpr int AB_IN = 5952, AB_INP = 6144, CD_IN = 4640, CD_INP = 4864;
constexpr int NE = 16, EDIM = 512;
constexpr int MODN = 6 * D;

constexpr size_t al256(size_t x) { return (x + 255) & ~(size_t)255; }
constexpr size_t WS_CTL = 0;
constexpr int    CW_CNT = 26624;
constexpr int    CNT_STRIDE = 64;
constexpr int    CW_CVT = 4224;
constexpr size_t CTL_BYTES = 131072;
constexpr int    CW_MOEQ = 4608;
constexpr int    CW_RDY = 8192;
constexpr size_t WS_MODV = WS_CTL + CTL_BYTES;
constexpr size_t WS_LB   = al256(WS_MODV + (size_t)2 * 5 * MODN * 4);
constexpr size_t WS_TABB = al256(WS_LB + 2 * 1024 * 4);
constexpr size_t WS_TABC = al256(WS_TABB + (size_t)S * 32 * 8);
constexpr size_t WS_TOK  = al256(WS_TABC + (size_t)S * 64 * 8);
constexpr size_t WS_LIST = al256(WS_TOK + (size_t)R * 16);
constexpr size_t WS_WABIN = al256(WS_LIST + (size_t)NE * R * 4);
constexpr size_t WS_WABOUT = al256(WS_WABIN + (size_t)AB_INP * D * 2);
constexpr size_t WS_WUQ  = al256(WS_WABOUT + (size_t)D * D * 2);
constexpr size_t WS_WUKV = al256(WS_WUQ + (size_t)1536 * 512 * 2);
constexpr size_t WS_WCDIN = al256(WS_WUKV + (size_t)2048 * 256 * 2);
constexpr size_t WS_WCDOUT = al256(WS_WCDIN + (size_t)CD_INP * D * 2);
constexpr size_t WS_W13  = al256(WS_WCDOUT + (size_t)D * D * 2);
constexpr size_t WS_W2   = al256(WS_W13 + (size_t)NE * 1024 * D * 2);
constexpr size_t WS_XRES = al256(WS_W2 + (size_t)NE * D * EDIM * 2);
constexpr size_t WS_H    = al256(WS_XRES + (size_t)R * D * 2);
constexpr size_t WS_P    = al256(WS_H + (size_t)R * D * 2);
constexpr size_t WS_ODIR = al256(WS_P + (size_t)R * AB_INP * 2);
constexpr size_t WS_QF   = WS_ODIR;
constexpr size_t WS_KVF  = al256(WS_QF + (size_t)R * 1536 * 2);
static_assert(WS_KVF + (size_t)R * 2048 * 2 <= WS_ODIR + (size_t)2 * R * 1024 * 4, "QF/KVF alias ODIR");
constexpr size_t WS_A2   = al256(WS_ODIR + (size_t)2 * R * 1024 * 4);
constexpr size_t WS_QB   = al256(WS_A2 + (size_t)R * D * 2);
constexpr size_t WS_KB   = al256(WS_QB + (size_t)NB * 8 * S * 192 * 2);
constexpr size_t WS_VB   = al256(WS_KB + (size_t)NB * 8 * S * 192 * 2);
constexpr size_t WS_SSQ  = al256(WS_VB + (size_t)NB * 8 * S * 128 * 2);
constexpr size_t WS_P5N_UNUSED = al256(WS_VB + (size_t)NB * 8 * S * 128 * 2);
constexpr size_t WS_P6N  = al256(WS_SSQ + (size_t)R * 16);
constexpr size_t WS_SVT  = WS_P6N;
constexpr size_t WS_SREC = al256(WS_SVT + (size_t)NB * 8 * 2 * 36 * 128 * 144);
constexpr int LDS_BYTES_C = 160 * 1024;
constexpr int PA = 144, PQ = 272;
constexpr int REC_A = 0, REC_QH = 64 * PA, REC_KHT = REC_QH + 64 * PQ, REC_AL = REC_KHT + 128 * PA, REC_BYTES = REC_AL + 512;
constexpr size_t WS_END  = al256(WS_SREC + (size_t)NB * 8 * 2 * 36 * REC_BYTES);
constexpr size_t WS_SVT1 = WS_W13;
constexpr size_t WS_SREC1 = al256(WS_SVT1 + (size_t)NB * 4 * 2 * 36 * 256 * 144);
static_assert(WS_SREC1 + (size_t)NB * 4 * 2 * 36 * REC_BYTES <= WS_XRES, "layer-1 scan images alias");
static_assert(WS_SVT + (size_t)NE * 1024 * D * 2 + (size_t)NE * D * EDIM * 2 <= WS_END, "layer-1 MoE weights alias");
static_assert((size_t)(2 * R + 256) * 512 * 2 <= WS_KB - WS_QB, "HIDDEN alias");
static_assert((size_t)R * 2 * D * 2 <= WS_ODIR - WS_P, "YSLOTS alias");

struct Args { const float* in[29]; float* out; unsigned char* ws; int ph_lo, ph_hi; };

typedef __bf16 bf16v2_t __attribute__((ext_vector_type(2)));
DEV unsigned cvtpk(float lo, float hi) { bf16v2_t v; v.x = (__bf16)lo; v.y = (__bf16)hi; return __builtin_bit_cast(unsigned, v); }
DEV bf16_t f2bf(float x) { return (bf16_t)(cvtpk(x, 0.f) & 0xffffu); }
DEV float bf2f(bf16_t x) { return __uint_as_float(((unsigned)x) << 16); }
DEV float bflo(unsigned w) { return __uint_as_float(w << 16); }
DEV float bfhi(unsigned w) { return __uint_as_float(w & 0xffff0000u); }
DEV float sigmoidf_(float x) { return 1.f / (1.f + __expf(-x)); }
DEV float siluf_(float x) { return x / (1.f + __expf(-x)); }
DEV float wave_sum(float v) {
#pragma unroll
    for (int o = 32; o >= 1; o >>= 1) v += __shfl_xor(v, o);
    return v;
}
DEV float wave_max(float v) {
#pragma unroll
    for (int o = 32; o >= 1; o >>= 1) v = fmaxf(v, __shfl_xor(v, o));
    return v;
}
DEV int tid_opaque() { int t = threadIdx.x; asm volatile("" : "+v"(t)); return t; }
DEV int modvec_of_row(int r) { const int b = r / S, t = r - b * S; return t < TC ? 4 : b; }

#define XB_TMO      128
#define XB_XCNT(j)  (256  + 64 * (j))
#define XB_XSUB(j)  (1280 + 64 * (j))
#define XB_XGEN(j)  (2304 + 64 * (j))
#define XB_TOP      3328
#define XB_TOPGEN   3392
#define XCD_BAR_WORDS 3456
#define XB_SPIN_CAP (1u << 18)
#define LAS __attribute__((address_space(3)))

__device__ __forceinline__ unsigned xb_ld(unsigned* p)              { return __hip_atomic_load(p, __ATOMIC_RELAXED, __HIP_MEMORY_SCOPE_AGENT); }
__device__ __forceinline__ unsigned xb_add(unsigned* p, unsigned v) { return __hip_atomic_fetch_add(p, v, __ATOMIC_RELAXED, __HIP_MEMORY_SCOPE_AGENT); }
__device__ __forceinline__ unsigned xb_xcc_id() { return (unsigned)__builtin_amdgcn_s_getreg((3 << 11) | 20) & 0xFu; }
#define XB_SPIN(cond, bar) do { unsigned _sp = 0; while (cond) { __builtin_amdgcn_s_sleep(1); \
    if ((++_sp & 255u) == 0u) { if (xb_ld(&(bar)[XB_TMO])) break; if (_sp > XB_SPIN_CAP) { atomicAdd(&(bar)[XB_TMO], 1u); break; } } } } while (0)

struct XcdBarrier {
    unsigned* bar; unsigned x;
    volatile LAS unsigned* st;
};

__device__ __forceinline__ XcdBarrier xcd_barrier_post(unsigned* bar, volatile LAS unsigned* st) {
    XcdBarrier b; b.bar = bar; b.x = xb_xcc_id(); b.st = st;
    if (threadIdx.x == 0) (void)xb_add(&bar[XB_XCNT(b.x)], 1u);
    return b;
}
__device__ __forceinline__ void xcd_barrier_complete(unsigned* bar, unsigned x, unsigned& nloc, unsigned& nx) {
    const unsigned G = gridDim.x * gridDim.y * gridDim.z;
    unsigned sum, cnt, mine, sp = 0u;
    for (;;) {
        sum = 0u; cnt = 0u; mine = 0u;
#pragma unroll
        for (unsigned j = 0; j < 16; ++j) { const unsigned c = xb_ld(&bar[XB_XCNT(j)]); sum += c; cnt += (c > 0u) ? 1u : 0u; mine = (j == x) ? c : mine; }
        if (sum == G) break;
        __builtin_amdgcn_s_sleep(1);
        if ((++sp & 255u) == 0u) { if (xb_ld(&bar[XB_TMO])) break; if (sp > XB_SPIN_CAP) { atomicAdd(&bar[XB_TMO], 1u); break; } }
    }
    nloc = mine > 0u ? mine : 1u; nx = cnt > 0u ? cnt : 1u;
}

__device__ __forceinline__ void xcd_barrier(const XcdBarrier& b) {
    asm volatile("s_waitcnt vmcnt(0)" ::: "memory");
    __syncthreads();
    if (threadIdx.x == 0) {
        unsigned* bar = b.bar;
        __builtin_amdgcn_s_waitcnt(0);
        unsigned nloc = b.st[0], nx = b.st[1];
        if (nloc == 0u) { xcd_barrier_complete(bar, b.x, nloc, nx); b.st[0] = nloc; b.st[1] = nx; }
        const unsigned old = xb_add(&bar[XB_XSUB(b.x)], 1u);
        const unsigned gen = old / nloc;
        if (old + 1u == (gen + 1u) * nloc) {
            __builtin_amdgcn_fence(__ATOMIC_RELEASE, "agent");
            asm volatile("s_waitcnt vmcnt(0)" ::: "memory");
            const unsigned og = xb_add(&bar[XB_TOP], 1u);
            const unsigned tg = og / nx;
            if (og + 1u == (tg + 1u) * nx) xb_add(&bar[XB_TOPGEN], 1u);
            else XB_SPIN(xb_ld(&bar[XB_TOPGEN]) == tg, bar);
            __builtin_amdgcn_fence(__ATOMIC_ACQUIRE, "agent");
            xb_add(&bar[XB_XGEN(b.x)], 1u);
            asm volatile("s_waitcnt vmcnt(0)" ::: "memory");
        } else {
            XB_SPIN(xb_ld(&bar[XB_XGEN(b.x)]) == gen, bar);
            __builtin_amdgcn_fence(__ATOMIC_ACQUIRE, "agent");
            asm volatile("s_waitcnt vmcnt(0)" ::: "memory");
        }
    }
    __syncthreads();
}


constexpr int BM = 256, BK = 64, HALF = 128, HT = HALF * BK, SHM_GEMM = 8 * HT * 2;
DEV int lds_byte(int r, int c) { int st = (r >> 4) * 2 + (c >> 5), rr = r & 15, cc = c & 31, ob = rr * 64 + cc * 2; return st * 1024 + (ob ^ (((ob >> 9) & 1) << 5)); }
DEV void stage_rc(int b, int& Rr, int& Cc) { int st = b / 1024, sb = b % 1024, swz = sb ^ (((sb >> 9) & 1) << 5); Rr = (st >> 1) * 16 + swz / 64; Cc = (st & 1) * 32 + (swz % 64) / 2; }

template <bool GATHER, int LDA_ = 0, class Epi>
DEV void gemm_tile(const bf16_t* __restrict__ A, const bf16_t* __restrict__ Bt, int ld, int K, int brow, int bcol,
                   const int* __restrict__ rowmap, int nvalid, char* smem, const Epi& epi) {
    bf16_t* shm = (bf16_t*)smem;
#define SA(b, h) (shm + ((b) * 2 + (h)) * HT)
#define SB(b, h) (shm + (4 + (b) * 2 + (h)) * HT)
#define GLDS(gp, lp) __builtin_amdgcn_global_load_lds((const unsigned*)(gp), (unsigned*)(lp), 16, 0, 0)
#define STAGE_A(P, h, kt) do { _Pragma("unroll") for (int _i = 0; _i < 2; ++_i) { \
        const char* _sb = GATHER ? (const char*)A + (size_t)(kt) * (BK * 2) : (const char*)A + ((size_t)(brow + (h) * HALF + _i * 64) * (LDA_ ? LDA_ : ld) + (size_t)(kt) * BK) * 2; \
        GLDS(_sb + (GATHER ? voffa[h][_i] : voffA), (char*)(P) + tid16 + _i * 8192); } } while (0)
#define STAGE_B(P, h, kt) do { _Pragma("unroll") for (int _i = 0; _i < 2; ++_i) { \
        const char* _sb = (const char*)Bt + ((size_t)(bcol + (h) * HALF + _i * 64) * ld + (size_t)(kt) * BK) * 2; \
        GLDS(_sb + voff, (char*)(P) + tid16 + _i * 8192); } } while (0)
#define LDA(dst, b, h) _Pragma("unroll") for (int m = 0; m < 4; ++m) _Pragma("unroll") for (int k = 0; k < 2; ++k) \
        dst[m][k] = *reinterpret_cast<const bf16x8*>((char*)SA(b, h) + lds_byte(wr * 64 + m * 16 + fr, k * 32 + fq * 8))
#define LDB(dst, b, h) _Pragma("unroll") for (int n = 0; n < 2; ++n) _Pragma("unroll") for (int k = 0; k < 2; ++k) \
        dst[n][k] = *reinterpret_cast<const bf16x8*>((char*)SB(b, h) + lds_byte(wc * 32 + n * 16 + fr, k * 32 + fq * 8))
#define MMA(ai, bj, At_, Bt_) do { __builtin_amdgcn_s_setprio(1); \
        _Pragma("unroll") for (int m = 0; m < 4; ++m) _Pragma("unroll") for (int n = 0; n < 2; ++n) _Pragma("unroll") for (int k = 0; k < 2; ++k) \
            acc[ai][bj][m][n] = __builtin_amdgcn_mfma_f32_16x16x32_bf16(Bt_[n][k], At_[m][k], acc[ai][bj][m][n], 0, 0, 0); \
        __builtin_amdgcn_s_setprio(0); } while (0)
#define WAIT_V(n) asm volatile("s_waitcnt vmcnt(" #n ")" ::: "memory")
#define WAIT_L(n) asm volatile("s_waitcnt lgkmcnt(" #n ")" ::: "memory")
#define BAR __builtin_amdgcn_s_barrier()
#define SCHED __builtin_amdgcn_sched_barrier(0)
    int tid = threadIdx.x; asm volatile("" : "+v"(tid));
    int wid = tid >> 6, lane = tid & 63, wr = wid >> 2, wc = wid & 3, fr = lane & 15, fq = lane >> 4;
    const int tid16 = tid * 16;
    unsigned voff, voffA; unsigned voffa[2][2];
    {
        int r0, c0; stage_rc(tid16, r0, c0);
        voff = (unsigned)(r0 * ld + c0) * 2u; voffA = LDA_ ? (unsigned)(r0 * LDA_ + c0) * 2u : voff;
#pragma unroll
        for (int h = 0; h < 2; ++h)
#pragma unroll
            for (int i = 0; i < 2; ++i) {
                if (GATHER) { int l0 = h * HALF + i * 64 + r0; l0 = l0 < nvalid ? l0 : nvalid - 1; voffa[h][i] = (unsigned)((rowmap[l0] >> 1) * ld + c0) * 2u; }
                else voffa[h][i] = 0u;
            }
    }
    f32x4 acc[2][2][4][2] = {};
    bf16x8 At[4][2], B0[2][2], B1[2][2];
    const int nt = K / BK;
    STAGE_B(SB(0, 0), 0, 0); STAGE_A(SA(0, 0), 0, 0);
    STAGE_B(SB(0, 1), 1, 0); STAGE_A(SA(0, 1), 1, 0);
    if (wr == 1) BAR;
    WAIT_V(4); BAR;
    STAGE_B(SB(1, 0), 0, 1); STAGE_A(SA(1, 0), 0, 1); STAGE_B(SB(1, 1), 1, 1);
    WAIT_V(6); BAR;
    for (int t = 0; t < nt - 2; t += 2) {
        LDB(B0, 0, 0); SCHED; LDA(At, 0, 0); STAGE_A(SA(1, 1), 1, t + 1);
        WAIT_L(8); BAR; WAIT_L(0); MMA(0, 0, At, B0); BAR; SCHED;
        LDB(B1, 0, 1); STAGE_B(SB(0, 0), 0, t + 2);
        BAR; WAIT_L(0); MMA(0, 1, At, B1); BAR;
        LDA(At, 0, 1); STAGE_A(SA(0, 0), 0, t + 2);
        BAR; WAIT_L(0); MMA(1, 0, At, B0); BAR; SCHED;
        STAGE_B(SB(0, 1), 1, t + 2);
        WAIT_V(6); BAR; MMA(1, 1, At, B1); BAR;
        LDB(B0, 1, 0); SCHED; LDA(At, 1, 0); STAGE_A(SA(0, 1), 1, t + 2);
        WAIT_L(8); BAR; WAIT_L(0); MMA(0, 0, At, B0); BAR; SCHED;
        LDB(B1, 1, 1); STAGE_B(SB(1, 0), 0, t + 3);
        BAR; WAIT_L(0); MMA(0, 1, At, B1); BAR;
        LDA(At, 1, 1); STAGE_A(SA(1, 0), 0, t + 3);
        BAR; WAIT_L(0); MMA(1, 0, At, B0); BAR; SCHED;
        STAGE_B(SB(1, 1), 1, t + 3);
        WAIT_V(6); BAR; MMA(1, 1, At, B1); BAR;
    }
    { LDB(B0, 0, 0); WAIT_V(0); LDA(At, 0, 0); STAGE_A(SA(1, 1), 1, nt - 1);
      BAR; WAIT_L(0); MMA(0, 0, At, B0); BAR;
      LDB(B1, 0, 1); BAR; WAIT_L(0); MMA(0, 1, At, B1); BAR;
      LDA(At, 0, 1); WAIT_V(4); BAR; WAIT_L(0); MMA(1, 0, At, B0); MMA(1, 1, At, B1); BAR; }
    { LDB(B0, 1, 0); LDA(At, 1, 0); WAIT_V(2); BAR; WAIT_L(0); MMA(0, 0, At, B0); BAR;
      LDB(B1, 1, 1); WAIT_V(0); BAR; WAIT_L(0); MMA(0, 1, At, B1); BAR;
      LDA(At, 1, 1); BAR; WAIT_L(0); MMA(1, 0, At, B0); MMA(1, 1, At, B1); BAR; }
    if (wr == 0) BAR;
    int tz = threadIdx.x; asm volatile("" : "+v"(tz)); wid = tz >> 6; lane = tz & 63; wr = wid >> 2; wc = wid & 3; fr = lane & 15; fq = lane >> 4;
    epi(acc, brow, bcol, wr, wc, fr, fq);
#undef SA
#undef SB
#undef STAGE_A
#undef STAGE_B
#undef GLDS
#undef LDA
#undef LDB
#undef MMA
}

struct EpiStoreF32 { float* C; int ldc;
    DEV void operator()(const f32x4 (&acc)[2][2][4][2], int brow, int bcol, int wr, int wc, int fr, int fq) const {
#pragma unroll
        for (int ai = 0; ai < 2; ++ai)
#pragma unroll
            for (int m = 0; m < 4; ++m) { float* rowp = C + (size_t)(brow + ai * HALF + wr * 64 + m * 16 + fr) * ldc + bcol + wc * 32 + fq * 4;
#pragma unroll
                for (int bj = 0; bj < 2; ++bj)
#pragma unroll
                    for (int n = 0; n < 2; ++n) *(f32x4*)(rowp + bj * HALF + n * 16) = acc[ai][bj][m][n]; }
    } };
struct EpiStoreBf16 { bf16_t* C; int ldc;
    DEV void operator()(const f32x4 (&acc)[2][2][4][2], int brow, int bcol, int wr, int wc, int fr, int fq) const {
#pragma unroll
        for (int ai = 0; ai < 2; ++ai)
#pragma unroll
            for (int m = 0; m < 4; ++m) { bf16_t* rowp = C + (size_t)(brow + ai * HALF + wr * 64 + m * 16 + fr) * ldc + bcol + wc * 32 + fq * 4;
#pragma unroll
                for (int bj = 0; bj < 2; ++bj)
#pragma unroll
                    for (int n = 0; n < 2; ++n) { const f32x4 v = acc[ai][bj][m][n]; u32x2 w; w.x = cvtpk(v[0], v[1]); w.y = cvtpk(v[2], v[3]); *(u32x2*)(rowp + bj * HALF + n * 16) = w; } }
    } };
struct EpiResidGate { bf16_t* X; const float* gate; bool dry; const float* xin; const float* cin;
    DEV void operator()(const f32x4 (&acc)[2][2][4][2], int brow, int bcol, int wr, int wc, int fr, int fq) const {
        const float* g = gate + (size_t)modvec_of_row(brow) * MODN + bcol + wc * 32 + fq * 4;
        f32x4 gv[2][2];
#pragma unroll
        for (int bj = 0; bj < 2; ++bj)
#pragma unroll
            for (int n = 0; n < 2; ++n) gv[bj][n] = *(const f32x4*)(g + bj * HALF + n * 16);
#pragma unroll
        for (int ai = 0; ai < 2; ++ai)
#pragma unroll
            for (int m = 0; m < 4; ++m) { const int lrow = ai * HALF + wr * 64 + m * 16 + fr; bf16_t* rowp = X + (size_t)(brow + lrow) * D + bcol + wc * 32 + fq * 4;
                const float* srcp = nullptr;
                if (xin) { const int b = brow / S, t0 = brow - b * S; srcp = (t0 < TC ? cin + ((size_t)b * TC + t0 + lrow) * D : xin + ((size_t)b * TL + (t0 - TC) + lrow) * D) + bcol + wc * 32 + fq * 4; }
#pragma unroll
                for (int bj = 0; bj < 2; ++bj)
#pragma unroll
                    for (int n = 0; n < 2; ++n) { f32x4 x;
                        if (xin) x = *(const f32x4*)(srcp + bj * HALF + n * 16); else { const u32x2 p = *(const u32x2*)(rowp + bj * HALF + n * 16); x = (f32x4){bflo(p.x), bfhi(p.x), bflo(p.y), bfhi(p.y)}; }
                        if (!dry) x += gv[bj][n] * acc[ai][bj][m][n];
                        u32x2 w; w.x = cvtpk(x[0], x[1]); w.y = cvtpk(x[2], x[3]); *(u32x2*)(rowp + bj * HALF + n * 16) = w; }
                if (m == 3) asm volatile("" ::: "memory"); }
    } };
struct EpiMoeUp { bf16_t* hid; int rowbase, nvalid;
    DEV void operator()(const f32x4 (&acc)[2][2][4][2], int brow, int bcol, int wr, int wc, int fr, int fq) const {
        const int hc = (bcol >> 1) + wc * 32 + fq * 4;
#pragma unroll
        for (int ai = 0; ai < 2; ++ai)
#pragma unroll
            for (int m = 0; m < 4; ++m) { const int lr = ai * HALF + wr * 64 + m * 16 + fr;
                if (lr < nvalid) { bf16_t* rowp = hid + (size_t)(rowbase + lr) * EDIM + hc;
#pragma unroll
                    for (int n = 0; n < 2; ++n) { const f32x4 a = acc[ai][0][m][n], b = acc[ai][1][m][n];
                        u32x2 w; w.x = cvtpk(siluf_(a[0]) * b[0], siluf_(a[1]) * b[1]); w.y = cvtpk(siluf_(a[2]) * b[2], siluf_(a[3]) * b[3]);
                        *(u32x2*)(rowp + n * 16) = w; } } }
    } };
struct EpiMoeDown { bf16_t* y; const int* list; int nvalid;
    DEV void operator()(const f32x4 (&acc)[2][2][4][2], int brow, int bcol, int wr, int wc, int fr, int fq) const {
        int li[2][4];
#pragma unroll
        for (int ai = 0; ai < 2; ++ai)
#pragma unroll
            for (int m = 0; m < 4; ++m) { const int lr = ai * HALF + wr * 64 + m * 16 + fr; li[ai][m] = list[lr < nvalid ? lr : nvalid - 1]; }
#pragma unroll
        for (int ai = 0; ai < 2; ++ai)
#pragma unroll
            for (int m = 0; m < 4; ++m) { const int lr = ai * HALF + wr * 64 + m * 16 + fr;
                if (lr < nvalid) { bf16_t* rowp = y + (size_t)li[ai][m] * D + bcol + wc * 32 + fq * 4;
#pragma unroll
                    for (int bj = 0; bj < 2; ++bj)
#pragma unroll
                        for (int n = 0; n < 2; ++n) { const f32x4 v = acc[ai][bj][m][n]; u32x2 w; w.x = cvtpk(v[0], v[1]); w.y = cvtpk(v[2], v[3]); *(u32x2*)(rowp + bj * HALF + n * 16) = w; } } }
    } };

DEV void row_bt(int r, int& b, int& t) { b = r / S; t = r - b * S; }
#define LDS_BARRIER() do { asm volatile("s_waitcnt lgkmcnt(0)" ::: "memory"); __builtin_amdgcn_s_barrier(); asm volatile("" ::: "memory"); } while (0)
struct EpiInAB { bf16_t* P; float* ssq; bf16_t* Kb; const float2* tb; char* smem;
    DEV void operator()(const f32x4 (&acc)[2][2][4][2], int brow, int bcol, int wr, int wc, int fr, int fq) const {
        const int pn = bcol >> 8;
        if (pn < 23) {
#pragma unroll
            for (int ai = 0; ai < 2; ++ai)
#pragma unroll
                for (int m = 0; m < 4; ++m) { bf16_t* rowp = P + (size_t)(brow + ai * HALF + wr * 64 + m * 16 + fr) * AB_INP + bcol + wc * 32 + fq * 4;
#pragma unroll
                    for (int bj = 0; bj < 2; ++bj)
#pragma unroll
                        for (int n = 0; n < 2; ++n) { const f32x4 v = acc[ai][bj][m][n]; u32x2 w; w.x = cvtpk(v[0], v[1]); w.y = cvtpk(v[2], v[3]); *(u32x2*)(rowp + bj * HALF + n * 16) = w; } }
            if (pn >= 20) {
                float* red = (float*)smem;
#pragma unroll
                for (int ai = 0; ai < 2; ++ai)
#pragma unroll
                    for (int m = 0; m < 4; ++m) { float sq = 0.f;
#pragma unroll
                        for (int bj = 0; bj < 2; ++bj)
#pragma unroll
                            for (int n = 0; n < 2; ++n) { const f32x4 v = acc[ai][bj][m][n]; sq += v[0] * v[0] + v[1] * v[1] + v[2] * v[2] + v[3] * v[3]; }
                        sq += __shfl_xor(sq, 16); sq += __shfl_xor(sq, 32);
                        if (fq == 0) red[(ai * HALF + wr * 64 + m * 16 + fr) * 4 + wc] = sq; }
                LDS_BARRIER();
                const int t_ = tid_opaque();
                if (t_ < 256) { const f32x4 q = *(const f32x4*)(red + t_ * 4); ssq[(size_t)(pn - 20) * R + brow + t_] = (q[0] + q[1]) + (q[2] + q[3]); }
                LDS_BARRIER();
            }
        } else if (wc < 2) {
            f32x4 cc[2][4][2];
#pragma unroll
            for (int ai = 0; ai < 2; ++ai)
#pragma unroll
                for (int m = 0; m < 4; ++m) { int b, t; row_bt(brow + ai * HALF + wr * 64 + m * 16 + fr, b, t);
#pragma unroll
                    for (int n = 0; n < 2; ++n) cc[ai][m][n] = *(const f32x4*)(tb + t * 32 + 16 * wc + 8 * n + 2 * fq); }
#pragma unroll
            for (int ai = 0; ai < 2; ++ai)
#pragma unroll
                for (int m = 0; m < 4; ++m) { int b, t; row_bt(brow + ai * HALF + wr * 64 + m * 16 + fr, b, t);
#pragma unroll
                    for (int n = 0; n < 2; ++n) { const f32x4 v = acc[ai][0][m][n]; const int p0 = 16 * wc + 8 * n + 2 * fq;
                        const float2 c0 = make_float2(cc[ai][m][n][0], cc[ai][m][n][1]), c1 = make_float2(cc[ai][m][n][2], cc[ai][m][n][3]);
                        const unsigned lo = cvtpk(v[0] * c0.x - v[1] * c0.y, v[2] * c1.x - v[3] * c1.y), hi = cvtpk(v[1] * c0.x + v[0] * c0.y, v[3] * c1.x + v[2] * c1.y);
#pragma unroll
                        for (int hh = 0; hh < 8; ++hh) { bf16_t* kp = Kb + (((size_t)b * 8 + hh) * S + t) * 192 + 128 + p0; *(unsigned*)kp = lo; *(unsigned*)(kp + 32) = hi; } } }
        }
    } };
struct EpiInCD { bf16_t* P; bf16_t* Qb; bf16_t* Kb; bf16_t* Vb; const float2* tc; const float* gq; const float* gk; char* smem;
    DEV void operator()(const f32x4 (&acc)[2][2][4][2], int brow, int bcol, int wr, int wc, int fr, int fq) const {
        const int pn = bcol >> 8;
        if (pn <= 4) {
            float* red = (float*)smem;
            f32x4 cc[2][4][2];
#pragma unroll
            for (int ai = 0; ai < 2; ++ai)
#pragma unroll
                for (int m = 0; m < 4; ++m) { int b, t; row_bt(brow + ai * HALF + wr * 64 + m * 16 + fr, b, t);
#pragma unroll
                    for (int n = 0; n < 2; ++n) cc[ai][m][n] = *(const f32x4*)(tc + t * 64 + 16 * wc + 8 * n + 2 * fq); }
#pragma unroll
            for (int ai = 0; ai < 2; ++ai)
#pragma unroll
                for (int m = 0; m < 4; ++m)
#pragma unroll
                    for (int bj = 0; bj < 2; ++bj) { float sq = 0.f;
#pragma unroll
                        for (int n = 0; n < 2; ++n) { const f32x4 v = acc[ai][bj][m][n]; sq += v[0] * v[0] + v[1] * v[1] + v[2] * v[2] + v[3] * v[3]; }
                        sq += __shfl_xor(sq, 16); sq += __shfl_xor(sq, 32);
                        if (fq == 0) red[((ai * HALF + wr * 64 + m * 16 + fr) * 2 + bj) * 4 + wc] = sq; }
            LDS_BARRIER();
            const float* gp = pn < 4 ? gq : gk;
            float g1[2][2], g2[2][2];
#pragma unroll
            for (int n = 0; n < 2; ++n) { const int p0 = 16 * wc + 8 * n + 2 * fq; g1[n][0] = gp[p0]; g1[n][1] = gp[p0 + 1]; g2[n][0] = gp[p0 + 64]; g2[n][1] = gp[p0 + 65]; }
#pragma unroll
            for (int ai = 0; ai < 2; ++ai)
#pragma unroll
                for (int m = 0; m < 4; ++m) { const int lr = ai * HALF + wr * 64 + m * 16 + fr; int b, t; row_bt(brow + lr, b, t);
#pragma unroll
                    for (int bj = 0; bj < 2; ++bj) { const f32x4 q4 = *(const f32x4*)(red + (lr * 2 + bj) * 4); const float rs = rsqrtf(((q4[0] + q4[1]) + (q4[2] + q4[3])) * (1.f / 128.f) + EPS);
                        bf16_t* dst = pn < 4 ? Qb + (((size_t)b * 8 + pn * 2 + bj) * S + t) * 128 : Kb + (((size_t)b * 2 + bj) * S + t) * 128;
#pragma unroll
                        for (int n = 0; n < 2; ++n) { const f32x4 v = acc[ai][bj][m][n]; const int p0 = 16 * wc + 8 * n + 2 * fq;
                            const float2 c0 = make_float2(cc[ai][m][n][0], cc[ai][m][n][1]), c1 = make_float2(cc[ai][m][n][2], cc[ai][m][n][3]);
                            const float x1a = v[0] * rs * g1[n][0], x2a = v[1] * rs * g2[n][0], x1b = v[2] * rs * g1[n][1], x2b = v[3] * rs * g2[n][1];
                            *(unsigned*)(dst + p0) = cvtpk(x1a * c0.x - x2a * c0.y, x1b * c1.x - x2b * c1.y);
                            *(unsigned*)(dst + 64 + p0) = cvtpk(x2a * c0.x + x1a * c0.y, x2b * c1.x + x1b * c1.y); } } }
            LDS_BARRIER();
        } else if (pn == 5) {
#pragma unroll
            for (int ai = 0; ai < 2; ++ai)
#pragma unroll
                for (int m = 0; m < 4; ++m) { int b, t; row_bt(brow + ai * HALF + wr * 64 + m * 16 + fr, b, t);
#pragma unroll
                    for (int bj = 0; bj < 2; ++bj)
#pragma unroll
                        for (int n = 0; n < 2; ++n) { const f32x4 v = acc[ai][bj][m][n]; u32x2 w; w.x = cvtpk(v[0], v[1]); w.y = cvtpk(v[2], v[3]);
                            *(u32x2*)(Vb + (((size_t)b * 2 + bj) * S + t) * 128 + wc * 32 + n * 16 + fq * 4) = w; } }
        } else {
#pragma unroll
            for (int ai = 0; ai < 2; ++ai)
#pragma unroll
                for (int m = 0; m < 4; ++m) { bf16_t* rowp = P + (size_t)(brow + ai * HALF + wr * 64 + m * 16 + fr) * CD_INP + bcol + wc * 32 + fq * 4;
#pragma unroll
                    for (int bj = 0; bj < 2; ++bj)
#pragma unroll
                        for (int n = 0; n < 2; ++n) { const f32x4 v = acc[ai][bj][m][n]; u32x2 w; w.x = cvtpk(v[0], v[1]); w.y = cvtpk(v[2], v[3]); *(u32x2*)(rowp + bj * HALF + n * 16) = w; } }
        }
    } };
struct EpiUQ { bf16_t* Qb; const float* ssq; const float2* tb;
    DEV void operator()(const f32x4 (&acc)[2][2][4][2], int brow, int bcol, int wr, int wc, int fr, int fq) const {
        const int pn = bcol >> 8;
#pragma unroll
        for (int ai = 0; ai < 2; ++ai)
#pragma unroll
            for (int m = 0; m < 4; ++m) { const int r = brow + ai * HALF + wr * 64 + m * 16 + fr; int b, t; row_bt(r, b, t);
                const float rs = rsqrtf((ssq[r] + ssq[R + r]) * (1.f / 512.f) + EPS);
#pragma unroll
                for (int bj = 0; bj < 2; ++bj)
#pragma unroll
                    for (int n = 0; n < 2; ++n) { const f32x4 v = acc[ai][bj][m][n] * rs;
                        if (pn < 4) { const int hh = pn * 2 + bj; bf16_t* qp = Qb + (((size_t)b * 8 + hh) * S + t) * 192 + wc * 32 + n * 16 + fq * 4;
                            u32x2 w; w.x = cvtpk(v[0], v[1]); w.y = cvtpk(v[2], v[3]); *(u32x2*)qp = w; }
                        else { const int cr = (pn - 4) * 256 + bj * HALF + wc * 32 + n * 16 + fq * 4, hh = cr >> 6, p0 = (cr & 63) >> 1;
                            const f32x4 cc = *(const f32x4*)(tb + t * 32 + p0); const float2 c0 = make_float2(cc[0], cc[1]), c1 = make_float2(cc[2], cc[3]);
                            bf16_t* qp = Qb + (((size_t)b * 8 + hh) * S + t) * 192 + 128 + p0;
                            *(unsigned*)qp = cvtpk(v[0] * c0.x - v[1] * c0.y, v[2] * c1.x - v[3] * c1.y); *(unsigned*)(qp + 32) = cvtpk(v[1] * c0.x + v[0] * c0.y, v[3] * c1.x + v[2] * c1.y); } } }
    } };
struct EpiUKV { bf16_t* Kb; bf16_t* Vb; const float* ssq;
    DEV void operator()(const f32x4 (&acc)[2][2][4][2], int brow, int bcol, int wr, int wc, int fr, int fq) const {
        const int hh = bcol >> 8;
#pragma unroll
        for (int ai = 0; ai < 2; ++ai)
#pragma unroll
            for (int m = 0; m < 4; ++m) { const int r = brow + ai * HALF + wr * 64 + m * 16 + fr; int b, t; row_bt(r, b, t);
                const float rs = rsqrtf(ssq[2 * R + r] * (1.f / 256.f) + EPS); const size_t rowi = ((size_t)b * 8 + hh) * S + t;
#pragma unroll
                for (int n = 0; n < 2; ++n) { const f32x4 kv = acc[ai][0][m][n] * rs, vv = acc[ai][1][m][n] * rs; const int c = wc * 32 + n * 16 + fq * 4;
                    u32x2 w; w.x = cvtpk(kv[0], kv[1]); w.y = cvtpk(kv[2], kv[3]); *(u32x2*)(Kb + rowi * 192 + c) = w;
                    w.x = cvtpk(vv[0], vv[1]); w.y = cvtpk(vv[2], vv[3]); *(u32x2*)(Vb + rowi * 128 + c) = w; } }
    } };

template <bool LATENT = false, int LDA_ = 0, class Epi>
DEV void gemm_phase(const bf16_t* A, const bf16_t* Bt, int M, int N, int K, char* smem, const Epi& epi, int& cursor, int tlo = 0, int thi = 1 << 30) {
    const int nM = M / BM, nN = N / BM, n = nM * nN;
    int first = cursor; cursor += n;
    int u = blockIdx.x; while (u < first) u += gridDim.x;
    for (; u < first + n; u += gridDim.x) { const int t = u - first; if (t < tlo || t >= thi) continue; const int pm = t % nM, pn = t / nM;
        const int prow = LATENT ? (pm >> 3) * 9 + 1 + (pm & 7) : pm;
        gemm_tile<false, LDA_>(A, Bt, K, K, prow * BM, pn * BM, nullptr, 0, smem, epi); }
}

struct CvtJob { const float* src; bf16_t* dst; int K, N, Nout, nb; size_t src_bs, dst_bs; int blk_rs, blk_base; const float* kscale; int perm = 0; };
constexpr int CVT_LDS_WAVE = 64 * 65 * 4, CVT_SLOT_OFF = 8 * CVT_LDS_WAVE;
DEV void cvt_issue(const CvtJob& j, int u, int lane, f32x4 (&e)[16]) {
    const int tN = j.Nout / 64, per = (j.K / 64) * tN;
    const int bt = u / per, rem = u - bt * per, kt = rem / tN, ntl = rem - kt * tN;
    const int n0 = ntl * 64 + (lane & 15) * 4;
    const float* sp = j.src + (size_t)bt * j.src_bs + (size_t)(kt * 64 + (lane >> 4)) * j.N + (n0 < j.N ? n0 : 0);
#pragma unroll
    for (int q = 0; q < 16; ++q) e[q] = *(const f32x4*)(sp + (size_t)(q * 4) * j.N);
}
DEV void cvt_finish(const CvtJob& j, int u, int lane, float* tile, const f32x4 (&e)[16]) {
    const int tN = j.Nout / 64, per = (j.K / 64) * tN;
    const int bt = u / per, rem = u - bt * per, kt = rem / tN, ntl = rem - kt * tN;
    const int r0 = lane >> 4, c4 = lane & 15; const bool valid = ntl * 64 + c4 * 4 < j.N;
#pragma unroll
    for (int q = 0; q < 16; ++q) { f32x4 x = e[q]; const int k = r0 + 4 * q; if (j.kscale) x *= j.kscale[kt * 64 + k]; if (!valid) x = (f32x4){0.f, 0.f, 0.f, 0.f};
        float* tp = tile + k * 65 + c4 * 4; tp[0] = x[0]; tp[1] = x[1]; tp[2] = x[2]; tp[3] = x[3]; }
    const int nl0 = lane >> 3, kc = (lane & 7) * 8;
#pragma unroll
    for (int p = 0; p < 8; ++p) { const int nl = p * 8 + nl0, nn = ntl * 64 + nl; float v[8];
#pragma unroll
        for (int i = 0; i < 8; ++i) v[i] = tile[(kc + i) * 65 + nl];
        int drow = (nn >> 7) * j.blk_rs + j.blk_base + (nn & 127);
        if (j.perm == 1) { const int hh = nn / 192, c = nn - hh * 192, i = c - 128; drow = c < 128 ? hh * 128 + c : 1024 + hh * 64 + (i < 32 ? 2 * i : 2 * (i - 32) + 1); }
        if (j.perm == 3 && nn < 1280) { const int c = nn & 127; drow = (nn & ~127) + (c < 64 ? 2 * c : 2 * (c - 64) + 1); }
        if (j.perm == 2 && nn >= 5888) { const int i = nn - 5888; drow = i < 64 ? 5888 + (i < 32 ? 2 * i : 2 * (i - 32) + 1) : nn; }
        *(u32x4*)(j.dst + (size_t)bt * j.dst_bs + (size_t)drow * j.K + kt * 64 + kc) = (u32x4){cvtpk(v[0], v[1]), cvtpk(v[2], v[3]), cvtpk(v[4], v[5]), cvtpk(v[6], v[7])}; }
}
DEV void cvt_run(const CvtJob& j, int u0, int ustep, int n, int lane, float* tile) {
    f32x4 eA[16], eB[16];
    cvt_issue(j, u0, lane, eA);
    int i = 0;
#pragma unroll 1
    for (; i + 2 < n; i += 2) {
        cvt_issue(j, u0 + (i + 1) * ustep, lane, eB);
        __builtin_amdgcn_sched_barrier(0);
        cvt_finish(j, u0 + i * ustep, lane, tile, eA);
        __builtin_amdgcn_sched_barrier(0);
        cvt_issue(j, u0 + (i + 2) * ustep, lane, eA);
        __builtin_amdgcn_sched_barrier(0);
        cvt_finish(j, u0 + (i + 1) * ustep, lane, tile, eB);
        __builtin_amdgcn_sched_barrier(0);
    }
    if (i + 1 < n) {
        cvt_issue(j, u0 + (i + 1) * ustep, lane, eB);
        __builtin_amdgcn_sched_barrier(0);
        cvt_finish(j, u0 + i * ustep, lane, tile, eA);
        __builtin_amdgcn_sched_barrier(0);
        cvt_finish(j, u0 + (i + 1) * ustep, lane, tile, eB);
    } else cvt_finish(j, u0 + i * ustep, lane, tile, eA);
}
DEV void cvt_weight(const float* __restrict__ src, bf16_t* __restrict__ dst, int K, int N, int Nout, int nb, size_t src_bs, size_t dst_bs,
                    int blk_rs, int blk_base, const float* __restrict__ kscale, char* smem, int perm = 0) {
    const CvtJob j{src, dst, K, N, Nout, nb, src_bs, dst_bs, blk_rs, blk_base, kscale, perm};
    const int tid = tid_opaque(), lane = tid & 63, w = tid >> 6, total = nb * (K / 64) * (Nout / 64);
    float* tile = (float*)(smem + w * CVT_LDS_WAVE);
    const int u0 = blockIdx.x * 8 + w, ustep = gridDim.x * 8;
    if (u0 < total) cvt_run(j, u0, ustep, (total - u0 + ustep - 1) / ustep, lane, tile);
    __syncthreads();
}
DEV bf16_t* moe_w13(const Args& a, int l) { return (bf16_t*)(a.ws + (l == 0 ? WS_W13 : WS_SVT)); }
DEV bf16_t* moe_w2(const Args& a, int l) { return (bf16_t*)(a.ws + (l == 0 ? WS_W2 : WS_SVT + (size_t)NE * 1024 * D * 2)); }
constexpr int CVT_IT = 8;
DEV void cvt_moe_dynamic(const Args& a, int l, char* smem) {
    const int tid = tid_opaque(), lane = tid & 63, w = tid >> 6;
    unsigned* counter = (unsigned*)(a.ws + WS_CTL) + CW_CVT + l * 64;
    volatile int* slot = (volatile int*)(smem + CVT_SLOT_OFF); float* tile = (float*)(smem + w * CVT_LDS_WAVE);
    const CvtJob j1{a.in[26] + (size_t)l * NE * D * EDIM, moe_w13(a, l), D, EDIM, EDIM, NE, (size_t)D * EDIM, (size_t)1024 * D, 256, 0, nullptr};
    const CvtJob j3{a.in[27] + (size_t)l * NE * D * EDIM, moe_w13(a, l), D, EDIM, EDIM, NE, (size_t)D * EDIM, (size_t)1024 * D, 256, 128, nullptr};
    const CvtJob j2{a.in[28] + (size_t)l * NE * EDIM * D, moe_w2(a, l), EDIM, D, D, NE, (size_t)EDIM * D, (size_t)D * EDIM, 128, 0, nullptr};
    constexpr int CPJ = 4096 / (8 * CVT_IT), NCHUNK = 3 * CPJ;
    for (;;) {
        __syncthreads();
        if (tid == 0) *slot = (int)atomicAdd(counter, 1u);
        __syncthreads();
        const int chunk = *slot;
        if (chunk >= NCHUNK) break;
        const int job = chunk / CPJ, u0 = (chunk - job * CPJ) * (8 * CVT_IT) + w;
        if (job == 0) cvt_run(j1, u0, 8, CVT_IT, lane, tile); else if (job == 1) cvt_run(j3, u0, 8, CVT_IT, lane, tile); else cvt_run(j2, u0, 8, CVT_IT, lane, tile);
    }
    __syncthreads();
}

DEV void cvt_cd_dynamic(const Args& a, char* smem) {
    const int tid = tid_opaque(), lane = tid & 63, w = tid >> 6;
    unsigned* counter = (unsigned*)(a.ws + WS_CTL) + CW_CVT + 3 * 64;
    volatile int* slot = (volatile int*)(smem + CVT_SLOT_OFF); float* tile = (float*)(smem + w * CVT_LDS_WAVE);
    const CvtJob jin{a.in[17], (bf16_t*)(a.ws + WS_WCDIN), D, CD_IN, CD_INP, 1, 0, 0, 128, 0, nullptr, 3};
    const CvtJob jout{a.in[18], (bf16_t*)(a.ws + WS_WCDOUT), D, D, D, 1, 0, 0, 128, 0, nullptr};
    const CvtJob jabo{a.in[10], (bf16_t*)(a.ws + WS_WABOUT), D, D, D, 1, 0, 0, 128, 0, nullptr};
    const CvtJob juq{a.in[14], (bf16_t*)(a.ws + WS_WUQ), 512, 1536, 1536, 1, 0, 0, 128, 0, a.in[13], 1};
    const CvtJob jukv{a.in[16], (bf16_t*)(a.ws + WS_WUKV), 256, 2048, 2048, 1, 0, 0, 128, 0, a.in[15]};
    constexpr int TIN = 32 * (CD_INP / 64), T1 = TIN + 32 * 32, T2 = T1 + 32 * 32, T3 = T2 + 8 * 24, T4 = T3 + 4 * 32, NCHUNK = T4 / (8 * CVT_IT);
    static_assert(TIN % (8 * CVT_IT) == 0 && T1 % (8 * CVT_IT) == 0 && T2 % (8 * CVT_IT) == 0 && T3 % (8 * CVT_IT) == 0 && T4 % (8 * CVT_IT) == 0, "chunk boundary");
    for (;;) {
        __syncthreads();
        if (tid == 0) *slot = (int)atomicAdd(counter, 1u);
        __syncthreads();
        const int chunk = *slot;
        if (chunk >= NCHUNK) break;
        const int g = chunk * (8 * CVT_IT) + w;
        if (g < TIN) cvt_run(jin, g, 8, CVT_IT, lane, tile); else if (g < T1) cvt_run(jout, g - TIN, 8, CVT_IT, lane, tile); else if (g < T2) cvt_run(jabo, g - T1, 8, CVT_IT, lane, tile);
        else if (g < T3) cvt_run(juq, g - T2, 8, CVT_IT, lane, tile); else cvt_run(jukv, g - T3, 8, CVT_IT, lane, tile);
    }
    __syncthreads();
}

template <bool DYN>
DEV void mod_phase(const Args& a, int l, char* smem) {
    float* sc = (float*)smem;
    float* red = sc + 5 * D;
    const int tid = tid_opaque(), w = tid >> 6, lane = tid & 63, cg = lane & 7, rr = lane >> 3;
    { float xv[5 * D / NT];
#pragma unroll
      for (int q = 0; q < 5 * D / NT; ++q) { const int i = tid + q * NT, v = i / D, k = i - v * D; xv[q] = v < 4 ? a.in[1][v * D + k] : a.in[3][k]; }
#pragma unroll
      for (int q = 0; q < 5 * D / NT; ++q) sc[tid + q * NT] = siluf_(xv[q]); }
    __syncthreads();
    float* modv = (float*)(a.ws + WS_MODV);
    unsigned* counter = (unsigned*)(a.ws + WS_CTL) + CW_CVT + 2 * 64; volatile int* slot = (volatile int*)(red + 8 * 5 * 32);
    for (int u = gridDim.x - 1 - blockIdx.x;; u += gridDim.x) {
        if (DYN) { __syncthreads(); if (tid == 0) *slot = (int)atomicAdd(counter, 1u); __syncthreads(); u = *slot; }
        if (u >= MODN / 32) break;
        const int c0 = u * 32;
        const float* wp = a.in[4] + (size_t)l * D * MODN + c0 + cg * 4;
        f32x4 acc[5] = {};
        for (int it0 = 0; it0 < D / 64; it0 += 8) { f32x4 wv[8];
#pragma unroll
            for (int q = 0; q < 8; ++q) wv[q] = *(const f32x4*)(wp + (size_t)((it0 + q) * 64 + w * 8 + rr) * MODN);
#pragma unroll
            for (int q = 0; q < 8; ++q) { const int k = (it0 + q) * 64 + w * 8 + rr;
#pragma unroll
                for (int v = 0; v < 5; ++v) acc[v] += wv[q] * sc[v * D + k]; } }
#pragma unroll
        for (int v = 0; v < 5; ++v)
#pragma unroll
            for (int j = 0; j < 4; ++j) { float x = acc[v][j]; x += __shfl_xor(x, 8); x += __shfl_xor(x, 16); x += __shfl_xor(x, 32); acc[v][j] = x; }
        if (rr == 0) {
#pragma unroll
            for (int v = 0; v < 5; ++v)
#pragma unroll
                for (int j = 0; j < 4; ++j) red[(w * 5 + v) * 32 + cg * 4 + j] = acc[v][j]; }
        __syncthreads();
        if (tid < 160) { const int v = tid >> 5, c = tid & 31; float s = 0.f;
#pragma unroll
            for (int ww = 0; ww < 8; ++ww) s += red[(ww * 5 + v) * 32 + c];
            modv[((size_t)l * 5 + v) * MODN + c0 + c] = s + a.in[5][l * MODN + c0 + c]; }
        __syncthreads();
    }
}

DEV void misc_phase(const Args& a) {
    const int gt = blockIdx.x * NT + tid_opaque(), gs = gridDim.x * NT;
    float* lb = (float*)(a.ws + WS_LB);
    for (int i = gt; i < 2 * 1024; i += gs) { const int d = i >> 10, c = i & 1023; const float* p = a.in[11] + (size_t)d * 3 * 1024 + c;
        const float x0 = p[0], x1 = p[1024], x2 = p[2048], m = fmaxf(x0, fmaxf(x1, x2));
        const float e0 = expf(x0 - m), e1 = expf(x1 - m), e2 = expf(x2 - m); lb[i] = e0 / (e0 + e1 + e2); }
    float2* tb = (float2*)(a.ws + WS_TABB); float2* tc = (float2*)(a.ws + WS_TABC);
    for (int i = gt; i < S * 32; i += gs) { const int t = (i >> 5) - TC, j = i & 31, q = j & 15; const float fr = powf(10000.f, -(float)q / 16.f);
        const float pos = (j < 16) ? (float)(t >> 6) : (float)(t & 63); const float an = pos * fr; tb[i] = t < 0 ? make_float2(1.f, 0.f) : make_float2(cosf(an), sinf(an)); }
    for (int i = gt; i < S * 64; i += gs) { const int t = (i >> 6) - TC, j = i & 63, q = j & 31; const float fr = powf(10000.f, -(float)q / 32.f);
        const float pos = (j < 32) ? (float)(t >> 6) : (float)(t & 63); const float an = pos * fr; tc[i] = t < 0 ? make_float2(1.f, 0.f) : make_float2(cosf(an), sinf(an)); }
}

template <bool ROUTER, bool FROM_IN = false>
DEV void norm_phase(const Args& a, int l, int chunk_shift, const float* gain, bool latent_only, char* smem, bool dry = false) {
    const int tid = tid_opaque(), w = tid >> 6, lane = tid & 63;
    const bf16_t* xres = (const bf16_t*)(a.ws + WS_XRES); bf16_t* h = (bf16_t*)(a.ws + WS_H);
    const float* modv = (const float*)(a.ws + WS_MODV) + (size_t)l * 5 * MODN;
    unsigned* cnt = (unsigned*)(a.ws + WS_CTL) + CW_CNT + l * 16 * CNT_STRIDE;
    int* tok = (int*)(a.ws + WS_TOK); int* list = (int*)(a.ws + WS_LIST);
    float* rw = (float*)smem;
    int* ent = (int*)(smem + 139264);
    if (ROUTER) { for (int i = tid; i < D * 16 / 4; i += NT) { const int c = i >> 2, q = i & 3; *(f32x4*)(rw + c * 16 + (c >> 2) * 4 + q * 4) = ((const f32x4*)a.in[24])[i]; }
                  if (tid < 128) ent[tid] = -1; __syncthreads(); }
    const int stride = gridDim.x * 8, rfirst = blockIdx.x * 8 + w;
#define NP_SKIP(rr) while ((rr) < R && latent_only && ((rr) % S) < TC) (rr) += stride
#define NP_LOAD(rr, XF, XB) do { const int b_ = (rr) / S, t_ = (rr) - b_ * S; const float* xp_ = t_ < TC ? a.in[2] + ((size_t)b_ * TC + t_) * D : a.in[0] + ((size_t)b_ * TL + (t_ - TC)) * D; const bf16_t* xb_ = xres + (size_t)(rr) * D; \
        _Pragma("unroll") for (int j = 0; j < 8; ++j) { if (FROM_IN) XF[j] = *(const f32x4*)(xp_ + j * 256 + lane * 4); else XB[j] = *(const u32x2*)(xb_ + j * 256 + lane * 4); } } while (0)
    int r = rfirst; NP_SKIP(r);
    f32x4 nxf[8]; u32x2 nxb[8];
    if (r < R) NP_LOAD(r, nxf, nxb);
    while (r < R) {
        const int nent = (r - rfirst) / stride;
        f32x4 x[8]; float ss = 0.f;
#pragma unroll
        for (int j = 0; j < 8; ++j) { if (FROM_IN) x[j] = nxf[j]; else { const u32x2 p = nxb[j]; x[j] = (f32x4){bflo(p.x), bfhi(p.x), bflo(p.y), bfhi(p.y)}; } }
        int rn = r + stride; NP_SKIP(rn);
        if (rn < R) NP_LOAD(rn, nxf, nxb);
        const int b = r / S, t = r - b * S; const int v = t < TC ? 4 : b;
        const float* sh = modv + (size_t)v * MODN + chunk_shift * D; const float* sc = sh + D;
#pragma unroll
        for (int j = 0; j < 8; ++j) ss += x[j][0] * x[j][0] + x[j][1] * x[j][1] + x[j][2] * x[j][2] + x[j][3] * x[j][3];
        ss = wave_sum(ss); const float rstd = rsqrtf(ss * (1.f / D) + EPS);
        float lg[16]; f32x2 lgp[8];
        if (ROUTER) {
#pragma unroll
            for (int e = 0; e < 8; ++e) lgp[e] = (f32x2){0.f, 0.f}; }
#pragma unroll
        for (int j = 0; j < 8; ++j) { const int c = j * 256 + lane * 4;
            const f32x4 g = *(const f32x4*)(gain + c), s1 = *(const f32x4*)(sc + c), s0 = *(const f32x4*)(sh + c);
            f32x4 y = (x[j] * rstd * g) * (1.f + s1) + s0;
            u32x2 pk; pk.x = cvtpk(y[0], y[1]); pk.y = cvtpk(y[2], y[3]); *(u32x2*)(h + (size_t)r * D + c) = pk;
            if (ROUTER) {
#pragma unroll
                for (int i = 0; i < 4; ++i) { const f32x4* wrow = (const f32x4*)(rw + (c + i) * 16 + (c >> 2) * 4);
#pragma unroll
                    for (int q = 0; q < 4; ++q) { const f32x4 wv = wrow[q]; const f32x2 yy = (f32x2){y[i], y[i]};
                        lgp[q * 2 + 0] += yy * (f32x2){wv[0], wv[1]}; lgp[q * 2 + 1] += yy * (f32x2){wv[2], wv[3]}; } }
                __builtin_amdgcn_sched_barrier(0); }
        }
        if (ROUTER) {
#pragma unroll
            for (int e = 0; e < 16; ++e) lg[e] = wave_sum(lgp[e >> 1][e & 1]);
            if (lane == 0 && !dry) {
                float scv[16], sel[16];
#pragma unroll
                for (int e = 0; e < 16; ++e) { scv[e] = 1.f / (1.f + __expf(-lg[e])); sel[e] = scv[e] + a.in[25][e]; }
                int gbest = 0; float gbv = -1e30f;
#pragma unroll
                for (int g = 0; g < 4; ++g) { float m1 = -1e30f, m2 = -1e30f;
#pragma unroll
                    for (int i = 0; i < 4; ++i) { const float s_ = sel[g * 4 + i]; if (s_ > m1) { m2 = m1; m1 = s_; } else if (s_ > m2) m2 = s_; }
                    const float gs = m1 + m2; if (gs > gbv) { gbv = gs; gbest = g; } }
                int e0 = 0, e1 = 0; float m1 = -1e30f, m2 = -1e30f; float w0 = 0.f, w1 = 0.f;
#pragma unroll
                for (int g = 0; g < 4; ++g) if (g == gbest) {
#pragma unroll
                    for (int i = 0; i < 4; ++i) { const float s_ = sel[g * 4 + i]; const int e = g * 4 + i;
                        if (s_ > m1) { m2 = m1; e1 = e0; w1 = w0; m1 = s_; e0 = e; w0 = scv[e]; } else if (s_ > m2) { m2 = s_; e1 = e; w1 = scv[e]; } } }
                const float inv = 1.f / (w0 + w1);
                ent[nent * 16 + w * 2 + 0] = (e0 << 24) | (r * 2); ent[nent * 16 + w * 2 + 1] = (e1 << 24) | (r * 2 + 1);
                tok[r * 4 + 0] = e0; tok[r * 4 + 1] = e1; ((float*)tok)[r * 4 + 2] = w0 * inv; ((float*)tok)[r * 4 + 3] = w1 * inv;
            }
        }
        r = rn;
    }
#undef NP_LOAD
#undef NP_SKIP
    if (ROUTER) {
        __syncthreads();
        if (tid < NE) { int c_ = 0;
            for (int j = 0; j < 128; ++j) c_ += ((ent[j] >> 24) == tid) ? 1 : 0;
            if (c_) { unsigned pos = atomicAdd(&cnt[tid * CNT_STRIDE], (unsigned)c_);
                for (int j = 0; j < 128; ++j) { const int en = ent[j]; if ((en >> 24) == tid) { __hip_atomic_store((__attribute__((address_space(1))) int*)(list + (size_t)tid * R + pos), en & 0xffffff, __ATOMIC_RELAXED, __HIP_MEMORY_SCOPE_AGENT); ++pos; } } } }
        __syncthreads();
    }
}

DEV void norm_router_phase(const Args& a, int l, int chunk_shift, const float* gain, bool latent_only, char* smem) {
    constexpr int WP = 2 * D + 16;
    constexpr int OFF_WLO = 16 * WP, OFF_ENT = 2 * 16 * WP, OFF_ROW = OFF_ENT + 512, OFF_RED = OFF_ROW + 256;
    static_assert(OFF_RED + 8 * 3 * 256 * 4 <= LDS_BYTES_C - 16, "router LDS");
    const int tid = tid_opaque(), w = tid >> 6, lane = tid & 63;
    const bf16_t* xres = (const bf16_t*)(a.ws + WS_XRES); bf16_t* h = (bf16_t*)(a.ws + WS_H); bf16_t* hlo = (bf16_t*)(a.ws + WS_P);
    const float* modv = (const float*)(a.ws + WS_MODV) + (size_t)l * 5 * MODN;
    unsigned* cnt = (unsigned*)(a.ws + WS_CTL) + CW_CNT + l * 16 * CNT_STRIDE;
    int* tok = (int*)(a.ws + WS_TOK); int* list = (int*)(a.ws + WS_LIST);
    char* whi = smem; char* wlo = smem + OFF_WLO; int* ent = (int*)(smem + OFF_ENT); int* rowtab = (int*)(smem + OFF_ROW); float* red = (float*)(smem + OFF_RED);
    for (int i = tid; i < (D / 2) * 4; i += NT) { const int kp = i >> 2, q = i & 3;
        const f32x4 w0 = ((const f32x4*)a.in[24])[(2 * kp) * 4 + q], w1 = ((const f32x4*)a.in[24])[(2 * kp + 1) * 4 + q];
#pragma unroll
        for (int e = 0; e < 4; ++e) { const unsigned hi = cvtpk(w0[e], w1[e]); const unsigned lo = cvtpk(w0[e] - bflo(hi), w1[e] - bfhi(hi));
            *(unsigned*)(whi + (q * 4 + e) * WP + kp * 4) = hi; *(unsigned*)(wlo + (q * 4 + e) * WP + kp * 4) = lo; } }
    if (tid < 128) ent[tid] = -1;
    if (tid < 64) rowtab[tid] = -1;
    __syncthreads();
    const int stride = gridDim.x * 8, rfirst = blockIdx.x * 8 + w;
#define NR_SKIP(rr) while ((rr) < R && latent_only && ((rr) % S) < TC) (rr) += stride
#define NR_LOAD(rr, XB) do { const bf16_t* xb_ = xres + (size_t)(rr) * D; _Pragma("unroll") for (int j = 0; j < 8; ++j) XB[j] = *(const u32x2*)(xb_ + j * 256 + lane * 4); } while (0)
    int r = rfirst; NR_SKIP(r);
    u32x2 nxb[8];
    if (r < R) NR_LOAD(r, nxb);
    while (r < R) {
        const int nent = (r - rfirst) / stride;
        f32x4 x[8]; float ss = 0.f;
#pragma unroll
        for (int j = 0; j < 8; ++j) { const u32x2 p = nxb[j]; x[j] = (f32x4){bflo(p.x), bfhi(p.x), bflo(p.y), bfhi(p.y)}; }
        int rn = r + stride; NR_SKIP(rn);
        if (rn < R) NR_LOAD(rn, nxb);
        const int b = r / S, t = r - b * S; const int v = t < TC ? 4 : b;
        const float* sh = modv + (size_t)v * MODN + chunk_shift * D; const float* sc = sh + D;
#pragma unroll
        for (int j = 0; j < 8; ++j) ss += x[j][0] * x[j][0] + x[j][1] * x[j][1] + x[j][2] * x[j][2] + x[j][3] * x[j][3];
        ss = wave_sum(ss); const float rstd = rsqrtf(ss * (1.f / D) + EPS);
#pragma unroll
        for (int j = 0; j < 8; ++j) { const int c = j * 256 + lane * 4;
            const f32x4 g = *(const f32x4*)(gain + c), s1 = *(const f32x4*)(sc + c), s0 = *(const f32x4*)(sh + c);
            const f32x4 y = (x[j] * rstd * g) * (1.f + s1) + s0;
            u32x2 pk; pk.x = cvtpk(y[0], y[1]); pk.y = cvtpk(y[2], y[3]); *(u32x2*)(h + (size_t)r * D + c) = pk;
            u32x2 pl; pl.x = cvtpk(y[0] - bflo(pk.x), y[1] - bfhi(pk.x)); pl.y = cvtpk(y[2] - bflo(pk.y), y[3] - bfhi(pk.y)); *(u32x2*)(hlo + (size_t)r * D + c) = pl; }
        if (lane == 0) rowtab[nent * 8 + w] = r;
        r = rn;
    }
#undef NR_LOAD
#undef NR_SKIP
    asm volatile("s_waitcnt vmcnt(0)" ::: "memory");
    __syncthreads();
    { const int rl = lane & 15, kq = lane >> 4; f32x4 acc[3] = {};
#pragma unroll
      for (int g = 0; g < 3; ++g) { int rr = rowtab[g * 16 + rl]; rr = rr < 0 ? 0 : rr;
          const bf16_t* ph = h + (size_t)rr * D + w * 256 + kq * 8; const bf16_t* pl = hlo + (size_t)rr * D + w * 256 + kq * 8;
          bf16x8 ah[8], al_[8];
#pragma unroll
          for (int kc = 0; kc < 8; ++kc) { ah[kc] = *(const bf16x8*)(ph + kc * 32); al_[kc] = *(const bf16x8*)(pl + kc * 32); }
#pragma unroll
          for (int kc = 0; kc < 8; ++kc) { const int kb = (w * 256 + kc * 32 + kq * 8) * 2;
              const bf16x8 bh = *(const bf16x8*)(whi + rl * WP + kb), bl = *(const bf16x8*)(wlo + rl * WP + kb);
              acc[g] = __builtin_amdgcn_mfma_f32_16x16x32_bf16(ah[kc], bh, acc[g], 0, 0, 0);
              acc[g] = __builtin_amdgcn_mfma_f32_16x16x32_bf16(ah[kc], bl, acc[g], 0, 0, 0);
              acc[g] = __builtin_amdgcn_mfma_f32_16x16x32_bf16(al_[kc], bh, acc[g], 0, 0, 0); }
#pragma unroll
          for (int q = 0; q < 4; ++q) red[((w * 3 + g) * 16 + kq * 4 + q) * 16 + rl] = acc[g][q]; } }
    __syncthreads();
    if (tid < 48) { const int rr = rowtab[tid];
        if (rr >= 0) { const int g = tid >> 4, tk = tid & 15;
            float lg[16];
#pragma unroll
            for (int e = 0; e < 16; ++e) { float s_ = 0.f;
#pragma unroll
                for (int ww = 0; ww < 8; ++ww) s_ += red[((ww * 3 + g) * 16 + tk) * 16 + e];
                lg[e] = s_; }
            float scv[16], sel[16];
#pragma unroll
            for (int e = 0; e < 16; ++e) { scv[e] = 1.f / (1.f + __expf(-lg[e])); sel[e] = scv[e] + a.in[25][e]; }
            int gbest = 0; float gbv = -1e30f;
#pragma unroll
            for (int gg = 0; gg < 4; ++gg) { float m1 = -1e30f, m2 = -1e30f;
#pragma unroll
                for (int i = 0; i < 4; ++i) { const float s_ = sel[gg * 4 + i]; if (s_ > m1) { m2 = m1; m1 = s_; } else if (s_ > m2) m2 = s_; }
                const float gs = m1 + m2; if (gs > gbv) { gbv = gs; gbest = gg; } }
            int e0 = 0, e1 = 0; float m1 = -1e30f, m2 = -1e30f; float w0 = 0.f, w1 = 0.f;
#pragma unroll
            for (int gg = 0; gg < 4; ++gg) if (gg == gbest) {
#pragma unroll
                for (int i = 0; i < 4; ++i) { const float s_ = sel[gg * 4 + i]; const int e = gg * 4 + i;
                    if (s_ > m1) { m2 = m1; e1 = e0; w1 = w0; m1 = s_; e0 = e; w0 = scv[e]; } else if (s_ > m2) { m2 = s_; e1 = e; w1 = scv[e]; } } }
            const float inv = 1.f / (w0 + w1);
            ent[tid * 2 + 0] = (e0 << 24) | (rr * 2); ent[tid * 2 + 1] = (e1 << 24) | (rr * 2 + 1);
            tok[rr * 4 + 0] = e0; tok[rr * 4 + 1] = e1; ((float*)tok)[rr * 4 + 2] = w0 * inv; ((float*)tok)[rr * 4 + 3] = w1 * inv; } }
    __syncthreads();
    if (tid < NE) { int c_ = 0;
        for (int j = 0; j < 128; ++j) c_ += ((ent[j] >> 24) == tid) ? 1 : 0;
        if (c_) { unsigned pos = atomicAdd(&cnt[tid * CNT_STRIDE], (unsigned)c_);
            for (int j = 0; j < 128; ++j) { const int en = ent[j]; if ((en >> 24) == tid) { __hip_atomic_store((__attribute__((address_space(1))) int*)(list + (size_t)tid * R + pos), en & 0xffffff, __ATOMIC_RELAXED, __HIP_MEMORY_SCOPE_AGENT); ++pos; } } } }
    __syncthreads();
}

DEV int scan_tok(int dir, int pos) { return dir == 0 ? pos : (pos < TC ? (TC - 1 - pos) : (S - 1 - (pos - TC))); }
template <int MODE>
DEV void scan_prep_phase(const Args& a, char* smem) {
    constexpr int NH = MODE == 0 ? 8 : 4, DV = MODE == 0 ? 128 : 256, LDP = MODE == 0 ? AB_INP : CD_INP, NVP = DV / 128;
    const int tid = tid_opaque(), dp = tid & 63, pg = tid >> 6, wid = tid >> 6, lane = tid & 63, l15 = lane & 15, l4 = lane >> 4;
    char* QT = smem; char* KT = smem + 64 * PQ; float* tot = (float*)(smem + 2 * 64 * PQ);
    float* aT = tot + 8 * 128;
    const bf16_t* P = (const bf16_t*)(a.ws + WS_P); const float* lb = (const float*)(a.ws + WS_LB);
    const float qscale = 0.08838834764831845f;
    const int nitems = NB * NH * 2 * 36;
#define SP_LOADS(it_, Q_, Z_, V_) do { const int c_ = (it_) % 36, dir_ = ((it_) / 36) & 1, hd_ = ((it_) / 72) % NH, b_ = (it_) / (72 * NH); \
        const int qcol_ = (MODE == 0 ? hd_ * 128 : 1536 + hd_ * 128) + 2 * dp, zcol_ = (MODE == 0 ? 1024 * (1 + dir_) + hd_ * 128 : 2048 + hd_ * 128) + 2 * dp, vcol_ = (MODE == 0 ? 3072 + hd_ * 128 : 2560 + hd_ * 256) + 2 * dp; \
        _Pragma("unroll") for (int j = 0; j < 8; ++j) { const bf16_t* pr = P + (size_t)(b_ * S + scan_tok(dir_, c_ * 64 + pg * 8 + j)) * LDP; \
            Q_[j] = *(const unsigned*)(pr + qcol_); Z_[j] = *(const unsigned*)(pr + zcol_); \
            _Pragma("unroll") for (int vv = 0; vv < NVP; ++vv) V_[vv][j] = *(const unsigned*)(pr + vcol_ + vv * 128); } } while (0)
    unsigned nz[8], nq[8], nv[NVP][8];
    if ((int)blockIdx.x < nitems) SP_LOADS((int)blockIdx.x, nq, nz, nv);
    for (int item = blockIdx.x; item < nitems; item += gridDim.x) {
        const int c = item % 36, dir = (item / 36) & 1, hd = (item / 72) % NH, b = item / (72 * NH);
        char* rec = (char*)(a.ws + (MODE == 0 ? WS_SREC : WS_SREC1)) + (size_t)item * REC_BYTES;
        char* vt = (char*)(a.ws + (MODE == 0 ? WS_SVT : WS_SVT1)) + (size_t)item * (DV * PA);
        unsigned zq[8], qq[8], kq[8], vq[NVP][8];
#pragma unroll
        for (int j = 0; j < 8; ++j) { qq[j] = nq[j]; zq[j] = nz[j]; kq[j] = nz[j];
#pragma unroll
            for (int vv = 0; vv < NVP; ++vv) vq[vv][j] = nv[vv][j]; }
        float lb0 = 0.f, lb1 = 0.f, gb0 = 0.f, gb1 = 0.f; float w0[16], w1[16]; u32x2 av = {0u, 0u};
        if (MODE == 0) { lb0 = lb[dir * 1024 + hd * 128 + 2 * dp]; lb1 = lb[dir * 1024 + hd * 128 + 2 * dp + 1]; }
        else { const int wc_ = hd * 128 + 2 * dp; gb0 = a.in[22][dir * 512 + wc_]; gb1 = a.in[22][dir * 512 + wc_ + 1];
#pragma unroll
            for (int i = 0; i < 16; ++i) { const float2 wv = *(const float2*)(a.in[21] + (size_t)(dir * 16 + i) * 512 + wc_); w0[i] = wv.x; w1[i] = wv.y; }
            const int pos = (tid & 255) >> 2, qd = tid & 3; const int r = b * S + scan_tok(dir, c * 64 + pos);
            av = *(const u32x2*)(P + (size_t)r * LDP + 4608 + dir * 16 + qd * 4); }
        __builtin_amdgcn_sched_barrier(0);
        { const int nxt = item + (int)gridDim.x < nitems ? item + (int)gridDim.x : item; SP_LOADS(nxt, nq, nz, nv); }
        __builtin_amdgcn_sched_barrier(0);
        if (MODE == 1) { if (tid < 256) { const int pos = tid >> 2, qd = tid & 3; *(f32x4*)(aT + pos * 16 + qd * 4) = (f32x4){bflo(av.x), bfhi(av.x), bflo(av.y), bfhi(av.y)}; }
            LDS_BARRIER(); }
        float g0[8], g1[8], k0[8], k1[8];
        if (MODE == 0) {
#pragma unroll
            for (int j = 0; j < 8; ++j) { const float f0 = lb0 + (1.f - lb0) * sigmoidf_(bflo(zq[j])), f1 = lb1 + (1.f - lb1) * sigmoidf_(bfhi(zq[j]));
                g0[j] = __logf(f0); g1[j] = __logf(f1); k0[j] = 1.f - f0; k1[j] = 1.f - f1; } }
        else {
#pragma unroll
            for (int j = 0; j < 8; ++j) { float z0 = gb0, z1 = gb1;
#pragma unroll
                for (int i4 = 0; i4 < 4; ++i4) { const f32x4 av = *(const f32x4*)(aT + (pg * 8 + j) * 16 + i4 * 4);
#pragma unroll
                    for (int e = 0; e < 4; ++e) { z0 += av[e] * w0[i4 * 4 + e]; z1 += av[e] * w1[i4 * 4 + e]; } }
                g0[j] = (fminf(z0, 0.f) - __logf(1.f + __expf(-fabsf(z0)))) * (1.f / 16.f); g1[j] = (fminf(z1, 0.f) - __logf(1.f + __expf(-fabsf(z1)))) * (1.f / 16.f);
                k0[j] = bflo(kq[j]); k1[j] = bfhi(kq[j]); } }
#pragma unroll
        for (int j = 1; j < 8; ++j) { g0[j] += g0[j - 1]; g1[j] += g1[j - 1]; }
        *(float2*)(tot + pg * 128 + 2 * dp) = make_float2(g0[7], g1[7]);
        LDS_BARRIER();
        float off0 = 0.f, off1 = 0.f, ref0 = 0.f, ref1 = 0.f, last0 = 0.f, last1 = 0.f;
#pragma unroll
        for (int p = 0; p < 8; ++p) { const float2 tp = *(const float2*)(tot + p * 128 + 2 * dp);
            if (p < pg) { off0 += tp.x; off1 += tp.y; } if (p < 4) { ref0 += tp.x; ref1 += tp.y; } last0 += tp.x; last1 += tp.y; }
        unsigned kh0[4], kh1[4];
        const float eref0 = __expf(ref0), eref1 = __expf(ref1), elr0 = __expf(last0 - ref0), elr1 = __expf(last1 - ref1);
#pragma unroll
        for (int j = 0; j < 8; j += 2) { float kha[2], khb[2];
#pragma unroll
            for (int e = 0; e < 2; ++e) { const int i = pg * 8 + j + e; const float G0 = off0 + g0[j + e], G1 = off1 + g1[j + e];
                float q0 = bflo(qq[j + e]), q1 = bfhi(qq[j + e]); if (MODE == 0) { q0 = siluf_(q0); q1 = siluf_(q1); } q0 *= qscale; q1 *= qscale;
                const float kk0 = k0[j + e], kk1 = k1[j + e];
                const float qt0 = q0 * __expf(G0 - ref0), qt1 = q1 * __expf(G1 - ref1), kt0 = kk0 * __expf(ref0 - G0), kt1 = kk1 * __expf(ref1 - G1);
                *(unsigned*)(QT + i * PQ + dp * 4) = cvtpk(qt0, qt1);
                *(unsigned*)(KT + i * PQ + dp * 4) = cvtpk(kt0, kt1);
                *(unsigned*)(rec + REC_QH + i * PQ + dp * 4) = cvtpk(qt0 * eref0, qt1 * eref1);
                kha[e] = kt0 * elr0; khb[e] = kt1 * elr1; }
            kh0[j >> 1] = cvtpk(kha[0], kha[1]); kh1[j >> 1] = cvtpk(khb[0], khb[1]); }
        *(u32x4*)(rec + REC_KHT + (2 * dp) * PA + pg * 16) = (u32x4){kh0[0], kh0[1], kh0[2], kh0[3]};
        *(u32x4*)(rec + REC_KHT + (2 * dp + 1) * PA + pg * 16) = (u32x4){kh1[0], kh1[1], kh1[2], kh1[3]};
        if (pg == 0) *(float2*)(rec + REC_AL + dp * 8) = make_float2(__expf(last0), __expf(last1));
#pragma unroll
        for (int vv = 0; vv < NVP; ++vv) { const int v0 = vv * 128 + 2 * dp; unsigned lo[4], hi[4];
#pragma unroll
            for (int j = 0; j < 8; j += 2) { lo[j >> 1] = (vq[vv][j] & 0xffffu) | (vq[vv][j + 1] << 16); hi[j >> 1] = (vq[vv][j] >> 16) | (vq[vv][j + 1] & 0xffff0000u); }
            *(u32x4*)(vt + v0 * PA + pg * 16) = (u32x4){lo[0], lo[1], lo[2], lo[3]};
            *(u32x4*)(vt + (v0 + 1) * PA + pg * 16) = (u32x4){hi[0], hi[1], hi[2], hi[3]}; }
        asm volatile("s_waitcnt lgkmcnt(0)" ::: "memory"); __builtin_amdgcn_s_barrier();
        { const int ti = wid >> 1; f32x4 acc[2] = {};
#pragma unroll
          for (int kk = 0; kk < 4; ++kk) { const int i = ti * 16 + l15;
              const bf16x8 bq = *(const bf16x8*)(QT + i * PQ + (kk * 32 + l4 * 8) * 2);
#pragma unroll
              for (int t2_ = 0; t2_ < 2; ++t2_) { const int sidx = ((wid & 1) * 2 + t2_) * 16 + l15;
                  const bf16x8 ak = *(const bf16x8*)(KT + sidx * PQ + (kk * 32 + l4 * 8) * 2);
                  acc[t2_] = __builtin_amdgcn_mfma_f32_16x16x32_bf16(ak, bq, acc[t2_], 0, 0, 0); } }
#pragma unroll
          for (int t2_ = 0; t2_ < 2; ++t2_) { const int tj = (wid & 1) * 2 + t2_, i = ti * 16 + l15, s0 = tj * 16 + 4 * l4;
              float x0 = (s0 + 0 <= i) ? acc[t2_][0] : 0.f, x1 = (s0 + 1 <= i) ? acc[t2_][1] : 0.f, x2 = (s0 + 2 <= i) ? acc[t2_][2] : 0.f, x3 = (s0 + 3 <= i) ? acc[t2_][3] : 0.f;
              u32x2 w_; w_.x = cvtpk(x0, x1); w_.y = cvtpk(x2, x3);
              *(u32x2*)(rec + REC_A + i * PA + s0 * 2) = w_; } }
    }
#undef SP_LOADS
    __syncthreads();
}
template <int MODE>
DEV void scan_seq_phase(const Args& a, char* smem) {
    constexpr int NH = MODE == 0 ? 8 : 4, DV = MODE == 0 ? 128 : 256, NVS = DV / 32;
    constexpr int B_A = REC_A, B_QH = REC_QH, B_KHT = REC_KHT, B_AL = REC_AL, B_VT = REC_BYTES, VTS = 32 * PA, BUFB = REC_BYTES + VTS;
    constexpr int NPIECE = BUFB / 16, NREC = REC_BYTES / 16, STB = 32 * PQ, NLD = 7 * 64;
    constexpr int NRL = (REC_BYTES / 128 + NVS - 1) / NVS, TOUCH_OFF = 3 * BUFB + STB;
    static_assert(NPIECE == 7 * NLD && REC_BYTES % 128 == 0 && VTS == 36 * 128 && NRL + 36 <= 128 && TOUCH_OFF + 256 <= LDS_BYTES_C - 16, "scan_seq layout");
    const int tid = tid_opaque(), wid = tid >> 6, lane = tid & 63, l15 = lane & 15, l4 = lane >> 4;
    char* ST = smem + 3 * BUFB;
    float* odir = (float*)(a.ws + WS_ODIR);
    for (int item = blockIdx.x; item < NB * NH * 2 * NVS; item += gridDim.x) {
        const int vs = (item >> 3) % NVS, rest = (item & 7) + 8 * ((item >> 3) / NVS);
        const int dir = rest & 1, hd = (rest >> 1) % NH, b = (rest >> 1) / NH;
        const char* rec0 = (const char*)(a.ws + (MODE == 0 ? WS_SREC : WS_SREC1)) + (size_t)rest * 36 * REC_BYTES;
        const char* vt0 = (const char*)(a.ws + (MODE == 0 ? WS_SVT : WS_SVT1)) + (size_t)rest * 36 * (DV * PA) + vs * VTS;
#define SC_LOAD(cc, bb) do { if (wid < 7) { const char* _r = rec0 + (size_t)(cc) * REC_BYTES; const char* _v = vt0 + (size_t)(cc) * (DV * PA) - REC_BYTES; char* _l = smem + (bb) * BUFB; \
        _Pragma("unroll") for (int _k = 0; _k < 7; ++_k) { const int _p = tid + _k * NLD; \
            __builtin_amdgcn_global_load_lds((const unsigned*)((_p < NREC ? _r : _v) + _p * 16), (unsigned*)(_l + _p * 16), 16, 0, 0); } } } while (0)
#define SC_TOUCH(cc) do { if (wid == 7) { _Pragma("unroll") for (int _q = 0; _q < 2; ++_q) { const int L_ = _q * 64 + lane; const char* tp_; \
        if (L_ < NRL) { int li_ = vs * NRL + L_; li_ = li_ < REC_BYTES / 128 - 1 ? li_ : REC_BYTES / 128 - 1; tp_ = rec0 + (size_t)(cc) * REC_BYTES + li_ * 128; } \
        else { int li_ = L_ - NRL; li_ = li_ < 35 ? li_ : 35; tp_ = vt0 + (size_t)(cc) * (DV * PA) + li_ * 128; } \
        __builtin_amdgcn_global_load_lds((const unsigned*)tp_, (unsigned*)(smem + TOUCH_OFF), 4, 0, 0); } } } while (0)
        for (int i = tid; i < STB / 16; i += NT) ((u32x4*)ST)[i] = (u32x4){0u, 0u, 0u, 0u};
        f32x4 Sacc[2] = {};
        SC_LOAD(0, 0); SC_LOAD(1, 1); SC_TOUCH(2); SC_TOUCH(3);
        asm volatile("s_waitcnt vmcnt(0) lgkmcnt(0)" ::: "memory"); __builtin_amdgcn_s_barrier(); asm volatile("" ::: "memory");
        int rb = 0;
#pragma unroll 1
        for (int c = 0; c < 36; ++c) {
            const char* buf = smem + rb * BUFB; const char* STr = ST; char* STw = ST;
            { const int nb2 = rb == 0 ? 2 : rb - 1;
              if (c + 2 < 36) SC_LOAD(c + 2, nb2); }
            rb = rb == 2 ? 0 : rb + 1;
            { const int ti = wid >> 1, tj = wid & 1, i = ti * 16 + l15, v = tj * 16 + l15, dr = wid * 16 + l15;
              bf16x8 ba[2], as_[4], bq[4], ak[2], bv[2][2];
#pragma unroll
              for (int kk = 0; kk < 2; ++kk) { ba[kk] = *(const bf16x8*)(buf + B_A + i * PA + (kk * 32 + l4 * 8) * 2); ak[kk] = *(const bf16x8*)(buf + B_KHT + dr * PA + (kk * 32 + l4 * 8) * 2);
                  bv[0][kk] = *(const bf16x8*)(buf + B_VT + l15 * PA + (kk * 32 + l4 * 8) * 2); bv[1][kk] = *(const bf16x8*)(buf + B_VT + (16 + l15) * PA + (kk * 32 + l4 * 8) * 2); }
              const f32x4 al = *(const f32x4*)(buf + B_AL + (wid * 16 + 4 * l4) * 4);
#pragma unroll
              for (int kk = 0; kk < 4; ++kk) { as_[kk] = *(const bf16x8*)(STr + v * PQ + (kk * 32 + l4 * 8) * 2); bq[kk] = *(const bf16x8*)(buf + B_QH + i * PQ + (kk * 32 + l4 * 8) * 2); }
              __builtin_amdgcn_sched_barrier(0);
              asm volatile("s_waitcnt lgkmcnt(0)" : "+v"(as_[0]), "+v"(as_[1]), "+v"(as_[2]), "+v"(as_[3]) :: "memory"); __builtin_amdgcn_s_barrier(); asm volatile("" ::: "memory");
              f32x4 acc = {}; Sacc[0] *= al; Sacc[1] *= al;
#pragma unroll
              for (int kk = 0; kk < 2; ++kk) {
                  acc = __builtin_amdgcn_mfma_f32_16x16x32_bf16(tj ? bv[1][kk] : bv[0][kk], ba[kk], acc, 0, 0, 0);
                  Sacc[0] = __builtin_amdgcn_mfma_f32_16x16x32_bf16(ak[kk], bv[0][kk], Sacc[0], 0, 0, 0);
                  Sacc[1] = __builtin_amdgcn_mfma_f32_16x16x32_bf16(ak[kk], bv[1][kk], Sacc[1], 0, 0, 0); }
#pragma unroll
              for (int kk = 0; kk < 4; ++kk) acc = __builtin_amdgcn_mfma_f32_16x16x32_bf16(as_[kk], bq[kk], acc, 0, 0, 0);
#pragma unroll
              for (int tv = 0; tv < 2; ++tv) { u32x2 w_; w_.x = cvtpk(Sacc[tv][0], Sacc[tv][1]); w_.y = cvtpk(Sacc[tv][2], Sacc[tv][3]);
                  *(u32x2*)(STw + (tv * 16 + l15) * PQ + (wid * 16 + 4 * l4) * 2) = w_; }
              const int r = b * S + scan_tok(dir, c * 64 + i);
              *(f32x4*)(odir + ((size_t)dir * R + r) * 1024 + hd * DV + vs * 32 + tj * 16 + 4 * l4) = acc; }
            SC_TOUCH(c + 4 < 36 ? c + 4 : 35);
            if (wid < 7) { if (c + 2 < 36) asm volatile("s_waitcnt vmcnt(8)" ::: "memory"); else asm volatile("s_waitcnt vmcnt(1)" ::: "memory"); } else asm volatile("s_waitcnt vmcnt(9)" ::: "memory");
            asm volatile("s_waitcnt lgkmcnt(0)" ::: "memory"); __builtin_amdgcn_s_barrier(); asm volatile("" ::: "memory");
        }
#undef SC_LOAD
#undef SC_TOUCH
    }
    asm volatile("s_waitcnt vmcnt(0)" ::: "memory"); __syncthreads();
}

namespace fa {
typedef short s16x4 __attribute__((ext_vector_type(4)));
typedef float f32x16 __attribute__((ext_vector_type(16)));
constexpr int QBLK = 32, KVBLK = 64, NW = 8;
constexpr float THR = 8.f;
#define FA_SBAR() __builtin_amdgcn_sched_barrier(0)
DEV int crow(int r, int hi) { return (r & 3) + 8 * (r >> 2) + 4 * hi; }
template <int DQ> DEV int kswz(int row, int colB) { return row * (DQ * 2) + (colB ^ ((row & 7) << 4)); }
template <int DQ> DEV void partialSM(f32x16& p0, f32x16& p1, float& m_reg, float& mn, float& alpha) {
    constexpr float SCALE = DQ == 128 ? 0.08838834764831845f : 0.07216878364870322f;
    constexpr float C = SCALE * 1.4426950408889634f;
    float pmax = p0[0];
#pragma unroll
    for (int r = 1; r < 16; ++r) pmax = fmaxf(pmax, p0[r]);
#pragma unroll
    for (int r = 0; r < 16; ++r) pmax = fmaxf(pmax, p1[r]);
    { auto rr = __builtin_amdgcn_permlane32_swap(__float_as_uint(pmax), __float_as_uint(pmax), false, false);
      pmax = fmaxf(__uint_as_float(rr[0]), __uint_as_float(rr[1])); }
    if (__builtin_expect(__all(pmax - m_reg <= THR / SCALE), 1)) { mn = m_reg; alpha = 1.f; }
    else { mn = fmaxf(m_reg, pmax); alpha = __builtin_amdgcn_exp2f((m_reg - mn) * C); m_reg = mn; }
    const float mnC = -mn * C;
#pragma unroll
    for (int r = 0; r < 16; ++r) p0[r] = fmaf(p0[r], C, mnC);
#pragma unroll
    for (int r = 0; r < 16; ++r) p1[r] = fmaf(p1[r], C, mnC);
#pragma unroll
    for (int r = 0; r < 16; ++r) p0[r] = __builtin_amdgcn_exp2f(p0[r]);
}
DEV void finishSM(f32x16& p0, f32x16& p1, float alpha, float& l_reg, bf16x8& pa0, bf16x8& pa1, bf16x8& pa2, bf16x8& pa3) {
#pragma unroll
    for (int r = 0; r < 16; ++r) p1[r] = __builtin_amdgcn_exp2f(p1[r]);
    float ps = 0;
#pragma unroll
    for (int r = 0; r < 16; ++r) ps += p0[r];
#pragma unroll
    for (int r = 0; r < 16; ++r) ps += p1[r];
    { auto rr = __builtin_amdgcn_permlane32_swap(__float_as_uint(ps), __float_as_uint(ps), false, false);
      ps = __uint_as_float(rr[0]) + __uint_as_float(rr[1]); }
    l_reg = l_reg * alpha + ps;
#define FA_PK4(P, BASE, OUT) do { unsigned a0 = cvtpk(P[BASE + 0], P[BASE + 1]), a1 = cvtpk(P[BASE + 2], P[BASE + 3]);   \
    unsigned b0 = cvtpk(P[BASE + 4], P[BASE + 5]), b1 = cvtpk(P[BASE + 6], P[BASE + 7]);                              \
    auto r0 = __builtin_amdgcn_permlane32_swap(a0, b0, false, false); auto r1 = __builtin_amdgcn_permlane32_swap(a1, b1, false, false); \
    u32x4 w = {r0[0], r1[0], r0[1], r1[1]}; OUT = *reinterpret_cast<bf16x8*>(&w); } while (0)
    FA_PK4(p0, 0, pa0); FA_PK4(p0, 8, pa1); FA_PK4(p1, 0, pa2); FA_PK4(p1, 8, pa3);
#undef FA_PK4
}
template <int DQ> DEV void qkt(f32x16& p0, f32x16& p1, const char* Ks, const bf16x8* qr, int r32, int hi) {
    p0 = f32x16{}; p1 = f32x16{};
#pragma unroll
    for (int d0 = 0; d0 < DQ / 16; ++d0) { const int cb = (d0 * 16 + hi * 8) * 2;
        const bf16x8 b0 = *reinterpret_cast<const bf16x8*>(Ks + kswz<DQ>(r32, cb));
        const bf16x8 b1 = *reinterpret_cast<const bf16x8*>(Ks + kswz<DQ>(32 + r32, cb));
        p0 = __builtin_amdgcn_mfma_f32_32x32x16_bf16(b0, qr[d0], p0, 0, 0, 0);
        p1 = __builtin_amdgcn_mfma_f32_32x32x16_bf16(b1, qr[d0], p1, 0, 0, 0); }
}
DEV int v_st(int k, int c) { const int kk = (k & ~0xC) | ((k & 4) << 1) | ((k & 8) >> 1); return ((kk >> 3) * 4 + (c >> 5)) * 512 + ((kk & 7) * 32 + (c & 31)) * 2; }
DEV int v_rd_base(int lane) { return ((lane & 3) << 3) | (((lane >> 2) & 3) << 6) | (((lane >> 4) & 1) << 5) | (((lane >> 5) & 1) << 8); }
constexpr int v_rd_off(int d0, int ks, int half) { return d0 * 512 + ks * 4096 + half * 2048; }
template <int OFF> DEV s16x4 tr_read(int vb) { s16x4 r; asm volatile("ds_read_b64_tr_b16 %0, %1 offset:%2" : "=&v"(r) : "v"(vb), "i"(OFF) : "memory"); return r; }
template <int D0> DEV void pv_one(f32x16& od, int vb, bf16x8 pa0, bf16x8 pa1, bf16x8 pa2, bf16x8 pa3) {
    const s16x4 l0 = tr_read<v_rd_off(D0, 0, 0)>(vb), h0 = tr_read<v_rd_off(D0, 0, 1)>(vb), l1 = tr_read<v_rd_off(D0, 1, 0)>(vb), h1 = tr_read<v_rd_off(D0, 1, 1)>(vb);
    const s16x4 l2 = tr_read<v_rd_off(D0, 2, 0)>(vb), h2 = tr_read<v_rd_off(D0, 2, 1)>(vb), l3 = tr_read<v_rd_off(D0, 3, 0)>(vb), h3 = tr_read<v_rd_off(D0, 3, 1)>(vb);
    asm volatile("s_waitcnt lgkmcnt(0)" ::: "memory"); FA_SBAR();
#define FA_PK(L, H) (bf16x8){L[0], L[1], L[2], L[3], H[0], H[1], H[2], H[3]}
    od = __builtin_amdgcn_mfma_f32_32x32x16_bf16(pa0, FA_PK(l0, h0), od, 0, 0, 0);
    od = __builtin_amdgcn_mfma_f32_32x32x16_bf16(pa1, FA_PK(l1, h1), od, 0, 0, 0);
    od = __builtin_amdgcn_mfma_f32_32x32x16_bf16(pa2, FA_PK(l2, h2), od, 0, 0, 0);
    od = __builtin_amdgcn_mfma_f32_32x32x16_bf16(pa3, FA_PK(l3, h3), od, 0, 0, 0);
#undef FA_PK
}
DEV void pv_d0(f32x16* o, int vb, bf16x8 pa0, bf16x8 pa1, bf16x8 pa2, bf16x8 pa3) {
    pv_one<0>(o[0], vb, pa0, pa1, pa2, pa3); pv_one<1>(o[1], vb, pa0, pa1, pa2, pa3); pv_one<2>(o[2], vb, pa0, pa1, pa2, pa3); pv_one<3>(o[3], vb, pa0, pa1, pa2, pa3);
}
template <int DQ>
DEV void attn_body(const bf16_t* __restrict__ Qb, const bf16_t* __restrict__ Kh, const bf16_t* __restrict__ Vh, bf16_t* __restrict__ Ob, int LDO_, int seq_, char* lds) {
    constexpr int LDO = D, seq = S; (void)LDO_; (void)seq_;
    constexpr int NKC = DQ / 64, KC8 = DQ / 8;
    constexpr int SHM_V = KVBLK * 128 * 2, SHM_K = KVBLK * DQ * 2;
    const int tid = tid_opaque(), wid = tid >> 6, lane = tid & 63, r32 = lane & 31, hi = lane >> 5;
    char* V_lds = lds; char* K_lds = lds + 2 * SHM_V;
    float* wsx = (float*)(lds + 2 * SHM_V + 2 * SHM_K) + wid * 64; float* li_l = wsx; float* al_l = wsx + 32;
    float m_reg = -1e30f, l_reg = 0; f32x16 o[4] = {}; bf16x8 qr[DQ / 16];
    const bf16_t* Qw = Qb + (size_t)(wid * QBLK + r32) * DQ + hi * 8;
#pragma unroll
    for (int d0 = 0; d0 < DQ / 16; ++d0) qr[d0] = *reinterpret_cast<const bf16x8*>(Qw + d0 * 16);
    const int sr = tid >> 4, sc = (tid & 15) * 8;
    const int vb0 = (int)(uintptr_t)V_lds + v_rd_base(lane);
    struct { bf16x8 vs0, vs1, ks[NKC]; } sr_[2];
#define SLOAD(i, k0) do { sr_[i].vs0 = *reinterpret_cast<const bf16x8*>(&Vh[(size_t)((k0) + sr) * 128 + sc]); sr_[i].vs1 = *reinterpret_cast<const bf16x8*>(&Vh[(size_t)((k0) + 32 + sr) * 128 + sc]); \
    _Pragma("unroll") for (int _c = 0; _c < NKC; ++_c) { const int ch = tid + _c * 512, kr = ch / KC8, kc = ch - kr * KC8; sr_[i].ks[_c] = *reinterpret_cast<const bf16x8*>(&Kh[(size_t)((k0) + kr) * DQ + kc * 8]); } } while (0)
#define SWRITE(b, i) do { const int t2_ = tid_opaque(), sr2_ = t2_ >> 4, sc2_ = (t2_ & 15) * 8; *(bf16x8*)(V_lds + (b) * SHM_V + v_st(sr2_, sc2_)) = sr_[i].vs0; *(bf16x8*)(V_lds + (b) * SHM_V + v_st(32 + sr2_, sc2_)) = sr_[i].vs1; \
    _Pragma("unroll") for (int _c = 0; _c < NKC; ++_c) { const int ch = tid + _c * 512, kr = ch / KC8, kc = ch - kr * KC8; *(bf16x8*)(K_lds + (b) * SHM_K + kswz<DQ>(kr, kc * 16)) = sr_[i].ks[_c]; } } while (0)
#define SWAIT() do { if constexpr (NKC == 2) asm volatile("s_waitcnt vmcnt(4)" ::: "memory"); else asm volatile("s_waitcnt vmcnt(5)" ::: "memory"); } while (0)
#define RESC(a_) do { if (__any((a_) < 1.f)) { if (hi == 0) al_l[r32] = (a_); asm volatile("s_waitcnt lgkmcnt(0)" ::: "memory"); \
    _Pragma("unroll") for (int d = 0; d < 4; ++d) _Pragma("unroll") for (int r = 0; r < 16; ++r) o[d][r] *= al_l[crow(r, hi)]; } } while (0)
    f32x16 pA0, pA1, pB0, pB1; float mnA, mnB, alA, alB; bf16x8 pa0, pa1, pa2, pa3; const int NTL = seq / KVBLK;
    constexpr int SE = 0, SO = 1;
    SLOAD(SE, 0); asm volatile("s_waitcnt vmcnt(0)" ::: "memory"); SWRITE(0, SE); __syncthreads();
    qkt<DQ>(pA0, pA1, K_lds, qr, r32, hi); partialSM<DQ>(pA0, pA1, m_reg, mnA, alA);
    SLOAD(SO, KVBLK); if (2 < NTL) SLOAD(SE, 2 * KVBLK);
    SWAIT(); SWRITE(1, SO); __syncthreads();
    for (int j = 1; j + 1 < NTL; j += 2) {
        FA_SBAR(); qkt<DQ>(pB0, pB1, K_lds + SHM_K, qr, r32, hi);
        finishSM(pA0, pA1, alA, l_reg, pa0, pa1, pa2, pa3); FA_SBAR();
        SLOAD(SO, (j + 2) * KVBLK); FA_SBAR();
        pv_d0(o, vb0, pa0, pa1, pa2, pa3); partialSM<DQ>(pB0, pB1, m_reg, mnB, alB);
        __syncthreads(); SWAIT(); SWRITE(0, SE);
        RESC(alB); __syncthreads();
        FA_SBAR(); qkt<DQ>(pA0, pA1, K_lds, qr, r32, hi);
        finishSM(pB0, pB1, alB, l_reg, pa0, pa1, pa2, pa3); FA_SBAR();
        if (j + 3 < NTL) SLOAD(SE, (j + 3) * KVBLK); FA_SBAR();
        pv_d0(o, vb0 + SHM_V, pa0, pa1, pa2, pa3); partialSM<DQ>(pA0, pA1, m_reg, mnA, alA);
        __syncthreads(); SWAIT(); SWRITE(1, SO);
        RESC(alA); __syncthreads();
    }
    FA_SBAR(); qkt<DQ>(pB0, pB1, K_lds + SHM_K, qr, r32, hi);
    finishSM(pA0, pA1, alA, l_reg, pa0, pa1, pa2, pa3); FA_SBAR();
    pv_d0(o, vb0, pa0, pa1, pa2, pa3); partialSM<DQ>(pB0, pB1, m_reg, mnB, alB);
    __syncthreads(); RESC(alB);
    finishSM(pB0, pB1, alB, l_reg, pa0, pa1, pa2, pa3); FA_SBAR();
    pv_d0(o, vb0 + SHM_V, pa0, pa1, pa2, pa3);
    if (hi == 0) li_l[r32] = l_reg; asm volatile("s_waitcnt lgkmcnt(0)" ::: "memory");
    float rli[16];
#pragma unroll
    for (int r = 0; r < 16; ++r) rli[r] = __builtin_amdgcn_rcpf(li_l[crow(r, hi)]);
    bf16_t* Ow = Ob + (size_t)(wid * QBLK) * LDO;
#pragma unroll
    for (int r = 0; r < 16; ++r) { const int orow = crow(r, hi);
#pragma unroll
        for (int d0 = 0; d0 < 4; ++d0) Ow[(size_t)orow * LDO + d0 * 32 + r32] = f2bf(o[d0][r] * rli[r]); }
    __syncthreads();
#undef SLOAD
#undef SWRITE
#undef SWAIT
#undef RESC
}

template <int DQ>
DEV void attn_body_simple(const bf16_t* __restrict__ Qb, const bf16_t* __restrict__ Kh, const bf16_t* __restrict__ Vh, bf16_t* __restrict__ Ob, int LDO, int seq, char* lds) {
    constexpr int NKC = DQ / 64, KC8 = DQ / 8;
    constexpr int SHM_V = KVBLK * 128 * 2, SHM_K = KVBLK * DQ * 2;
    const int tid = tid_opaque(), wid = tid >> 6, lane = tid & 63, r32 = lane & 31, hi = lane >> 5;
    char* V_lds = lds; char* K_lds = lds + 2 * SHM_V;
    float* wsx = (float*)(lds + 2 * SHM_V + 2 * SHM_K) + wid * 64; float* li_l = wsx; float* al_l = wsx + 32;
    float m_reg = -1e30f, l_reg = 0; f32x16 o[4] = {}; bf16x8 qr[DQ / 16];
    const bf16_t* Qw = Qb + (size_t)(wid * QBLK + r32) * DQ + hi * 8;
#pragma unroll
    for (int d0 = 0; d0 < DQ / 16; ++d0) qr[d0] = *reinterpret_cast<const bf16x8*>(Qw + d0 * 16);
    const int sr = tid >> 4, sc = (tid & 15) * 8, vst0 = v_st(sr, sc), vst1 = v_st(32 + sr, sc);
    const int vb0 = (int)(uintptr_t)V_lds + v_rd_base(lane);
    bf16x8 vs0, vs1, ks[NKC];
#define SLOAD(k0) do { vs0 = *reinterpret_cast<const bf16x8*>(&Vh[(size_t)((k0) + sr) * 128 + sc]); vs1 = *reinterpret_cast<const bf16x8*>(&Vh[(size_t)((k0) + 32 + sr) * 128 + sc]); \
    _Pragma("unroll") for (int _c = 0; _c < NKC; ++_c) { const int ch = tid + _c * 512, kr = ch / KC8, kc = ch - kr * KC8; ks[_c] = *reinterpret_cast<const bf16x8*>(&Kh[(size_t)((k0) + kr) * DQ + kc * 8]); } } while (0)
#define SWRITE(b) do { *(bf16x8*)(V_lds + (b) * SHM_V + vst0) = vs0; *(bf16x8*)(V_lds + (b) * SHM_V + vst1) = vs1; \
    _Pragma("unroll") for (int _c = 0; _c < NKC; ++_c) { const int ch = tid + _c * 512, kr = ch / KC8, kc = ch - kr * KC8; *(bf16x8*)(K_lds + (b) * SHM_K + kswz<DQ>(kr, kc * 16)) = ks[_c]; } } while (0)
    f32x16 p0, p1; float mn, al; bf16x8 pa0, pa1, pa2, pa3; const int NTL = seq / KVBLK;
    SLOAD(0); SWRITE(0); __syncthreads();
    for (int j = 0; j < NTL; ++j) {
        const int bsel = j & 1;
        if (j + 1 < NTL) SLOAD((j + 1) * KVBLK);
        FA_SBAR(); qkt<DQ>(p0, p1, K_lds + bsel * SHM_K, qr, r32, hi);
        partialSM<DQ>(p0, p1, m_reg, mn, al);
        if (__any(al < 1.f)) { if (hi == 0) al_l[r32] = al; asm volatile("s_waitcnt lgkmcnt(0)" ::: "memory");
#pragma unroll
            for (int d = 0; d < 4; ++d)
#pragma unroll
                for (int r = 0; r < 16; ++r) o[d][r] *= al_l[crow(r, hi)]; }
        finishSM(p0, p1, al, l_reg, pa0, pa1, pa2, pa3); FA_SBAR();
        pv_d0(o, vb0 + bsel * SHM_V, pa0, pa1, pa2, pa3);
        if (j + 1 < NTL) SWRITE(bsel ^ 1);
        __syncthreads();
    }
    if (hi == 0) li_l[r32] = l_reg; asm volatile("s_waitcnt lgkmcnt(0)" ::: "memory");
    float rli[16];
#pragma unroll
    for (int r = 0; r < 16; ++r) rli[r] = __builtin_amdgcn_rcpf(li_l[crow(r, hi)]);
    bf16_t* Ow = Ob + (size_t)(wid * QBLK) * LDO;
#pragma unroll
    for (int r = 0; r < 16; ++r) { const int orow = crow(r, hi);
#pragma unroll
        for (int d0 = 0; d0 < 4; ++d0) Ow[(size_t)orow * LDO + d0 * 32 + r32] = f2bf(o[d0][r] * rli[r]); }
    __syncthreads();
#undef SLOAD
#undef SWRITE
}
}

template <int DQ, int HKV, bool WITH_CTX>
DEV void attn_phase(const Args& a, int colbase, char* smem) {
    const bf16_t* Qb = (const bf16_t*)(a.ws + WS_QB); const bf16_t* Kb = (const bf16_t*)(a.ws + WS_KB); const bf16_t* Vb = (const bf16_t*)(a.ws + WS_VB);
    bf16_t* A2 = (bf16_t*)(a.ws + WS_A2);
    const int nunits = 256 + (WITH_CTX ? 32 : 0);
    for (int u = blockIdx.x; u < nunits; u += gridDim.x) {
        int b, hh, qb, nk;
        if (u < 256) { if (HKV == 8) { const int bh = u & 31; b = bh >> 3; hh = bh & 7; qb = 1 + (u >> 5); }
                       else { const int pr = u & 7, rest = u >> 3; b = pr >> 1; hh = (pr & 1) * 4 + (rest & 3); qb = 1 + (rest >> 2); }
                       nk = S; }
        else { const int bh = u - 256; b = bh >> 3; hh = bh & 7; qb = 0; nk = TC; }
        const int hk = hh / (8 / HKV);
        if constexpr (DQ == 192) fa::attn_body_simple<DQ>(Qb + (((size_t)b * 8 + hh) * S + qb * 256) * DQ, Kb + ((size_t)b * HKV + hk) * S * DQ, Vb + ((size_t)b * HKV + hk) * S * 128,
                          A2 + ((size_t)b * S + qb * 256) * D + colbase + hh * 128, D, nk, smem);
        else fa::attn_body<DQ>(Qb + (((size_t)b * 8 + hh) * S + qb * 256) * DQ, Kb + ((size_t)b * HKV + hk) * S * DQ, Vb + ((size_t)b * HKV + hk) * S * 128,
                          A2 + ((size_t)b * S + qb * 256) * D + colbase + hh * 128, D, nk, smem);
    }
}

template <int MODE>
DEV void mixout_phase(const Args& a, bool latent_only) {
    const int tid = tid_opaque(), w = tid >> 6, lane = tid & 63;
    constexpr int NH = MODE == 0 ? 8 : 4, DV = MODE == 0 ? 128 : 256, LDP = MODE == 0 ? AB_INP : CD_INP, GC = MODE == 0 ? 4096 : 3584, CB = MODE == 0 ? 0 : 1024, PER = DV / 64;
    const bf16_t* P = (const bf16_t*)(a.ws + WS_P); const float* odir = (const float*)(a.ws + WS_ODIR); bf16_t* A2 = (bf16_t*)(a.ws + WS_A2);
    const float* g = MODE == 0 ? a.in[12] : a.in[23];
    for (int it = blockIdx.x * 8 + w; it < R * NH; it += gridDim.x * 8) {
        const int r = it / NH, hd = it - r * NH; const int t = r % S; if (latent_only && t < TC) continue;
        float o[PER]; float ss = 0.f;
#pragma unroll
        for (int j = 0; j < PER; ++j) { const int c = hd * DV + j * 64 + lane; o[j] = odir[(size_t)r * 1024 + c] + odir[((size_t)R + r) * 1024 + c]; ss += o[j] * o[j]; }
        ss = wave_sum(ss); const float rs = rsqrtf(ss * (1.f / DV) + EPS);
#pragma unroll
        for (int j = 0; j < PER; ++j) { const int c = hd * DV + j * 64 + lane; const float gt = bf2f(P[(size_t)r * LDP + GC + c]);
            const float act = MODE == 0 ? sigmoidf_(gt) : siluf_(gt);
            A2[(size_t)r * D + CB + c] = f2bf(o[j] * rs * g[j * 64 + lane] * act); }
    }
}

#define GAS __attribute__((address_space(1)))
typedef GAS unsigned gu32; typedef GAS unsigned long long gu64;
#define RLX_AGENT __ATOMIC_RELAXED, __HIP_MEMORY_SCOPE_AGENT
struct EpiMoeUpSc1 { bf16_t* hid; int rowbase, nvalid;
    DEV void operator()(const f32x4 (&acc)[2][2][4][2], int brow, int bcol, int wr, int wc, int fr, int fq) const {
        const int hc = (bcol >> 1) + wc * 32 + fq * 4;
#pragma unroll
        for (int ai = 0; ai < 2; ++ai)
#pragma unroll
            for (int m = 0; m < 4; ++m) { const int lr = ai * HALF + wr * 64 + m * 16 + fr;
                if (lr < nvalid) { bf16_t* rowp = hid + (size_t)(rowbase + lr) * EDIM + hc;
#pragma unroll
                    for (int n = 0; n < 2; ++n) { const f32x4 a_ = acc[ai][0][m][n], b_ = acc[ai][1][m][n];
                        const unsigned lo = cvtpk(siluf_(a_[0]) * b_[0], siluf_(a_[1]) * b_[1]), hi = cvtpk(siluf_(a_[2]) * b_[2], siluf_(a_[3]) * b_[3]);
                        __hip_atomic_store((gu64*)(rowp + n * 16), (unsigned long long)lo | ((unsigned long long)hi << 32), RLX_AGENT); } } }
    } };
DEV void moe_phase_fused(const Args& a, int l, char* smem) {
    const int tid = tid_opaque();
    unsigned* ctl = (unsigned*)(a.ws + WS_CTL);
    unsigned* cnt = ctl + CW_CNT + l * 16 * CNT_STRIDE; unsigned* head = ctl + CW_MOEQ + l * 64; unsigned* ready = ctl + CW_RDY + l * (NE * 36 * 16);
    const int* list = (const int*)(a.ws + WS_LIST);
    const bf16_t* h = (const bf16_t*)(a.ws + WS_H); const bf16_t* w13 = moe_w13(a, l); const bf16_t* w2 = moe_w2(a, l);
    bf16_t* hid = (bf16_t*)(a.ws + WS_QB); bf16_t* y = (bf16_t*)(a.ws + WS_P);
    volatile int* tab = (volatile int*)(smem + SHM_GEMM);
    if (tid == 0) { int ub = 0, of = 0, nts[NE];
        for (int e = 0; e < NE; ++e) { const int n = (int)__hip_atomic_load((gu32*)(cnt + e * CNT_STRIDE), RLX_AGENT); nts[e] = (n + 255) >> 8; tab[e] = n; tab[16 + e] = ub; tab[50 + e] = of; ub += nts[e] * 4; of += n; }
        tab[32] = ub; int db = ub;
        for (int e = 0; e < NE; ++e) { tab[33 + e] = db; db += nts[e] * 8; }
        tab[49] = db; }
    for (;;) {
        __syncthreads();
        if (tid == 0) tab[66] = (int)__hip_atomic_fetch_add((gu32*)head, 1u, RLX_AGENT);
        __syncthreads();
        const int item = __builtin_amdgcn_readfirstlane(tab[66]), nup = __builtin_amdgcn_readfirstlane(tab[32]), ntot = __builtin_amdgcn_readfirstlane(tab[49]);
        if (item >= ntot) break;
        const bool up = item < nup; const int tb0 = up ? 16 : 33;
        int e = 0;
#pragma unroll 1
        for (int q = 1; q < NE; ++q) if (item >= __builtin_amdgcn_readfirstlane(tab[tb0 + q])) e = q;
        const int n = __builtin_amdgcn_readfirstlane(tab[e]), nt_ = (n + 255) >> 8, t = item - __builtin_amdgcn_readfirstlane(tab[tb0 + e]), off = __builtin_amdgcn_readfirstlane(tab[50 + e]);
        const int i = t % nt_, pn = t / nt_, nv = min(256, n - i * 256);
        gu32* flag = (gu32*)(ready + (e * 36 + i) * 16);
        if (up) {
            EpiMoeUpSc1 epi{hid, off + i * 256, nv};
            gemm_tile<true>(h, w13 + (size_t)e * 1024 * D, D, D, 0, pn * 256, list + (size_t)e * R + i * 256, nv, smem, epi);
            asm volatile("s_waitcnt vmcnt(0)" ::: "memory");
            __syncthreads();
            if (tid == 0) __hip_atomic_fetch_add(flag, 1u, RLX_AGENT);
        } else {
            if (tid < 64) { unsigned spins = 0;
                while ((unsigned)__builtin_amdgcn_readfirstlane(__hip_atomic_load(flag, RLX_AGENT)) < 4u) { __builtin_amdgcn_s_sleep(2); if (++spins > (1u << 22)) break; }
                __builtin_amdgcn_fence(__ATOMIC_ACQUIRE, "agent");
                asm volatile("s_waitcnt vmcnt(0)" ::: "memory"); }
            __syncthreads();
            EpiMoeDown epi{y, list + (size_t)e * R + i * 256, nv};
            gemm_tile<false>(hid, w2 + (size_t)e * D * EDIM, EDIM, EDIM, off + i * 256, pn * 256, nullptr, 0, smem, epi);
        }
    }
    __syncthreads();
}

DEV void moe_phase_up(const Args& a, int l, char* smem) {
    unsigned* cnt = (unsigned*)(a.ws + WS_CTL) + CW_CNT + l * 16 * CNT_STRIDE;
    const int* list = (const int*)(a.ws + WS_LIST);
    const bf16_t* h = (const bf16_t*)(a.ws + WS_H); const bf16_t* w13 = moe_w13(a, l); bf16_t* hid = (bf16_t*)(a.ws + WS_QB);
    int u = blockIdx.x, base = 0, off = 0;
    for (int e = 0; e < NE; ++e) { const int n = (int)__builtin_amdgcn_readfirstlane(__hip_atomic_load(cnt + e * CNT_STRIDE, __ATOMIC_RELAXED, __HIP_MEMORY_SCOPE_AGENT)), nt_ = (n + 255) >> 8, nu = nt_ * 4;
        for (; u < base + nu; u += gridDim.x) { const int t = u - base, i = t % nt_, pn = t / nt_; const int nv = min(256, n - i * 256);
            EpiMoeUp epi{hid, off + i * 256, nv};
            gemm_tile<true>(h, w13 + (size_t)e * 1024 * D, D, D, 0, pn * 256, list + (size_t)e * R + i * 256, nv, smem, epi); }
        base += nu; off += n; }
}
DEV void moe_phase_down(const Args& a, int l, char* smem) {
    unsigned* cnt = (unsigned*)(a.ws + WS_CTL) + CW_CNT + l * 16 * CNT_STRIDE;
    const int* list = (const int*)(a.ws + WS_LIST);
    const bf16_t* hid = (const bf16_t*)(a.ws + WS_QB); const bf16_t* w2 = moe_w2(a, l); bf16_t* y = (bf16_t*)(a.ws + WS_P);
    int u = blockIdx.x, base = 0, off = 0;
    for (int e = 0; e < NE; ++e) { const int n = (int)__builtin_amdgcn_readfirstlane(__hip_atomic_load(cnt + e * CNT_STRIDE, __ATOMIC_RELAXED, __HIP_MEMORY_SCOPE_AGENT)), nt_ = (n + 255) >> 8, nu = nt_ * 8;
        for (; u < base + nu; u += gridDim.x) { const int t = u - base, i = t % nt_, pn = t / nt_; const int nv = min(256, n - i * 256);
            EpiMoeDown epi{y, list + (size_t)e * R + i * 256, nv};
            gemm_tile<false>(hid, w2 + (size_t)e * D * EDIM, EDIM, EDIM, off + i * 256, pn * 256, nullptr, 0, smem, epi); }
        base += nu; off += n; }
}
template <bool FINAL>
DEV void combine_phase(const Args& a, int l, bool latent_only, bool dry = false) {
    const int tid = tid_opaque(), w = tid >> 6, lane = tid & 63;
    bf16_t* xres = (bf16_t*)(a.ws + WS_XRES); const bf16_t* y = (const bf16_t*)(a.ws + WS_P); const float* tokf = (const float*)(a.ws + WS_TOK);
    const float* modv = (const float*)(a.ws + WS_MODV) + (size_t)l * 5 * MODN; bf16_t* h = (bf16_t*)(a.ws + WS_H);
    const float* gain = FINAL ? a.in[8] : a.in[6] + (size_t)(l + 1) * D;
    const int stride = gridDim.x * 8;
#define CB_SKIP(rr) while ((rr) < R && latent_only && ((rr) % S) < TC) (rr) += stride
#define CB_LOAD(rr, Y0, Y1, XQ, W0, W1) do { const bf16_t* y0_ = y + (size_t)(2 * (rr)) * D; const bf16_t* xp_ = xres + (size_t)(rr) * D; W0 = tokf[(rr) * 4 + 2]; W1 = tokf[(rr) * 4 + 3]; \
        _Pragma("unroll") for (int j = 0; j < 8; ++j) { const int c = j * 256 + lane * 4; Y0[j] = *(const u32x2*)(y0_ + c); Y1[j] = *(const u32x2*)(y0_ + D + c); XQ[j] = *(const u32x2*)(xp_ + c); } } while (0)
    int r = blockIdx.x * 8 + w; CB_SKIP(r);
    u32x2 ny0[8], ny1[8], nxq[8]; float nw0 = 0.f, nw1 = 0.f;
    if (r < R) CB_LOAD(r, ny0, ny1, nxq, nw0, nw1);
    while (r < R) {
        u32x2 cy0[8], cy1[8], cxq[8]; const float w0 = nw0, w1 = nw1;
#pragma unroll
        for (int j = 0; j < 8; ++j) { cy0[j] = ny0[j]; cy1[j] = ny1[j]; cxq[j] = nxq[j]; }
        int rn = r + stride; CB_SKIP(rn);
        if (rn < R) CB_LOAD(rn, ny0, ny1, nxq, nw0, nw1);
        const int b = r / S, t = r - b * S; const int v = t < TC ? 4 : b;
        const float* g2 = modv + (size_t)v * MODN + 5 * D; bf16_t* xp = xres + (size_t)r * D;
        f32x4 x[8]; float ss = 0.f;
#pragma unroll
        for (int j = 0; j < 8; ++j) { const int c = j * 256 + lane * 4;
            const u32x2 a0 = cy0[j], a1 = cy1[j], xq = cxq[j];
            const f32x4 yy = {w0 * bflo(a0.x) + w1 * bflo(a1.x), w0 * bfhi(a0.x) + w1 * bfhi(a1.x), w0 * bflo(a0.y) + w1 * bflo(a1.y), w0 * bfhi(a0.y) + w1 * bfhi(a1.y)};
            x[j] = (f32x4){bflo(xq.x), bfhi(xq.x), bflo(xq.y), bfhi(xq.y)} + *(const f32x4*)(g2 + c) * yy;
            if (!FINAL && !dry) { u32x2 xw; xw.x = cvtpk(x[j][0], x[j][1]); xw.y = cvtpk(x[j][2], x[j][3]); *(u32x2*)(xp + c) = xw; }
            ss += x[j][0] * x[j][0] + x[j][1] * x[j][1] + x[j][2] * x[j][2] + x[j][3] * x[j][3]; }
        ss = wave_sum(ss); const float rs = rsqrtf(ss * (1.f / D) + EPS);
        if (FINAL) { float* op = a.out + ((size_t)b * TL + (t - TC)) * D;
#pragma unroll
            for (int j = 0; j < 8; ++j) { const int c = j * 256 + lane * 4; *(f32x4*)(op + c) = x[j] * rs * *(const f32x4*)(gain + c); } }
        else { const float* sh = modv + 5 * MODN + (size_t)v * MODN; const float* sc = sh + D;
#pragma unroll
            for (int j = 0; j < 8; ++j) { const int c = j * 256 + lane * 4;
                const f32x4 yv = (x[j] * rs * *(const f32x4*)(gain + c)) * (1.f + *(const f32x4*)(sc + c)) + *(const f32x4*)(sh + c);
                u32x2 pk; pk.x = cvtpk(yv[0], yv[1]); pk.y = cvtpk(yv[2], yv[3]); if (!dry) *(u32x2*)(h + (size_t)r * D + c) = pk; } }
        r = rn;
    }
#undef CB_LOAD
#undef CB_SKIP
}

constexpr int LDS_BYTES = LDS_BYTES_C;
constexpr int NPHASES = 25;
__global__ void __launch_bounds__(NT, 2) fwd(Args a) {
    extern __shared__ __attribute__((aligned(16))) char smem[];
    unsigned char* ws = a.ws;
    const int lo = a.ph_lo, hi = a.ph_hi;
    volatile LAS unsigned* xbw = (volatile LAS unsigned*)(smem + LDS_BYTES - 16);
    if (threadIdx.x < 4) xbw[threadIdx.x] = 0u;
    __syncthreads();
    XcdBarrier bar; bar.bar = (unsigned*)(ws + WS_CTL); bar.x = 0; bar.st = xbw;
    if (hi - lo > 1) bar = xcd_barrier_post((unsigned*)(ws + WS_CTL), xbw);
#ifndef BARRIER_REP
#define BARRIER_REP 1
#endif
#ifndef TPROBE_MASK
#define TPROBE_MASK 0u
#endif
#ifndef TPROBE_ALPHA
#define TPROBE_ALPHA 4
#endif
    unsigned long long tp_prev = TPROBE_MASK ? __builtin_amdgcn_s_memrealtime() : 0ull, tp_acc = 0ull;
#define TPROBE(k) do { if (TPROBE_MASK) { const unsigned long long tn_ = __builtin_amdgcn_s_memrealtime(); if ((TPROBE_MASK >> (k)) & 1u) tp_acc += tn_ - tp_prev; tp_prev = tn_; } } while (0)
#ifndef WPROBE_MASK
#define WPROBE_MASK 0u
#endif
    unsigned long long wp_acc = 0ull;
#define SEAM(k) do { if (IN(k) && IN((k) + 1)) { const unsigned long long wa_ = WPROBE_MASK ? __builtin_amdgcn_s_memrealtime() : 0ull; for (int br_ = 0; br_ < BARRIER_REP; ++br_) xcd_barrier(bar); \
        if (WPROBE_MASK && ((WPROBE_MASK >> (k)) & 1u)) wp_acc += __builtin_amdgcn_s_memrealtime() - wa_; TPROBE(k); } } while (0)
#ifndef PHASE_MASK
#define PHASE_MASK 0xFFFFFFFFu
#endif
#define IN(k) (((PHASE_MASK >> (k)) & 1u) && lo <= (k) && (k) < hi)
#ifndef REPEAT_MASK
#define REPEAT_MASK 0u
#endif
#ifndef SUBREP
#define SUBREP 0
#endif
#define PHASE(k) if (IN(k)) for (int rep_ = 0; rep_ < ((((REPEAT_MASK) >> (k)) & 1u) ? 2 : 1); ++rep_, ((((REPEAT_MASK) >> (k)) & 1u) ? __syncthreads() : (void)0))
    const float* modv = (const float*)(ws + WS_MODV);
    bf16_t* H = (bf16_t*)(ws + WS_H); bf16_t* P = (bf16_t*)(ws + WS_P); bf16_t* A2 = (bf16_t*)(ws + WS_A2); bf16_t* XR = (bf16_t*)(ws + WS_XRES);
    PHASE(0) {
        cvt_weight(a.in[9], (bf16_t*)(ws + WS_WABIN), D, AB_IN, AB_INP, 1, 0, 0, 128, 0, nullptr, smem, 2);
        mod_phase<false>(a, 0, smem);
        misc_phase(a);
    }
    SEAM(0);
    PHASE(1) norm_phase<false, true>(a, 0, 0, a.in[6], false, smem);
    SEAM(1);
    PHASE(2) { int cur = 0; EpiInAB e{P, (float*)(ws + WS_SSQ), (bf16_t*)(ws + WS_KB), (const float2*)(ws + WS_TABB), smem};
#ifdef SEAM_PROBE
                 gemm_phase(H, (const bf16_t*)(ws + WS_WABIN), R, AB_INP, D, smem, e, cur, 0, 512); xcd_barrier(bar); cur = 0; gemm_phase(H, (const bf16_t*)(ws + WS_WABIN), R, AB_INP, D, smem, e, cur, 512, 864);
#else
                 gemm_phase(H, (const bf16_t*)(ws + WS_WABIN), R, AB_INP, D, smem, e, cur);
#endif
                 if (rep_ == 0) { cvt_cd_dynamic(a, smem); mod_phase<true>(a, 1, smem); } }
    SEAM(2);
    PHASE(3) { int cur = 0; EpiUQ e1{(bf16_t*)(ws + WS_QB), (const float*)(ws + WS_SSQ), (const float2*)(ws + WS_TABB)};
                 gemm_phase<false, AB_INP>(P + 5120, (const bf16_t*)(ws + WS_WUQ), R, 1536, 512, smem, e1, cur);
                 EpiUKV e2{(bf16_t*)(ws + WS_KB), (bf16_t*)(ws + WS_VB), (const float*)(ws + WS_SSQ)};
                 gemm_phase<false, AB_INP>(P + 5632, (const bf16_t*)(ws + WS_WUKV), R, 2048, 256, smem, e2, cur);
                 scan_prep_phase<0>(a, smem); if (SUBREP & 1) scan_prep_phase<0>(a, smem); }
    SEAM(3);
    PHASE(6) scan_seq_phase<0>(a, smem);
    PHASE(7) attn_phase<192, 8, true>(a, 1024, smem);
    SEAM(7);
    PHASE(8) { mixout_phase<0>(a, false); if (SUBREP & 2) mixout_phase<0>(a, false); }
    SEAM(8);
    PHASE(9) { int cur = 0; EpiResidGate e{XR, modv + 2 * D, rep_ > 0, rep_ > 0 ? nullptr : a.in[0], a.in[2]}; gemm_phase(A2, (const bf16_t*)(ws + WS_WABOUT), R, D, D, smem, e, cur); cvt_moe_dynamic(a, 0, smem); }
    SEAM(9);
    PHASE(10) norm_router_phase(a, 0, 3, a.in[7], false, smem);
    SEAM(10);
#ifndef MOE_SPLIT
    PHASE(11) { moe_phase_fused(a, 0, smem); cvt_moe_dynamic(a, 1, smem); }
    SEAM(11);
#else
    PHASE(11) { moe_phase_up(a, 0, smem); cvt_moe_dynamic(a, 1, smem); }
    SEAM(11);
    PHASE(12) { moe_phase_down(a, 0, smem); cvt_moe_dynamic(a, 1, smem); }
    SEAM(12);
#endif
    PHASE(13) { combine_phase<false>(a, 0, false, rep_ > 0); cvt_moe_dynamic(a, 1, smem); }
    SEAM(13);
    PHASE(15) { int cur = 0; EpiInCD e{P, (bf16_t*)(ws + WS_QB), (bf16_t*)(ws + WS_KB), (bf16_t*)(ws + WS_VB), (const float2*)(ws + WS_TABC), a.in[19], a.in[20], smem}; gemm_phase(H, (const bf16_t*)(ws + WS_WCDIN), R, CD_INP, D, smem, e, cur); }
    SEAM(15);
    PHASE(16) { scan_prep_phase<1>(a, smem); if (SUBREP & 1) scan_prep_phase<1>(a, smem); }
    SEAM(16);
    PHASE(17) scan_seq_phase<1>(a, smem);
    PHASE(18) attn_phase<128, 2, false>(a, 0, smem);
    SEAM(18);
    PHASE(19) { mixout_phase<1>(a, true); if (SUBREP & 2) mixout_phase<1>(a, true); }
    SEAM(19);
    PHASE(20) { int cur = 0; EpiResidGate e{XR, modv + 5 * MODN + 2 * D, rep_ > 0, nullptr, nullptr}; gemm_phase<true>(A2, (const bf16_t*)(ws + WS_WCDOUT), NB * TL, D, D, smem, e, cur); }
    SEAM(20);
    PHASE(21) norm_router_phase(a, 1, 3, a.in[7] + D, true, smem);
    SEAM(21);
#ifndef MOE_SPLIT
    PHASE(22) moe_phase_fused(a, 1, smem);
    SEAM(22);
#else
    PHASE(22) moe_phase_up(a, 1, smem);
    SEAM(22);
    PHASE(23) moe_phase_down(a, 1, smem);
    SEAM(23);
#endif
    PHASE(24) combine_phase<true>(a, 1, true);
    if (TPROBE_MASK) { TPROBE(24);
        if (blockIdx.x == 0) { const unsigned long long t0_ = __builtin_amdgcn_s_memrealtime(); while (__builtin_amdgcn_s_memrealtime() - t0_ < (unsigned long long)TPROBE_ALPHA * tp_acc) __builtin_amdgcn_s_sleep(8); } }
    if (WPROBE_MASK) { unsigned* wsum = (unsigned*)(ws + WS_CTL) + 30000;
        if (threadIdx.x == 0) atomicAdd(wsum, (unsigned)wp_acc);
        xcd_barrier(bar);
        if (blockIdx.x == 0) { const unsigned long long tot_ = __hip_atomic_load(wsum, __ATOMIC_RELAXED, __HIP_MEMORY_SCOPE_AGENT) / gridDim.x;
            const unsigned long long t0_ = __builtin_amdgcn_s_memrealtime(); while (__builtin_amdgcn_s_memrealtime() - t0_ < (unsigned long long)TPROBE_ALPHA * tot_) __builtin_amdgcn_s_sleep(8); } }
#undef IN
#undef PHASE
#undef SEAM
}

extern "C" void kernel_launch(void* const* d_in, const int* in_sizes, int n_in, void* d_out, int out_size, void* d_ws, size_t ws_size, hipStream_t stream) {
    static int grid = 0;
    if (grid == 0) {
        if (n_in != 29 || out_size != NB * TL * D || ws_size < WS_END) { fprintf(stderr, "kernel_launch: shape/workspace mismatch: n_in %d out %d ws %zu (need %zu)\n", n_in, out_size, ws_size, (size_t)WS_END); grid = -1; return; }
        int dev = 0, cus = 0;
        if (hipGetDevice(&dev) != hipSuccess || hipDeviceGetAttribute(&cus, hipDeviceAttributeMultiprocessorCount, dev) != hipSuccess) { grid = -1; return; }
        if (hipFuncSetAttribute((const void*)fwd, hipFuncAttributeMaxDynamicSharedMemorySize, LDS_BYTES) != hipSuccess) { fprintf(stderr, "kernel_launch: hipFuncSetAttribute failed\n"); grid = -1; return; }
        grid = cus > 0 ? cus : 256;
    }
    if (grid < 0) return;
    (void)hipMemsetAsync((char*)d_ws + WS_CTL, 0, CTL_BYTES, stream);
    Args a{};
    for (int i = 0; i < 29; ++i) a.in[i] = (const float*)d_in[i];
    a.out = (float*)d_out; a.ws = (unsigned char*)d_ws;
#ifndef MK_PER_PHASE
    a.ph_lo = 0; a.ph_hi = NPHASES; hipLaunchKernelGGL(fwd, dim3(grid), dim3(NT), LDS_BYTES, stream, a);
#else
    for (int ph = 0; ph < NPHASES; ++ph) { a.ph_lo = ph; a.ph_hi = ph + 1; hipLaunchKernelGGL(fwd, dim3(grid), dim3(NT), LDS_BYTES, stream, a); }
#endif
}
```

```cpp
#include <hip/hip_runtime.h>
#include <cstdio>
#include <cstdint>

#define DEV __device__ __forceinline__
typedef unsigned short bf16_t;
typedef short bf16x8 __attribute__((ext_vector_type(8)));
typedef float f32x4 __attribute__((ext_vector_type(4)));
typedef float f32x2 __attribute__((ext_vector_type(2)));
typedef unsigned u32x4 __attribute__((ext_vector_type(4)));
typedef unsigned u32x2 __attribute__((ext_vector_type(2)));

constexpr int NB = 4, TL = 2048, TC = 256, S = TL + TC, R = NB * S, D = 2048;
constexpr int NT = 512;
constexpr float EPS = 1e-6f;
constexpr int AB_IN = 5952, AB_INP = 6144, CD_IN = 4640, CD_INP = 4864;
constexpr int NE = 16, EDIM = 512;
constexpr int MODN = 6 * D;

constexpr size_t al256(size_t x) { return (x + 255) & ~(size_t)255; }
constexpr size_t WS_CTL = 0;
constexpr int    CW_CNT = 26624;
constexpr int    CNT_STRIDE = 64;
constexpr int    CW_CVT = 4224;
constexpr size_t CTL_BYTES = 131072;
constexpr int    CW_MOEQ = 4608;
constexpr int    CW_RDY = 8192;
constexpr size_t WS_MODV = WS_CTL + CTL_BYTES;
constexpr size_t WS_LB   = al256(WS_MODV + (size_t)2 * 5 * MODN * 4);
constexpr size_t WS_TABB = al256(WS_LB + 2 * 1024 * 4);
constexpr size_t WS_TABC = al256(WS_TABB + (size_t)S * 32 * 8);
constexpr size_t WS_TOK  = al256(WS_TABC + (size_t)S * 64 * 8);
constexpr size_t WS_LIST = al256(WS_TOK + (size_t)R * 16);
constexpr size_t WS_WABIN = al256(WS_LIST + (size_t)NE * R * 4);
constexpr size_t WS_WABOUT = al256(WS_WABIN + (size_t)AB_INP * D * 2);
constexpr size_t WS_WUQ  = al256(WS_WABOUT + (size_t)D * D * 2);
constexpr size_t WS_WUKV = al256(WS_WUQ + (size_t)1536 * 512 * 2);
constexpr size_t WS_WCDIN = al256(WS_WUKV + (size_t)2048 * 256 * 2);
constexpr size_t WS_WCDOUT = al256(WS_WCDIN + (size_t)CD_INP * D * 2);
constexpr size_t WS_W13  = al256(WS_WCDOUT + (size_t)D * D * 2);
constexpr size_t WS_W2   = al256(WS_W13 + (size_t)NE * 1024 * D * 2);
constexpr size_t WS_XRES = al256(WS_W2 + (size_t)NE * D * EDIM * 2);
constexpr size_t WS_H    = al256(WS_XRES + (size_t)R * D * 2);
constexpr size_t WS_P    = al256(WS_H + (size_t)R * D * 2);
constexpr size_t WS_ODIR = al256(WS_P + (size_t)R * AB_INP * 2);
constexpr size_t WS_QF   = WS_ODIR;
constexpr size_t WS_KVF  = al256(WS_QF + (size_t)R * 1536 * 2);
static_assert(WS_KVF + (size_t)R * 2048 * 2 <= WS_ODIR + (size_t)2 * R * 1024 * 4, "QF/KVF alias ODIR");
constexpr size_t WS_A2   = al256(WS_ODIR + (size_t)2 * R * 1024 * 4);
constexpr size_t WS_QB   = al256(WS_A2 + (size_t)R * D * 2);
constexpr size_t WS_KB   = al256(WS_QB + (size_t)NB * 8 * S * 192 * 2);
constexpr size_t WS_VB   = al256(WS_KB + (size_t)NB * 8 * S * 192 * 2);
constexpr size_t WS_SSQ  = al256(WS_VB + (size_t)NB * 8 * S * 128 * 2);
constexpr size_t WS_P5N_UNUSED = al256(WS_VB + (size_t)NB * 8 * S * 128 * 2);
constexpr size_t WS_P6N  = al256(WS_SSQ + (size_t)R * 16);
constexpr size_t WS_SVT  = WS_P6N;
constexpr size_t WS_SREC = al256(WS_SVT + (size_t)NB * 8 * 2 * 36 * 128 * 144);
constexpr int LDS_BYTES_C = 160 * 1024;
constexpr int PA = 144, PQ = 272;
constexpr int REC_A = 0, REC_QH = 64 * PA, REC_KHT = REC_QH + 64 * PQ, REC_AL = REC_KHT + 128 * PA, REC_BYTES = REC_AL + 512;
constexpr size_t WS_END  = al256(WS_SREC + (size_t)NB * 8 * 2 * 36 * REC_BYTES);
constexpr size_t WS_SVT1 = WS_W13;
constexpr size_t WS_SREC1 = al256(WS_SVT1 + (size_t)NB * 4 * 2 * 36 * 256 * 144);
static_assert(WS_SREC1 + (size_t)NB * 4 * 2 * 36 * REC_BYTES <= WS_XRES, "layer-1 scan images alias");
static_assert(WS_SVT + (size_t)NE * 1024 * D * 2 + (size_t)NE * D * EDIM * 2 <= WS_END, "layer-1 MoE weights alias");
static_assert((size_t)(2 * R + 256) * 512 * 2 <= WS_KB - WS_QB, "HIDDEN alias");
static_assert((size_t)R * 2 * D * 2 <= WS_ODIR - WS_P, "YSLOTS alias");

struct Args { const float* in[29]; float* out; unsigned char* ws; int ph_lo, ph_hi; };

typedef __bf16 bf16v2_t __attribute__((ext_vector_type(2)));
DEV unsigned cvtpk(float lo, float hi) { bf16v2_t v; v.x = (__bf16)lo; v.y = (__bf16)hi; return __builtin_bit_cast(unsigned, v); }
DEV bf16_t f2bf(float x) { return (bf16_t)(cvtpk(x, 0.f) & 0xffffu); }
DEV float bf2f(bf16_t x) { return __uint_as_float(((unsigned)x) << 16); }
DEV float bflo(unsigned w) { return __uint_as_float(w << 16); }
DEV float bfhi(unsigned w) { return __uint_as_float(w & 0xffff0000u); }
DEV float sigmoidf_(float x) { return 1.f / (1.f + __expf(-x)); }
DEV float siluf_(float x) { return x / (1.f + __expf(-x)); }
DEV float wave_sum(float v) {
#pragma unroll
    for (int o = 32; o >= 1; o >>= 1) v += __shfl_xor(v, o);
    return v;
}
DEV float wave_max(float v) {
#pragma unroll
    for (int o = 32; o >= 1; o >>= 1) v = fmaxf(v, __shfl_xor(v, o));
    return v;
}
DEV int tid_opaque() { int t = threadIdx.x; asm volatile("" : "+v"(t)); return t; }
DEV int modvec_of_row(int r) { const int b = r / S, t = r - b * S; return t < TC ? 4 : b; }

#define XB_TMO      128
#define XB_XCNT(j)  (256  + 64 * (j))
#define XB_XSUB(j)  (1280 + 64 * (j))
#define XB_XGEN(j)  (2304 + 64 * (j))
#define XB_TOP      3328
#define XB_TOPGEN   3392
#define XCD_BAR_WORDS 3456
#define XB_SPIN_CAP (1u << 18)
#define LAS __attribute__((address_space(3)))

__device__ __forceinline__ unsigned xb_ld(unsigned* p)              { return __hip_atomic_load(p, __ATOMIC_RELAXED, __HIP_MEMORY_SCOPE_AGENT); }
__device__ __forceinline__ unsigned xb_add(unsigned* p, unsigned v) { return __hip_atomic_fetch_add(p, v, __ATOMIC_RELAXED, __HIP_MEMORY_SCOPE_AGENT); }
__device__ __forceinline__ unsigned xb_xcc_id() { return (unsigned)__builtin_amdgcn_s_getreg((3 << 11) | 20) & 0xFu; }
#define XB_SPIN(cond, bar) do { unsigned _sp = 0; while (cond) { __builtin_amdgcn_s_sleep(1); \
    if ((++_sp & 255u) == 0u) { if (xb_ld(&(bar)[XB_TMO])) break; if (_sp > XB_SPIN_CAP) { atomicAdd(&(bar)[XB_TMO], 1u); break; } } } } while (0)

struct XcdBarrier {
    unsigned* bar; unsigned x;
    volatile LAS unsigned* st;
};

__device__ __forceinline__ XcdBarrier xcd_barrier_post(unsigned* bar, volatile LAS unsigned* st) {
    XcdBarrier b; b.bar = bar; b.x = xb_xcc_id(); b.st = st;
    if (threadIdx.x == 0) (void)xb_add(&bar[XB_XCNT(b.x)], 1u);
    return b;
}
__device__ __forceinline__ void xcd_barrier_complete(unsigned* bar, unsigned x, unsigned& nloc, unsigned& nx) {
    const unsigned G = gridDim.x * gridDim.y * gridDim.z;
    unsigned sum, cnt, mine, sp = 0u;
    for (;;) {
        sum = 0u; cnt = 0u; mine = 0u;
#pragma unroll
        for (unsigned j = 0; j < 16; ++j) { const unsigned c = xb_ld(&bar[XB_XCNT(j)]); sum += c; cnt += (c > 0u) ? 1u : 0u; mine = (j == x) ? c : mine; }
        if (sum == G) break;
        __builtin_amdgcn_s_sleep(1);
        if ((++sp & 255u) == 0u) { if (xb_ld(&bar[XB_TMO])) break; if (sp > XB_SPIN_CAP) { atomicAdd(&bar[XB_TMO], 1u); break; } }
    }
    nloc = mine > 0u ? mine : 1u; nx = cnt > 0u ? cnt : 1u;
}

__device__ __forceinline__ void xcd_barrier(const XcdBarrier& b) {
    asm volatile("s_waitcnt vmcnt(0)" ::: "memory");
    __syncthreads();
    if (threadIdx.x == 0) {
        unsigned* bar = b.bar;
        __builtin_amdgcn_s_waitcnt(0);
        unsigned nloc = b.st[0], nx = b.st[1];
        if (nloc == 0u) { xcd_barrier_complete(bar, b.x, nloc, nx); b.st[0] = nloc; b.st[1] = nx; }
        const unsigned old = xb_add(&bar[XB_XSUB(b.x)], 1u);
        const unsigned gen = old / nloc;
        if (old + 1u == (gen + 1u) * nloc) {
            __builtin_amdgcn_fence(__ATOMIC_RELEASE, "agent");
            asm volatile("s_waitcnt vmcnt(0)" ::: "memory");
            const unsigned og = xb_add(&bar[XB_TOP], 1u);
            const unsigned tg = og / nx;
            if (og + 1u == (tg + 1u) * nx) xb_add(&bar[XB_TOPGEN], 1u);
            else XB_SPIN(xb_ld(&bar[XB_TOPGEN]) == tg, bar);
            __builtin_amdgcn_fence(__ATOMIC_ACQUIRE, "agent");
            xb_add(&bar[XB_XGEN(b.x)], 1u);
            asm volatile("s_waitcnt vmcnt(0)" ::: "memory");
        } else {
            XB_SPIN(xb_ld(&bar[XB_XGEN(b.x)]) == gen, bar);
            __builtin_amdgcn_fence(__ATOMIC_ACQUIRE, "agent");
            asm volatile("s_waitcnt vmcnt(0)" ::: "memory");
        }
    }
    __syncthreads();
}


constexpr int BM = 256, BK = 64, HALF = 128, HT = HALF * BK, SHM_GEMM = 8 * HT * 2;
DEV int lds_byte(int r, int c) { int st = (r >> 4) * 2 + (c >> 5), rr = r & 15, cc = c & 31, ob = rr * 64 + cc * 2; return st * 1024 + (ob ^ (((ob >> 9) & 1) << 5)); }
DEV void stage_rc(int b, int& Rr, int& Cc) { int st = b / 1024, sb = b % 1024, swz = sb ^ (((sb >> 9) & 1) << 5); Rr = (st >> 1) * 16 + swz / 64; Cc = (st & 1) * 32 + (swz % 64) / 2; }

template <bool GATHER, int LDA_ = 0, class Epi>
DEV void gemm_tile(const bf16_t* __restrict__ A, const bf16_t* __restrict__ Bt, int ld, int K, int brow, int bcol,
                   const int* __restrict__ rowmap, int nvalid, char* smem, const Epi& epi) {
    bf16_t* shm = (bf16_t*)smem;
#define SA(b, h) (shm + ((b) * 2 + (h)) * HT)
#define SB(b, h) (shm + (4 + (b) * 2 + (h)) * HT)
#define GLDS(gp, lp) __builtin_amdgcn_global_load_lds((const unsigned*)(gp), (unsigned*)(lp), 16, 0, 0)
#define STAGE_A(P, h, kt) do { _Pragma("unroll") for (int _i = 0; _i < 2; ++_i) { \
        const char* _sb = GATHER ? (const char*)A + (size_t)(kt) * (BK * 2) : (const char*)A + ((size_t)(brow + (h) * HALF + _i * 64) * (LDA_ ? LDA_ : ld) + (size_t)(kt) * BK) * 2; \
        GLDS(_sb + (GATHER ? voffa[h][_i] : voffA), (char*)(P) + tid16 + _i * 8192); } } while (0)
#define STAGE_B(P, h, kt) do { _Pragma("unroll") for (int _i = 0; _i < 2; ++_i) { \
        const char* _sb = (const char*)Bt + ((size_t)(bcol + (h) * HALF + _i * 64) * ld + (size_t)(kt) * BK) * 2; \
        GLDS(_sb + voff, (char*)(P) + tid16 + _i * 8192); } } while (0)
#define LDA(dst, b, h) _Pragma("unroll") for (int m = 0; m < 4; ++m) _Pragma("unroll") for (int k = 0; k < 2; ++k) \
        dst[m][k] = *reinterpret_cast<const bf16x8*>((char*)SA(b, h) + lds_byte(wr * 64 + m * 16 + fr, k * 32 + fq * 8))
#define LDB(dst, b, h) _Pragma("unroll") for (int n = 0; n < 2; ++n) _Pragma("unroll") for (int k = 0; k < 2; ++k) \
        dst[n][k] = *reinterpret_cast<const bf16x8*>((char*)SB(b, h) + lds_byte(wc * 32 + n * 16 + fr, k * 32 + fq * 8))
#define MMA(ai, bj, At_, Bt_) do { __builtin_amdgcn_s_setprio(1); \
        _Pragma("unroll") for (int m = 0; m < 4; ++m) _Pragma("unroll") for (int n = 0; n < 2; ++n) _Pragma("unroll") for (int k = 0; k < 2; ++k) \
            acc[ai][bj][m][n] = __builtin_amdgcn_mfma_f32_16x16x32_bf16(Bt_[n][k], At_[m][k], acc[ai][bj][m][n], 0, 0, 0); \
        __builtin_amdgcn_s_setprio(0); } while (0)
#define WAIT_V(n) asm volatile("s_waitcnt vmcnt(" #n ")" ::: "memory")
#define WAIT_L(n) asm volatile("s_waitcnt lgkmcnt(" #n ")" ::: "memory")
#define BAR __builtin_amdgcn_s_barrier()
#define SCHED __builtin_amdgcn_sched_barrier(0)
    int tid = threadIdx.x; asm volatile("" : "+v"(tid));
    int wid = tid >> 6, lane = tid & 63, wr = wid >> 2, wc = wid & 3, fr = lane & 15, fq = lane >> 4;
    const int tid16 = tid * 16;
    unsigned voff, voffA; unsigned voffa[2][2];
    {
        int r0, c0; stage_rc(tid16, r0, c0);
        voff = (unsigned)(r0 * ld + c0) * 2u; voffA = LDA_ ? (unsigned)(r0 * LDA_ + c0) * 2u : voff;
#pragma unroll
        for (int h = 0; h < 2; ++h)
#pragma unroll
            for (int i = 0; i < 2; ++i) {
                if (GATHER) { int l0 = h * HALF + i * 64 + r0; l0 = l0 < nvalid ? l0 : nvalid - 1; voffa[h][i] = (unsigned)((rowmap[l0] >> 1) * ld + c0) * 2u; }
                else voffa[h][i] = 0u;
            }
    }
    f32x4 acc[2][2][4][2] = {};
    bf16x8 At[4][2], B0[2][2], B1[2][2];
    const int nt = K / BK;
    STAGE_B(SB(0, 0), 0, 0); STAGE_A(SA(0, 0), 0, 0);
    STAGE_B(SB(0, 1), 1, 0); STAGE_A(SA(0, 1), 1, 0);
    if (wr == 1) BAR;
    WAIT_V(4); BAR;
    STAGE_B(SB(1, 0), 0, 1); STAGE_A(SA(1, 0), 0, 1); STAGE_B(SB(1, 1), 1, 1);
    WAIT_V(6); BAR;
    for (int t = 0; t < nt - 2; t += 2) {
        LDB(B0, 0, 0); SCHED; LDA(At, 0, 0); STAGE_A(SA(1, 1), 1, t + 1);
        WAIT_L(8); BAR; WAIT_L(0); MMA(0, 0, At, B0); BAR; SCHED;
        LDB(B1, 0, 1); STAGE_B(SB(0, 0), 0, t + 2);
        BAR; WAIT_L(0); MMA(0, 1, At, B1); BAR;
        LDA(At, 0, 1); STAGE_A(SA(0, 0), 0, t + 2);
        BAR; WAIT_L(0); MMA(1, 0, At, B0); BAR; SCHED;
        STAGE_B(SB(0, 1), 1, t + 2);
        WAIT_V(6); BAR; MMA(1, 1, At, B1); BAR;
        LDB(B0, 1, 0); SCHED; LDA(At, 1, 0); STAGE_A(SA(0, 1), 1, t + 2);
        WAIT_L(8); BAR; WAIT_L(0); MMA(0, 0, At, B0); BAR; SCHED;
        LDB(B1, 1, 1); STAGE_B(SB(1, 0), 0, t + 3);
        BAR; WAIT_L(0); MMA(0, 1, At, B1); BAR;
        LDA(At, 1, 1); STAGE_A(SA(1, 0), 0, t + 3);
        BAR; WAIT_L(0); MMA(1, 0, At, B0); BAR; SCHED;
        STAGE_B(SB(1, 1), 1, t + 3);
        WAIT_V(6); BAR; MMA(1, 1, At, B1); BAR;
    }
    { LDB(B0, 0, 0); WAIT_V(0); LDA(At, 0, 0); STAGE_A(SA(1, 1), 1, nt - 1);
      BAR; WAIT_L(0); MMA(0, 0, At, B0); BAR;
      LDB(B1, 0, 1); BAR; WAIT_L(0); MMA(0, 1, At, B1); BAR;
      LDA(At, 0, 1); WAIT_V(4); BAR; WAIT_L(0); MMA(1, 0, At, B0); MMA(1, 1, At, B1); BAR; }
    { LDB(B0, 1, 0); LDA(At, 1, 0); WAIT_V(2); BAR; WAIT_L(0); MMA(0, 0, At, B0); BAR;
      LDB(B1, 1, 1); WAIT_V(0); BAR; WAIT_L(0); MMA(0, 1, At, B1); BAR;
      LDA(At, 1, 1); BAR; WAIT_L(0); MMA(1, 0, At, B0); MMA(1, 1, At, B1); BAR; }
    if (wr == 0) BAR;
    int tz = threadIdx.x; asm volatile("" : "+v"(tz)); wid = tz >> 6; lane = tz & 63; wr = wid >> 2; wc = wid & 3; fr = lane & 15; fq = lane >> 4;
    epi(acc, brow, bcol, wr, wc, fr, fq);
#undef SA
#undef SB
#undef STAGE_A
#undef STAGE_B
#undef GLDS
#undef LDA
#undef LDB
#undef MMA
}

struct EpiStoreF32 { float* C; int ldc;
    DEV void operator()(const f32x4 (&acc)[2][2][4][2], int brow, int bcol, int wr, int wc, int fr, int fq) const {
#pragma unroll
        for (int ai = 0; ai < 2; ++ai)
#pragma unroll
            for (int m = 0; m < 4; ++m) { float* rowp = C + (size_t)(brow + ai * HALF + wr * 64 + m * 16 + fr) * ldc + bcol + wc * 32 + fq * 4;
#pragma unroll
                for (int bj = 0; bj < 2; ++bj)
#pragma unroll
                    for (int n = 0; n < 2; ++n) *(f32x4*)(rowp + bj * HALF + n * 16) = acc[ai][bj][m][n]; }
    } };
struct EpiStoreBf16 { bf16_t* C; int ldc;
    DEV void operator()(const f32x4 (&acc)[2][2][4][2], int brow, int bcol, int wr, int wc, int fr, int fq) const {
#pragma unroll
        for (int ai = 0; ai < 2; ++ai)
#pragma unroll
            for (int m = 0; m < 4; ++m) { bf16_t* rowp = C + (size_t)(brow + ai * HALF + wr * 64 + m * 16 + fr) * ldc + bcol + wc * 32 + fq * 4;
#pragma unroll
                for (int bj = 0; bj < 2; ++bj)
#pragma unroll
                    for (int n = 0; n < 2; ++n) { const f32x4 v = acc[ai][bj][m][n]; u32x2 w; w.x = cvtpk(v[0], v[1]); w.y = cvtpk(v[2], v[3]); *(u32x2*)(rowp + bj * HALF + n * 16) = w; } }
    } };
struct EpiResidGate { bf16_t* X; const float* gate; bool dry; const float* xin; const float* cin;
    DEV void operator()(const f32x4 (&acc)[2][2][4][2], int brow, int bcol, int wr, int wc, int fr, int fq) const {
        const float* g = gate + (size_t)modvec_of_row(brow) * MODN + bcol + wc * 32 + fq * 4;
        f32x4 gv[2][2];
#pragma unroll
        for (int bj = 0; bj < 2; ++bj)
#pragma unroll
            for (int n = 0; n < 2; ++n) gv[bj][n] = *(const f32x4*)(g + bj * HALF + n * 16);
#pragma unroll
        for (int ai = 0; ai < 2; ++ai)
#pragma unroll
            for (int m = 0; m < 4; ++m) { const int lrow = ai * HALF + wr * 64 + m * 16 + fr; bf16_t* rowp = X + (size_t)(brow + lrow) * D + bcol + wc * 32 + fq * 4;
                const float* srcp = nullptr;
                if (xin) { const int b = brow / S, t0 = brow - b * S; srcp = (t0 < TC ? cin + ((size_t)b * TC + t0 + lrow) * D : xin + ((size_t)b * TL + (t0 - TC) + lrow) * D) + bcol + wc * 32 + fq * 4; }
#pragma unroll
                for (int bj = 0; bj < 2; ++bj)
#pragma unroll
                    for (int n = 0; n < 2; ++n) { f32x4 x;
                        if (xin) x = *(const f32x4*)(srcp + bj * HALF + n * 16); else { const u32x2 p = *(const u32x2*)(rowp + bj * HALF + n * 16); x = (f32x4){bflo(p.x), bfhi(p.x), bflo(p.y), bfhi(p.y)}; }
                        if (!dry) x += gv[bj][n] * acc[ai][bj][m][n];
                        u32x2 w; w.x = cvtpk(x[0], x[1]); w.y = cvtpk(x[2], x[3]); *(u32x2*)(rowp + bj * HALF + n * 16) = w; }
                if (m == 3) asm volatile("" ::: "memory"); }
    } };
struct EpiMoeUp { bf16_t* hid; int rowbase, nvalid;
    DEV void operator()(const f32x4 (&acc)[2][2][4][2], int brow, int bcol, int wr, int wc, int fr, int fq) const {
        const int hc = (bcol >> 1) + wc * 32 + fq * 4;
#pragma unroll
        for (int ai = 0; ai < 2; ++ai)
#pragma unroll
            for (int m = 0; m < 4; ++m) { const int lr = ai * HALF + wr * 64 + m * 16 + fr;
                if (lr < nvalid) { bf16_t* rowp = hid + (size_t)(rowbase + lr) * EDIM + hc;
#pragma unroll
                    for (int n = 0; n < 2; ++n) { const f32x4 a = acc[ai][0][m][n], b = acc[ai][1][m][n];
                        u32x2 w; w.x = cvtpk(siluf_(a[0]) * b[0], siluf_(a[1]) * b[1]); w.y = cvtpk(siluf_(a[2]) * b[2], siluf_(a[3]) * b[3]);
                        *(u32x2*)(rowp + n * 16) = w; } } }
    } };
struct EpiMoeDown { bf16_t* y; const int* list; int nvalid;
    DEV void operator()(const f32x4 (&acc)[2][2][4][2], int brow, int bcol, int wr, int wc, int fr, int fq) const {
        int li[2][4];
#pragma unroll
        for (int ai = 0; ai < 2; ++ai)
#pragma unroll
            for (int m = 0; m < 4; ++m) { const int lr = ai * HALF + wr * 64 + m * 16 + fr; li[ai][m] = list[lr < nvalid ? lr : nvalid - 1]; }
#pragma unroll
        for (int ai = 0; ai < 2; ++ai)
#pragma unroll
            for (int m = 0; m < 4; ++m) { const int lr = ai * HALF + wr * 64 + m * 16 + fr;
                if (lr < nvalid) { bf16_t* rowp = y + (size_t)li[ai][m] * D + bcol + wc * 32 + fq * 4;
#pragma unroll
                    for (int bj = 0; bj < 2; ++bj)
#pragma unroll
                        for (int n = 0; n < 2; ++n) { const f32x4 v = acc[ai][bj][m][n]; u32x2 w; w.x = cvtpk(v[0], v[1]); w.y = cvtpk(v[2], v[3]); *(u32x2*)(rowp + bj * HALF + n * 16) = w; } } }
    } };

DEV void row_bt(int r, int& b, int& t) { b = r / S; t = r - b * S; }
#define LDS_BARRIER() do { asm volatile("s_waitcnt lgkmcnt(0)" ::: "memory"); __builtin_amdgcn_s_barrier(); asm volatile("" ::: "memory"); } while (0)
struct EpiInAB { bf16_t* P; float* ssq; bf16_t* Kb; const float2* tb; char* smem;
    DEV void operator()(const f32x4 (&acc)[2][2][4][2], int brow, int bcol, int wr, int wc, int fr, int fq) const {
        const int pn = bcol >> 8;
        if (pn < 23) {
#pragma unroll
            for (int ai = 0; ai < 2; ++ai)
#pragma unroll
                for (int m = 0; m < 4; ++m) { bf16_t* rowp = P + (size_t)(brow + ai * HALF + wr * 64 + m * 16 + fr) * AB_INP + bcol + wc * 32 + fq * 4;
#pragma unroll
                    for (int bj = 0; bj < 2; ++bj)
#pragma unroll
                        for (int n = 0; n < 2; ++n) { const f32x4 v = acc[ai][bj][m][n]; u32x2 w; w.x = cvtpk(v[0], v[1]); w.y = cvtpk(v[2], v[3]); *(u32x2*)(rowp + bj * HALF + n * 16) = w; } }
            if (pn >= 20) {
                float* red = (float*)smem;
#pragma unroll
                for (int ai = 0; ai < 2; ++ai)
#pragma unroll
                    for (int m = 0; m < 4; ++m) { float sq = 0.f;
#pragma unroll
                        for (int bj = 0; bj < 2; ++bj)
#pragma unroll
                            for (int n = 0; n < 2; ++n) { const f32x4 v = acc[ai][bj][m][n]; sq += v[0] * v[0] + v[1] * v[1] + v[2] * v[2] + v[3] * v[3]; }
                        sq += __shfl_xor(sq, 16); sq += __shfl_xor(sq, 32);
                        if (fq == 0) red[(ai * HALF + wr * 64 + m * 16 + fr) * 4 + wc] = sq; }
                LDS_BARRIER();
                const int t_ = tid_opaque();
                if (t_ < 256) { const f32x4 q = *(const f32x4*)(red + t_ * 4); ssq[(size_t)(pn - 20) * R + brow + t_] = (q[0] + q[1]) + (q[2] + q[3]); }
                LDS_BARRIER();
            }
        } else if (wc < 2) {
            f32x4 cc[2][4][2];
#pragma unroll
            for (int ai = 0; ai < 2; ++ai)
#pragma unroll
                for (int m = 0; m < 4; ++m) { int b, t; row_bt(brow + ai * HALF + wr * 64 + m * 16 + fr, b, t);
#pragma unroll
                    for (int n = 0; n < 2; ++n) cc[ai][m][n] = *(const f32x4*)(tb + t * 32 + 16 * wc + 8 * n + 2 * fq); }
#pragma unroll
            for (int ai = 0; ai < 2; ++ai)
#pragma unroll
                for (int m = 0; m < 4; ++m) { int b, t; row_bt(brow + ai * HALF + wr * 64 + m * 16 + fr, b, t);
#pragma unroll
                    for (int n = 0; n < 2; ++n) { const f32x4 v = acc[ai][0][m][n]; const int p0 = 16 * wc + 8 * n + 2 * fq;
                        const float2 c0 = make_float2(cc[ai][m][n][0], cc[ai][m][n][1]), c1 = make_float2(cc[ai][m][n][2], cc[ai][m][n][3]);
                        const unsigned lo = cvtpk(v[0] * c0.x - v[1] * c0.y, v[2] * c1.x - v[3] * c1.y), hi = cvtpk(v[1] * c0.x + v[0] * c0.y, v[3] * c1.x + v[2] * c1.y);
#pragma unroll
                        for (int hh = 0; hh < 8; ++hh) { bf16_t* kp = Kb + (((size_t)b * 8 + hh) * S + t) * 192 + 128 + p0; *(unsigned*)kp = lo; *(unsigned*)(kp + 32) = hi; } } }
        }
    } };
struct EpiInCD { bf16_t* P; bf16_t* Qb; bf16_t* Kb; bf16_t* Vb; const float2* tc; const float* gq; const float* gk; char* smem;
    DEV void operator()(const f32x4 (&acc)[2][2][4][2], int brow, int bcol, int wr, int wc, int fr, int fq) const {
        const int pn = bcol >> 8;
        if (pn <= 4) {
            float* red = (float*)smem;
            f32x4 cc[2][4][2];
#pragma unroll
            for (int ai = 0; ai < 2; ++ai)
#pragma unroll
                for (int m = 0; m < 4; ++m) { int b, t; row_bt(brow + ai * HALF + wr * 64 + m * 16 + fr, b, t);
#pragma unroll
                    for (int n = 0; n < 2; ++n) cc[ai][m][n] = *(const f32x4*)(tc + t * 64 + 16 * wc + 8 * n + 2 * fq); }
#pragma unroll
            for (int ai = 0; ai < 2; ++ai)
#pragma unroll
                for (int m = 0; m < 4; ++m)
#pragma unroll
                    for (int bj = 0; bj < 2; ++bj) { float sq = 0.f;
#pragma unroll
                        for (int n = 0; n < 2; ++n) { const f32x4 v = acc[ai][bj][m][n]; sq += v[0] * v[0] + v[1] * v[1] + v[2] * v[2] + v[3] * v[3]; }
                        sq += __shfl_xor(sq, 16); sq += __shfl_xor(sq, 32);
                        if (fq == 0) red[((ai * HALF + wr * 64 + m * 16 + fr) * 2 + bj) * 4 + wc] = sq; }
            LDS_BARRIER();
            const float* gp = pn < 4 ? gq : gk;
            float g1[2][2], g2[2][2];
#pragma unroll
            for (int n = 0; n < 2; ++n) { const int p0 = 16 * wc + 8 * n + 2 * fq; g1[n][0] = gp[p0]; g1[n][1] = gp[p0 + 1]; g2[n][0] = gp[p0 + 64]; g2[n][1] = gp[p0 + 65]; }
#pragma unroll
            for (int ai = 0; ai < 2; ++ai)
#pragma unroll
                for (int m = 0; m < 4; ++m) { const int lr = ai * HALF + wr * 64 + m * 16 + fr; int b, t; row_bt(brow + lr, b, t);
#pragma unroll
                    for (int bj = 0; bj < 2; ++bj) { const f32x4 q4 = *(const f32x4*)(red + (lr * 2 + bj) * 4); const float rs = rsqrtf(((q4[0] + q4[1]) + (q4[2] + q4[3])) * (1.f / 128.f) + EPS);
                        bf16_t* dst = pn < 4 ? Qb + (((size_t)b * 8 + pn * 2 + bj) * S + t) * 128 : Kb + (((size_t)b * 2 + bj) * S + t) * 128;
#pragma unroll
                        for (int n = 0; n < 2; ++n) { const f32x4 v = acc[ai][bj][m][n]; const int p0 = 16 * wc + 8 * n + 2 * fq;
                            const float2 c0 = make_float2(cc[ai][m][n][0], cc[ai][m][n][1]), c1 = make_float2(cc[ai][m][n][2], cc[ai][m][n][3]);
                            const float x1a = v[0] * rs * g1[n][0], x2a = v[1] * rs * g2[n][0], x1b = v[2] * rs * g1[n][1], x2b = v[3] * rs * g2[n][1];
                            *(unsigned*)(dst + p0) = cvtpk(x1a * c0.x - x2a * c0.y, x1b * c1.x - x2b * c1.y);
                            *(unsigned*)(dst + 64 + p0) = cvtpk(x2a * c0.x + x1a * c0.y, x2b * c1.x + x1b * c1.y); } } }
            LDS_BARRIER();
        } else if (pn == 5) {
#pragma unroll
            for (int ai = 0; ai < 2; ++ai)
#pragma unroll
                for (int m = 0; m < 4; ++m) { int b, t; row_bt(brow + ai * HALF + wr * 64 + m * 16 + fr, b, t);
#pragma unroll
                    for (int bj = 0; bj < 2; ++bj)
#pragma unroll
                        for (int n = 0; n < 2; ++n) { const f32x4 v = acc[ai][bj][m][n]; u32x2 w; w.x = cvtpk(v[0], v[1]); w.y = cvtpk(v[2], v[3]);
                            *(u32x2*)(Vb + (((size_t)b * 2 + bj) * S + t) * 128 + wc * 32 + n * 16 + fq * 4) = w; } }
        } else {
#pragma unroll
            for (int ai = 0; ai < 2; ++ai)
#pragma unroll
                for (int m = 0; m < 4; ++m) { bf16_t* rowp = P + (size_t)(brow + ai * HALF + wr * 64 + m * 16 + fr) * CD_INP + bcol + wc * 32 + fq * 4;
#pragma unroll
                    for (int bj = 0; bj < 2; ++bj)
#pragma unroll
                        for (int n = 0; n < 2; ++n) { const f32x4 v = acc[ai][bj][m][n]; u32x2 w; w.x = cvtpk(v[0], v[1]); w.y = cvtpk(v[2], v[3]); *(u32x2*)(rowp + bj * HALF + n * 16) = w; } }
        }
    } };
struct EpiUQ { bf16_t* Qb; const float* ssq; const float2* tb;
    DEV void operator()(const f32x4 (&acc)[2][2][4][2], int brow, int bcol, int wr, int wc, int fr, int fq) const {
        const int pn = bcol >> 8;
#pragma unroll
        for (int ai = 0; ai < 2; ++ai)
#pragma unroll
            for (int m = 0; m < 4; ++m) { const int r = brow + ai * HALF + wr * 64 + m * 16 + fr; int b, t; row_bt(r, b, t);
                const float rs = rsqrtf((ssq[r] + ssq[R + r]) * (1.f / 512.f) + EPS);
#pragma unroll
                for (int bj = 0; bj < 2; ++bj)
#pragma unroll
                    for (int n = 0; n < 2; ++n) { const f32x4 v = acc[ai][bj][m][n] * rs;
                        if (pn < 4) { const int hh = pn * 2 + bj; bf16_t* qp = Qb + (((size_t)b * 8 + hh) * S + t) * 192 + wc * 32 + n * 16 + fq * 4;
                            u32x2 w; w.x = cvtpk(v[0], v[1]); w.y = cvtpk(v[2], v[3]); *(u32x2*)qp = w; }
                        else { const int cr = (pn - 4) * 256 + bj * HALF + wc * 32 + n * 16 + fq * 4, hh = cr >> 6, p0 = (cr & 63) >> 1;
                            const f32x4 cc = *(const f32x4*)(tb + t * 32 + p0); const float2 c0 = make_float2(cc[0], cc[1]), c1 = make_float2(cc[2], cc[3]);
                            bf16_t* qp = Qb + (((size_t)b * 8 + hh) * S + t) * 192 + 128 + p0;
                            *(unsigned*)qp = cvtpk(v[0] * c0.x - v[1] * c0.y, v[2] * c1.x - v[3] * c1.y); *(unsigned*)(qp + 32) = cvtpk(v[1] * c0.x + v[0] * c0.y, v[3] * c1.x + v[2] * c1.y); } } }
    } };
struct EpiUKV { bf16_t* Kb; bf16_t* Vb; const float* ssq;
    DEV void operator()(const f32x4 (&acc)[2][2][4][2], int brow, int bcol, int wr, int wc, int fr, int fq) const {
        const int hh = bcol >> 8;
#pragma unroll
        for (int ai = 0; ai < 2; ++ai)
#pragma unroll
            for (int m = 0; m < 4; ++m) { const int r = brow + ai * HALF + wr * 64 + m * 16 + fr; int b, t; row_bt(r, b, t);
                const float rs = rsqrtf(ssq[2 * R + r] * (1.f / 256.f) + EPS); const size_t rowi = ((size_t)b * 8 + hh) * S + t;
#pragma unroll
                for (int n = 0; n < 2; ++n) { const f32x4 kv = acc[ai][0][m][n] * rs, vv = acc[ai][1][m][n] * rs; const int c = wc * 32 + n * 16 + fq * 4;
                    u32x2 w; w.x = cvtpk(kv[0], kv[1]); w.y = cvtpk(kv[2], kv[3]); *(u32x2*)(Kb + rowi * 192 + c) = w;
                    w.x = cvtpk(vv[0], vv[1]); w.y = cvtpk(vv[2], vv[3]); *(u32x2*)(Vb + rowi * 128 + c) = w; } }
    } };

template <bool LATENT = false, int LDA_ = 0, class Epi>
DEV void gemm_phase(const bf16_t* A, const bf16_t* Bt, int M, int N, int K, char* smem, const Epi& epi, int& cursor, int tlo = 0, int thi = 1 << 30) {
    const int nM = M / BM, nN = N / BM, n = nM * nN;
    int first = cursor; cursor += n;
    int u = blockIdx.x; while (u < first) u += gridDim.x;
    for (; u < first + n; u += gridDim.x) { const int t = u - first; if (t < tlo || t >= thi) continue; const int pm = t % nM, pn = t / nM;
        const int prow = LATENT ? (pm >> 3) * 9 + 1 + (pm & 7) : pm;
        gemm_tile<false, LDA_>(A, Bt, K, K, prow * BM, pn * BM, nullptr, 0, smem, epi); }
}

struct CvtJob { const float* src; bf16_t* dst; int K, N, Nout, nb; size_t src_bs, dst_bs; int blk_rs, blk_base; const float* kscale; int perm = 0; };
constexpr int CVT_LDS_WAVE = 64 * 65 * 4, CVT_SLOT_OFF = 8 * CVT_LDS_WAVE;
DEV void cvt_issue(const CvtJob& j, int u, int lane, f32x4 (&e)[16]) {
    const int tN = j.Nout / 64, per = (j.K / 64) * tN;
    const int bt = u / per, rem = u - bt * per, kt = rem / tN, ntl = rem - kt * tN;
    const int n0 = ntl * 64 + (lane & 15) * 4;
    const float* sp = j.src + (size_t)bt * j.src_bs + (size_t)(kt * 64 + (lane >> 4)) * j.N + (n0 < j.N ? n0 : 0);
#pragma unroll
    for (int q = 0; q < 16; ++q) e[q] = *(const f32x4*)(sp + (size_t)(q * 4) * j.N);
}
DEV void cvt_finish(const CvtJob& j, int u, int lane, float* tile, const f32x4 (&e)[16]) {
    const int tN = j.Nout / 64, per = (j.K / 64) * tN;
    const int bt = u / per, rem = u - bt * per, kt = rem / tN, ntl = rem - kt * tN;
    const int r0 = lane >> 4, c4 = lane & 15; const bool valid = ntl * 64 + c4 * 4 < j.N;
#pragma unroll
    for (int q = 0; q < 16; ++q) { f32x4 x = e[q]; const int k = r0 + 4 * q; if (j.kscale) x *= j.kscale[kt * 64 + k]; if (!valid) x = (f32x4){0.f, 0.f, 0.f, 0.f};
        float* tp = tile + k * 65 + c4 * 4; tp[0] = x[0]; tp[1] = x[1]; tp[2] = x[2]; tp[3] = x[3]; }
    const int nl0 = lane >> 3, kc = (lane & 7) * 8;
#pragma unroll
    for (int p = 0; p < 8; ++p) { const int nl = p * 8 + nl0, nn = ntl * 64 + nl; float v[8];
#pragma unroll
        for (int i = 0; i < 8; ++i) v[i] = tile[(kc + i) * 65 + nl];
        int drow = (nn >> 7) * j.blk_rs + j.blk_base + (nn & 127);
        if (j.perm == 1) { const int hh = nn / 192, c = nn - hh * 192, i = c - 128; drow = c < 128 ? hh * 128 + c : 1024 + hh * 64 + (i < 32 ? 2 * i : 2 * (i - 32) + 1); }
        if (j.perm == 3 && nn < 1280) { const int c = nn & 127; drow = (nn & ~127) + (c < 64 ? 2 * c : 2 * (c - 64) + 1); }
        if (j.perm == 2 && nn >= 5888) { const int i = nn - 5888; drow = i < 64 ? 5888 + (i < 32 ? 2 * i : 2 * (i - 32) + 1) : nn; }
        *(u32x4*)(j.dst + (size_t)bt * j.dst_bs + (size_t)drow * j.K + kt * 64 + kc) = (u32x4){cvtpk(v[0], v[1]), cvtpk(v[2], v[3]), cvtpk(v[4], v[5]), cvtpk(v[6], v[7])}; }
}
DEV void cvt_run(const CvtJob& j, int u0, int ustep, int n, int lane, float* tile) {
    f32x4 eA[16], eB[16];
    cvt_issue(j, u0, lane, eA);
    int i = 0;
#pragma unroll 1
    for (; i + 2 < n; i += 2) {
        cvt_issue(j, u0 + (i + 1) * ustep, lane, eB);
        __builtin_amdgcn_sched_barrier(0);
        cvt_finish(j, u0 + i * ustep, lane, tile, eA);
        __builtin_amdgcn_sched_barrier(0);
        cvt_issue(j, u0 + (i + 2) * ustep, lane, eA);
        __builtin_amdgcn_sched_barrier(0);
        cvt_finish(j, u0 + (i + 1) * ustep, lane, tile, eB);
        __builtin_amdgcn_sched_barrier(0);
    }
    if (i + 1 < n) {
        cvt_issue(j, u0 + (i + 1) * ustep, lane, eB);
        __builtin_amdgcn_sched_barrier(0);
        cvt_finish(j, u0 + i * ustep, lane, tile, eA);
        __builtin_amdgcn_sched_barrier(0);
        cvt_finish(j, u0 + (i + 1) * ustep, lane, tile, eB);
    } else cvt_finish(j, u0 + i * ustep, lane, tile, eA);
}
DEV void cvt_weight(const float* __restrict__ src, bf16_t* __restrict__ dst, int K, int N, int Nout, int nb, size_t src_bs, size_t dst_bs,
                    int blk_rs, int blk_base, const float* __restrict__ kscale, char* smem, int perm = 0) {
    const CvtJob j{src, dst, K, N, Nout, nb, src_bs, dst_bs, blk_rs, blk_base, kscale, perm};
    const int tid = tid_opaque(), lane = tid & 63, w = tid >> 6, total = nb * (K / 64) * (Nout / 64);
    float* tile = (float*)(smem + w * CVT_LDS_WAVE);
    const int u0 = blockIdx.x * 8 + w, ustep = gridDim.x * 8;
    if (u0 < total) cvt_run(j, u0, ustep, (total - u0 + ustep - 1) / ustep, lane, tile);
    __syncthreads();
}
DEV bf16_t* moe_w13(const Args& a, int l) { return (bf16_t*)(a.ws + (l == 0 ? WS_W13 : WS_SVT)); }
DEV bf16_t* moe_w2(const Args& a, int l) { return (bf16_t*)(a.ws + (l == 0 ? WS_W2 : WS_SVT + (size_t)NE * 1024 * D * 2)); }
constexpr int CVT_IT = 8;
DEV void cvt_moe_dynamic(const Args& a, int l, char* smem) {
    const int tid = tid_opaque(), lane = tid & 63, w = tid >> 6;
    unsigned* counter = (unsigned*)(a.ws + WS_CTL) + CW_CVT + l * 64;
    volatile int* slot = (volatile int*)(smem + CVT_SLOT_OFF); float* tile = (float*)(smem + w * CVT_LDS_WAVE);
    const CvtJob j1{a.in[26] + (size_t)l * NE * D * EDIM, moe_w13(a, l), D, EDIM, EDIM, NE, (size_t)D * EDIM, (size_t)1024 * D, 256, 0, nullptr};
    const CvtJob j3{a.in[27] + (size_t)l * NE * D * EDIM, moe_w13(a, l), D, EDIM, EDIM, NE, (size_t)D * EDIM, (size_t)1024 * D, 256, 128, nullptr};
    const CvtJob j2{a.in[28] + (size_t)l * NE * EDIM * D, moe_w2(a, l), EDIM, D, D, NE, (size_t)EDIM * D, (size_t)D * EDIM, 128, 0, nullptr};
    constexpr int CPJ = 4096 / (8 * CVT_IT), NCHUNK = 3 * CPJ;
    for (;;) {
        __syncthreads();
        if (tid == 0) *slot = (int)atomicAdd(counter, 1u);
        __syncthreads();
        const int chunk = *slot;
        if (chunk >= NCHUNK) break;
        const int job = chunk / CPJ, u0 = (chunk - job * CPJ) * (8 * CVT_IT) + w;
        if (job == 0) cvt_run(j1, u0, 8, CVT_IT, lane, tile); else if (job == 1) cvt_run(j3, u0, 8, CVT_IT, lane, tile); else cvt_run(j2, u0, 8, CVT_IT, lane, tile);
    }
    __syncthreads();
}

DEV void cvt_cd_dynamic(const Args& a, char* smem) {
    const int tid = tid_opaque(), lane = tid & 63, w = tid >> 6;
    unsigned* counter = (unsigned*)(a.ws + WS_CTL) + CW_CVT + 3 * 64;
    volatile int* slot = (volatile int*)(smem + CVT_SLOT_OFF); float* tile = (float*)(smem + w * CVT_LDS_WAVE);
    const CvtJob jin{a.in[17], (bf16_t*)(a.ws + WS_WCDIN), D, CD_IN, CD_INP, 1, 0, 0, 128, 0, nullptr, 3};
    const CvtJob jout{a.in[18], (bf16_t*)(a.ws + WS_WCDOUT), D, D, D, 1, 0, 0, 128, 0, nullptr};
    const CvtJob jabo{a.in[10], (bf16_t*)(a.ws + WS_WABOUT), D, D, D, 1, 0, 0, 128, 0, nullptr};
    const CvtJob juq{a.in[14], (bf16_t*)(a.ws + WS_WUQ), 512, 1536, 1536, 1, 0, 0, 128, 0, a.in[13], 1};
    const CvtJob jukv{a.in[16], (bf16_t*)(a.ws + WS_WUKV), 256, 2048, 2048, 1, 0, 0, 128, 0, a.in[15]};
    constexpr int TIN = 32 * (CD_INP / 64), T1 = TIN + 32 * 32, T2 = T1 + 32 * 32, T3 = T2 + 8 * 24, T4 = T3 + 4 * 32, NCHUNK = T4 / (8 * CVT_IT);
    static_assert(TIN % (8 * CVT_IT) == 0 && T1 % (8 * CVT_IT) == 0 && T2 % (8 * CVT_IT) == 0 && T3 % (8 * CVT_IT) == 0 && T4 % (8 * CVT_IT) == 0, "chunk boundary");
    for (;;) {
        __syncthreads();
        if (tid == 0) *slot = (int)atomicAdd(counter, 1u);
        __syncthreads();
        const int chunk = *slot;
        if (chunk >= NCHUNK) break;
        const int g = chunk * (8 * CVT_IT) + w;
        if (g < TIN) cvt_run(jin, g, 8, CVT_IT, lane, tile); else if (g < T1) cvt_run(jout, g - TIN, 8, CVT_IT, lane, tile); else if (g < T2) cvt_run(jabo, g - T1, 8, CVT_IT, lane, tile);
        else if (g < T3) cvt_run(juq, g - T2, 8, CVT_IT, lane, tile); else cvt_run(jukv, g - T3, 8, CVT_IT, lane, tile);
    }
    __syncthreads();
}

template <bool DYN>
DEV void mod_phase(const Args& a, int l, char* smem) {
    float* sc = (float*)smem;
    float* red = sc + 5 * D;
    const int tid = tid_opaque(), w = tid >> 6, lane = tid & 63, cg = lane & 7, rr = lane >> 3;
    { float xv[5 * D / NT];
#pragma unroll
      for (int q = 0; q < 5 * D / NT; ++q) { const int i = tid + q * NT, v = i / D, k = i - v * D; xv[q] = v < 4 ? a.in[1][v * D + k] : a.in[3][k]; }
#pragma unroll
      for (int q = 0; q < 5 * D / NT; ++q) sc[tid + q * NT] = siluf_(xv[q]); }
    __syncthreads();
    float* modv = (float*)(a.ws + WS_MODV);
    unsigned* counter = (unsigned*)(a.ws + WS_CTL) + CW_CVT + 2 * 64; volatile int* slot = (volatile int*)(red + 8 * 5 * 32);
    for (int u = gridDim.x - 1 - blockIdx.x;; u += gridDim.x) {
        if (DYN) { __syncthreads(); if (tid == 0) *slot = (int)atomicAdd(counter, 1u); __syncthreads(); u = *slot; }
        if (u >= MODN / 32) break;
        const int c0 = u * 32;
        const float* wp = a.in[4] + (size_t)l * D * MODN + c0 + cg * 4;
        f32x4 acc[5] = {};
        for (int it0 = 0; it0 < D / 64; it0 += 8) { f32x4 wv[8];
#pragma unroll
            for (int q = 0; q < 8; ++q) wv[q] = *(const f32x4*)(wp + (size_t)((it0 + q) * 64 + w * 8 + rr) * MODN);
#pragma unroll
            for (int q = 0; q < 8; ++q) { const int k = (it0 + q) * 64 + w * 8 + rr;
#pragma unroll
                for (int v = 0; v < 5; ++v) acc[v] += wv[q] * sc[v * D + k]; } }
#pragma unroll
        for (int v = 0; v < 5; ++v)
#pragma unroll
            for (int j = 0; j < 4; ++j) { float x = acc[v][j]; x += __shfl_xor(x, 8); x += __shfl_xor(x, 16); x += __shfl_xor(x, 32); acc[v][j] = x; }
        if (rr == 0) {
#pragma unroll
            for (int v = 0; v < 5; ++v)
#pragma unroll
                for (int j = 0; j < 4; ++j) red[(w * 5 + v) * 32 + cg * 4 + j] = acc[v][j]; }
        __syncthreads();
        if (tid < 160) { const int v = tid >> 5, c = tid & 31; float s = 0.f;
#pragma unroll
            for (int ww = 0; ww < 8; ++ww) s += red[(ww * 5 + v) * 32 + c];
            modv[((size_t)l * 5 + v) * MODN + c0 + c] = s + a.in[5][l * MODN + c0 + c]; }
        __syncthreads();
    }
}

DEV void misc_phase(const Args& a) {
    const int gt = blockIdx.x * NT + tid_opaque(), gs = gridDim.x * NT;
    float* lb = (float*)(a.ws + WS_LB);
    for (int i = gt; i < 2 * 1024; i += gs) { const int d = i >> 10, c = i & 1023; const float* p = a.in[11] + (size_t)d * 3 * 1024 + c;
        const float x0 = p[0], x1 = p[1024], x2 = p[2048], m = fmaxf(x0, fmaxf(x1, x2));
        const float e0 = expf(x0 - m), e1 = expf(x1 - m), e2 = expf(x2 - m); lb[i] = e0 / (e0 + e1 + e2); }
    float2* tb = (float2*)(a.ws + WS_TABB); float2* tc = (float2*)(a.ws + WS_TABC);
    for (int i = gt; i < S * 32; i += gs) { const int t = (i >> 5) - TC, j = i & 31, q = j & 15; const float fr = powf(10000.f, -(float)q / 16.f);
        const float pos = (j < 16) ? (float)(t >> 6) : (float)(t & 63); const float an = pos * fr; tb[i] = t < 0 ? make_float2(1.f, 0.f) : make_float2(cosf(an), sinf(an)); }
    for (int i = gt; i < S * 64; i += gs) { const int t = (i >> 6) - TC, j = i & 63, q = j & 31; const float fr = powf(10000.f, -(float)q / 32.f);
        const float pos = (j < 32) ? (float)(t >> 6) : (float)(t & 63); const float an = pos * fr; tc[i] = t < 0 ? make_float2(1.f, 0.f) : make_float2(cosf(an), sinf(an)); }
}

template <bool ROUTER, bool FROM_IN = false>
DEV void norm_phase(const Args& a, int l, int chunk_shift, const float* gain, bool latent_only, char* smem, bool dry = false) {
    const int tid = tid_opaque(), w = tid >> 6, lane = tid & 63;
    const bf16_t* xres = (const bf16_t*)(a.ws + WS_XRES); bf16_t* h = (bf16_t*)(a.ws + WS_H);
    const float* modv = (const float*)(a.ws + WS_MODV) + (size_t)l * 5 * MODN;
    unsigned* cnt = (unsigned*)(a.ws + WS_CTL) + CW_CNT + l * 16 * CNT_STRIDE;
    int* tok = (int*)(a.ws + WS_TOK); int* list = (int*)(a.ws + WS_LIST);
    float* rw = (float*)smem;
    int* ent = (int*)(smem + 139264);
    if (ROUTER) { for (int i = tid; i < D * 16 / 4; i += NT) { const int c = i >> 2, q = i & 3; *(f32x4*)(rw + c * 16 + (c >> 2) * 4 + q * 4) = ((const f32x4*)a.in[24])[i]; }
                  if (tid < 128) ent[tid] = -1; __syncthreads(); }
    const int stride = gridDim.x * 8, rfirst = blockIdx.x * 8 + w;
#define NP_SKIP(rr) while ((rr) < R && latent_only && ((rr) % S) < TC) (rr) += stride
#define NP_LOAD(rr, XF, XB) do { const int b_ = (rr) / S, t_ = (rr) - b_ * S; const float* xp_ = t_ < TC ? a.in[2] + ((size_t)b_ * TC + t_) * D : a.in[0] + ((size_t)b_ * TL + (t_ - TC)) * D; const bf16_t* xb_ = xres + (size_t)(rr) * D; \
        _Pragma("unroll") for (int j = 0; j < 8; ++j) { if (FROM_IN) XF[j] = *(const f32x4*)(xp_ + j * 256 + lane * 4); else XB[j] = *(const u32x2*)(xb_ + j * 256 + lane * 4); } } while (0)
    int r = rfirst; NP_SKIP(r);
    f32x4 nxf[8]; u32x2 nxb[8];
    if (r < R) NP_LOAD(r, nxf, nxb);
    while (r < R) {
        const int nent = (r - rfirst) / stride;
        f32x4 x[8]; float ss = 0.f;
#pragma unroll
        for (int j = 0; j < 8; ++j) { if (FROM_IN) x[j] = nxf[j]; else { const u32x2 p = nxb[j]; x[j] = (f32x4){bflo(p.x), bfhi(p.x), bflo(p.y), bfhi(p.y)}; } }
        const int b = r / S, t = r - b * S; const int v = t < TC ? 4 : b;
        const float* sh = modv + (size_t)v * MODN + chunk_shift * D; const float* sc = sh + D;
        f32x4 gv[8], s1v[8], s0v[8];
#pragma unroll
        for (int j = 0; j < 8; ++j) { const int c = j * 256 + lane * 4; gv[j] = *(const f32x4*)(gain + c); s1v[j] = *(const f32x4*)(sc + c); s0v[j] = *(const f32x4*)(sh + c); }
        __builtin_amdgcn_sched_barrier(0);
        int rn = r + stride; NP_SKIP(rn);
        if (rn < R) NP_LOAD(rn, nxf, nxb);
        __builtin_amdgcn_sched_barrier(0);
#pragma unroll
        for (int j = 0; j < 8; ++j) ss += x[j][0] * x[j][0] + x[j][1] * x[j][1] + x[j][2] * x[j][2] + x[j][3] * x[j][3];
        ss = wave_sum(ss); const float rstd = rsqrtf(ss * (1.f / D) + EPS);
        float lg[16]; f32x2 lgp[8];
        if (ROUTER) {
#pragma unroll
            for (int e = 0; e < 8; ++e) lgp[e] = (f32x2){0.f, 0.f}; }
#pragma unroll
        for (int j = 0; j < 8; ++j) { const int c = j * 256 + lane * 4;
            const f32x4 g = gv[j], s1 = s1v[j], s0 = s0v[j];
            f32x4 y = (x[j] * rstd * g) * (1.f + s1) + s0;
            u32x2 pk; pk.x = cvtpk(y[0], y[1]); pk.y = cvtpk(y[2], y[3]); *(u32x2*)(h + (size_t)r * D + c) = pk;
            if (ROUTER) {
#pragma unroll
                for (int i = 0; i < 4; ++i) { const f32x4* wrow = (const f32x4*)(rw + (c + i) * 16 + (c >> 2) * 4);
#pragma unroll
                    for (int q = 0; q < 4; ++q) { const f32x4 wv = wrow[q]; const f32x2 yy = (f32x2){y[i], y[i]};
                        lgp[q * 2 + 0] += yy * (f32x2){wv[0], wv[1]}; lgp[q * 2 + 1] += yy * (f32x2){wv[2], wv[3]}; } }
                __builtin_amdgcn_sched_barrier(0); }
        }
        if (ROUTER) {
#pragma unroll
            for (int e = 0; e < 16; ++e) lg[e] = wave_sum(lgp[e >> 1][e & 1]);
            if (lane == 0 && !dry) {
                float scv[16], sel[16];
#pragma unroll
                for (int e = 0; e < 16; ++e) { scv[e] = 1.f / (1.f + __expf(-lg[e])); sel[e] = scv[e] + a.in[25][e]; }
                int gbest = 0; float gbv = -1e30f;
#pragma unroll
                for (int g = 0; g < 4; ++g) { float m1 = -1e30f, m2 = -1e30f;
#pragma unroll
                    for (int i = 0; i < 4; ++i) { const float s_ = sel[g * 4 + i]; if (s_ > m1) { m2 = m1; m1 = s_; } else if (s_ > m2) m2 = s_; }
                    const float gs = m1 + m2; if (gs > gbv) { gbv = gs; gbest = g; } }
                int e0 = 0, e1 = 0; float m1 = -1e30f, m2 = -1e30f; float w0 = 0.f, w1 = 0.f;
#pragma unroll
                for (int g = 0; g < 4; ++g) if (g == gbest) {
#pragma unroll
                    for (int i = 0; i < 4; ++i) { const float s_ = sel[g * 4 + i]; const int e = g * 4 + i;
                        if (s_ > m1) { m2 = m1; e1 = e0; w1 = w0; m1 = s_; e0 = e; w0 = scv[e]; } else if (s_ > m2) { m2 = s_; e1 = e; w1 = scv[e]; } } }
                const float inv = 1.f / (w0 + w1);
                ent[nent * 16 + w * 2 + 0] = (e0 << 24) | (r * 2); ent[nent * 16 + w * 2 + 1] = (e1 << 24) | (r * 2 + 1);
                tok[r * 4 + 0] = e0; tok[r * 4 + 1] = e1; ((float*)tok)[r * 4 + 2] = w0 * inv; ((float*)tok)[r * 4 + 3] = w1 * inv;
            }
        }
        r = rn;
    }
#undef NP_LOAD
#undef NP_SKIP
    if (ROUTER) {
        __syncthreads();
        if (tid < NE) { int c_ = 0;
            for (int j = 0; j < 128; ++j) c_ += ((ent[j] >> 24) == tid) ? 1 : 0;
            if (c_) { unsigned pos = atomicAdd(&cnt[tid * CNT_STRIDE], (unsigned)c_);
                for (int j = 0; j < 128; ++j) { const int en = ent[j]; if ((en >> 24) == tid) { __hip_atomic_store((__attribute__((address_space(1))) int*)(list + (size_t)tid * R + pos), en & 0xffffff, __ATOMIC_RELAXED, __HIP_MEMORY_SCOPE_AGENT); ++pos; } } } }
        __syncthreads();
    }
}

DEV void norm_router_phase(const Args& a, int l, int chunk_shift, const float* gain, bool latent_only, char* smem) {
    constexpr int WP = 2 * D + 16;
    constexpr int OFF_WLO = 16 * WP, OFF_ENT = 2 * 16 * WP, OFF_ROW = OFF_ENT + 512, OFF_RED = OFF_ROW + 256;
    static_assert(OFF_RED + 8 * 3 * 256 * 4 <= LDS_BYTES_C - 16, "router LDS");
    const int tid = tid_opaque(), w = tid >> 6, lane = tid & 63;
    const bf16_t* xres = (const bf16_t*)(a.ws + WS_XRES); bf16_t* h = (bf16_t*)(a.ws + WS_H); bf16_t* hlo = (bf16_t*)(a.ws + WS_P);
    const float* modv = (const float*)(a.ws + WS_MODV) + (size_t)l * 5 * MODN;
    unsigned* cnt = (unsigned*)(a.ws + WS_CTL) + CW_CNT + l * 16 * CNT_STRIDE;
    int* tok = (int*)(a.ws + WS_TOK); int* list = (int*)(a.ws + WS_LIST);
    char* whi = smem; char* wlo = smem + OFF_WLO; int* ent = (int*)(smem + OFF_ENT); int* rowtab = (int*)(smem + OFF_ROW); float* red = (float*)(smem + OFF_RED);
    for (int i = tid; i < (D / 2) * 4; i += NT) { const int kp = i >> 2, q = i & 3;
        const f32x4 w0 = ((const f32x4*)a.in[24])[(2 * kp) * 4 + q], w1 = ((const f32x4*)a.in[24])[(2 * kp + 1) * 4 + q];
#pragma unroll
        for (int e = 0; e < 4; ++e) { const unsigned hi = cvtpk(w0[e], w1[e]); const unsigned lo = cvtpk(w0[e] - bflo(hi), w1[e] - bfhi(hi));
            *(unsigned*)(whi + (q * 4 + e) * WP + kp * 4) = hi; *(unsigned*)(wlo + (q * 4 + e) * WP + kp * 4) = lo; } }
    if (tid < 128) ent[tid] = -1;
    if (tid < 64) rowtab[tid] = -1;
    __syncthreads();
    const int stride = gridDim.x * 8, rfirst = blockIdx.x * 8 + w;
#define NR_SKIP(rr) while ((rr) < R && latent_only && ((rr) % S) < TC) (rr) += stride
#define NR_LOAD(rr, XB) do { const bf16_t* xb_ = xres + (size_t)(rr) * D; _Pragma("unroll") for (int j = 0; j < 8; ++j) XB[j] = *(const u32x2*)(xb_ + j * 256 + lane * 4); } while (0)
    int r = rfirst; NR_SKIP(r);
    u32x2 nxb[8];
    if (r < R) NR_LOAD(r, nxb);
    while (r < R) {
        const int nent = (r - rfirst) / stride;
        f32x4 x[8]; float ss = 0.f;
#pragma unroll
        for (int j = 0; j < 8; ++j) { const u32x2 p = nxb[j]; x[j] = (f32x4){bflo(p.x), bfhi(p.x), bflo(p.y), bfhi(p.y)}; }
        const int b = r / S, t = r - b * S; const int v = t < TC ? 4 : b;
        const float* sh = modv + (size_t)v * MODN + chunk_shift * D; const float* sc = sh + D;
        f32x4 gv[8], s1v[8], s0v[8];
#pragma unroll
        for (int j = 0; j < 8; ++j) { const int c = j * 256 + lane * 4; gv[j] = *(const f32x4*)(gain + c); s1v[j] = *(const f32x4*)(sc + c); s0v[j] = *(const f32x4*)(sh + c); }
        __builtin_amdgcn_sched_barrier(0);
        int rn = r + stride; NR_SKIP(rn);
        if (rn < R) NR_LOAD(rn, nxb);
        __builtin_amdgcn_sched_barrier(0);
#pragma unroll
        for (int j = 0; j < 8; ++j) ss += x[j][0] * x[j][0] + x[j][1] * x[j][1] + x[j][2] * x[j][2] + x[j][3] * x[j][3];
        ss = wave_sum(ss); const float rstd = rsqrtf(ss * (1.f / D) + EPS);
#pragma unroll
        for (int j = 0; j < 8; ++j) { const int c = j * 256 + lane * 4;
            const f32x4 g = gv[j], s1 = s1v[j], s0 = s0v[j];
            const f32x4 y = (x[j] * rstd * g) * (1.f + s1) + s0;
            u32x2 pk; pk.x = cvtpk(y[0], y[1]); pk.y = cvtpk(y[2], y[3]); *(u32x2*)(h + (size_t)r * D + c) = pk;
            u32x2 pl; pl.x = cvtpk(y[0] - bflo(pk.x), y[1] - bfhi(pk.x)); pl.y = cvtpk(y[2] - bflo(pk.y), y[3] - bfhi(pk.y)); *(u32x2*)(hlo + (size_t)r * D + c) = pl; }
        if (lane == 0) rowtab[nent * 8 + w] = r;
        r = rn;
    }
#undef NR_LOAD
#undef NR_SKIP
    asm volatile("s_waitcnt vmcnt(0)" ::: "memory");
    __syncthreads();
    { const int rl = lane & 15, kq = lane >> 4; f32x4 acc[3] = {};
#pragma unroll
      for (int g = 0; g < 3; ++g) { int rr = rowtab[g * 16 + rl]; rr = rr < 0 ? 0 : rr;
          const bf16_t* ph = h + (size_t)rr * D + w * 256 + kq * 8; const bf16_t* pl = hlo + (size_t)rr * D + w * 256 + kq * 8;
          bf16x8 ah[8], al_[8];
#pragma unroll
          for (int kc = 0; kc < 8; ++kc) { ah[kc] = *(const bf16x8*)(ph + kc * 32); al_[kc] = *(const bf16x8*)(pl + kc * 32); }
#pragma unroll
          for (int kc = 0; kc < 8; ++kc) { const int kb = (w * 256 + kc * 32 + kq * 8) * 2;
              const bf16x8 bh = *(const bf16x8*)(whi + rl * WP + kb), bl = *(const bf16x8*)(wlo + rl * WP + kb);
              acc[g] = __builtin_amdgcn_mfma_f32_16x16x32_bf16(ah[kc], bh, acc[g], 0, 0, 0);
              acc[g] = __builtin_amdgcn_mfma_f32_16x16x32_bf16(ah[kc], bl, acc[g], 0, 0, 0);
              acc[g] = __builtin_amdgcn_mfma_f32_16x16x32_bf16(al_[kc], bh, acc[g], 0, 0, 0); }
#pragma unroll
          for (int q = 0; q < 4; ++q) red[((w * 3 + g) * 16 + kq * 4 + q) * 16 + rl] = acc[g][q]; } }
    __syncthreads();
    if (tid < 48) { const int rr = rowtab[tid];
        if (rr >= 0) { const int g = tid >> 4, tk = tid & 15;
            float lg[16];
#pragma unroll
            for (int e = 0; e < 16; ++e) { float s_ = 0.f;
#pragma unroll
                for (int ww = 0; ww < 8; ++ww) s_ += red[((ww * 3 + g) * 16 + tk) * 16 + e];
                lg[e] = s_; }
            float scv[16], sel[16];
#pragma unroll
            for (int e = 0; e < 16; ++e) { scv[e] = 1.f / (1.f + __expf(-lg[e])); sel[e] = scv[e] + a.in[25][e]; }
            int gbest = 0; float gbv = -1e30f;
#pragma unroll
            for (int gg = 0; gg < 4; ++gg) { float m1 = -1e30f, m2 = -1e30f;
#pragma unroll
                for (int i = 0; i < 4; ++i) { const float s_ = sel[gg * 4 + i]; if (s_ > m1) { m2 = m1; m1 = s_; } else if (s_ > m2) m2 = s_; }
                const float gs = m1 + m2; if (gs > gbv) { gbv = gs; gbest = gg; } }
            int e0 = 0, e1 = 0; float m1 = -1e30f, m2 = -1e30f; float w0 = 0.f, w1 = 0.f;
#pragma unroll
            for (int gg = 0; gg < 4; ++gg) if (gg == gbest) {
#pragma unroll
                for (int i = 0; i < 4; ++i) { const float s_ = sel[gg * 4 + i]; const int e = gg * 4 + i;
                    if (s_ > m1) { m2 = m1; e1 = e0; w1 = w0; m1 = s_; e0 = e; w0 = scv[e]; } else if (s_ > m2) { m2 = s_; e1 = e; w1 = scv[e]; } } }
            const float inv = 1.f / (w0 + w1);
            ent[tid * 2 + 0] = (e0 << 24) | (rr * 2); ent[tid * 2 + 1] = (e1 << 24) | (rr * 2 + 1);
            tok[rr * 4 + 0] = e0; tok[rr * 4 + 1] = e1; ((float*)tok)[rr * 4 + 2] = w0 * inv; ((float*)tok)[rr * 4 + 3] = w1 * inv; } }
    __syncthreads();
    if (tid < NE) { int c_ = 0;
        for (int j = 0; j < 128; ++j) c_ += ((ent[j] >> 24) == tid) ? 1 : 0;
        if (c_) { unsigned pos = atomicAdd(&cnt[tid * CNT_STRIDE], (unsigned)c_);
            for (int j = 0; j < 128; ++j) { const int en = ent[j]; if ((en >> 24) == tid) { __hip_atomic_store((__attribute__((address_space(1))) int*)(list + (size_t)tid * R + pos), en & 0xffffff, __ATOMIC_RELAXED, __HIP_MEMORY_SCOPE_AGENT); ++pos; } } } }
    __syncthreads();
}

DEV int scan_tok(int dir, int pos) { return dir == 0 ? pos : (pos < TC ? (TC - 1 - pos) : (S - 1 - (pos - TC))); }
template <int MODE>
DEV void scan_prep_phase(const Args& a, char* smem) {
    constexpr int NH = MODE == 0 ? 8 : 4, DV = MODE == 0 ? 128 : 256, LDP = MODE == 0 ? AB_INP : CD_INP, NVP = DV / 128;
    const int tid = tid_opaque(), dp = tid & 63, pg = tid >> 6, wid = tid >> 6, lane = tid & 63, l15 = lane & 15, l4 = lane >> 4;
    char* QT = smem; char* KT = smem + 64 * PQ; float* tot = (float*)(smem + 2 * 64 * PQ);
    float* aT = tot + 8 * 128;
    const bf16_t* P = (const bf16_t*)(a.ws + WS_P); const float* lb = (const float*)(a.ws + WS_LB);
    const float qscale = 0.08838834764831845f;
    const int nitems = NB * NH * 2 * 36;
#define SP_LOADS(it_, Q_, Z_, V_) do { const int c_ = (it_) % 36, dir_ = ((it_) / 36) & 1, hd_ = ((it_) / 72) % NH, b_ = (it_) / (72 * NH); \
        const int qcol_ = (MODE == 0 ? hd_ * 128 : 1536 + hd_ * 128) + 2 * dp, zcol_ = (MODE == 0 ? 1024 * (1 + dir_) + hd_ * 128 : 2048 + hd_ * 128) + 2 * dp, vcol_ = (MODE == 0 ? 3072 + hd_ * 128 : 2560 + hd_ * 256) + 2 * dp; \
        _Pragma("unroll") for (int j = 0; j < 8; ++j) { const bf16_t* pr = P + (size_t)(b_ * S + scan_tok(dir_, c_ * 64 + pg * 8 + j)) * LDP; \
            Q_[j] = *(const unsigned*)(pr + qcol_); Z_[j] = *(const unsigned*)(pr + zcol_); \
            _Pragma("unroll") for (int vv = 0; vv < NVP; ++vv) V_[vv][j] = *(const unsigned*)(pr + vcol_ + vv * 128); } } while (0)
    unsigned nz[8], nq[8], nv[NVP][8];
    if ((int)blockIdx.x < nitems) SP_LOADS((int)blockIdx.x, nq, nz, nv);
    for (int item = blockIdx.x; item < nitems; item += gridDim.x) {
        const int c = item % 36, dir = (item / 36) & 1, hd = (item / 72) % NH, b = item / (72 * NH);
        char* rec = (char*)(a.ws + (MODE == 0 ? WS_SREC : WS_SREC1)) + (size_t)item * REC_BYTES;
        char* vt = (char*)(a.ws + (MODE == 0 ? WS_SVT : WS_SVT1)) + (size_t)item * (DV * PA);
        unsigned zq[8], qq[8], kq[8], vq[NVP][8];
#pragma unroll
        for (int j = 0; j < 8; ++j) { qq[j] = nq[j]; zq[j] = nz[j]; kq[j] = nz[j];
#pragma unroll
            for (int vv = 0; vv < NVP; ++vv) vq[vv][j] = nv[vv][j]; }
        float lb0 = 0.f, lb1 = 0.f, gb0 = 0.f, gb1 = 0.f; float w0[16], w1[16]; u32x2 av = {0u, 0u};
        if (MODE == 0) { lb0 = lb[dir * 1024 + hd * 128 + 2 * dp]; lb1 = lb[dir * 1024 + hd * 128 + 2 * dp + 1]; }
        else { const int wc_ = hd * 128 + 2 * dp; gb0 = a.in[22][dir * 512 + wc_]; gb1 = a.in[22][dir * 512 + wc_ + 1];
#pragma unroll
            for (int i = 0; i < 16; ++i) { const float2 wv = *(const float2*)(a.in[21] + (size_t)(dir * 16 + i) * 512 + wc_); w0[i] = wv.x; w1[i] = wv.y; }
            const int pos = (tid & 255) >> 2, qd = tid & 3; const int r = b * S + scan_tok(dir, c * 64 + pos);
            av = *(const u32x2*)(P + (size_t)r * LDP + 4608 + dir * 16 + qd * 4); }
        __builtin_amdgcn_sched_barrier(0);
        { const int nxt = item + (int)gridDim.x < nitems ? item + (int)gridDim.x : item; SP_LOADS(nxt, nq, nz, nv); }
        __builtin_amdgcn_sched_barrier(0);
        if (MODE == 1) { if (tid < 256) { const int pos = tid >> 2, qd = tid & 3; *(f32x4*)(aT + pos * 16 + qd * 4) = (f32x4){bflo(av.x), bfhi(av.x), bflo(av.y), bfhi(av.y)}; }
            LDS_BARRIER(); }
        float g0[8], g1[8], k0[8], k1[8];
        if (MODE == 0) {
#pragma unroll
            for (int j = 0; j < 8; ++j) { const float f0 = lb0 + (1.f - lb0) * sigmoidf_(bflo(zq[j])), f1 = lb1 + (1.f - lb1) * sigmoidf_(bfhi(zq[j]));
                g0[j] = __logf(f0); g1[j] = __logf(f1); k0[j] = 1.f - f0; k1[j] = 1.f - f1; } }
        else {
#pragma unroll
            for (int j = 0; j < 8; ++j) { float z0 = gb0, z1 = gb1;
#pragma unroll
                for (int i4 = 0; i4 < 4; ++i4) { const f32x4 av = *(const f32x4*)(aT + (pg * 8 + j) * 16 + i4 * 4);
#pragma unroll
                    for (int e = 0; e < 4; ++e) { z0 += av[e] * w0[i4 * 4 + e]; z1 += av[e] * w1[i4 * 4 + e]; } }
                g0[j] = (fminf(z0, 0.f) - __logf(1.f + __expf(-fabsf(z0)))) * (1.f / 16.f); g1[j] = (fminf(z1, 0.f) - __logf(1.f + __expf(-fabsf(z1)))) * (1.f / 16.f);
                k0[j] = bflo(kq[j]); k1[j] = bfhi(kq[j]); } }
#pragma unroll
        for (int j = 1; j < 8; ++j) { g0[j] += g0[j - 1]; g1[j] += g1[j - 1]; }
        *(float2*)(tot + pg * 128 + 2 * dp) = make_float2(g0[7], g1[7]);
        LDS_BARRIER();
        float off0 = 0.f, off1 = 0.f, ref0 = 0.f, ref1 = 0.f, last0 = 0.f, last1 = 0.f;
#pragma unroll
        for (int p = 0; p < 8; ++p) { const float2 tp = *(const float2*)(tot + p * 128 + 2 * dp);
            if (p < pg) { off0 += tp.x; off1 += tp.y; } if (p < 4) { ref0 += tp.x; ref1 += tp.y; } last0 += tp.x; last1 += tp.y; }
        unsigned kh0[4], kh1[4];
        const float eref0 = __expf(ref0), eref1 = __expf(ref1), elr0 = __expf(last0 - ref0), elr1 = __expf(last1 - ref1);
#pragma unroll
        for (int j = 0; j < 8; j += 2) { float kha[2], khb[2];
#pragma unroll
            for (int e = 0; e < 2; ++e) { const int i = pg * 8 + j + e; const float G0 = off0 + g0[j + e], G1 = off1 + g1[j + e];
                float q0 = bflo(qq[j + e]), q1 = bfhi(qq[j + e]); if (MODE == 0) { q0 = siluf_(q0); q1 = siluf_(q1); } q0 *= qscale; q1 *= qscale;
                const float kk0 = k0[j + e], kk1 = k1[j + e];
                const float qt0 = q0 * __expf(G0 - ref0), qt1 = q1 * __expf(G1 - ref1), kt0 = kk0 * __expf(ref0 - G0), kt1 = kk1 * __expf(ref1 - G1);
                *(unsigned*)(QT + i * PQ + dp * 4) = cvtpk(qt0, qt1);
                *(unsigned*)(KT + i * PQ + dp * 4) = cvtpk(kt0, kt1);
                *(unsigned*)(rec + REC_QH + i * PQ + dp * 4) = cvtpk(qt0 * eref0, qt1 * eref1);
                kha[e] = kt0 * elr0; khb[e] = kt1 * elr1; }
            kh0[j >> 1] = cvtpk(kha[0], kha[1]); kh1[j >> 1] = cvtpk(khb[0], khb[1]); }
        *(u32x4*)(rec + REC_KHT + (2 * dp) * PA + pg * 16) = (u32x4){kh0[0], kh0[1], kh0[2], kh0[3]};
        *(u32x4*)(rec + REC_KHT + (2 * dp + 1) * PA + pg * 16) = (u32x4){kh1[0], kh1[1], kh1[2], kh1[3]};
        if (pg == 0) *(float2*)(rec + REC_AL + dp * 8) = make_float2(__expf(last0), __expf(last1));
#pragma unroll
        for (int vv = 0; vv < NVP; ++vv) { const int v0 = vv * 128 + 2 * dp; unsigned lo[4], hi[4];
#pragma unroll
            for (int j = 0; j < 8; j += 2) { lo[j >> 1] = (vq[vv][j] & 0xffffu) | (vq[vv][j + 1] << 16); hi[j >> 1] = (vq[vv][j] >> 16) | (vq[vv][j + 1] & 0xffff0000u); }
            *(u32x4*)(vt + v0 * PA + pg * 16) = (u32x4){lo[0], lo[1], lo[2], lo[3]};
            *(u32x4*)(vt + (v0 + 1) * PA + pg * 16) = (u32x4){hi[0], hi[1], hi[2], hi[3]}; }
        asm volatile("s_waitcnt lgkmcnt(0)" ::: "memory"); __builtin_amdgcn_s_barrier();
        { const int ti = wid >> 1; f32x4 acc[2] = {};
#pragma unroll
          for (int kk = 0; kk < 4; ++kk) { const int i = ti * 16 + l15;
              const bf16x8 bq = *(const bf16x8*)(QT + i * PQ + (kk * 32 + l4 * 8) * 2);
#pragma unroll
              for (int t2_ = 0; t2_ < 2; ++t2_) { const int sidx = ((wid & 1) * 2 + t2_) * 16 + l15;
                  const bf16x8 ak = *(const bf16x8*)(KT + sidx * PQ + (kk * 32 + l4 * 8) * 2);
                  acc[t2_] = __builtin_amdgcn_mfma_f32_16x16x32_bf16(ak, bq, acc[t2_], 0, 0, 0); } }
#pragma unroll
          for (int t2_ = 0; t2_ < 2; ++t2_) { const int tj = (wid & 1) * 2 + t2_, i = ti * 16 + l15, s0 = tj * 16 + 4 * l4;
              float x0 = (s0 + 0 <= i) ? acc[t2_][0] : 0.f, x1 = (s0 + 1 <= i) ? acc[t2_][1] : 0.f, x2 = (s0 + 2 <= i) ? acc[t2_][2] : 0.f, x3 = (s0 + 3 <= i) ? acc[t2_][3] : 0.f;
              u32x2 w_; w_.x = cvtpk(x0, x1); w_.y = cvtpk(x2, x3);
              *(u32x2*)(rec + REC_A + i * PA + s0 * 2) = w_; } }
    }
#undef SP_LOADS
    __syncthreads();
}
template <int MODE>
DEV void scan_seq_phase(const Args& a, char* smem) {
    constexpr int NH = MODE == 0 ? 8 : 4, DV = MODE == 0 ? 128 : 256, NVS = DV / 32;
    constexpr int B_A = REC_A, B_QH = REC_QH, B_KHT = REC_KHT, B_AL = REC_AL, B_VT = REC_BYTES, VTS = 32 * PA, BUFB = REC_BYTES + VTS;
    constexpr int NPIECE = BUFB / 16, NREC = REC_BYTES / 16, STB = 32 * PQ, NLD = 7 * 64;
    constexpr int NRL = (REC_BYTES / 128 + NVS - 1) / NVS, TOUCH_OFF = 3 * BUFB + STB;
    static_assert(NPIECE == 7 * NLD && REC_BYTES % 128 == 0 && VTS == 36 * 128 && NRL + 36 <= 128 && TOUCH_OFF + 256 <= LDS_BYTES_C - 16, "scan_seq layout");
    const int tid = tid_opaque(), wid = tid >> 6, lane = tid & 63, l15 = lane & 15, l4 = lane >> 4;
    char* ST = smem + 3 * BUFB;
    float* odir = (float*)(a.ws + WS_ODIR);
    for (int item = blockIdx.x; item < NB * NH * 2 * NVS; item += gridDim.x) {
        const int vs = (item >> 3) % NVS, rest = (item & 7) + 8 * ((item >> 3) / NVS);
        const int dir = rest & 1, hd = (rest >> 1) % NH, b = (rest >> 1) / NH;
        const char* rec0 = (const char*)(a.ws + (MODE == 0 ? WS_SREC : WS_SREC1)) + (size_t)rest * 36 * REC_BYTES;
        const char* vt0 = (const char*)(a.ws + (MODE == 0 ? WS_SVT : WS_SVT1)) + (size_t)rest * 36 * (DV * PA) + vs * VTS;
#define SC_LOAD(cc, bb) do { if (wid < 7) { const char* _r = rec0 + (size_t)(cc) * REC_BYTES; const char* _v = vt0 + (size_t)(cc) * (DV * PA) - REC_BYTES; char* _l = smem + (bb) * BUFB; \
        _Pragma("unroll") for (int _k = 0; _k < 7; ++_k) { const int _p = tid + _k * NLD; \
            __builtin_amdgcn_global_load_lds((const unsigned*)((_p < NREC ? _r : _v) + _p * 16), (unsigned*)(_l + _p * 16), 16, 0, 0); } } } while (0)
#define SC_TOUCH(cc) do { if (wid == 7) { _Pragma("unroll") for (int _q = 0; _q < 2; ++_q) { const int L_ = _q * 64 + lane; const char* tp_; \
        if (L_ < NRL) { int li_ = vs * NRL + L_; li_ = li_ < REC_BYTES / 128 - 1 ? li_ : REC_BYTES / 128 - 1; tp_ = rec0 + (size_t)(cc) * REC_BYTES + li_ * 128; } \
        else { int li_ = L_ - NRL; li_ = li_ < 35 ? li_ : 35; tp_ = vt0 + (size_t)(cc) * (DV * PA) + li_ * 128; } \
        __builtin_amdgcn_global_load_lds((const unsigned*)tp_, (unsigned*)(smem + TOUCH_OFF), 4, 0, 0); } } } while (0)
        for (int i = tid; i < STB / 16; i += NT) ((u32x4*)ST)[i] = (u32x4){0u, 0u, 0u, 0u};
        f32x4 Sacc[2] = {};
        SC_LOAD(0, 0); SC_LOAD(1, 1); SC_TOUCH(2); SC_TOUCH(3);
        asm volatile("s_waitcnt vmcnt(0) lgkmcnt(0)" ::: "memory"); __builtin_amdgcn_s_barrier(); asm volatile("" ::: "memory");
        int rb = 0;
#pragma unroll 1
        for (int c = 0; c < 36; ++c) {
            const char* buf = smem + rb * BUFB; const char* STr = ST; char* STw = ST;
            { const int nb2 = rb == 0 ? 2 : rb - 1;
              if (c + 2 < 36) SC_LOAD(c + 2, nb2); }
            rb = rb == 2 ? 0 : rb + 1;
            { const int ti = wid >> 1, tj = wid & 1, i = ti * 16 + l15, v = tj * 16 + l15, dr = wid * 16 + l15;
              bf16x8 ba[2], as_[4], bq[4], ak[2], bv[2][2];
#pragma unroll
              for (int kk = 0; kk < 2; ++kk) { ba[kk] = *(const bf16x8*)(buf + B_A + i * PA + (kk * 32 + l4 * 8) * 2); ak[kk] = *(const bf16x8*)(buf + B_KHT + dr * PA + (kk * 32 + l4 * 8) * 2);
                  bv[0][kk] = *(const bf16x8*)(buf + B_VT + l15 * PA + (kk * 32 + l4 * 8) * 2); bv[1][kk] = *(const bf16x8*)(buf + B_VT + (16 + l15) * PA + (kk * 32 + l4 * 8) * 2); }
              const f32x4 al = *(const f32x4*)(buf + B_AL + (wid * 16 + 4 * l4) * 4);
#pragma unroll
              for (int kk = 0; kk < 4; ++kk) { as_[kk] = *(const bf16x8*)(STr + v * PQ + (kk * 32 + l4 * 8) * 2); bq[kk] = *(const bf16x8*)(buf + B_QH + i * PQ + (kk * 32 + l4 * 8) * 2); }
              __builtin_amdgcn_sched_barrier(0);
              asm volatile("s_waitcnt lgkmcnt(0)" : "+v"(as_[0]), "+v"(as_[1]), "+v"(as_[2]), "+v"(as_[3]) :: "memory"); __builtin_amdgcn_s_barrier(); asm volatile("" ::: "memory");
              f32x4 acc = {}; Sacc[0] *= al; Sacc[1] *= al;
#pragma unroll
              for (int kk = 0; kk < 2; ++kk) {
                  acc = __builtin_amdgcn_mfma_f32_16x16x32_bf16(tj ? bv[1][kk] : bv[0][kk], ba[kk], acc, 0, 0, 0);
                  Sacc[0] = __builtin_amdgcn_mfma_f32_16x16x32_bf16(ak[kk], bv[0][kk], Sacc[0], 0, 0, 0);
                  Sacc[1] = __builtin_amdgcn_mfma_f32_16x16x32_bf16(ak[kk], bv[1][kk], Sacc[1], 0, 0, 0); }
#pragma unroll
              for (int kk = 0; kk < 4; ++kk) acc = __builtin_amdgcn_mfma_f32_16x16x32_bf16(as_[kk], bq[kk], acc, 0, 0, 0);
#pragma unroll
              for (int tv = 0; tv < 2; ++tv) { u32x2 w_; w_.x = cvtpk(Sacc[tv][0], Sacc[tv][1]); w_.y = cvtpk(Sacc[tv][2], Sacc[tv][3]);
                  *(u32x2*)(STw + (tv * 16 + l15) * PQ + (wid * 16 + 4 * l4) * 2) = w_; }
              const int r = b * S + scan_tok(dir, c * 64 + i);
              *(f32x4*)(odir + ((size_t)dir * R + r) * 1024 + hd * DV + vs * 32 + tj * 16 + 4 * l4) = acc; }
            SC_TOUCH(c + 4 < 36 ? c + 4 : 35);
            if (wid < 7) { if (c + 2 < 36) asm volatile("s_waitcnt vmcnt(8)" ::: "memory"); else asm volatile("s_waitcnt vmcnt(1)" ::: "memory"); } else asm volatile("s_waitcnt vmcnt(9)" ::: "memory");
            asm volatile("s_waitcnt lgkmcnt(0)" ::: "memory"); __builtin_amdgcn_s_barrier(); asm volatile("" ::: "memory");
        }
#undef SC_LOAD
#undef SC_TOUCH
    }
    asm volatile("s_waitcnt vmcnt(0)" ::: "memory"); __syncthreads();
}

namespace fa {
typedef short s16x4 __attribute__((ext_vector_type(4)));
typedef float f32x16 __attribute__((ext_vector_type(16)));
constexpr int QBLK = 32, KVBLK = 64, NW = 8;
constexpr float THR = 8.f;
#define FA_SBAR() __builtin_amdgcn_sched_barrier(0)
DEV int crow(int r, int hi) { return (r & 3) + 8 * (r >> 2) + 4 * hi; }
template <int DQ> DEV int kswz(int row, int colB) { return row * (DQ * 2) + (colB ^ ((row & 7) << 4)); }
template <int DQ> DEV void partialSM(f32x16& p0, f32x16& p1, float& m_reg, float& mn, float& alpha) {
    constexpr float SCALE = DQ == 128 ? 0.08838834764831845f : 0.07216878364870322f;
    constexpr float C = SCALE * 1.4426950408889634f;
    float pmax = p0[0];
#pragma unroll
    for (int r = 1; r < 16; ++r) pmax = fmaxf(pmax, p0[r]);
#pragma unroll
    for (int r = 0; r < 16; ++r) pmax = fmaxf(pmax, p1[r]);
    { auto rr = __builtin_amdgcn_permlane32_swap(__float_as_uint(pmax), __float_as_uint(pmax), false, false);
      pmax = fmaxf(__uint_as_float(rr[0]), __uint_as_float(rr[1])); }
    if (__builtin_expect(__all(pmax - m_reg <= THR / SCALE), 1)) { mn = m_reg; alpha = 1.f; }
    else { mn = fmaxf(m_reg, pmax); alpha = __builtin_amdgcn_exp2f((m_reg - mn) * C); m_reg = mn; }
    const float mnC = -mn * C;
#pragma unroll
    for (int r = 0; r < 16; ++r) p0[r] = fmaf(p0[r], C, mnC);
#pragma unroll
    for (int r = 0; r < 16; ++r) p1[r] = fmaf(p1[r], C, mnC);
#pragma unroll
    for (int r = 0; r < 16; ++r) p0[r] = __builtin_amdgcn_exp2f(p0[r]);
}
DEV void finishSM(f32x16& p0, f32x16& p1, float alpha, float& l_reg, bf16x8& pa0, bf16x8& pa1, bf16x8& pa2, bf16x8& pa3) {
#pragma unroll
    for (int r = 0; r < 16; ++r) p1[r] = __builtin_amdgcn_exp2f(p1[r]);
    float ps = 0;
#pragma unroll
    for (int r = 0; r < 16; ++r) ps += p0[r];
#pragma unroll
    for (int r = 0; r < 16; ++r) ps += p1[r];
    { auto rr = __builtin_amdgcn_permlane32_swap(__float_as_uint(ps), __float_as_uint(ps), false, false);
      ps = __uint_as_float(rr[0]) + __uint_as_float(rr[1]); }
    l_reg = l_reg * alpha + ps;
#define FA_PK4(P, BASE, OUT) do { unsigned a0 = cvtpk(P[BASE + 0], P[BASE + 1]), a1 = cvtpk(P[BASE + 2], P[BASE + 3]);   \
    unsigned b0 = cvtpk(P[BASE + 4], P[BASE + 5]), b1 = cvtpk(P[BASE + 6], P[BASE + 7]);                              \
    auto r0 = __builtin_amdgcn_permlane32_swap(a0, b0, false, false); auto r1 = __builtin_amdgcn_permlane32_swap(a1, b1, false, false); \
    u32x4 w = {r0[0], r1[0], r0[1], r1[1]}; OUT = *reinterpret_cast<bf16x8*>(&w); } while (0)
    FA_PK4(p0, 0, pa0); FA_PK4(p0, 8, pa1); FA_PK4(p1, 0, pa2); FA_PK4(p1, 8, pa3);
#undef FA_PK4
}
template <int DQ> DEV void qkt(f32x16& p0, f32x16& p1, const char* Ks, const bf16x8* qr, int r32, int hi) {
    p0 = f32x16{}; p1 = f32x16{};
#pragma unroll
    for (int d0 = 0; d0 < DQ / 16; ++d0) { const int cb = (d0 * 16 + hi * 8) * 2;
        const bf16x8 b0 = *reinterpret_cast<const bf16x8*>(Ks + kswz<DQ>(r32, cb));
        const bf16x8 b1 = *reinterpret_cast<const bf16x8*>(Ks + kswz<DQ>(32 + r32, cb));
        p0 = __builtin_amdgcn_mfma_f32_32x32x16_bf16(b0, qr[d0], p0, 0, 0, 0);
        p1 = __builtin_amdgcn_mfma_f32_32x32x16_bf16(b1, qr[d0], p1, 0, 0, 0); }
}
DEV int v_st(int k, int c) { const int kk = (k & ~0xC) | ((k & 4) << 1) | ((k & 8) >> 1); return ((kk >> 3) * 4 + (c >> 5)) * 512 + ((kk & 7) * 32 + (c & 31)) * 2; }
DEV int v_rd_base(int lane) { return ((lane & 3) << 3) | (((lane >> 2) & 3) << 6) | (((lane >> 4) & 1) << 5) | (((lane >> 5) & 1) << 8); }
constexpr int v_rd_off(int d0, int ks, int half) { return d0 * 512 + ks * 4096 + half * 2048; }
template <int OFF> DEV s16x4 tr_read(int vb) { s16x4 r; asm volatile("ds_read_b64_tr_b16 %0, %1 offset:%2" : "=&v"(r) : "v"(vb), "i"(OFF) : "memory"); return r; }
template <int D0> DEV void pv_one(f32x16& od, int vb, bf16x8 pa0, bf16x8 pa1, bf16x8 pa2, bf16x8 pa3) {
    const s16x4 l0 = tr_read<v_rd_off(D0, 0, 0)>(vb), h0 = tr_read<v_rd_off(D0, 0, 1)>(vb), l1 = tr_read<v_rd_off(D0, 1, 0)>(vb), h1 = tr_read<v_rd_off(D0, 1, 1)>(vb);
    const s16x4 l2 = tr_read<v_rd_off(D0, 2, 0)>(vb), h2 = tr_read<v_rd_off(D0, 2, 1)>(vb), l3 = tr_read<v_rd_off(D0, 3, 0)>(vb), h3 = tr_read<v_rd_off(D0, 3, 1)>(vb);
    asm volatile("s_waitcnt lgkmcnt(0)" ::: "memory"); FA_SBAR();
#define FA_PK(L, H) (bf16x8){L[0], L[1], L[2], L[3], H[0], H[1], H[2], H[3]}
    od = __builtin_amdgcn_mfma_f32_32x32x16_bf16(pa0, FA_PK(l0, h0), od, 0, 0, 0);
    od = __builtin_amdgcn_mfma_f32_32x32x16_bf16(pa1, FA_PK(l1, h1), od, 0, 0, 0);
    od = __builtin_amdgcn_mfma_f32_32x32x16_bf16(pa2, FA_PK(l2, h2), od, 0, 0, 0);
    od = __builtin_amdgcn_mfma_f32_32x32x16_bf16(pa3, FA_PK(l3, h3), od, 0, 0, 0);
#undef FA_PK
}
DEV void pv_d0(f32x16* o, int vb, bf16x8 pa0, bf16x8 pa1, bf16x8 pa2, bf16x8 pa3) {
    pv_one<0>(o[0], vb, pa0, pa1, pa2, pa3); pv_one<1>(o[1], vb, pa0, pa1, pa2, pa3); pv_one<2>(o[2], vb, pa0, pa1, pa2, pa3); pv_one<3>(o[3], vb, pa0, pa1, pa2, pa3);
}
template <int DQ>
DEV void attn_body(const bf16_t* __restrict__ Qb, const bf16_t* __restrict__ Kh, const bf16_t* __restrict__ Vh, bf16_t* __restrict__ Ob, int LDO_, int seq_, char* lds) {
    constexpr int LDO = D, seq = S; (void)LDO_; (void)seq_;
    constexpr int NKC = DQ / 64, KC8 = DQ / 8;
    constexpr int SHM_V = KVBLK * 128 * 2, SHM_K = KVBLK * DQ * 2;
    const int tid = tid_opaque(), wid = tid >> 6, lane = tid & 63, r32 = lane & 31, hi = lane >> 5;
    char* V_lds = lds; char* K_lds = lds + 2 * SHM_V;
    float* wsx = (float*)(lds + 2 * SHM_V + 2 * SHM_K) + wid * 64; float* li_l = wsx; float* al_l = wsx + 32;
    float m_reg = -1e30f, l_reg = 0; f32x16 o[4] = {}; bf16x8 qr[DQ / 16];
    const bf16_t* Qw = Qb + (size_t)(wid * QBLK + r32) * DQ + hi * 8;
#pragma unroll
    for (int d0 = 0; d0 < DQ / 16; ++d0) qr[d0] = *reinterpret_cast<const bf16x8*>(Qw + d0 * 16);
    const int sr = tid >> 4, sc = (tid & 15) * 8;
    const int vb0 = (int)(uintptr_t)V_lds + v_rd_base(lane);
    struct { bf16x8 vs0, vs1, ks[NKC]; } sr_[2];
#define SLOAD(i, k0) do { sr_[i].vs0 = *reinterpret_cast<const bf16x8*>(&Vh[(size_t)((k0) + sr) * 128 + sc]); sr_[i].vs1 = *reinterpret_cast<const bf16x8*>(&Vh[(size_t)((k0) + 32 + sr) * 128 + sc]); \
    _Pragma("unroll") for (int _c = 0; _c < NKC; ++_c) { const int ch = tid + _c * 512, kr = ch / KC8, kc = ch - kr * KC8; sr_[i].ks[_c] = *reinterpret_cast<const bf16x8*>(&Kh[(size_t)((k0) + kr) * DQ + kc * 8]); } } while (0)
#define SWRITE(b, i) do { const int t2_ = tid_opaque(), sr2_ = t2_ >> 4, sc2_ = (t2_ & 15) * 8; *(bf16x8*)(V_lds + (b) * SHM_V + v_st(sr2_, sc2_)) = sr_[i].vs0; *(bf16x8*)(V_lds + (b) * SHM_V + v_st(32 + sr2_, sc2_)) = sr_[i].vs1; \
    _Pragma("unroll") for (int _c = 0; _c < NKC; ++_c) { const int ch = tid + _c * 512, kr = ch / KC8, kc = ch - kr * KC8; *(bf16x8*)(K_lds + (b) * SHM_K + kswz<DQ>(kr, kc * 16)) = sr_[i].ks[_c]; } } while (0)
#define SWAIT() do { if constexpr (NKC == 2) asm volatile("s_waitcnt vmcnt(4)" ::: "memory"); else asm volatile("s_waitcnt vmcnt(5)" ::: "memory"); } while (0)
#define RESC(a_) do { if (__any((a_) < 1.f)) { if (hi == 0) al_l[r32] = (a_); asm volatile("s_waitcnt lgkmcnt(0)" ::: "memory"); \
    _Pragma("unroll") for (int d = 0; d < 4; ++d) _Pragma("unroll") for (int r = 0; r < 16; ++r) o[d][r] *= al_l[crow(r, hi)]; } } while (0)
    f32x16 pA0, pA1, pB0, pB1; float mnA, mnB, alA, alB; bf16x8 pa0, pa1, pa2, pa3; const int NTL = seq / KVBLK;
    constexpr int SE = 0, SO = 1;
    SLOAD(SE, 0); asm volatile("s_waitcnt vmcnt(0)" ::: "memory"); SWRITE(0, SE); __syncthreads();
    qkt<DQ>(pA0, pA1, K_lds, qr, r32, hi); partialSM<DQ>(pA0, pA1, m_reg, mnA, alA);
    SLOAD(SO, KVBLK); if (2 < NTL) SLOAD(SE, 2 * KVBLK);
    SWAIT(); SWRITE(1, SO); __syncthreads();
    for (int j = 1; j + 1 < NTL; j += 2) {
        FA_SBAR(); qkt<DQ>(pB0, pB1, K_lds + SHM_K, qr, r32, hi);
        finishSM(pA0, pA1, alA, l_reg, pa0, pa1, pa2, pa3); FA_SBAR();
        SLOAD(SO, (j + 2) * KVBLK); FA_SBAR();
        pv_d0(o, vb0, pa0, pa1, pa2, pa3); partialSM<DQ>(pB0, pB1, m_reg, mnB, alB);
        __syncthreads(); SWAIT(); SWRITE(0, SE);
        RESC(alB); __syncthreads();
        FA_SBAR(); qkt<DQ>(pA0, pA1, K_lds, qr, r32, hi);
        finishSM(pB0, pB1, alB, l_reg, pa0, pa1, pa2, pa3); FA_SBAR();
        if (j + 3 < NTL) SLOAD(SE, (j + 3) * KVBLK); FA_SBAR();
        pv_d0(o, vb0 + SHM_V, pa0, pa1, pa2, pa3); partialSM<DQ>(pA0, pA1, m_reg, mnA, alA);
        __syncthreads(); SWAIT(); SWRITE(1, SO);
        RESC(alA); __syncthreads();
    }
    FA_SBAR(); qkt<DQ>(pB0, pB1, K_lds + SHM_K, qr, r32, hi);
    finishSM(pA0, pA1, alA, l_reg, pa0, pa1, pa2, pa3); FA_SBAR();
    pv_d0(o, vb0, pa0, pa1, pa2, pa3); partialSM<DQ>(pB0, pB1, m_reg, mnB, alB);
    __syncthreads(); RESC(alB);
    finishSM(pB0, pB1, alB, l_reg, pa0, pa1, pa2, pa3); FA_SBAR();
    pv_d0(o, vb0 + SHM_V, pa0, pa1, pa2, pa3);
    if (hi == 0) li_l[r32] = l_reg; asm volatile("s_waitcnt lgkmcnt(0)" ::: "memory");
    float rli[16];
#pragma unroll
    for (int r = 0; r < 16; ++r) rli[r] = __builtin_amdgcn_rcpf(li_l[crow(r, hi)]);
    bf16_t* Ow = Ob + (size_t)(wid * QBLK) * LDO;
#pragma unroll
    for (int r = 0; r < 16; ++r) { const int orow = crow(r, hi);
#pragma unroll
        for (int d0 = 0; d0 < 4; ++d0) Ow[(size_t)orow * LDO + d0 * 32 + r32] = f2bf(o[d0][r] * rli[r]); }
    __syncthreads();
#undef SLOAD
#undef SWRITE
#undef SWAIT
#undef RESC
}

template <int DQ>
DEV void attn_body_simple(const bf16_t* __restrict__ Qb, const bf16_t* __restrict__ Kh, const bf16_t* __restrict__ Vh, bf16_t* __restrict__ Ob, int LDO, int seq, char* lds) {
    constexpr int NKC = DQ / 64, KC8 = DQ / 8;
    constexpr int SHM_V = KVBLK * 128 * 2, SHM_K = KVBLK * DQ * 2;
    const int tid = tid_opaque(), wid = tid >> 6, lane = tid & 63, r32 = lane & 31, hi = lane >> 5;
    char* V_lds = lds; char* K_lds = lds + 2 * SHM_V;
    float* wsx = (float*)(lds + 2 * SHM_V + 2 * SHM_K) + wid * 64; float* li_l = wsx; float* al_l = wsx + 32;
    float m_reg = -1e30f, l_reg = 0; f32x16 o[4] = {}; bf16x8 qr[DQ / 16];
    const bf16_t* Qw = Qb + (size_t)(wid * QBLK + r32) * DQ + hi * 8;
#pragma unroll
    for (int d0 = 0; d0 < DQ / 16; ++d0) qr[d0] = *reinterpret_cast<const bf16x8*>(Qw + d0 * 16);
    const int sr = tid >> 4, sc = (tid & 15) * 8, vst0 = v_st(sr, sc), vst1 = v_st(32 + sr, sc);
    const int vb0 = (int)(uintptr_t)V_lds + v_rd_base(lane);
    bf16x8 vs0, vs1, ks[NKC];
#define SLOAD(k0) do { vs0 = *reinterpret_cast<const bf16x8*>(&Vh[(size_t)((k0) + sr) * 128 + sc]); vs1 = *reinterpret_cast<const bf16x8*>(&Vh[(size_t)((k0) + 32 + sr) * 128 + sc]); \
    _Pragma("unroll") for (int _c = 0; _c < NKC; ++_c) { const int ch = tid + _c * 512, kr = ch / KC8, kc = ch - kr * KC8; ks[_c] = *reinterpret_cast<const bf16x8*>(&Kh[(size_t)((k0) + kr) * DQ + kc * 8]); } } while (0)
#define SWRITE(b) do { *(bf16x8*)(V_lds + (b) * SHM_V + vst0) = vs0; *(bf16x8*)(V_lds + (b) * SHM_V + vst1) = vs1; \
    _Pragma("unroll") for (int _c = 0; _c < NKC; ++_c) { const int ch = tid + _c * 512, kr = ch / KC8, kc = ch - kr * KC8; *(bf16x8*)(K_lds + (b) * SHM_K + kswz<DQ>(kr, kc * 16)) = ks[_c]; } } while (0)
    f32x16 p0, p1; float mn, al; bf16x8 pa0, pa1, pa2, pa3; const int NTL = seq / KVBLK;
    SLOAD(0); SWRITE(0); __syncthreads();
    for (int j = 0; j < NTL; ++j) {
        const int bsel = j & 1;
        if (j + 1 < NTL) SLOAD((j + 1) * KVBLK);
        FA_SBAR(); qkt<DQ>(p0, p1, K_lds + bsel * SHM_K, qr, r32, hi);
        partialSM<DQ>(p0, p1, m_reg, mn, al);
        if (__any(al < 1.f)) { if (hi == 0) al_l[r32] = al; asm volatile("s_waitcnt lgkmcnt(0)" ::: "memory");
#pragma unroll
            for (int d = 0; d < 4; ++d)
#pragma unroll
                for (int r = 0; r < 16; ++r) o[d][r] *= al_l[crow(r, hi)]; }
        finishSM(p0, p1, al, l_reg, pa0, pa1, pa2, pa3); FA_SBAR();
        pv_d0(o, vb0 + bsel * SHM_V, pa0, pa1, pa2, pa3);
        if (j + 1 < NTL) SWRITE(bsel ^ 1);
        __syncthreads();
    }
    if (hi == 0) li_l[r32] = l_reg; asm volatile("s_waitcnt lgkmcnt(0)" ::: "memory");
    float rli[16];
#pragma unroll
    for (int r = 0; r < 16; ++r) rli[r] = __builtin_amdgcn_rcpf(li_l[crow(r, hi)]);
    bf16_t* Ow = Ob + (size_t)(wid * QBLK) * LDO;
#pragma unroll
    for (int r = 0; r < 16; ++r) { const int orow = crow(r, hi);
#pragma unroll
        for (int d0 = 0; d0 < 4; ++d0) Ow[(size_t)orow * LDO + d0 * 32 + r32] = f2bf(o[d0][r] * rli[r]); }
    __syncthreads();
#undef SLOAD
#undef SWRITE
}
}

template <int DQ, int HKV, bool WITH_CTX>
DEV void attn_phase(const Args& a, int colbase, char* smem) {
    const bf16_t* Qb = (const bf16_t*)(a.ws + WS_QB); const bf16_t* Kb = (const bf16_t*)(a.ws + WS_KB); const bf16_t* Vb = (const bf16_t*)(a.ws + WS_VB);
    bf16_t* A2 = (bf16_t*)(a.ws + WS_A2);
    const int nunits = 256 + (WITH_CTX ? 32 : 0);
    for (int u = blockIdx.x; u < nunits; u += gridDim.x) {
        int b, hh, qb, nk;
        if (u < 256) { if (HKV == 8) { const int bh = u & 31; b = bh >> 3; hh = bh & 7; qb = 1 + (u >> 5); }
                       else { const int pr = u & 7, rest = u >> 3; b = pr >> 1; hh = (pr & 1) * 4 + (rest & 3); qb = 1 + (rest >> 2); }
                       nk = S; }
        else { const int bh = u - 256; b = bh >> 3; hh = bh & 7; qb = 0; nk = TC; }
        const int hk = hh / (8 / HKV);
        if constexpr (DQ == 192) fa::attn_body_simple<DQ>(Qb + (((size_t)b * 8 + hh) * S + qb * 256) * DQ, Kb + ((size_t)b * HKV + hk) * S * DQ, Vb + ((size_t)b * HKV + hk) * S * 128,
                          A2 + ((size_t)b * S + qb * 256) * D + colbase + hh * 128, D, nk, smem);
        else fa::attn_body<DQ>(Qb + (((size_t)b * 8 + hh) * S + qb * 256) * DQ, Kb + ((size_t)b * HKV + hk) * S * DQ, Vb + ((size_t)b * HKV + hk) * S * 128,
                          A2 + ((size_t)b * S + qb * 256) * D + colbase + hh * 128, D, nk, smem);
    }
}

template <int MODE>
DEV void mixout_phase(const Args& a, bool latent_only) {
    const int tid = tid_opaque(), w = tid >> 6, lane = tid & 63;
    constexpr int NH = MODE == 0 ? 8 : 4, DV = MODE == 0 ? 128 : 256, LDP = MODE == 0 ? AB_INP : CD_INP, GC = MODE == 0 ? 4096 : 3584, CB = MODE == 0 ? 0 : 1024, PER = DV / 64;
    const bf16_t* P = (const bf16_t*)(a.ws + WS_P); const float* odir = (const float*)(a.ws + WS_ODIR); bf16_t* A2 = (bf16_t*)(a.ws + WS_A2);
    const float* g = MODE == 0 ? a.in[12] : a.in[23];
    for (int it = blockIdx.x * 8 + w; it < R * NH; it += gridDim.x * 8) {
        const int r = it / NH, hd = it - r * NH; const int t = r % S; if (latent_only && t < TC) continue;
        float o[PER]; float ss = 0.f;
#pragma unroll
        for (int j = 0; j < PER; ++j) { const int c = hd * DV + j * 64 + lane; o[j] = odir[(size_t)r * 1024 + c] + odir[((size_t)R + r) * 1024 + c]; ss += o[j] * o[j]; }
        ss = wave_sum(ss); const float rs = rsqrtf(ss * (1.f / DV) + EPS);
#pragma unroll
        for (int j = 0; j < PER; ++j) { const int c = hd * DV + j * 64 + lane; const float gt = bf2f(P[(size_t)r * LDP + GC + c]);
            const float act = MODE == 0 ? sigmoidf_(gt) : siluf_(gt);
            A2[(size_t)r * D + CB + c] = f2bf(o[j] * rs * g[j * 64 + lane] * act); }
    }
}

#define GAS __attribute__((address_space(1)))
typedef GAS unsigned gu32; typedef GAS unsigned long long gu64;
#define RLX_AGENT __ATOMIC_RELAXED, __HIP_MEMORY_SCOPE_AGENT
struct EpiMoeUpSc1 { bf16_t* hid; int rowbase, nvalid;
    DEV void operator()(const f32x4 (&acc)[2][2][4][2], int brow, int bcol, int wr, int wc, int fr, int fq) const {
        const int hc = (bcol >> 1) + wc * 32 + fq * 4;
#pragma unroll
        for (int ai = 0; ai < 2; ++ai)
#pragma unroll
            for (int m = 0; m < 4; ++m) { const int lr = ai * HALF + wr * 64 + m * 16 + fr;
                if (lr < nvalid) { bf16_t* rowp = hid + (size_t)(rowbase + lr) * EDIM + hc;
#pragma unroll
                    for (int n = 0; n < 2; ++n) { const f32x4 a_ = acc[ai][0][m][n], b_ = acc[ai][1][m][n];
                        const unsigned lo = cvtpk(siluf_(a_[0]) * b_[0], siluf_(a_[1]) * b_[1]), hi = cvtpk(siluf_(a_[2]) * b_[2], siluf_(a_[3]) * b_[3]);
                        __hip_atomic_store((gu64*)(rowp + n * 16), (unsigned long long)lo | ((unsigned long long)hi << 32), RLX_AGENT); } } }
    } };
DEV void moe_phase_fused(const Args& a, int l, char* smem) {
    const int tid = tid_opaque();
    unsigned* ctl = (unsigned*)(a.ws + WS_CTL);
    unsigned* cnt = ctl + CW_CNT + l * 16 * CNT_STRIDE; unsigned* head = ctl + CW_MOEQ + l * 64; unsigned* ready = ctl + CW_RDY + l * (NE * 36 * 16);
    const int* list = (const int*)(a.ws + WS_LIST);
    const bf16_t* h = (const bf16_t*)(a.ws + WS_H); const bf16_t* w13 = moe_w13(a, l); const bf16_t* w2 = moe_w2(a, l);
    bf16_t* hid = (bf16_t*)(a.ws + WS_QB); bf16_t* y = (bf16_t*)(a.ws + WS_P);
    volatile int* tab = (volatile int*)(smem + SHM_GEMM);
    if (tid == 0) { int ub = 0, of = 0, nts[NE];
        for (int e = 0; e < NE; ++e) { const int n = (int)__hip_atomic_load((gu32*)(cnt + e * CNT_STRIDE), RLX_AGENT); nts[e] = (n + 255) >> 8; tab[e] = n; tab[16 + e] = ub; tab[50 + e] = of; ub += nts[e] * 4; of += n; }
        tab[32] = ub; int db = ub;
        for (int e = 0; e < NE; ++e) { tab[33 + e] = db; db += nts[e] * 8; }
        tab[49] = db; }
    for (;;) {
        __syncthreads();
        if (tid == 0) tab[66] = (int)__hip_atomic_fetch_add((gu32*)head, 1u, RLX_AGENT);
        __syncthreads();
        const int item = __builtin_amdgcn_readfirstlane(tab[66]), nup = __builtin_amdgcn_readfirstlane(tab[32]), ntot = __builtin_amdgcn_readfirstlane(tab[49]);
        if (item >= ntot) break;
        const bool up = item < nup; const int tb0 = up ? 16 : 33;
        int e = 0;
#pragma unroll 1
        for (int q = 1; q < NE; ++q) if (item >= __builtin_amdgcn_readfirstlane(tab[tb0 + q])) e = q;
        const int n = __builtin_amdgcn_readfirstlane(tab[e]), nt_ = (n + 255) >> 8, t = item - __builtin_amdgcn_readfirstlane(tab[tb0 + e]), off = __builtin_amdgcn_readfirstlane(tab[50 + e]);
        const int i = t % nt_, pn = t / nt_, nv = min(256, n - i * 256);
        gu32* flag = (gu32*)(ready + (e * 36 + i) * 16);
        if (up) {
            EpiMoeUpSc1 epi{hid, off + i * 256, nv};
            gemm_tile<true>(h, w13 + (size_t)e * 1024 * D, D, D, 0, pn * 256, list + (size_t)e * R + i * 256, nv, smem, epi);
            asm volatile("s_waitcnt vmcnt(0)" ::: "memory");
            __syncthreads();
            if (tid == 0) __hip_atomic_fetch_add(flag, 1u, RLX_AGENT);
        } else {
            if (tid < 64) { unsigned spins = 0;
                while ((unsigned)__builtin_amdgcn_readfirstlane(__hip_atomic_load(flag, RLX_AGENT)) < 4u) { __builtin_amdgcn_s_sleep(2); if (++spins > (1u << 22)) break; }
                __builtin_amdgcn_fence(__ATOMIC_ACQUIRE, "agent");
                asm volatile("s_waitcnt vmcnt(0)" ::: "memory"); }
            __syncthreads();
            EpiMoeDown epi{y, list + (size_t)e * R + i * 256, nv};
            gemm_tile<false>(hid, w2 + (size_t)e * D * EDIM, EDIM, EDIM, off + i * 256, pn * 256, nullptr, 0, smem, epi);
        }
    }
    __syncthreads();
}

DEV void moe_phase_up(const Args& a, int l, char* smem) {
    unsigned* cnt = (unsigned*)(a.ws + WS_CTL) + CW_CNT + l * 16 * CNT_STRIDE;
    const int* list = (const int*)(a.ws + WS_LIST);
    const bf16_t* h = (const bf16_t*)(a.ws + WS_H); const bf16_t* w13 = moe_w13(a, l); bf16_t* hid = (bf16_t*)(a.ws + WS_QB);
    int u = blockIdx.x, base = 0, off = 0;
    for (int e = 0; e < NE; ++e) { const int n = (int)__builtin_amdgcn_readfirstlane(__hip_atomic_load(cnt + e * CNT_STRIDE, __ATOMIC_RELAXED, __HIP_MEMORY_SCOPE_AGENT)), nt_ = (n + 255) >> 8, nu = nt_ * 4;
        for (; u < base + nu; u += gridDim.x) { const int t = u - base, i = t % nt_, pn = t / nt_; const int nv = min(256, n - i * 256);
            EpiMoeUp epi{hid, off + i * 256, nv};
            gemm_tile<true>(h, w13 + (size_t)e * 1024 * D, D, D, 0, pn * 256, list + (size_t)e * R + i * 256, nv, smem, epi); }
        base += nu; off += n; }
}
DEV void moe_phase_down(const Args& a, int l, char* smem) {
    unsigned* cnt = (unsigned*)(a.ws + WS_CTL) + CW_CNT + l * 16 * CNT_STRIDE;
    const int* list = (const int*)(a.ws + WS_LIST);
    const bf16_t* hid = (const bf16_t*)(a.ws + WS_QB); const bf16_t* w2 = moe_w2(a, l); bf16_t* y = (bf16_t*)(a.ws + WS_P);
    int u = blockIdx.x, base = 0, off = 0;
    for (int e = 0; e < NE; ++e) { const int n = (int)__builtin_amdgcn_readfirstlane(__hip_atomic_load(cnt + e * CNT_STRIDE, __ATOMIC_RELAXED, __HIP_MEMORY_SCOPE_AGENT)), nt_ = (n + 255) >> 8, nu = nt_ * 8;
        for (; u < base + nu; u += gridDim.x) { const int t = u - base, i = t % nt_, pn = t / nt_; const int nv = min(256, n - i * 256);
            EpiMoeDown epi{y, list + (size_t)e * R + i * 256, nv};
            gemm_tile<false>(hid, w2 + (size_t)e * D * EDIM, EDIM, EDIM, off + i * 256, pn * 256, nullptr, 0, smem, epi); }
        base += nu; off += n; }
}
template <bool FINAL>
DEV void combine_phase(const Args& a, int l, bool latent_only, bool dry = false) {
    const int tid = tid_opaque(), w = tid >> 6, lane = tid & 63;
    bf16_t* xres = (bf16_t*)(a.ws + WS_XRES); const bf16_t* y = (const bf16_t*)(a.ws + WS_P); const float* tokf = (const float*)(a.ws + WS_TOK);
    const float* modv = (const float*)(a.ws + WS_MODV) + (size_t)l * 5 * MODN; bf16_t* h = (bf16_t*)(a.ws + WS_H);
    const float* gain = FINAL ? a.in[8] : a.in[6] + (size_t)(l + 1) * D;
    const int stride = gridDim.x * 8;
#define CB_SKIP(rr) while ((rr) < R && latent_only && ((rr) % S) < TC) (rr) += stride
#define CB_LOAD(rr, Y0, Y1, XQ, W0, W1) do { const bf16_t* y0_ = y + (size_t)(2 * (rr)) * D; const bf16_t* xp_ = xres + (size_t)(rr) * D; W0 = tokf[(rr) * 4 + 2]; W1 = tokf[(rr) * 4 + 3]; \
        _Pragma("unroll") for (int j = 0; j < 8; ++j) { const int c = j * 256 + lane * 4; Y0[j] = *(const u32x2*)(y0_ + c); Y1[j] = *(const u32x2*)(y0_ + D + c); XQ[j] = *(const u32x2*)(xp_ + c); } } while (0)
    int r = blockIdx.x * 8 + w; CB_SKIP(r);
    u32x2 ny0[8], ny1[8], nxq[8]; float nw0 = 0.f, nw1 = 0.f;
    if (r < R) CB_LOAD(r, ny0, ny1, nxq, nw0, nw1);
    while (r < R) {
        const float w0 = nw0, w1 = nw1;
        const int b = r / S, t = r - b * S; const int v = t < TC ? 4 : b;
        const float* g2 = modv + (size_t)v * MODN + 5 * D; bf16_t* xp = xres + (size_t)r * D;
        f32x4 g2v[8];
#pragma unroll
        for (int j = 0; j < 8; ++j) g2v[j] = *(const f32x4*)(g2 + j * 256 + lane * 4);
        __builtin_amdgcn_sched_barrier(0);
        f32x4 x[8]; float ss = 0.f;
#pragma unroll
        for (int j = 0; j < 8; ++j) { const int c = j * 256 + lane * 4;
            const u32x2 a0 = ny0[j], a1 = ny1[j], xq = nxq[j];
            const f32x4 yy = {w0 * bflo(a0.x) + w1 * bflo(a1.x), w0 * bfhi(a0.x) + w1 * bfhi(a1.x), w0 * bflo(a0.y) + w1 * bflo(a1.y), w0 * bfhi(a0.y) + w1 * bfhi(a1.y)};
            x[j] = (f32x4){bflo(xq.x), bfhi(xq.x), bflo(xq.y), bfhi(xq.y)} + g2v[j] * yy;
            if (!FINAL && !dry) { u32x2 xw; xw.x = cvtpk(x[j][0], x[j][1]); xw.y = cvtpk(x[j][2], x[j][3]); *(u32x2*)(xp + c) = xw; }
            ss += x[j][0] * x[j][0] + x[j][1] * x[j][1] + x[j][2] * x[j][2] + x[j][3] * x[j][3]; }
        __builtin_amdgcn_sched_barrier(0);
        const float* sh = modv + 5 * MODN + (size_t)v * MODN; const float* sc = sh + D;
        f32x4 gv[8], scv[FINAL ? 1 : 8], shv[FINAL ? 1 : 8];
#pragma unroll
        for (int j = 0; j < 8; ++j) { const int c = j * 256 + lane * 4; gv[j] = *(const f32x4*)(gain + c); if (!FINAL) { scv[j] = *(const f32x4*)(sc + c); shv[j] = *(const f32x4*)(sh + c); } }
        __builtin_amdgcn_sched_barrier(0);
        int rn = r + stride; CB_SKIP(rn);
        if (rn < R) CB_LOAD(rn, ny0, ny1, nxq, nw0, nw1);
        __builtin_amdgcn_sched_barrier(0);
        ss = wave_sum(ss); const float rs = rsqrtf(ss * (1.f / D) + EPS);
        if (FINAL) { float* op = a.out + ((size_t)b * TL + (t - TC)) * D;
#pragma unroll
            for (int j = 0; j < 8; ++j) { const int c = j * 256 + lane * 4; *(f32x4*)(op + c) = x[j] * rs * gv[j]; } }
        else {
#pragma unroll
            for (int j = 0; j < 8; ++j) { const int c = j * 256 + lane * 4;
                const f32x4 yv = (x[j] * rs * gv[j]) * (1.f + scv[FINAL ? 0 : j]) + shv[FINAL ? 0 : j];
                u32x2 pk; pk.x = cvtpk(yv[0], yv[1]); pk.y = cvtpk(yv[2], yv[3]); if (!dry) *(u32x2*)(h + (size_t)r * D + c) = pk; } }
        r = rn;
    }
#undef CB_LOAD
#undef CB_SKIP
}

constexpr int LDS_BYTES = LDS_BYTES_C;
constexpr int NPHASES = 25;
__global__ void __launch_bounds__(NT, 2) fwd(Args a) {
    extern __shared__ __attribute__((aligned(16))) char smem[];
    unsigned char* ws = a.ws;
    const int lo = a.ph_lo, hi = a.ph_hi;
    volatile LAS unsigned* xbw = (volatile LAS unsigned*)(smem + LDS_BYTES - 16);
    if (threadIdx.x < 4) xbw[threadIdx.x] = 0u;
    __syncthreads();
    XcdBarrier bar; bar.bar = (unsigned*)(ws + WS_CTL); bar.x = 0; bar.st = xbw;
    if (hi - lo > 1) bar = xcd_barrier_post((unsigned*)(ws + WS_CTL), xbw);
#ifndef BARRIER_REP
#define BARRIER_REP 1
#endif
#ifndef TPROBE_MASK
#define TPROBE_MASK 0u
#endif
#ifndef TPROBE_ALPHA
#define TPROBE_ALPHA 4
#endif
    unsigned long long tp_prev = TPROBE_MASK ? __builtin_amdgcn_s_memrealtime() : 0ull, tp_acc = 0ull;
#define TPROBE(k) do { if (TPROBE_MASK) { const unsigned long long tn_ = __builtin_amdgcn_s_memrealtime(); if ((TPROBE_MASK >> (k)) & 1u) tp_acc += tn_ - tp_prev; tp_prev = tn_; } } while (0)
#ifndef WPROBE_MASK
#define WPROBE_MASK 0u
#endif
    unsigned long long wp_acc = 0ull;
#define SEAM(k) do { if (IN(k) && IN((k) + 1)) { const unsigned long long wa_ = WPROBE_MASK ? __builtin_amdgcn_s_memrealtime() : 0ull; for (int br_ = 0; br_ < BARRIER_REP; ++br_) xcd_barrier(bar); \
        if (WPROBE_MASK && ((WPROBE_MASK >> (k)) & 1u)) wp_acc += __builtin_amdgcn_s_memrealtime() - wa_; TPROBE(k); } } while (0)
#ifndef PHASE_MASK
#define PHASE_MASK 0xFFFFFFFFu
#endif
#define IN(k) (((PHASE_MASK >> (k)) & 1u) && lo <= (k) && (k) < hi)
#ifndef REPEAT_MASK
#define REPEAT_MASK 0u
#endif
#ifndef SUBREP
#define SUBREP 0
#endif
#define PHASE(k) if (IN(k)) for (int rep_ = 0; rep_ < ((((REPEAT_MASK) >> (k)) & 1u) ? 2 : 1); ++rep_, ((((REPEAT_MASK) >> (k)) & 1u) ? __syncthreads() : (void)0))
    const float* modv = (const float*)(ws + WS_MODV);
    bf16_t* H = (bf16_t*)(ws + WS_H); bf16_t* P = (bf16_t*)(ws + WS_P); bf16_t* A2 = (bf16_t*)(ws + WS_A2); bf16_t* XR = (bf16_t*)(ws + WS_XRES);
    PHASE(0) {
        cvt_weight(a.in[9], (bf16_t*)(ws + WS_WABIN), D, AB_IN, AB_INP, 1, 0, 0, 128, 0, nullptr, smem, 2);
        mod_phase<false>(a, 0, smem);
        misc_phase(a);
    }
    SEAM(0);
    PHASE(1) norm_phase<false, true>(a, 0, 0, a.in[6], false, smem);
    SEAM(1);
    PHASE(2) { int cur = 0; EpiInAB e{P, (float*)(ws + WS_SSQ), (bf16_t*)(ws + WS_KB), (const float2*)(ws + WS_TABB), smem};
#ifdef SEAM_PROBE
                 gemm_phase(H, (const bf16_t*)(ws + WS_WABIN), R, AB_INP, D, smem, e, cur, 0, 512); xcd_barrier(bar); cur = 0; gemm_phase(H, (const bf16_t*)(ws + WS_WABIN), R, AB_INP, D, smem, e, cur, 512, 864);
#else
                 gemm_phase(H, (const bf16_t*)(ws + WS_WABIN), R, AB_INP, D, smem, e, cur);
#endif
                 if (rep_ == 0) { cvt_cd_dynamic(a, smem); mod_phase<true>(a, 1, smem); } }
    SEAM(2);
    PHASE(3) { int cur = 0; EpiUQ e1{(bf16_t*)(ws + WS_QB), (const float*)(ws + WS_SSQ), (const float2*)(ws + WS_TABB)};
                 gemm_phase<false, AB_INP>(P + 5120, (const bf16_t*)(ws + WS_WUQ), R, 1536, 512, smem, e1, cur);
                 EpiUKV e2{(bf16_t*)(ws + WS_KB), (bf16_t*)(ws + WS_VB), (const float*)(ws + WS_SSQ)};
                 gemm_phase<false, AB_INP>(P + 5632, (const bf16_t*)(ws + WS_WUKV), R, 2048, 256, smem, e2, cur);
                 scan_prep_phase<0>(a, smem); if (SUBREP & 1) scan_prep_phase<0>(a, smem); }
    SEAM(3);
    PHASE(6) scan_seq_phase<0>(a, smem);
    PHASE(7) attn_phase<192, 8, true>(a, 1024, smem);
    SEAM(7);
    PHASE(8) { mixout_phase<0>(a, false); if (SUBREP & 2) mixout_phase<0>(a, false); }
    SEAM(8);
    PHASE(9) { int cur = 0; EpiResidGate e{XR, modv + 2 * D, rep_ > 0, rep_ > 0 ? nullptr : a.in[0], a.in[2]}; gemm_phase(A2, (const bf16_t*)(ws + WS_WABOUT), R, D, D, smem, e, cur); cvt_moe_dynamic(a, 0, smem); }
    SEAM(9);
    PHASE(10) norm_router_phase(a, 0, 3, a.in[7], false, smem);
    SEAM(10);
#ifndef MOE_SPLIT
    PHASE(11) { moe_phase_fused(a, 0, smem); cvt_moe_dynamic(a, 1, smem); }
    SEAM(11);
#else
    PHASE(11) { moe_phase_up(a, 0, smem); cvt_moe_dynamic(a, 1, smem); }
    SEAM(11);
    PHASE(12) { moe_phase_down(a, 0, smem); cvt_moe_dynamic(a, 1, smem); }
    SEAM(12);
#endif
    PHASE(13) { combine_phase<false>(a, 0, false, rep_ > 0); cvt_moe_dynamic(a, 1, smem); }
    SEAM(13);
    PHASE(15) { int cur = 0; EpiInCD e{P, (bf16_t*)(ws + WS_QB), (bf16_t*)(ws + WS_KB), (bf16_t*)(ws + WS_VB), (const float2*)(ws + WS_TABC), a.in[19], a.in[20], smem}; gemm_phase(H, (const bf16_t*)(ws + WS_WCDIN), R, CD_INP, D, smem, e, cur); }
    SEAM(15);
    PHASE(16) { scan_prep_phase<1>(a, smem); if (SUBREP & 1) scan_prep_phase<1>(a, smem); }
    SEAM(16);
    PHASE(17) scan_seq_phase<1>(a, smem);
    PHASE(18) attn_phase<128, 2, false>(a, 0, smem);
    SEAM(18);
    PHASE(19) { mixout_phase<1>(a, true); if (SUBREP & 2) mixout_phase<1>(a, true); }
    SEAM(19);
    PHASE(20) { int cur = 0; EpiResidGate e{XR, modv + 5 * MODN + 2 * D, rep_ > 0, nullptr, nullptr}; gemm_phase<true>(A2, (const bf16_t*)(ws + WS_WCDOUT), NB * TL, D, D, smem, e, cur); }
    SEAM(20);
    PHASE(21) norm_router_phase(a, 1, 3, a.in[7] + D, true, smem);
    SEAM(21);
#ifndef MOE_SPLIT
    PHASE(22) moe_phase_fused(a, 1, smem);
    SEAM(22);
#else
    PHASE(22) moe_phase_up(a, 1, smem);
    SEAM(22);
    PHASE(23) moe_phase_down(a, 1, smem);
    SEAM(23);
#endif
    PHASE(24) combine_phase<true>(a, 1, true);
    if (TPROBE_MASK) { TPROBE(24);
        if (blockIdx.x == 0) { const unsigned long long t0_ = __builtin_amdgcn_s_memrealtime(); while (__builtin_amdgcn_s_memrealtime() - t0_ < (unsigned long long)TPROBE_ALPHA * tp_acc) __builtin_amdgcn_s_sleep(8); } }
    if (WPROBE_MASK) { unsigned* wsum = (unsigned*)(ws + WS_CTL) + 30000;
        if (threadIdx.x == 0) atomicAdd(wsum, (unsigned)wp_acc);
        xcd_barrier(bar);
        if (blockIdx.x == 0) { const unsigned long long tot_ = __hip_atomic_load(wsum, __ATOMIC_RELAXED, __HIP_MEMORY_SCOPE_AGENT) / gridDim.x;
            const unsigned long long t0_ = __builtin_amdgcn_s_memrealtime(); while (__builtin_amdgcn_s_memrealtime() - t0_ < (unsigned long long)TPROBE_ALPHA * tot_) __builtin_amdgcn_s_sleep(8); } }
#undef IN
#undef PHASE
#undef SEAM
}

extern "C" void kernel_launch(void* const* d_in, const int* in_sizes, int n_in, void* d_out, int out_size, void* d_ws, size_t ws_size, hipStream_t stream) {
    static int grid = 0;
    if (grid == 0) {
        if (n_in != 29 || out_size != NB * TL * D || ws_size < WS_END) { fprintf(stderr, "kernel_launch: shape/workspace mismatch: n_in %d out %d ws %zu (need %zu)\n", n_in, out_size, ws_size, (size_t)WS_END); grid = -1; return; }
        int dev = 0, cus = 0;
        if (hipGetDevice(&dev) != hipSuccess || hipDeviceGetAttribute(&cus, hipDeviceAttributeMultiprocessorCount, dev) != hipSuccess) { grid = -1; return; }
        if (hipFuncSetAttribute((const void*)fwd, hipFuncAttributeMaxDynamicSharedMemorySize, LDS_BYTES) != hipSuccess) { fprintf(stderr, "kernel_launch: hipFuncSetAttribute failed\n"); grid = -1; return; }
        grid = cus > 0 ? cus : 256;
    }
    if (grid < 0) return;
    (void)hipMemsetAsync((char*)d_ws + WS_CTL, 0, CTL_BYTES, stream);
    Args a{};
    for (int i = 0; i < 29; ++i) a.in[i] = (const float*)d_in[i];
    a.out = (float*)d_out; a.ws = (unsigned char*)d_ws;
#ifndef MK_PER_PHASE
    a.ph_lo = 0; a.ph_hi = NPHASES; hipLaunchKernelGGL(fwd, dim3(grid), dim3(NT), LDS_BYTES, stream, a);
#else
    for (int ph = 0; ph < NPHASES; ++ph) { a.ph_lo = ph; a.ph_hi = ph + 1; hipLaunchKernelGGL(fwd, dim3(grid), dim3(NT), LDS_BYTES, stream, a); }
#endif
}
```

```cpp
#include <hip/hip_runtime.h>
#include <cstdio>
#include <cstdint>

#define DEV __device__ __forceinline__
typedef unsigned short bf16_t;
typedef short bf16x8 __attribute__((ext_vector_type(8)));
typedef float f32x4 __attribute__((ext_vector_type(4)));
typedef float f32x2 __attribute__((ext_vector_type(2)));
typedef unsigned u32x4 __attribute__((ext_vector_type(4)));
typedef unsigned u32x2 __attribute__((ext_vector_type(2)));

constexpr int NB = 4, TL = 2048, TC = 256, S = TL + TC, R = NB * S, D = 2048;
constexpr int NT = 512;
constexpr float EPS = 1e-6f;
constexpr int AB_IN = 5952, AB_INP = 6144, CD_IN = 4640, CD_INP = 4864;
constexpr int NE = 16, EDIM = 512;
constexpr int MODN = 6 * D;

constexpr size_t al256(size_t x) { return (x + 255) & ~(size_t)255; }
constexpr size_t WS_CTL = 0;
constexpr int    CW_CNT = 26624;
constexpr int    CNT_STRIDE = 64;
constexpr int    CW_CVT = 4224;
constexpr size_t CTL_BYTES = 131072;
constexpr int    CW_MOEQ = 4608;
constexpr int    CW_RDY = 8192;
constexpr size_t WS_MODV = WS_CTL + CTL_BYTES;
constexpr size_t WS_LB   = al256(WS_MODV + (size_t)2 * 5 * MODN * 4);
constexpr size_t WS_TABB = al256(WS_LB + 2 * 1024 * 4);
constexpr size_t WS_TABC = al256(WS_TABB + (size_t)S * 32 * 8);
constexpr size_t WS_TOK  = al256(WS_TABC + (size_t)S * 64 * 8);
constexpr size_t WS_LIST = al256(WS_TOK + (size_t)R * 16);
constexpr size_t WS_WABIN = al256(WS_LIST + (size_t)NE * R * 4);
constexpr size_t WS_WABOUT = al256(WS_WABIN + (size_t)AB_INP * D * 2);
constexpr size_t WS_WUQ  = al256(WS_WABOUT + (size_t)D * D * 2);
constexpr size_t WS_WUKV = al256(WS_WUQ + (size_t)1536 * 512 * 2);
constexpr size_t WS_WCDIN = al256(WS_WUKV + (size_t)2048 * 256 * 2);
constexpr size_t WS_WCDOUT = al256(WS_WCDIN + (size_t)CD_INP * D * 2);
constexpr size_t WS_W13  = al256(WS_WCDOUT + (size_t)D * D * 2);
constexpr size_t WS_W2   = al256(WS_W13 + (size_t)NE * 1024 * D * 2);
constexpr size_t WS_XRES = al256(WS_W2 + (size_t)NE * D * EDIM * 2);
constexpr size_t WS_H    = al256(WS_XRES + (size_t)R * D * 2);
constexpr size_t WS_P    = al256(WS_H + (size_t)R * D * 2);
constexpr size_t WS_ODIR = al256(WS_P + (size_t)R * AB_INP * 2);
constexpr size_t WS_QF   = WS_ODIR;
constexpr size_t WS_KVF  = al256(WS_QF + (size_t)R * 1536 * 2);
static_assert(WS_KVF + (size_t)R * 2048 * 2 <= WS_ODIR + (size_t)2 * R * 1024 * 4, "QF/KVF alias ODIR");
constexpr size_t WS_A2   = al256(WS_ODIR + (size_t)2 * R * 1024 * 4);
constexpr size_t WS_QB   = al256(WS_A2 + (size_t)R * D * 2);
constexpr size_t WS_KB   = al256(WS_QB + (size_t)NB * 8 * S * 192 * 2);
constexpr size_t WS_VB   = al256(WS_KB + (size_t)NB * 8 * S * 192 * 2);
constexpr size_t WS_SSQ  = al256(WS_VB + (size_t)NB * 8 * S * 128 * 2);
constexpr size_t WS_P5N_UNUSED = al256(WS_VB + (size_t)NB * 8 * S * 128 * 2);
constexpr size_t WS_P6N  = al256(WS_SSQ + (size_t)R * 16);
constexpr size_t WS_SVT  = WS_P6N;
constexpr size_t WS_SREC = al256(WS_SVT + (size_t)NB * 8 * 2 * 36 * 128 * 144);
constexpr int LDS_BYTES_C = 160 * 1024;
constexpr int PA = 144, PQ = 272;
constexpr int REC_A = 0, REC_QH = 64 * PA, REC_KHT = REC_QH + 64 * PQ, REC_AL = REC_KHT + 128 * PA, REC_BYTES = REC_AL + 512;
constexpr size_t WS_END  = al256(WS_SREC + (size_t)NB * 8 * 2 * 36 * REC_BYTES);
constexpr size_t WS_SVT1 = WS_W13;
constexpr size_t WS_SREC1 = al256(WS_SVT1 + (size_t)NB * 4 * 2 * 36 * 256 * 144);
static_assert(WS_SREC1 + (size_t)NB * 4 * 2 * 36 * REC_BYTES <= WS_XRES, "layer-1 scan images alias");
static_assert(WS_SVT + (size_t)NE * 1024 * D * 2 + (size_t)NE * D * EDIM * 2 <= WS_END, "layer-1 MoE weights alias");
static_assert((size_t)(2 * R + 256) * 512 * 2 <= WS_KB - WS_QB, "HIDDEN alias");
static_assert((size_t)R * 2 * D * 2 <= WS_ODIR - WS_P, "YSLOTS alias");

struct Args { const float* in[29]; float* out; unsigned char* ws; int ph_lo, ph_hi; };

typedef __bf16 bf16v2_t __attribute__((ext_vector_type(2)));
DEV unsigned cvtpk(float lo, float hi) { bf16v2_t v; v.x = (__bf16)lo; v.y = (__bf16)hi; return __builtin_bit_cast(unsigned, v); }
DEV bf16_t f2bf(float x) { return (bf16_t)(cvtpk(x, 0.f) & 0xffffu); }
DEV float bf2f(bf16_t x) { return __uint_as_float(((unsigned)x) << 16); }
DEV float bflo(unsigned w) { return __uint_as_float(w << 16); }
DEV float bfhi(unsigned w) { return __uint_as_float(w & 0xffff0000u); }
DEV float sigmoidf_(float x) { return 1.f / (1.f + __expf(-x)); }
DEV float siluf_(float x) { return x / (1.f + __expf(-x)); }
DEV float wave_sum(float v) {
#pragma unroll
    for (int o = 32; o >= 1; o >>= 1) v += __shfl_xor(v, o);
    return v;
}
DEV float wave_max(float v) {
#pragma unroll
    for (int o = 32; o >= 1; o >>= 1) v = fmaxf(v, __shfl_xor(v, o));
    return v;
}
DEV int tid_opaque() { int t = threadIdx.x; asm volatile("" : "+v"(t)); return t; }
DEV int modvec_of_row(int r) { const int b = r / S, t = r - b * S; return t < TC ? 4 : b; }

#define XB_TMO      128
#define XB_XCNT(j)  (256  + 64 * (j))
#define XB_XSUB(j)  (1280 + 64 * (j))
#define XB_XGEN(j)  (2304 + 64 * (j))
#define XB_TOP      3328
#define XB_TOPGEN   3392
#define XCD_BAR_WORDS 3456
#define XB_SPIN_CAP (1u << 18)
#define LAS __attribute__((address_space(3)))

__device__ __forceinline__ unsigned xb_ld(unsigned* p)              { return __hip_atomic_load(p, __ATOMIC_RELAXED, __HIP_MEMORY_SCOPE_AGENT); }
__device__ __forceinline__ unsigned xb_add(unsigned* p, unsigned v) { return __hip_atomic_fetch_add(p, v, __ATOMIC_RELAXED, __HIP_MEMORY_SCOPE_AGENT); }
__device__ __forceinline__ unsigned xb_xcc_id() { return (unsigned)__builtin_amdgcn_s_getreg((3 << 11) | 20) & 0xFu; }
#define XB_SPIN(cond, bar) do { unsigned _sp = 0; while (cond) { __builtin_amdgcn_s_sleep(1); \
    if ((++_sp & 255u) == 0u) { if (xb_ld(&(bar)[XB_TMO])) break; if (_sp > XB_SPIN_CAP) { atomicAdd(&(bar)[XB_TMO], 1u); break; } } } } while (0)

struct XcdBarrier {
    unsigned* bar; unsigned x;
    volatile LAS unsigned* st;
};

__device__ __forceinline__ XcdBarrier xcd_barrier_post(unsigned* bar, volatile LAS unsigned* st) {
    XcdBarrier b; b.bar = bar; b.x = xb_xcc_id(); b.st = st;
    if (threadIdx.x == 0) (void)xb_add(&bar[XB_XCNT(b.x)], 1u);
    return b;
}
__device__ __forceinline__ void xcd_barrier_complete(unsigned* bar, unsigned x, unsigned& nloc, unsigned& nx) {
    const unsigned G = gridDim.x * gridDim.y * gridDim.z;
    unsigned sum, cnt, mine, sp = 0u;
    for (;;) {
        sum = 0u; cnt = 0u; mine = 0u;
#pragma unroll
        for (unsigned j = 0; j < 16; ++j) { const unsigned c = xb_ld(&bar[XB_XCNT(j)]); sum += c; cnt += (c > 0u) ? 1u : 0u; mine = (j == x) ? c : mine; }
        if (sum == G) break;
        __builtin_amdgcn_s_sleep(1);
        if ((++sp & 255u) == 0u) { if (xb_ld(&bar[XB_TMO])) break; if (sp > XB_SPIN_CAP) { atomicAdd(&bar[XB_TMO], 1u); break; } }
    }
    nloc = mine > 0u ? mine : 1u; nx = cnt > 0u ? cnt : 1u;
}

__device__ __forceinline__ void xcd_barrier(const XcdBarrier& b) {
    asm volatile("s_waitcnt vmcnt(0)" ::: "memory");
    __syncthreads();
    if (threadIdx.x == 0) {
        unsigned* bar = b.bar;
        __builtin_amdgcn_s_waitcnt(0);
        unsigned nloc = b.st[0], nx = b.st[1];
        if (nloc == 0u) { xcd_barrier_complete(bar, b.x, nloc, nx); b.st[0] = nloc; b.st[1] = nx; }
        const unsigned old = xb_add(&bar[XB_XSUB(b.x)], 1u);
        const unsigned gen = old / nloc;
        if (old + 1u == (gen + 1u) * nloc) {
            __builtin_amdgcn_fence(__ATOMIC_RELEASE, "agent");
            asm volatile("s_waitcnt vmcnt(0)" ::: "memory");
            const unsigned og = xb_add(&bar[XB_TOP], 1u);
            const unsigned tg = og / nx;
            if (og + 1u == (tg + 1u) * nx) xb_add(&bar[XB_TOPGEN], 1u);
            else XB_SPIN(xb_ld(&bar[XB_TOPGEN]) == tg, bar);
            __builtin_amdgcn_fence(__ATOMIC_ACQUIRE, "agent");
            xb_add(&bar[XB_XGEN(b.x)], 1u);
            asm volatile("s_waitcnt vmcnt(0)" ::: "memory");
        } else {
            XB_SPIN(xb_ld(&bar[XB_XGEN(b.x)]) == gen, bar);
            __builtin_amdgcn_fence(__ATOMIC_ACQUIRE, "agent");
            asm volatile("s_waitcnt vmcnt(0)" ::: "memory");
        }
    }
    __syncthreads();
}


constexpr int BM = 256, BK = 64, HALF = 128, HT = HALF * BK, SHM_GEMM = 8 * HT * 2;
DEV int lds_byte(int r, int c) { int st = (r >> 4) * 2 + (c >> 5), rr = r & 15, cc = c & 31, ob = rr * 64 + cc * 2; return st * 1024 + (ob ^ (((ob >> 9) & 1) << 5)); }
DEV void stage_rc(int b, int& Rr, int& Cc) { int st = b / 1024, sb = b % 1024, swz = sb ^ (((sb >> 9) & 1) << 5); Rr = (st >> 1) * 16 + swz / 64; Cc = (st & 1) * 32 + (swz % 64) / 2; }

template <bool GATHER, int LDA_ = 0, class Epi>
DEV void gemm_tile(const bf16_t* __restrict__ A, const bf16_t* __restrict__ Bt, int ld, int K, int brow, int bcol,
                   const int* __restrict__ rowmap, int nvalid, char* smem, const Epi& epi) {
    bf16_t* shm = (bf16_t*)smem;
#define SA(b, h) (shm + ((b) * 2 + (h)) * HT)
#define SB(b, h) (shm + (4 + (b) * 2 + (h)) * HT)
#define GLDS(gp, lp) __builtin_amdgcn_global_load_lds((const unsigned*)(gp), (unsigned*)(lp), 16, 0, 0)
#define STAGE_A(P, h, kt) do { _Pragma("unroll") for (int _i = 0; _i < 2; ++_i) { \
        const char* _sb = GATHER ? (const char*)A + (size_t)(kt) * (BK * 2) : (const char*)A + ((size_t)(brow + (h) * HALF + _i * 64) * (LDA_ ? LDA_ : ld) + (size_t)(kt) * BK) * 2; \
        GLDS(_sb + (GATHER ? voffa[h][_i] : voffA), (char*)(P) + tid16 + _i * 8192); } } while (0)
#define STAGE_B(P, h, kt) do { _Pragma("unroll") for (int _i = 0; _i < 2; ++_i) { \
        const char* _sb = (const char*)Bt + ((size_t)(bcol + (h) * HALF + _i * 64) * ld + (size_t)(kt) * BK) * 2; \
        GLDS(_sb + voff, (char*)(P) + tid16 + _i * 8192); } } while (0)
#define LDA(dst, b, h) _Pragma("unroll") for (int m = 0; m < 4; ++m) _Pragma("unroll") for (int k = 0; k < 2; ++k) \
        dst[m][k] = *reinterpret_cast<const bf16x8*>((char*)SA(b, h) + lds_byte(wr * 64 + m * 16 + fr, k * 32 + fq * 8))
#define LDB(dst, b, h) _Pragma("unroll") for (int n = 0; n < 2; ++n) _Pragma("unroll") for (int k = 0; k < 2; ++k) \
        dst[n][k] = *reinterpret_cast<const bf16x8*>((char*)SB(b, h) + lds_byte(wc * 32 + n * 16 + fr, k * 32 + fq * 8))
#define MMA(ai, bj, At_, Bt_) do { __builtin_amdgcn_s_setprio(1); \
        _Pragma("unroll") for (int m = 0; m < 4; ++m) _Pragma("unroll") for (int n = 0; n < 2; ++n) _Pragma("unroll") for (int k = 0; k < 2; ++k) \
            acc[ai][bj][m][n] = __builtin_amdgcn_mfma_f32_16x16x32_bf16(Bt_[n][k], At_[m][k], acc[ai][bj][m][n], 0, 0, 0); \
        __builtin_amdgcn_s_setprio(0); } while (0)
#define WAIT_V(n) asm volatile("s_waitcnt vmcnt(" #n ")" ::: "memory")
#define WAIT_L(n) asm volatile("s_waitcnt lgkmcnt(" #n ")" ::: "memory")
#define BAR __builtin_amdgcn_s_barrier()
#define SCHED __builtin_amdgcn_sched_barrier(0)
    int tid = threadIdx.x; asm volatile("" : "+v"(tid));
    int wid = tid >> 6, lane = tid & 63, wr = wid >> 2, wc = wid & 3, fr = lane & 15, fq = lane >> 4;
    const int tid16 = tid * 16;
    unsigned voff, voffA; unsigned voffa[2][2];
    {
        int r0, c0; stage_rc(tid16, r0, c0);
        voff = (unsigned)(r0 * ld + c0) * 2u; voffA = LDA_ ? (unsigned)(r0 * LDA_ + c0) * 2u : voff;
#pragma unroll
        for (int h = 0; h < 2; ++h)
#pragma unroll
            for (int i = 0; i < 2; ++i) {
                if (GATHER) { int l0 = h * HALF + i * 64 + r0; l0 = l0 < nvalid ? l0 : nvalid - 1; voffa[h][i] = (unsigned)((rowmap[l0] >> 1) * ld + c0) * 2u; }
                else voffa[h][i] = 0u;
            }
    }
    f32x4 acc[2][2][4][2] = {};
    bf16x8 At[4][2], B0[2][2], B1[2][2];
    const int nt = K / BK;
    STAGE_B(SB(0, 0), 0, 0); STAGE_A(SA(0, 0), 0, 0);
    STAGE_B(SB(0, 1), 1, 0); STAGE_A(SA(0, 1), 1, 0);
    if (wr == 1) BAR;
    WAIT_V(4); BAR;
    STAGE_B(SB(1, 0), 0, 1); STAGE_A(SA(1, 0), 0, 1); STAGE_B(SB(1, 1), 1, 1);
    WAIT_V(6); BAR;
    for (int t = 0; t < nt - 2; t += 2) {
        LDB(B0, 0, 0); SCHED; LDA(At, 0, 0); STAGE_A(SA(1, 1), 1, t + 1);
        WAIT_L(8); BAR; WAIT_L(0); MMA(0, 0, At, B0); BAR; SCHED;
        LDB(B1, 0, 1); STAGE_B(SB(0, 0), 0, t + 2);
        BAR; WAIT_L(0); MMA(0, 1, At, B1); BAR;
        LDA(At, 0, 1); STAGE_A(SA(0, 0), 0, t + 2);
        BAR; WAIT_L(0); MMA(1, 0, At, B0); BAR; SCHED;
        STAGE_B(SB(0, 1), 1, t + 2);
        WAIT_V(6); BAR; MMA(1, 1, At, B1); BAR;
        LDB(B0, 1, 0); SCHED; LDA(At, 1, 0); STAGE_A(SA(0, 1), 1, t + 2);
        WAIT_L(8); BAR; WAIT_L(0); MMA(0, 0, At, B0); BAR; SCHED;
        LDB(B1, 1, 1); STAGE_B(SB(1, 0), 0, t + 3);
        BAR; WAIT_L(0); MMA(0, 1, At, B1); BAR;
        LDA(At, 1, 1); STAGE_A(SA(1, 0), 0, t + 3);
        BAR; WAIT_L(0); MMA(1, 0, At, B0); BAR; SCHED;
        STAGE_B(SB(1, 1), 1, t + 3);
        WAIT_V(6); BAR; MMA(1, 1, At, B1); BAR;
    }
    { LDB(B0, 0, 0); WAIT_V(0); LDA(At, 0, 0); STAGE_A(SA(1, 1), 1, nt - 1);
      BAR; WAIT_L(0); MMA(0, 0, At, B0); BAR;
      LDB(B1, 0, 1); BAR; WAIT_L(0); MMA(0, 1, At, B1); BAR;
      LDA(At, 0, 1); WAIT_V(4); BAR; WAIT_L(0); MMA(1, 0, At, B0); MMA(1, 1, At, B1); BAR; }
    { LDB(B0, 1, 0); LDA(At, 1, 0); WAIT_V(2); BAR; WAIT_L(0); MMA(0, 0, At, B0); BAR;
      LDB(B1, 1, 1); WAIT_V(0); BAR; WAIT_L(0); MMA(0, 1, At, B1); BAR;
      LDA(At, 1, 1); BAR; WAIT_L(0); MMA(1, 0, At, B0); MMA(1, 1, At, B1); BAR; }
    if (wr == 0) BAR;
    int tz = threadIdx.x; asm volatile("" : "+v"(tz)); wid = tz >> 6; lane = tz & 63; wr = wid >> 2; wc = wid & 3; fr = lane & 15; fq = lane >> 4;
    epi(acc, brow, bcol, wr, wc, fr, fq);
#undef SA
#undef SB
#undef STAGE_A
#undef STAGE_B
#undef GLDS
#undef LDA
#undef LDB
#undef MMA
}

struct EpiStoreF32 { float* C; int ldc;
    DEV void operator()(const f32x4 (&acc)[2][2][4][2], int brow, int bcol, int wr, int wc, int fr, int fq) const {
#pragma unroll
        for (int ai = 0; ai < 2; ++ai)
#pragma unroll
            for (int m = 0; m < 4; ++m) { float* rowp = C + (size_t)(brow + ai * HALF + wr * 64 + m * 16 + fr) * ldc + bcol + wc * 32 + fq * 4;
#pragma unroll
                for (int bj = 0; bj < 2; ++bj)
#pragma unroll
                    for (int n = 0; n < 2; ++n) *(f32x4*)(rowp + bj * HALF + n * 16) = acc[ai][bj][m][n]; }
    } };
struct EpiStoreBf16 { bf16_t* C; int ldc;
    DEV void operator()(const f32x4 (&acc)[2][2][4][2], int brow, int bcol, int wr, int wc, int fr, int fq) const {
#pragma unroll
        for (int ai = 0; ai < 2; ++ai)
#pragma unroll
            for (int m = 0; m < 4; ++m) { bf16_t* rowp = C + (size_t)(brow + ai * HALF + wr * 64 + m * 16 + fr) * ldc + bcol + wc * 32 + fq * 4;
#pragma unroll
                for (int bj = 0; bj < 2; ++bj)
#pragma unroll
                    for (int n = 0; n < 2; ++n) { const f32x4 v = acc[ai][bj][m][n]; u32x2 w; w.x = cvtpk(v[0], v[1]); w.y = cvtpk(v[2], v[3]); *(u32x2*)(rowp + bj * HALF + n * 16) = w; } }
    } };
template <bool FROM_IN>
struct EpiResidGate { bf16_t* X; const float* gate; bool dry; const float* xin; const float* cin;
    DEV void operator()(const f32x4 (&acc)[2][2][4][2], int brow, int bcol, int wr, int wc, int fr, int fq) const {
        const float* g = gate + (size_t)modvec_of_row(brow) * MODN + bcol + wc * 32 + fq * 4;
        f32x4 gv[2][2];
#pragma unroll
        for (int bj = 0; bj < 2; ++bj)
#pragma unroll
            for (int n = 0; n < 2; ++n) gv[bj][n] = *(const f32x4*)(g + bj * HALF + n * 16);
#pragma unroll
        for (int ai = 0; ai < 2; ++ai)
#pragma unroll
            for (int m = 0; m < 4; ++m) { const int lrow = ai * HALF + wr * 64 + m * 16 + fr; bf16_t* rowp = X + (size_t)(brow + lrow) * D + bcol + wc * 32 + fq * 4;
                f32x4 x[2][2];
                if (FROM_IN) { const int b = brow / S, t0 = brow - b * S;
                    const float* srcp = (t0 < TC ? cin + ((size_t)b * TC + t0 + lrow) * D : xin + ((size_t)b * TL + (t0 - TC) + lrow) * D) + bcol + wc * 32 + fq * 4;
#pragma unroll
                    for (int bj = 0; bj < 2; ++bj)
#pragma unroll
                        for (int n = 0; n < 2; ++n) x[bj][n] = *(const f32x4*)(srcp + bj * HALF + n * 16); }
                else {
#pragma unroll
                    for (int bj = 0; bj < 2; ++bj)
#pragma unroll
                        for (int n = 0; n < 2; ++n) { const u32x2 p = *(const u32x2*)(rowp + bj * HALF + n * 16); x[bj][n] = (f32x4){bflo(p.x), bfhi(p.x), bflo(p.y), bfhi(p.y)}; } }
#pragma unroll
                for (int bj = 0; bj < 2; ++bj)
#pragma unroll
                    for (int n = 0; n < 2; ++n) { f32x4 xv = x[bj][n];
                        if (!dry) xv += gv[bj][n] * acc[ai][bj][m][n];
                        u32x2 w; w.x = cvtpk(xv[0], xv[1]); w.y = cvtpk(xv[2], xv[3]); *(u32x2*)(rowp + bj * HALF + n * 16) = w; }
                if (m == 3) asm volatile("" ::: "memory"); }
    } };
struct EpiMoeUp { bf16_t* hid; int rowbase, nvalid;
    DEV void operator()(const f32x4 (&acc)[2][2][4][2], int brow, int bcol, int wr, int wc, int fr, int fq) const {
        const int hc = (bcol >> 1) + wc * 32 + fq * 4;
#pragma unroll
        for (int ai = 0; ai < 2; ++ai)
#pragma unroll
            for (int m = 0; m < 4; ++m) { const int lr = ai * HALF + wr * 64 + m * 16 + fr;
                if (lr < nvalid) { bf16_t* rowp = hid + (size_t)(rowbase + lr) * EDIM + hc;
#pragma unroll
                    for (int n = 0; n < 2; ++n) { const f32x4 a = acc[ai][0][m][n], b = acc[ai][1][m][n];
                        u32x2 w; w.x = cvtpk(siluf_(a[0]) * b[0], siluf_(a[1]) * b[1]); w.y = cvtpk(siluf_(a[2]) * b[2], siluf_(a[3]) * b[3]);
                        *(u32x2*)(rowp + n * 16) = w; } } }
    } };
struct EpiMoeDown { bf16_t* y; const int* list; int nvalid;
    DEV void operator()(const f32x4 (&acc)[2][2][4][2], int brow, int bcol, int wr, int wc, int fr, int fq) const {
        int li[2][4];
#pragma unroll
        for (int ai = 0; ai < 2; ++ai)
#pragma unroll
            for (int m = 0; m < 4; ++m) { const int lr = ai * HALF + wr * 64 + m * 16 + fr; li[ai][m] = list[lr < nvalid ? lr : nvalid - 1]; }
#pragma unroll
        for (int ai = 0; ai < 2; ++ai)
#pragma unroll
            for (int m = 0; m < 4; ++m) { const int lr = ai * HALF + wr * 64 + m * 16 + fr;
                if (lr < nvalid) { bf16_t* rowp = y + (size_t)li[ai][m] * D + bcol + wc * 32 + fq * 4;
#pragma unroll
                    for (int bj = 0; bj < 2; ++bj)
#pragma unroll
                        for (int n = 0; n < 2; ++n) { const f32x4 v = acc[ai][bj][m][n]; u32x2 w; w.x = cvtpk(v[0], v[1]); w.y = cvtpk(v[2], v[3]); *(u32x2*)(rowp + bj * HALF + n * 16) = w; } } }
    } };

DEV void row_bt(int r, int& b, int& t) { b = r / S; t = r - b * S; }
#define LDS_BARRIER() do { asm volatile("s_waitcnt lgkmcnt(0)" ::: "memory"); __builtin_amdgcn_s_barrier(); asm volatile("" ::: "memory"); } while (0)
struct EpiInAB { bf16_t* P; float* ssq; bf16_t* Kb; const float2* tb; char* smem;
    DEV void operator()(const f32x4 (&acc)[2][2][4][2], int brow, int bcol, int wr, int wc, int fr, int fq) const {
        const int pn = bcol >> 8;
        if (pn < 23) {
#pragma unroll
            for (int ai = 0; ai < 2; ++ai)
#pragma unroll
                for (int m = 0; m < 4; ++m) { bf16_t* rowp = P + (size_t)(brow + ai * HALF + wr * 64 + m * 16 + fr) * AB_INP + bcol + wc * 32 + fq * 4;
#pragma unroll
                    for (int bj = 0; bj < 2; ++bj)
#pragma unroll
                        for (int n = 0; n < 2; ++n) { const f32x4 v = acc[ai][bj][m][n]; u32x2 w; w.x = cvtpk(v[0], v[1]); w.y = cvtpk(v[2], v[3]); *(u32x2*)(rowp + bj * HALF + n * 16) = w; } }
            if (pn >= 20) {
                float* red = (float*)smem;
#pragma unroll
                for (int ai = 0; ai < 2; ++ai)
#pragma unroll
                    for (int m = 0; m < 4; ++m) { float sq = 0.f;
#pragma unroll
                        for (int bj = 0; bj < 2; ++bj)
#pragma unroll
                            for (int n = 0; n < 2; ++n) { const f32x4 v = acc[ai][bj][m][n]; sq += v[0] * v[0] + v[1] * v[1] + v[2] * v[2] + v[3] * v[3]; }
                        sq += __shfl_xor(sq, 16); sq += __shfl_xor(sq, 32);
                        if (fq == 0) red[(ai * HALF + wr * 64 + m * 16 + fr) * 4 + wc] = sq; }
                LDS_BARRIER();
                const int t_ = tid_opaque();
                if (t_ < 256) { const f32x4 q = *(const f32x4*)(red + t_ * 4); ssq[(size_t)(pn - 20) * R + brow + t_] = (q[0] + q[1]) + (q[2] + q[3]); }
                LDS_BARRIER();
            }
        } else if (wc < 2) {
            f32x4 cc[2][4][2];
#pragma unroll
            for (int ai = 0; ai < 2; ++ai)
#pragma unroll
                for (int m = 0; m < 4; ++m) { int b, t; row_bt(brow + ai * HALF + wr * 64 + m * 16 + fr, b, t);
#pragma unroll
                    for (int n = 0; n < 2; ++n) cc[ai][m][n] = *(const f32x4*)(tb + t * 32 + 16 * wc + 8 * n + 2 * fq); }
#pragma unroll
            for (int ai = 0; ai < 2; ++ai)
#pragma unroll
                for (int m = 0; m < 4; ++m) { int b, t; row_bt(brow + ai * HALF + wr * 64 + m * 16 + fr, b, t);
#pragma unroll
                    for (int n = 0; n < 2; ++n) { const f32x4 v = acc[ai][0][m][n]; const int p0 = 16 * wc + 8 * n + 2 * fq;
                        const float2 c0 = make_float2(cc[ai][m][n][0], cc[ai][m][n][1]), c1 = make_float2(cc[ai][m][n][2], cc[ai][m][n][3]);
                        const unsigned lo = cvtpk(v[0] * c0.x - v[1] * c0.y, v[2] * c1.x - v[3] * c1.y), hi = cvtpk(v[1] * c0.x + v[0] * c0.y, v[3] * c1.x + v[2] * c1.y);
#pragma unroll
                        for (int hh = 0; hh < 8; ++hh) { bf16_t* kp = Kb + (((size_t)b * 8 + hh) * S + t) * 192 + 128 + p0; *(unsigned*)kp = lo; *(unsigned*)(kp + 32) = hi; } } }
        }
    } };
struct EpiInCD { bf16_t* P; bf16_t* Qb; bf16_t* Kb; bf16_t* Vb; const float2* tc; const float* gq; const float* gk; char* smem;
    DEV void operator()(const f32x4 (&acc)[2][2][4][2], int brow, int bcol, int wr, int wc, int fr, int fq) const {
        const int pn = bcol >> 8;
        if (pn <= 4) {
            float* red = (float*)smem;
            f32x4 cc[2][4][2];
#pragma unroll
            for (int ai = 0; ai < 2; ++ai)
#pragma unroll
                for (int m = 0; m < 4; ++m) { int b, t; row_bt(brow + ai * HALF + wr * 64 + m * 16 + fr, b, t);
#pragma unroll
                    for (int n = 0; n < 2; ++n) cc[ai][m][n] = *(const f32x4*)(tc + t * 64 + 16 * wc + 8 * n + 2 * fq); }
#pragma unroll
            for (int ai = 0; ai < 2; ++ai)
#pragma unroll
                for (int m = 0; m < 4; ++m)
#pragma unroll
                    for (int bj = 0; bj < 2; ++bj) { float sq = 0.f;
#pragma unroll
                        for (int n = 0; n < 2; ++n) { const f32x4 v = acc[ai][bj][m][n]; sq += v[0] * v[0] + v[1] * v[1] + v[2] * v[2] + v[3] * v[3]; }
                        sq += __shfl_xor(sq, 16); sq += __shfl_xor(sq, 32);
                        if (fq == 0) red[((ai * HALF + wr * 64 + m * 16 + fr) * 2 + bj) * 4 + wc] = sq; }
            LDS_BARRIER();
            const float* gp = pn < 4 ? gq : gk;
            float g1[2][2], g2[2][2];
#pragma unroll
            for (int n = 0; n < 2; ++n) { const int p0 = 16 * wc + 8 * n + 2 * fq; g1[n][0] = gp[p0]; g1[n][1] = gp[p0 + 1]; g2[n][0] = gp[p0 + 64]; g2[n][1] = gp[p0 + 65]; }
#pragma unroll
            for (int ai = 0; ai < 2; ++ai)
#pragma unroll
                for (int m = 0; m < 4; ++m) { const int lr = ai * HALF + wr * 64 + m * 16 + fr; int b, t; row_bt(brow + lr, b, t);
#pragma unroll
                    for (int bj = 0; bj < 2; ++bj) { const f32x4 q4 = *(const f32x4*)(red + (lr * 2 + bj) * 4); const float rs = rsqrtf(((q4[0] + q4[1]) + (q4[2] + q4[3])) * (1.f / 128.f) + EPS);
                        bf16_t* dst = pn < 4 ? Qb + (((size_t)b * 8 + pn * 2 + bj) * S + t) * 128 : Kb + (((size_t)b * 2 + bj) * S + t) * 128;
#pragma unroll
                        for (int n = 0; n < 2; ++n) { const f32x4 v = acc[ai][bj][m][n]; const int p0 = 16 * wc + 8 * n + 2 * fq;
                            const float2 c0 = make_float2(cc[ai][m][n][0], cc[ai][m][n][1]), c1 = make_float2(cc[ai][m][n][2], cc[ai][m][n][3]);
                            const float x1a = v[0] * rs * g1[n][0], x2a = v[1] * rs * g2[n][0], x1b = v[2] * rs * g1[n][1], x2b = v[3] * rs * g2[n][1];
                            *(unsigned*)(dst + p0) = cvtpk(x1a * c0.x - x2a * c0.y, x1b * c1.x - x2b * c1.y);
                            *(unsigned*)(dst + 64 + p0) = cvtpk(x2a * c0.x + x1a * c0.y, x2b * c1.x + x1b * c1.y); } } }
            LDS_BARRIER();
        } else if (pn == 5) {
#pragma unroll
            for (int ai = 0; ai < 2; ++ai)
#pragma unroll
                for (int m = 0; m < 4; ++m) { int b, t; row_bt(brow + ai * HALF + wr * 64 + m * 16 + fr, b, t);
#pragma unroll
                    for (int bj = 0; bj < 2; ++bj)
#pragma unroll
                        for (int n = 0; n < 2; ++n) { const f32x4 v = acc[ai][bj][m][n]; u32x2 w; w.x = cvtpk(v[0], v[1]); w.y = cvtpk(v[2], v[3]);
                            *(u32x2*)(Vb + (((size_t)b * 2 + bj) * S + t) * 128 + wc * 32 + n * 16 + fq * 4) = w; } }
        } else {
#pragma unroll
            for (int ai = 0; ai < 2; ++ai)
#pragma unroll
                for (int m = 0; m < 4; ++m) { bf16_t* rowp = P + (size_t)(brow + ai * HALF + wr * 64 + m * 16 + fr) * CD_INP + bcol + wc * 32 + fq * 4;
#pragma unroll
                    for (int bj = 0; bj < 2; ++bj)
#pragma unroll
                        for (int n = 0; n < 2; ++n) { const f32x4 v = acc[ai][bj][m][n]; u32x2 w; w.x = cvtpk(v[0], v[1]); w.y = cvtpk(v[2], v[3]); *(u32x2*)(rowp + bj * HALF + n * 16) = w; } }
        }
    } };
struct EpiUQ { bf16_t* Qb; const float* ssq; const float2* tb;
    DEV void operator()(const f32x4 (&acc)[2][2][4][2], int brow, int bcol, int wr, int wc, int fr, int fq) const {
        const int pn = bcol >> 8;
        float sa[2][4], sb[2][4];
#pragma unroll
        for (int ai = 0; ai < 2; ++ai)
#pragma unroll
            for (int m = 0; m < 4; ++m) { const int r = brow + ai * HALF + wr * 64 + m * 16 + fr; sa[ai][m] = ssq[r]; sb[ai][m] = ssq[R + r]; }
        if (pn < 4) {
#pragma unroll
            for (int ai = 0; ai < 2; ++ai)
#pragma unroll
                for (int m = 0; m < 4; ++m) { const int r = brow + ai * HALF + wr * 64 + m * 16 + fr; int b, t; row_bt(r, b, t);
                    const float rs = rsqrtf((sa[ai][m] + sb[ai][m]) * (1.f / 512.f) + EPS);
#pragma unroll
                    for (int bj = 0; bj < 2; ++bj)
#pragma unroll
                        for (int n = 0; n < 2; ++n) { const f32x4 v = acc[ai][bj][m][n] * rs;
                            const int hh = pn * 2 + bj; bf16_t* qp = Qb + (((size_t)b * 8 + hh) * S + t) * 192 + wc * 32 + n * 16 + fq * 4;
                            u32x2 w; w.x = cvtpk(v[0], v[1]); w.y = cvtpk(v[2], v[3]); *(u32x2*)qp = w; } }
        } else {
#pragma unroll
            for (int ai = 0; ai < 2; ++ai) {
                f32x4 cc[4][2];
#pragma unroll
                for (int m = 0; m < 4; ++m) { const int r = brow + ai * HALF + wr * 64 + m * 16 + fr; int b, t; row_bt(r, b, t);
#pragma unroll
                    for (int n = 0; n < 2; ++n) cc[m][n] = *(const f32x4*)(tb + t * 32 + (((wc & 1) * 32 + n * 16 + fq * 4) >> 1)); }
                __builtin_amdgcn_sched_barrier(0);
#pragma unroll
                for (int m = 0; m < 4; ++m) { const int r = brow + ai * HALF + wr * 64 + m * 16 + fr; int b, t; row_bt(r, b, t);
                    const float rs = rsqrtf((sa[ai][m] + sb[ai][m]) * (1.f / 512.f) + EPS);
#pragma unroll
                    for (int bj = 0; bj < 2; ++bj)
#pragma unroll
                        for (int n = 0; n < 2; ++n) { const f32x4 v = acc[ai][bj][m][n] * rs;
                            const int cr = (pn - 4) * 256 + bj * HALF + wc * 32 + n * 16 + fq * 4, hh = cr >> 6, p0 = (cr & 63) >> 1;
                            const float2 c0 = make_float2(cc[m][n][0], cc[m][n][1]), c1 = make_float2(cc[m][n][2], cc[m][n][3]);
                            bf16_t* qp = Qb + (((size_t)b * 8 + hh) * S + t) * 192 + 128 + p0;
                            *(unsigned*)qp = cvtpk(v[0] * c0.x - v[1] * c0.y, v[2] * c1.x - v[3] * c1.y); *(unsigned*)(qp + 32) = cvtpk(v[1] * c0.x + v[0] * c0.y, v[3] * c1.x + v[2] * c1.y); } }
                __builtin_amdgcn_sched_barrier(0); }
        }
    } };
struct EpiUKV { bf16_t* Kb; bf16_t* Vb; const float* ssq;
    DEV void operator()(const f32x4 (&acc)[2][2][4][2], int brow, int bcol, int wr, int wc, int fr, int fq) const {
        const int hh = bcol >> 8;
        float sa[2][4];
#pragma unroll
        for (int ai = 0; ai < 2; ++ai)
#pragma unroll
            for (int m = 0; m < 4; ++m) sa[ai][m] = ssq[2 * R + brow + ai * HALF + wr * 64 + m * 16 + fr];
#pragma unroll
        for (int ai = 0; ai < 2; ++ai)
#pragma unroll
            for (int m = 0; m < 4; ++m) { const int r = brow + ai * HALF + wr * 64 + m * 16 + fr; int b, t; row_bt(r, b, t);
                const float rs = rsqrtf(sa[ai][m] * (1.f / 256.f) + EPS); const size_t rowi = ((size_t)b * 8 + hh) * S + t;
#pragma unroll
                for (int n = 0; n < 2; ++n) { const f32x4 kv = acc[ai][0][m][n] * rs, vv = acc[ai][1][m][n] * rs; const int c = wc * 32 + n * 16 + fq * 4;
                    u32x2 w; w.x = cvtpk(kv[0], kv[1]); w.y = cvtpk(kv[2], kv[3]); *(u32x2*)(Kb + rowi * 192 + c) = w;
                    w.x = cvtpk(vv[0], vv[1]); w.y = cvtpk(vv[2], vv[3]); *(u32x2*)(Vb + rowi * 128 + c) = w; } }
    } };

template <bool LATENT = false, int LDA_ = 0, class Epi>
DEV void gemm_phase(const bf16_t* A, const bf16_t* Bt, int M, int N, int K, char* smem, const Epi& epi, int& cursor, int tlo = 0, int thi = 1 << 30) {
    const int nM = M / BM, nN = N / BM, n = nM * nN;
    int first = cursor; cursor += n;
    int u = blockIdx.x; while (u < first) u += gridDim.x;
    for (; u < first + n; u += gridDim.x) { const int t = u - first; if (t < tlo || t >= thi) continue; const int pm = t % nM, pn = t / nM;
        const int prow = LATENT ? (pm >> 3) * 9 + 1 + (pm & 7) : pm;
        gemm_tile<false, LDA_>(A, Bt, K, K, prow * BM, pn * BM, nullptr, 0, smem, epi); }
}

struct CvtJob { const float* src; bf16_t* dst; int K, N, Nout, nb; size_t src_bs, dst_bs; int blk_rs, blk_base; const float* kscale; int perm = 0; };
constexpr int CVT_LDS_WAVE = 64 * 65 * 4, CVT_SLOT_OFF = 8 * CVT_LDS_WAVE;
DEV void cvt_issue(const CvtJob& j, int u, int lane, f32x4 (&e)[16]) {
    const int tN = j.Nout / 64, per = (j.K / 64) * tN;
    const int bt = u / per, rem = u - bt * per, kt = rem / tN, ntl = rem - kt * tN;
    const int n0 = ntl * 64 + (lane & 15) * 4;
    const float* sp = j.src + (size_t)bt * j.src_bs + (size_t)(kt * 64 + (lane >> 4)) * j.N + (n0 < j.N ? n0 : 0);
#pragma unroll
    for (int q = 0; q < 16; ++q) e[q] = *(const f32x4*)(sp + (size_t)(q * 4) * j.N);
}
DEV void cvt_finish(const CvtJob& j, int u, int lane, float* tile, const f32x4 (&e)[16]) {
    const int tN = j.Nout / 64, per = (j.K / 64) * tN;
    const int bt = u / per, rem = u - bt * per, kt = rem / tN, ntl = rem - kt * tN;
    const int r0 = lane >> 4, c4 = lane & 15; const bool valid = ntl * 64 + c4 * 4 < j.N;
#pragma unroll
    for (int q = 0; q < 16; ++q) { f32x4 x = e[q]; const int k = r0 + 4 * q; if (j.kscale) x *= j.kscale[kt * 64 + k]; if (!valid) x = (f32x4){0.f, 0.f, 0.f, 0.f};
        float* tp = tile + k * 65 + c4 * 4; tp[0] = x[0]; tp[1] = x[1]; tp[2] = x[2]; tp[3] = x[3]; }
    const int nl0 = lane >> 3, kc = (lane & 7) * 8;
#pragma unroll
    for (int p = 0; p < 8; ++p) { const int nl = p * 8 + nl0, nn = ntl * 64 + nl; float v[8];
#pragma unroll
        for (int i = 0; i < 8; ++i) v[i] = tile[(kc + i) * 65 + nl];
        int drow = (nn >> 7) * j.blk_rs + j.blk_base + (nn & 127);
        if (j.perm == 1) { const int hh = nn / 192, c = nn - hh * 192, i = c - 128; drow = c < 128 ? hh * 128 + c : 1024 + hh * 64 + (i < 32 ? 2 * i : 2 * (i - 32) + 1); }
        if (j.perm == 3 && nn < 1280) { const int c = nn & 127; drow = (nn & ~127) + (c < 64 ? 2 * c : 2 * (c - 64) + 1); }
        if (j.perm == 2 && nn >= 5888) { const int i = nn - 5888; drow = i < 64 ? 5888 + (i < 32 ? 2 * i : 2 * (i - 32) + 1) : nn; }
        *(u32x4*)(j.dst + (size_t)bt * j.dst_bs + (size_t)drow * j.K + kt * 64 + kc) = (u32x4){cvtpk(v[0], v[1]), cvtpk(v[2], v[3]), cvtpk(v[4], v[5]), cvtpk(v[6], v[7])}; }
}
DEV void cvt_run(const CvtJob& j, int u0, int ustep, int n, int lane, float* tile) {
    f32x4 eA[16], eB[16];
    cvt_issue(j, u0, lane, eA);
    int i = 0;
#pragma unroll 1
    for (; i + 2 < n; i += 2) {
        cvt_issue(j, u0 + (i + 1) * ustep, lane, eB);
        __builtin_amdgcn_sched_barrier(0);
        cvt_finish(j, u0 + i * ustep, lane, tile, eA);
        __builtin_amdgcn_sched_barrier(0);
        cvt_issue(j, u0 + (i + 2) * ustep, lane, eA);
        __builtin_amdgcn_sched_barrier(0);
        cvt_finish(j, u0 + (i + 1) * ustep, lane, tile, eB);
        __builtin_amdgcn_sched_barrier(0);
    }
    if (i + 1 < n) {
        cvt_issue(j, u0 + (i + 1) * ustep, lane, eB);
        __builtin_amdgcn_sched_barrier(0);
        cvt_finish(j, u0 + i * ustep, lane, tile, eA);
        __builtin_amdgcn_sched_barrier(0);
        cvt_finish(j, u0 + (i + 1) * ustep, lane, tile, eB);
    } else cvt_finish(j, u0 + i * ustep, lane, tile, eA);
}
DEV void cvt_weight(const float* __restrict__ src, bf16_t* __restrict__ dst, int K, int N, int Nout, int nb, size_t src_bs, size_t dst_bs,
                    int blk_rs, int blk_base, const float* __restrict__ kscale, char* smem, int perm = 0) {
    const CvtJob j{src, dst, K, N, Nout, nb, src_bs, dst_bs, blk_rs, blk_base, kscale, perm};
    const int tid = tid_opaque(), lane = tid & 63, w = tid >> 6, total = nb * (K / 64) * (Nout / 64);
    float* tile = (float*)(smem + w * CVT_LDS_WAVE);
    const int u0 = blockIdx.x * 8 + w, ustep = gridDim.x * 8;
    if (u0 < total) cvt_run(j, u0, ustep, (total - u0 + ustep - 1) / ustep, lane, tile);
    __syncthreads();
}
DEV bf16_t* moe_w13(const Args& a, int l) { return (bf16_t*)(a.ws + (l == 0 ? WS_W13 : WS_SVT)); }
DEV bf16_t* moe_w2(const Args& a, int l) { return (bf16_t*)(a.ws + (l == 0 ? WS_W2 : WS_SVT + (size_t)NE * 1024 * D * 2)); }
constexpr int CVT_IT = 8;
DEV void cvt_moe_dynamic(const Args& a, int l, char* smem) {
    const int tid = tid_opaque(), lane = tid & 63, w = tid >> 6;
    unsigned* counter = (unsigned*)(a.ws + WS_CTL) + CW_CVT + l * 64;
    volatile int* slot = (volatile int*)(smem + CVT_SLOT_OFF); float* tile = (float*)(smem + w * CVT_LDS_WAVE);
    const CvtJob j1{a.in[26] + (size_t)l * NE * D * EDIM, moe_w13(a, l), D, EDIM, EDIM, NE, (size_t)D * EDIM, (size_t)1024 * D, 256, 0, nullptr};
    const CvtJob j3{a.in[27] + (size_t)l * NE * D * EDIM, moe_w13(a, l), D, EDIM, EDIM, NE, (size_t)D * EDIM, (size_t)1024 * D, 256, 128, nullptr};
    const CvtJob j2{a.in[28] + (size_t)l * NE * EDIM * D, moe_w2(a, l), EDIM, D, D, NE, (size_t)EDIM * D, (size_t)D * EDIM, 128, 0, nullptr};
    constexpr int CPJ = 4096 / (8 * CVT_IT), NCHUNK = 3 * CPJ;
    for (;;) {
        __syncthreads();
        if (tid == 0) *slot = (int)atomicAdd(counter, 1u);
        __syncthreads();
        const int chunk = *slot;
        if (chunk >= NCHUNK) break;
        const int job = chunk / CPJ, u0 = (chunk - job * CPJ) * (8 * CVT_IT) + w;
        if (job == 0) cvt_run(j1, u0, 8, CVT_IT, lane, tile); else if (job == 1) cvt_run(j3, u0, 8, CVT_IT, lane, tile); else cvt_run(j2, u0, 8, CVT_IT, lane, tile);
    }
    __syncthreads();
}

DEV void cvt_cd_dynamic(const Args& a, char* smem) {
    const int tid = tid_opaque(), lane = tid & 63, w = tid >> 6;
    unsigned* counter = (unsigned*)(a.ws + WS_CTL) + CW_CVT + 3 * 64;
    volatile int* slot = (volatile int*)(smem + CVT_SLOT_OFF); float* tile = (float*)(smem + w * CVT_LDS_WAVE);
    const CvtJob jin{a.in[17], (bf16_t*)(a.ws + WS_WCDIN), D, CD_IN, CD_INP, 1, 0, 0, 128, 0, nullptr, 3};
    const CvtJob jout{a.in[18], (bf16_t*)(a.ws + WS_WCDOUT), D, D, D, 1, 0, 0, 128, 0, nullptr};
    const CvtJob jabo{a.in[10], (bf16_t*)(a.ws + WS_WABOUT), D, D, D, 1, 0, 0, 128, 0, nullptr};
    const CvtJob juq{a.in[14], (bf16_t*)(a.ws + WS_WUQ), 512, 1536, 1536, 1, 0, 0, 128, 0, a.in[13], 1};
    const CvtJob jukv{a.in[16], (bf16_t*)(a.ws + WS_WUKV), 256, 2048, 2048, 1, 0, 0, 128, 0, a.in[15]};
    constexpr int TIN = 32 * (CD_INP / 64), T1 = TIN + 32 * 32, T2 = T1 + 32 * 32, T3 = T2 + 8 * 24, T4 = T3 + 4 * 32, NCHUNK = T4 / (8 * CVT_IT);
    static_assert(TIN % (8 * CVT_IT) == 0 && T1 % (8 * CVT_IT) == 0 && T2 % (8 * CVT_IT) == 0 && T3 % (8 * CVT_IT) == 0 && T4 % (8 * CVT_IT) == 0, "chunk boundary");
    for (;;) {
        __syncthreads();
        if (tid == 0) *slot = (int)atomicAdd(counter, 1u);
        __syncthreads();
        const int chunk = *slot;
        if (chunk >= NCHUNK) break;
        const int g = chunk * (8 * CVT_IT) + w;
        if (g < TIN) cvt_run(jin, g, 8, CVT_IT, lane, tile); else if (g < T1) cvt_run(jout, g - TIN, 8, CVT_IT, lane, tile); else if (g < T2) cvt_run(jabo, g - T1, 8, CVT_IT, lane, tile);
        else if (g < T3) cvt_run(juq, g - T2, 8, CVT_IT, lane, tile); else cvt_run(jukv, g - T3, 8, CVT_IT, lane, tile);
    }
    __syncthreads();
}

template <bool DYN>
DEV void mod_phase(const Args& a, int l, char* smem) {
    float* sc = (float*)smem;
    float* red = sc + 5 * D;
    const int tid = tid_opaque(), w = tid >> 6, lane = tid & 63, cg = lane & 7, rr = lane >> 3;
    { float xv[5 * D / NT];
#pragma unroll
      for (int q = 0; q < 5 * D / NT; ++q) { const int i = tid + q * NT, v = i / D, k = i - v * D; xv[q] = v < 4 ? a.in[1][v * D + k] : a.in[3][k]; }
#pragma unroll
      for (int q = 0; q < 5 * D / NT; ++q) sc[tid + q * NT] = siluf_(xv[q]); }
    __syncthreads();
    float* modv = (float*)(a.ws + WS_MODV);
    unsigned* counter = (unsigned*)(a.ws + WS_CTL) + CW_CVT + 2 * 64; volatile int* slot = (volatile int*)(red + 8 * 5 * 32);
    for (int u = gridDim.x - 1 - blockIdx.x;; u += gridDim.x) {
        if (DYN) { __syncthreads(); if (tid == 0) *slot = (int)atomicAdd(counter, 1u); __syncthreads(); u = *slot; }
        if (u >= MODN / 32) break;
        const int c0 = u * 32;
        const float* wp = a.in[4] + (size_t)l * D * MODN + c0 + cg * 4;
        f32x4 acc[5] = {};
        for (int it0 = 0; it0 < D / 64; it0 += 8) { f32x4 wv[8];
#pragma unroll
            for (int q = 0; q < 8; ++q) wv[q] = *(const f32x4*)(wp + (size_t)((it0 + q) * 64 + w * 8 + rr) * MODN);
#pragma unroll
            for (int q = 0; q < 8; ++q) { const int k = (it0 + q) * 64 + w * 8 + rr;
#pragma unroll
                for (int v = 0; v < 5; ++v) acc[v] += wv[q] * sc[v * D + k]; } }
#pragma unroll
        for (int v = 0; v < 5; ++v)
#pragma unroll
            for (int j = 0; j < 4; ++j) { float x = acc[v][j]; x += __shfl_xor(x, 8); x += __shfl_xor(x, 16); x += __shfl_xor(x, 32); acc[v][j] = x; }
        if (rr == 0) {
#pragma unroll
            for (int v = 0; v < 5; ++v)
#pragma unroll
                for (int j = 0; j < 4; ++j) red[(w * 5 + v) * 32 + cg * 4 + j] = acc[v][j]; }
        __syncthreads();
        if (tid < 160) { const int v = tid >> 5, c = tid & 31; float s = 0.f;
#pragma unroll
            for (int ww = 0; ww < 8; ++ww) s += red[(ww * 5 + v) * 32 + c];
            modv[((size_t)l * 5 + v) * MODN + c0 + c] = s + a.in[5][l * MODN + c0 + c]; }
        __syncthreads();
    }
}

DEV void misc_phase(const Args& a) {
    const int gt = blockIdx.x * NT + tid_opaque(), gs = gridDim.x * NT;
    float* lb = (float*)(a.ws + WS_LB);
    for (int i = gt; i < 2 * 1024; i += gs) { const int d = i >> 10, c = i & 1023; const float* p = a.in[11] + (size_t)d * 3 * 1024 + c;
        const float x0 = p[0], x1 = p[1024], x2 = p[2048], m = fmaxf(x0, fmaxf(x1, x2));
        const float e0 = expf(x0 - m), e1 = expf(x1 - m), e2 = expf(x2 - m); lb[i] = e0 / (e0 + e1 + e2); }
    float2* tb = (float2*)(a.ws + WS_TABB); float2* tc = (float2*)(a.ws + WS_TABC);
    for (int i = gt; i < S * 32; i += gs) { const int t = (i >> 5) - TC, j = i & 31, q = j & 15; const float fr = powf(10000.f, -(float)q / 16.f);
        const float pos = (j < 16) ? (float)(t >> 6) : (float)(t & 63); const float an = pos * fr; tb[i] = t < 0 ? make_float2(1.f, 0.f) : make_float2(cosf(an), sinf(an)); }
    for (int i = gt; i < S * 64; i += gs) { const int t = (i >> 6) - TC, j = i & 63, q = j & 31; const float fr = powf(10000.f, -(float)q / 32.f);
        const float pos = (j < 32) ? (float)(t >> 6) : (float)(t & 63); const float an = pos * fr; tc[i] = t < 0 ? make_float2(1.f, 0.f) : make_float2(cosf(an), sinf(an)); }
}

template <bool ROUTER, bool FROM_IN = false>
DEV void norm_phase(const Args& a, int l, int chunk_shift, const float* gain, bool latent_only, char* smem, bool dry = false) {
    const int tid = tid_opaque(), w = tid >> 6, lane = tid & 63;
    const bf16_t* xres = (const bf16_t*)(a.ws + WS_XRES); bf16_t* h = (bf16_t*)(a.ws + WS_H);
    const float* modv = (const float*)(a.ws + WS_MODV) + (size_t)l * 5 * MODN;
    unsigned* cnt = (unsigned*)(a.ws + WS_CTL) + CW_CNT + l * 16 * CNT_STRIDE;
    int* tok = (int*)(a.ws + WS_TOK); int* list = (int*)(a.ws + WS_LIST);
    float* rw = (float*)smem;
    int* ent = (int*)(smem + 139264);
    if (ROUTER) { for (int i = tid; i < D * 16 / 4; i += NT) { const int c = i >> 2, q = i & 3; *(f32x4*)(rw + c * 16 + (c >> 2) * 4 + q * 4) = ((const f32x4*)a.in[24])[i]; }
                  if (tid < 128) ent[tid] = -1; __syncthreads(); }
    const int stride = gridDim.x * 8, rfirst = blockIdx.x * 8 + w;
#define NP_SKIP(rr) while ((rr) < R && latent_only && ((rr) % S) < TC) (rr) += stride
#define NP_LOAD(rr, XF, XB) do { const int b_ = (rr) / S, t_ = (rr) - b_ * S; const float* xp_ = t_ < TC ? a.in[2] + ((size_t)b_ * TC + t_) * D : a.in[0] + ((size_t)b_ * TL + (t_ - TC)) * D; const bf16_t* xb_ = xres + (size_t)(rr) * D; \
        _Pragma("unroll") for (int j = 0; j < 8; ++j) { if (FROM_IN) XF[j] = *(const f32x4*)(xp_ + j * 256 + lane * 4); else XB[j] = *(const u32x2*)(xb_ + j * 256 + lane * 4); } } while (0)
    int r = rfirst; NP_SKIP(r);
    f32x4 nxf[8]; u32x2 nxb[8];
    if (r < R) NP_LOAD(r, nxf, nxb);
    while (r < R) {
        const int nent = (r - rfirst) / stride;
        f32x4 x[8]; float ss = 0.f;
#pragma unroll
        for (int j = 0; j < 8; ++j) { if (FROM_IN) x[j] = nxf[j]; else { const u32x2 p = nxb[j]; x[j] = (f32x4){bflo(p.x), bfhi(p.x), bflo(p.y), bfhi(p.y)}; } }
        const int b = r / S, t = r - b * S; const int v = t < TC ? 4 : b;
        const float* sh = modv + (size_t)v * MODN + chunk_shift * D; const float* sc = sh + D;
        f32x4 gv[8], s1v[8], s0v[8];
#pragma unroll
        for (int j = 0; j < 8; ++j) { const int c = j * 256 + lane * 4; gv[j] = *(const f32x4*)(gain + c); s1v[j] = *(const f32x4*)(sc + c); s0v[j] = *(const f32x4*)(sh + c); }
        __builtin_amdgcn_sched_barrier(0);
        int rn = r + stride; NP_SKIP(rn);
        { const int rp_ = rn < R ? rn : r; NP_LOAD(rp_, nxf, nxb); }
        __builtin_amdgcn_sched_barrier(0);
#pragma unroll
        for (int j = 0; j < 8; ++j) ss += x[j][0] * x[j][0] + x[j][1] * x[j][1] + x[j][2] * x[j][2] + x[j][3] * x[j][3];
        ss = wave_sum(ss); const float rstd = rsqrtf(ss * (1.f / D) + EPS);
        float lg[16]; f32x2 lgp[8];
        if (ROUTER) {
#pragma unroll
            for (int e = 0; e < 8; ++e) lgp[e] = (f32x2){0.f, 0.f}; }
#pragma unroll
        for (int j = 0; j < 8; ++j) { const int c = j * 256 + lane * 4;
            const f32x4 g = gv[j], s1 = s1v[j], s0 = s0v[j];
            f32x4 y = (x[j] * rstd * g) * (1.f + s1) + s0;
            u32x2 pk; pk.x = cvtpk(y[0], y[1]); pk.y = cvtpk(y[2], y[3]); *(u32x2*)(h + (size_t)r * D + c) = pk;
            if (ROUTER) {
#pragma unroll
                for (int i = 0; i < 4; ++i) { const f32x4* wrow = (const f32x4*)(rw + (c + i) * 16 + (c >> 2) * 4);
#pragma unroll
                    for (int q = 0; q < 4; ++q) { const f32x4 wv = wrow[q]; const f32x2 yy = (f32x2){y[i], y[i]};
                        lgp[q * 2 + 0] += yy * (f32x2){wv[0], wv[1]}; lgp[q * 2 + 1] += yy * (f32x2){wv[2], wv[3]}; } }
                __builtin_amdgcn_sched_barrier(0); }
        }
        if (ROUTER) {
#pragma unroll
            for (int e = 0; e < 16; ++e) lg[e] = wave_sum(lgp[e >> 1][e & 1]);
            if (lane == 0 && !dry) {
                float scv[16], sel[16];
#pragma unroll
                for (int e = 0; e < 16; ++e) { scv[e] = 1.f / (1.f + __expf(-lg[e])); sel[e] = scv[e] + a.in[25][e]; }
                int gbest = 0; float gbv = -1e30f;
#pragma unroll
                for (int g = 0; g < 4; ++g) { float m1 = -1e30f, m2 = -1e30f;
#pragma unroll
                    for (int i = 0; i < 4; ++i) { const float s_ = sel[g * 4 + i]; if (s_ > m1) { m2 = m1; m1 = s_; } else if (s_ > m2) m2 = s_; }
                    const float gs = m1 + m2; if (gs > gbv) { gbv = gs; gbest = g; } }
                int e0 = 0, e1 = 0; float m1 = -1e30f, m2 = -1e30f; float w0 = 0.f, w1 = 0.f;
#pragma unroll
                for (int g = 0; g < 4; ++g) if (g == gbest) {
#pragma unroll
                    for (int i = 0; i < 4; ++i) { const float s_ = sel[g * 4 + i]; const int e = g * 4 + i;
                        if (s_ > m1) { m2 = m1; e1 = e0; w1 = w0; m1 = s_; e0 = e; w0 = scv[e]; } else if (s_ > m2) { m2 = s_; e1 = e; w1 = scv[e]; } } }
                const float inv = 1.f / (w0 + w1);
                ent[nent * 16 + w * 2 + 0] = (e0 << 24) | (r * 2); ent[nent * 16 + w * 2 + 1] = (e1 << 24) | (r * 2 + 1);
                tok[r * 4 + 0] = e0; tok[r * 4 + 1] = e1; ((float*)tok)[r * 4 + 2] = w0 * inv; ((float*)tok)[r * 4 + 3] = w1 * inv;
            }
        }
        __builtin_amdgcn_sched_barrier(0);
        r = rn;
    }
#undef NP_LOAD
#undef NP_SKIP
    if (ROUTER) {
        __syncthreads();
        if (tid < NE) { int c_ = 0;
            for (int j = 0; j < 128; ++j) c_ += ((ent[j] >> 24) == tid) ? 1 : 0;
            if (c_) { unsigned pos = atomicAdd(&cnt[tid * CNT_STRIDE], (unsigned)c_);
                for (int j = 0; j < 128; ++j) { const int en = ent[j]; if ((en >> 24) == tid) { __hip_atomic_store((__attribute__((address_space(1))) int*)(list + (size_t)tid * R + pos), en & 0xffffff, __ATOMIC_RELAXED, __HIP_MEMORY_SCOPE_AGENT); ++pos; } } } }
        __syncthreads();
    }
}

DEV void norm_router_phase(const Args& a, int l, int chunk_shift, const float* gain, bool latent_only, char* smem) {
    constexpr int WP = 2 * D + 16;
    constexpr int OFF_WLO = 16 * WP, OFF_ENT = 2 * 16 * WP, OFF_ROW = OFF_ENT + 512, OFF_RED = OFF_ROW + 256;
    static_assert(OFF_RED + 8 * 3 * 256 * 4 <= LDS_BYTES_C - 16, "router LDS");
    const int tid = tid_opaque(), w = tid >> 6, lane = tid & 63;
    const bf16_t* xres = (const bf16_t*)(a.ws + WS_XRES); bf16_t* h = (bf16_t*)(a.ws + WS_H); bf16_t* hlo = (bf16_t*)(a.ws + WS_P);
    const float* modv = (const float*)(a.ws + WS_MODV) + (size_t)l * 5 * MODN;
    unsigned* cnt = (unsigned*)(a.ws + WS_CTL) + CW_CNT + l * 16 * CNT_STRIDE;
    int* tok = (int*)(a.ws + WS_TOK); int* list = (int*)(a.ws + WS_LIST);
    char* whi = smem; char* wlo = smem + OFF_WLO; int* ent = (int*)(smem + OFF_ENT); int* rowtab = (int*)(smem + OFF_ROW); float* red = (float*)(smem + OFF_RED);
    for (int i = tid; i < (D / 2) * 4; i += NT) { const int kp = i >> 2, q = i & 3;
        const f32x4 w0 = ((const f32x4*)a.in[24])[(2 * kp) * 4 + q], w1 = ((const f32x4*)a.in[24])[(2 * kp + 1) * 4 + q];
#pragma unroll
        for (int e = 0; e < 4; ++e) { const unsigned hi = cvtpk(w0[e], w1[e]); const unsigned lo = cvtpk(w0[e] - bflo(hi), w1[e] - bfhi(hi));
            *(unsigned*)(whi + (q * 4 + e) * WP + kp * 4) = hi; *(unsigned*)(wlo + (q * 4 + e) * WP + kp * 4) = lo; } }
    if (tid < 128) ent[tid] = -1;
    if (tid < 64) rowtab[tid] = -1;
    __syncthreads();
    const int stride = gridDim.x * 8, rfirst = blockIdx.x * 8 + w;
#define NR_SKIP(rr) while ((rr) < R && latent_only && ((rr) % S) < TC) (rr) += stride
#define NR_LOAD(rr, XB) do { const bf16_t* xb_ = xres + (size_t)(rr) * D; _Pragma("unroll") for (int j = 0; j < 8; ++j) XB[j] = *(const u32x2*)(xb_ + j * 256 + lane * 4); } while (0)
    int r = rfirst; NR_SKIP(r);
    u32x2 nxb[8];
    if (r < R) NR_LOAD(r, nxb);
    while (r < R) {
        const int nent = (r - rfirst) / stride;
        f32x4 x[8]; float ss = 0.f;
#pragma unroll
        for (int j = 0; j < 8; ++j) { const u32x2 p = nxb[j]; x[j] = (f32x4){bflo(p.x), bfhi(p.x), bflo(p.y), bfhi(p.y)}; }
        const int b = r / S, t = r - b * S; const int v = t < TC ? 4 : b;
        const float* sh = modv + (size_t)v * MODN + chunk_shift * D; const float* sc = sh + D;
        f32x4 gv[8], s1v[8], s0v[8];
#pragma unroll
        for (int j = 0; j < 8; ++j) { const int c = j * 256 + lane * 4; gv[j] = *(const f32x4*)(gain + c); s1v[j] = *(const f32x4*)(sc + c); s0v[j] = *(const f32x4*)(sh + c); }
        __builtin_amdgcn_sched_barrier(0);
        int rn = r + stride; NR_SKIP(rn);
        { const int rp_ = rn < R ? rn : r; NR_LOAD(rp_, nxb); }
        __builtin_amdgcn_sched_barrier(0);
#pragma unroll
        for (int j = 0; j < 8; ++j) ss += x[j][0] * x[j][0] + x[j][1] * x[j][1] + x[j][2] * x[j][2] + x[j][3] * x[j][3];
        ss = wave_sum(ss); const float rstd = rsqrtf(ss * (1.f / D) + EPS);
#pragma unroll
        for (int j = 0; j < 8; ++j) { const int c = j * 256 + lane * 4;
            const f32x4 g = gv[j], s1 = s1v[j], s0 = s0v[j];
            const f32x4 y = (x[j] * rstd * g) * (1.f + s1) + s0;
            u32x2 pk; pk.x = cvtpk(y[0], y[1]); pk.y = cvtpk(y[2], y[3]); *(u32x2*)(h + (size_t)r * D + c) = pk;
            u32x2 pl; pl.x = cvtpk(y[0] - bflo(pk.x), y[1] - bfhi(pk.x)); pl.y = cvtpk(y[2] - bflo(pk.y), y[3] - bfhi(pk.y)); *(u32x2*)(hlo + (size_t)r * D + c) = pl; }
        if (lane == 0) rowtab[nent * 8 + w] = r;
        __builtin_amdgcn_sched_barrier(0);
        r = rn;
    }
#undef NR_LOAD
#undef NR_SKIP
    asm volatile("s_waitcnt vmcnt(0)" ::: "memory");
    __syncthreads();
    { const int rl = lane & 15, kq = lane >> 4; f32x4 acc[3] = {};
#pragma unroll
      for (int g = 0; g < 3; ++g) { int rr = rowtab[g * 16 + rl]; rr = rr < 0 ? 0 : rr;
          const bf16_t* ph = h + (size_t)rr * D + w * 256 + kq * 8; const bf16_t* pl = hlo + (size_t)rr * D + w * 256 + kq * 8;
          bf16x8 ah[8], al_[8];
#pragma unroll
          for (int kc = 0; kc < 8; ++kc) { ah[kc] = *(const bf16x8*)(ph + kc * 32); al_[kc] = *(const bf16x8*)(pl + kc * 32); }
#pragma unroll
          for (int kc = 0; kc < 8; ++kc) { const int kb = (w * 256 + kc * 32 + kq * 8) * 2;
              const bf16x8 bh = *(const bf16x8*)(whi + rl * WP + kb), bl = *(const bf16x8*)(wlo + rl * WP + kb);
              acc[g] = __builtin_amdgcn_mfma_f32_16x16x32_bf16(ah[kc], bh, acc[g], 0, 0, 0);
              acc[g] = __builtin_amdgcn_mfma_f32_16x16x32_bf16(ah[kc], bl, acc[g], 0, 0, 0);
              acc[g] = __builtin_amdgcn_mfma_f32_16x16x32_bf16(al_[kc], bh, acc[g], 0, 0, 0); }
#pragma unroll
          for (int q = 0; q < 4; ++q) red[((w * 3 + g) * 16 + kq * 4 + q) * 16 + rl] = acc[g][q]; } }
    __syncthreads();
    if (tid < 48) { const int rr = rowtab[tid];
        if (rr >= 0) { const int g = tid >> 4, tk = tid & 15;
            float lg[16];
#pragma unroll
            for (int e = 0; e < 16; ++e) { float s_ = 0.f;
#pragma unroll
                for (int ww = 0; ww < 8; ++ww) s_ += red[((ww * 3 + g) * 16 + tk) * 16 + e];
                lg[e] = s_; }
            float scv[16], sel[16];
#pragma unroll
            for (int e = 0; e < 16; ++e) { scv[e] = 1.f / (1.f + __expf(-lg[e])); sel[e] = scv[e] + a.in[25][e]; }
            int gbest = 0; float gbv = -1e30f;
#pragma unroll
            for (int gg = 0; gg < 4; ++gg) { float m1 = -1e30f, m2 = -1e30f;
#pragma unroll
                for (int i = 0; i < 4; ++i) { const float s_ = sel[gg * 4 + i]; if (s_ > m1) { m2 = m1; m1 = s_; } else if (s_ > m2) m2 = s_; }
                const float gs = m1 + m2; if (gs > gbv) { gbv = gs; gbest = gg; } }
            int e0 = 0, e1 = 0; float m1 = -1e30f, m2 = -1e30f; float w0 = 0.f, w1 = 0.f;
#pragma unroll
            for (int gg = 0; gg < 4; ++gg) if (gg == gbest) {
#pragma unroll
                for (int i = 0; i < 4; ++i) { const float s_ = sel[gg * 4 + i]; const int e = gg * 4 + i;
                    if (s_ > m1) { m2 = m1; e1 = e0; w1 = w0; m1 = s_; e0 = e; w0 = scv[e]; } else if (s_ > m2) { m2 = s_; e1 = e; w1 = scv[e]; } } }
            const float inv = 1.f / (w0 + w1);
            ent[tid * 2 + 0] = (e0 << 24) | (rr * 2); ent[tid * 2 + 1] = (e1 << 24) | (rr * 2 + 1);
            tok[rr * 4 + 0] = e0; tok[rr * 4 + 1] = e1; ((float*)tok)[rr * 4 + 2] = w0 * inv; ((float*)tok)[rr * 4 + 3] = w1 * inv; } }
    __syncthreads();
    if (tid < NE) { int c_ = 0;
        for (int j = 0; j < 128; ++j) c_ += ((ent[j] >> 24) == tid) ? 1 : 0;
        if (c_) { unsigned pos = atomicAdd(&cnt[tid * CNT_STRIDE], (unsigned)c_);
            for (int j = 0; j < 128; ++j) { const int en = ent[j]; if ((en >> 24) == tid) { __hip_atomic_store((__attribute__((address_space(1))) int*)(list + (size_t)tid * R + pos), en & 0xffffff, __ATOMIC_RELAXED, __HIP_MEMORY_SCOPE_AGENT); ++pos; } } } }
    __syncthreads();
}

DEV int scan_tok(int dir, int pos) { return dir == 0 ? pos : (pos < TC ? (TC - 1 - pos) : (S - 1 - (pos - TC))); }
template <int MODE>
DEV void scan_prep_phase(const Args& a, char* smem) {
    constexpr int NH = MODE == 0 ? 8 : 4, DV = MODE == 0 ? 128 : 256, LDP = MODE == 0 ? AB_INP : CD_INP, NVP = DV / 128;
    const int tid = tid_opaque(), dp = tid & 63, pg = tid >> 6, wid = tid >> 6, lane = tid & 63, l15 = lane & 15, l4 = lane >> 4;
    char* QT = smem; char* KT = smem + 64 * PQ; float* tot = (float*)(smem + 2 * 64 * PQ);
    float* aT = tot + 8 * 128;
    const bf16_t* P = (const bf16_t*)(a.ws + WS_P); const float* lb = (const float*)(a.ws + WS_LB);
    const float qscale = 0.08838834764831845f;
    const int nitems = NB * NH * 2 * 36;
#define SP_LOADS(it_, Q_, Z_, V_) do { const int c_ = (it_) % 36, dir_ = ((it_) / 36) & 1, hd_ = ((it_) / 72) % NH, b_ = (it_) / (72 * NH); \
        const int qcol_ = (MODE == 0 ? hd_ * 128 : 1536 + hd_ * 128) + 2 * dp, zcol_ = (MODE == 0 ? 1024 * (1 + dir_) + hd_ * 128 : 2048 + hd_ * 128) + 2 * dp, vcol_ = (MODE == 0 ? 3072 + hd_ * 128 : 2560 + hd_ * 256) + 2 * dp; \
        _Pragma("unroll") for (int j = 0; j < 8; ++j) { const bf16_t* pr = P + (size_t)(b_ * S + scan_tok(dir_, c_ * 64 + pg * 8 + j)) * LDP; \
            Q_[j] = *(const unsigned*)(pr + qcol_); Z_[j] = *(const unsigned*)(pr + zcol_); \
            _Pragma("unroll") for (int vv = 0; vv < NVP; ++vv) V_[vv][j] = *(const unsigned*)(pr + vcol_ + vv * 128); } } while (0)
    unsigned nz[8], nq[8], nv[NVP][8];
    if ((int)blockIdx.x < nitems) SP_LOADS((int)blockIdx.x, nq, nz, nv);
    for (int item = blockIdx.x; item < nitems; item += gridDim.x) {
        const int c = item % 36, dir = (item / 36) & 1, hd = (item / 72) % NH, b = item / (72 * NH);
        char* rec = (char*)(a.ws + (MODE == 0 ? WS_SREC : WS_SREC1)) + (size_t)item * REC_BYTES;
        char* vt = (char*)(a.ws + (MODE == 0 ? WS_SVT : WS_SVT1)) + (size_t)item * (DV * PA);
        unsigned zq[8], qq[8], kq[8], vq[NVP][8];
#pragma unroll
        for (int j = 0; j < 8; ++j) { qq[j] = nq[j]; zq[j] = nz[j]; kq[j] = nz[j];
#pragma unroll
            for (int vv = 0; vv < NVP; ++vv) vq[vv][j] = nv[vv][j]; }
        float lb0 = 0.f, lb1 = 0.f, gb0 = 0.f, gb1 = 0.f; float w0[16], w1[16]; u32x2 av = {0u, 0u};
        if (MODE == 0) { lb0 = lb[dir * 1024 + hd * 128 + 2 * dp]; lb1 = lb[dir * 1024 + hd * 128 + 2 * dp + 1]; }
        else { const int wc_ = hd * 128 + 2 * dp; gb0 = a.in[22][dir * 512 + wc_]; gb1 = a.in[22][dir * 512 + wc_ + 1];
#pragma unroll
            for (int i = 0; i < 16; ++i) { const float2 wv = *(const float2*)(a.in[21] + (size_t)(dir * 16 + i) * 512 + wc_); w0[i] = wv.x; w1[i] = wv.y; }
            const int pos = (tid & 255) >> 2, qd = tid & 3; const int r = b * S + scan_tok(dir, c * 64 + pos);
            av = *(const u32x2*)(P + (size_t)r * LDP + 4608 + dir * 16 + qd * 4); }
        __builtin_amdgcn_sched_barrier(0);
        { const int nxt = item + (int)gridDim.x < nitems ? item + (int)gridDim.x : item; SP_LOADS(nxt, nq, nz, nv); }
        __builtin_amdgcn_sched_barrier(0);
        if (MODE == 1) { if (tid < 256) { const int pos = tid >> 2, qd = tid & 3; *(f32x4*)(aT + pos * 16 + qd * 4) = (f32x4){bflo(av.x), bfhi(av.x), bflo(av.y), bfhi(av.y)}; }
            LDS_BARRIER(); }
        float g0[8], g1[8], k0[8], k1[8];
        if (MODE == 0) {
#pragma unroll
            for (int j = 0; j < 8; ++j) { const float f0 = lb0 + (1.f - lb0) * sigmoidf_(bflo(zq[j])), f1 = lb1 + (1.f - lb1) * sigmoidf_(bfhi(zq[j]));
                g0[j] = __logf(f0); g1[j] = __logf(f1); k0[j] = 1.f - f0; k1[j] = 1.f - f1; } }
        else {
#pragma unroll
            for (int j = 0; j < 8; ++j) { float z0 = gb0, z1 = gb1;
#pragma unroll
                for (int i4 = 0; i4 < 4; ++i4) { const f32x4 av = *(const f32x4*)(aT + (pg * 8 + j) * 16 + i4 * 4);
#pragma unroll
                    for (int e = 0; e < 4; ++e) { z0 += av[e] * w0[i4 * 4 + e]; z1 += av[e] * w1[i4 * 4 + e]; } }
                g0[j] = (fminf(z0, 0.f) - __logf(1.f + __expf(-fabsf(z0)))) * (1.f / 16.f); g1[j] = (fminf(z1, 0.f) - __logf(1.f + __expf(-fabsf(z1)))) * (1.f / 16.f);
                k0[j] = bflo(kq[j]); k1[j] = bfhi(kq[j]); } }
#pragma unroll
        for (int j = 1; j < 8; ++j) { g0[j] += g0[j - 1]; g1[j] += g1[j - 1]; }
        *(float2*)(tot + pg * 128 + 2 * dp) = make_float2(g0[7], g1[7]);
        LDS_BARRIER();
        float off0 = 0.f, off1 = 0.f, ref0 = 0.f, ref1 = 0.f, last0 = 0.f, last1 = 0.f;
#pragma unroll
        for (int p = 0; p < 8; ++p) { const float2 tp = *(const float2*)(tot + p * 128 + 2 * dp);
            if (p < pg) { off0 += tp.x; off1 += tp.y; } if (p < 4) { ref0 += tp.x; ref1 += tp.y; } last0 += tp.x; last1 += tp.y; }
        unsigned kh0[4], kh1[4];
        const float eref0 = __expf(ref0), eref1 = __expf(ref1), elr0 = __expf(last0 - ref0), elr1 = __expf(last1 - ref1);
#pragma unroll
        for (int j = 0; j < 8; j += 2) { float kha[2], khb[2];
#pragma unroll
            for (int e = 0; e < 2; ++e) { const int i = pg * 8 + j + e; const float G0 = off0 + g0[j + e], G1 = off1 + g1[j + e];
                float q0 = bflo(qq[j + e]), q1 = bfhi(qq[j + e]); if (MODE == 0) { q0 = siluf_(q0); q1 = siluf_(q1); } q0 *= qscale; q1 *= qscale;
                const float kk0 = k0[j + e], kk1 = k1[j + e];
                const float qt0 = q0 * __expf(G0 - ref0), qt1 = q1 * __expf(G1 - ref1), kt0 = kk0 * __expf(ref0 - G0), kt1 = kk1 * __expf(ref1 - G1);
                *(unsigned*)(QT + i * PQ + dp * 4) = cvtpk(qt0, qt1);
                *(unsigned*)(KT + i * PQ + dp * 4) = cvtpk(kt0, kt1);
                *(unsigned*)(rec + REC_QH + i * PQ + dp * 4) = cvtpk(qt0 * eref0, qt1 * eref1);
                kha[e] = kt0 * elr0; khb[e] = kt1 * elr1; }
            kh0[j >> 1] = cvtpk(kha[0], kha[1]); kh1[j >> 1] = cvtpk(khb[0], khb[1]); }
        *(u32x4*)(rec + REC_KHT + (2 * dp) * PA + pg * 16) = (u32x4){kh0[0], kh0[1], kh0[2], kh0[3]};
        *(u32x4*)(rec + REC_KHT + (2 * dp + 1) * PA + pg * 16) = (u32x4){kh1[0], kh1[1], kh1[2], kh1[3]};
        if (pg == 0) *(float2*)(rec + REC_AL + dp * 8) = make_float2(__expf(last0), __expf(last1));
#pragma unroll
        for (int vv = 0; vv < NVP; ++vv) { const int v0 = vv * 128 + 2 * dp; unsigned lo[4], hi[4];
#pragma unroll
            for (int j = 0; j < 8; j += 2) { lo[j >> 1] = (vq[vv][j] & 0xffffu) | (vq[vv][j + 1] << 16); hi[j >> 1] = (vq[vv][j] >> 16) | (vq[vv][j + 1] & 0xffff0000u); }
            *(u32x4*)(vt + v0 * PA + pg * 16) = (u32x4){lo[0], lo[1], lo[2], lo[3]};
            *(u32x4*)(vt + (v0 + 1) * PA + pg * 16) = (u32x4){hi[0], hi[1], hi[2], hi[3]}; }
        asm volatile("s_waitcnt lgkmcnt(0)" ::: "memory"); __builtin_amdgcn_s_barrier();
        { const int ti = wid >> 1; f32x4 acc[2] = {};
#pragma unroll
          for (int kk = 0; kk < 4; ++kk) { const int i = ti * 16 + l15;
              const bf16x8 bq = *(const bf16x8*)(QT + i * PQ + (kk * 32 + l4 * 8) * 2);
#pragma unroll
              for (int t2_ = 0; t2_ < 2; ++t2_) { const int sidx = ((wid & 1) * 2 + t2_) * 16 + l15;
                  const bf16x8 ak = *(const bf16x8*)(KT + sidx * PQ + (kk * 32 + l4 * 8) * 2);
                  acc[t2_] = __builtin_amdgcn_mfma_f32_16x16x32_bf16(ak, bq, acc[t2_], 0, 0, 0); } }
#pragma unroll
          for (int t2_ = 0; t2_ < 2; ++t2_) { const int tj = (wid & 1) * 2 + t2_, i = ti * 16 + l15, s0 = tj * 16 + 4 * l4;
              float x0 = (s0 + 0 <= i) ? acc[t2_][0] : 0.f, x1 = (s0 + 1 <= i) ? acc[t2_][1] : 0.f, x2 = (s0 + 2 <= i) ? acc[t2_][2] : 0.f, x3 = (s0 + 3 <= i) ? acc[t2_][3] : 0.f;
              u32x2 w_; w_.x = cvtpk(x0, x1); w_.y = cvtpk(x2, x3);
              *(u32x2*)(rec + REC_A + i * PA + s0 * 2) = w_; } }
    }
#undef SP_LOADS
    __syncthreads();
}
template <int MODE>
DEV void scan_seq_phase(const Args& a, char* smem) {
    constexpr int NH = MODE == 0 ? 8 : 4, DV = MODE == 0 ? 128 : 256, NVS = DV / 32;
    constexpr int B_A = REC_A, B_QH = REC_QH, B_KHT = REC_KHT, B_AL = REC_AL, B_VT = REC_BYTES, VTS = 32 * PA, BUFB = REC_BYTES + VTS;
    constexpr int NPIECE = BUFB / 16, NREC = REC_BYTES / 16, STB = 32 * PQ, NLD = 7 * 64;
    constexpr int NRL = (REC_BYTES / 128 + NVS - 1) / NVS, TOUCH_OFF = 3 * BUFB + STB;
    static_assert(NPIECE == 7 * NLD && REC_BYTES % 128 == 0 && VTS == 36 * 128 && NRL + 36 <= 128 && TOUCH_OFF + 256 <= LDS_BYTES_C - 16, "scan_seq layout");
    const int tid = tid_opaque(), wid = tid >> 6, lane = tid & 63, l15 = lane & 15, l4 = lane >> 4;
    char* ST = smem + 3 * BUFB;
    float* odir = (float*)(a.ws + WS_ODIR);
    for (int item = blockIdx.x; item < NB * NH * 2 * NVS; item += gridDim.x) {
        const int vs = (item >> 3) % NVS, rest = (item & 7) + 8 * ((item >> 3) / NVS);
        const int dir = rest & 1, hd = (rest >> 1) % NH, b = (rest >> 1) / NH;
        const char* rec0 = (const char*)(a.ws + (MODE == 0 ? WS_SREC : WS_SREC1)) + (size_t)rest * 36 * REC_BYTES;
        const char* vt0 = (const char*)(a.ws + (MODE == 0 ? WS_SVT : WS_SVT1)) + (size_t)rest * 36 * (DV * PA) + vs * VTS;
#define SC_LOAD(cc, bb) do { if (wid < 7) { const char* _r = rec0 + (size_t)(cc) * REC_BYTES; const char* _v = vt0 + (size_t)(cc) * (DV * PA) - REC_BYTES; char* _l = smem + (bb) * BUFB; \
        _Pragma("unroll") for (int _k = 0; _k < 7; ++_k) { const int _p = tid + _k * NLD; \
            __builtin_amdgcn_global_load_lds((const unsigned*)((_p < NREC ? _r : _v) + _p * 16), (unsigned*)(_l + _p * 16), 16, 0, 0); } } } while (0)
#define SC_TOUCH(cc) do { if (wid == 7) { _Pragma("unroll") for (int _q = 0; _q < 2; ++_q) { const int L_ = _q * 64 + lane; const char* tp_; \
        if (L_ < NRL) { int li_ = vs * NRL + L_; li_ = li_ < REC_BYTES / 128 - 1 ? li_ : REC_BYTES / 128 - 1; tp_ = rec0 + (size_t)(cc) * REC_BYTES + li_ * 128; } \
        else { int li_ = L_ - NRL; li_ = li_ < 35 ? li_ : 35; tp_ = vt0 + (size_t)(cc) * (DV * PA) + li_ * 128; } \
        __builtin_amdgcn_global_load_lds((const unsigned*)tp_, (unsigned*)(smem + TOUCH_OFF), 4, 0, 0); } } } while (0)
        for (int i = tid; i < STB / 16; i += NT) ((u32x4*)ST)[i] = (u32x4){0u, 0u, 0u, 0u};
        f32x4 Sacc[2] = {};
        SC_LOAD(0, 0); SC_LOAD(1, 1); SC_TOUCH(2); SC_TOUCH(3);
        asm volatile("s_waitcnt vmcnt(0) lgkmcnt(0)" ::: "memory"); __builtin_amdgcn_s_barrier(); asm volatile("" ::: "memory");
        int rb = 0;
#pragma unroll 1
        for (int c = 0; c < 36; ++c) {
            const char* buf = smem + rb * BUFB; const char* STr = ST; char* STw = ST;
            { const int nb2 = rb == 0 ? 2 : rb - 1;
              if (c + 2 < 36) SC_LOAD(c + 2, nb2); }
            rb = rb == 2 ? 0 : rb + 1;
            { const int ti = wid >> 1, tj = wid & 1, i = ti * 16 + l15, v = tj * 16 + l15, dr = wid * 16 + l15;
              bf16x8 ba[2], as_[4], bq[4], ak[2], bv[2][2];
#pragma unroll
              for (int kk = 0; kk < 2; ++kk) { ba[kk] = *(const bf16x8*)(buf + B_A + i * PA + (kk * 32 + l4 * 8) * 2); ak[kk] = *(const bf16x8*)(buf + B_KHT + dr * PA + (kk * 32 + l4 * 8) * 2);
                  bv[0][kk] = *(const bf16x8*)(buf + B_VT + l15 * PA + (kk * 32 + l4 * 8) * 2); bv[1][kk] = *(const bf16x8*)(buf + B_VT + (16 + l15) * PA + (kk * 32 + l4 * 8) * 2); }
              const f32x4 al = *(const f32x4*)(buf + B_AL + (wid * 16 + 4 * l4) * 4);
#pragma unroll
              for (int kk = 0; kk < 4; ++kk) { as_[kk] = *(const bf16x8*)(STr + v * PQ + (kk * 32 + l4 * 8) * 2); bq[kk] = *(const bf16x8*)(buf + B_QH + i * PQ + (kk * 32 + l4 * 8) * 2); }
              __builtin_amdgcn_sched_barrier(0);
              asm volatile("s_waitcnt lgkmcnt(0)" : "+v"(as_[0]), "+v"(as_[1]), "+v"(as_[2]), "+v"(as_[3]) :: "memory"); __builtin_amdgcn_s_barrier(); asm volatile("" ::: "memory");
              f32x4 acc = {}; Sacc[0] *= al; Sacc[1] *= al;
#pragma unroll
              for (int kk = 0; kk < 2; ++kk) {
                  acc = __builtin_amdgcn_mfma_f32_16x16x32_bf16(tj ? bv[1][kk] : bv[0][kk], ba[kk], acc, 0, 0, 0);
                  Sacc[0] = __builtin_amdgcn_mfma_f32_16x16x32_bf16(ak[kk], bv[0][kk], Sacc[0], 0, 0, 0);
                  Sacc[1] = __builtin_amdgcn_mfma_f32_16x16x32_bf16(ak[kk], bv[1][kk], Sacc[1], 0, 0, 0); }
#pragma unroll
              for (int kk = 0; kk < 4; ++kk) acc = __builtin_amdgcn_mfma_f32_16x16x32_bf16(as_[kk], bq[kk], acc, 0, 0, 0);
#pragma unroll
              for (int tv = 0; tv < 2; ++tv) { u32x2 w_; w_.x = cvtpk(Sacc[tv][0], Sacc[tv][1]); w_.y = cvtpk(Sacc[tv][2], Sacc[tv][3]);
                  *(u32x2*)(STw + (tv * 16 + l15) * PQ + (wid * 16 + 4 * l4) * 2) = w_; }
              const int r = b * S + scan_tok(dir, c * 64 + i);
              *(f32x4*)(odir + ((size_t)dir * R + r) * 1024 + hd * DV + vs * 32 + tj * 16 + 4 * l4) = acc; }
            SC_TOUCH(c + 4 < 36 ? c + 4 : 35);
            if (wid < 7) { if (c + 2 < 36) asm volatile("s_waitcnt vmcnt(8)" ::: "memory"); else asm volatile("s_waitcnt vmcnt(1)" ::: "memory"); } else asm volatile("s_waitcnt vmcnt(9)" ::: "memory");
            asm volatile("s_waitcnt lgkmcnt(0)" ::: "memory"); __builtin_amdgcn_s_barrier(); asm volatile("" ::: "memory");
        }
#undef SC_LOAD
#undef SC_TOUCH
    }
    asm volatile("s_waitcnt vmcnt(0)" ::: "memory"); __syncthreads();
}

namespace fa {
typedef short s16x4 __attribute__((ext_vector_type(4)));
typedef float f32x16 __attribute__((ext_vector_type(16)));
constexpr int QBLK = 32, KVBLK = 64, NW = 8;
constexpr float THR = 8.f;
#define FA_SBAR() __builtin_amdgcn_sched_barrier(0)
DEV int crow(int r, int hi) { return (r & 3) + 8 * (r >> 2) + 4 * hi; }
template <int DQ> DEV int kswz(int row, int colB) { return row * (DQ * 2) + (colB ^ ((row & 7) << 4)); }
template <int DQ> DEV void partialSM(f32x16& p0, f32x16& p1, float& m_reg, float& mn, float& alpha) {
    constexpr float SCALE = DQ == 128 ? 0.08838834764831845f : 0.07216878364870322f;
    constexpr float C = SCALE * 1.4426950408889634f;
    float pmax = p0[0];
#pragma unroll
    for (int r = 1; r < 16; ++r) pmax = fmaxf(pmax, p0[r]);
#pragma unroll
    for (int r = 0; r < 16; ++r) pmax = fmaxf(pmax, p1[r]);
    { auto rr = __builtin_amdgcn_permlane32_swap(__float_as_uint(pmax), __float_as_uint(pmax), false, false);
      pmax = fmaxf(__uint_as_float(rr[0]), __uint_as_float(rr[1])); }
    if (__builtin_expect(__all(pmax - m_reg <= THR / SCALE), 1)) { mn = m_reg; alpha = 1.f; }
    else { mn = fmaxf(m_reg, pmax); alpha = __builtin_amdgcn_exp2f((m_reg - mn) * C); m_reg = mn; }
    const float mnC = -mn * C;
#pragma unroll
    for (int r = 0; r < 16; ++r) p0[r] = fmaf(p0[r], C, mnC);
#pragma unroll
    for (int r = 0; r < 16; ++r) p1[r] = fmaf(p1[r], C, mnC);
#pragma unroll
    for (int r = 0; r < 16; ++r) p0[r] = __builtin_amdgcn_exp2f(p0[r]);
}
DEV void finishSM(f32x16& p0, f32x16& p1, float alpha, float& l_reg, bf16x8& pa0, bf16x8& pa1, bf16x8& pa2, bf16x8& pa3) {
#pragma unroll
    for (int r = 0; r < 16; ++r) p1[r] = __builtin_amdgcn_exp2f(p1[r]);
    float ps = 0;
#pragma unroll
    for (int r = 0; r < 16; ++r) ps += p0[r];
#pragma unroll
    for (int r = 0; r < 16; ++r) ps += p1[r];
    { auto rr = __builtin_amdgcn_permlane32_swap(__float_as_uint(ps), __float_as_uint(ps), false, false);
      ps = __uint_as_float(rr[0]) + __uint_as_float(rr[1]); }
    l_reg = l_reg * alpha + ps;
#define FA_PK4(P, BASE, OUT) do { unsigned a0 = cvtpk(P[BASE + 0], P[BASE + 1]), a1 = cvtpk(P[BASE + 2], P[BASE + 3]);   \
    unsigned b0 = cvtpk(P[BASE + 4], P[BASE + 5]), b1 = cvtpk(P[BASE + 6], P[BASE + 7]);                              \
    auto r0 = __builtin_amdgcn_permlane32_swap(a0, b0, false, false); auto r1 = __builtin_amdgcn_permlane32_swap(a1, b1, false, false); \
    u32x4 w = {r0[0], r1[0], r0[1], r1[1]}; OUT = *reinterpret_cast<bf16x8*>(&w); } while (0)
    FA_PK4(p0, 0, pa0); FA_PK4(p0, 8, pa1); FA_PK4(p1, 0, pa2); FA_PK4(p1, 8, pa3);
#undef FA_PK4
}
template <int DQ> DEV void qkt(f32x16& p0, f32x16& p1, const char* Ks, const bf16x8* qr, int r32, int hi) {
    p0 = f32x16{}; p1 = f32x16{};
#pragma unroll
    for (int d0 = 0; d0 < DQ / 16; ++d0) { const int cb = (d0 * 16 + hi * 8) * 2;
        const bf16x8 b0 = *reinterpret_cast<const bf16x8*>(Ks + kswz<DQ>(r32, cb));
        const bf16x8 b1 = *reinterpret_cast<const bf16x8*>(Ks + kswz<DQ>(32 + r32, cb));
        p0 = __builtin_amdgcn_mfma_f32_32x32x16_bf16(b0, qr[d0], p0, 0, 0, 0);
        p1 = __builtin_amdgcn_mfma_f32_32x32x16_bf16(b1, qr[d0], p1, 0, 0, 0); }
}
DEV int v_st(int k, int c) { const int kk = (k & ~0xC) | ((k & 4) << 1) | ((k & 8) >> 1); return ((kk >> 3) * 4 + (c >> 5)) * 512 + ((kk & 7) * 32 + (c & 31)) * 2; }
DEV int v_rd_base(int lane) { return ((lane & 3) << 3) | (((lane >> 2) & 3) << 6) | (((lane >> 4) & 1) << 5) | (((lane >> 5) & 1) << 8); }
constexpr int v_rd_off(int d0, int ks, int half) { return d0 * 512 + ks * 4096 + half * 2048; }
template <int OFF> DEV s16x4 tr_read(int vb) { s16x4 r; asm volatile("ds_read_b64_tr_b16 %0, %1 offset:%2" : "=&v"(r) : "v"(vb), "i"(OFF) : "memory"); return r; }
template <int D0> DEV void pv_one(f32x16& od, int vb, bf16x8 pa0, bf16x8 pa1, bf16x8 pa2, bf16x8 pa3) {
    const s16x4 l0 = tr_read<v_rd_off(D0, 0, 0)>(vb), h0 = tr_read<v_rd_off(D0, 0, 1)>(vb), l1 = tr_read<v_rd_off(D0, 1, 0)>(vb), h1 = tr_read<v_rd_off(D0, 1, 1)>(vb);
    const s16x4 l2 = tr_read<v_rd_off(D0, 2, 0)>(vb), h2 = tr_read<v_rd_off(D0, 2, 1)>(vb), l3 = tr_read<v_rd_off(D0, 3, 0)>(vb), h3 = tr_read<v_rd_off(D0, 3, 1)>(vb);
    asm volatile("s_waitcnt lgkmcnt(0)" ::: "memory"); FA_SBAR();
#define FA_PK(L, H) (bf16x8){L[0], L[1], L[2], L[3], H[0], H[1], H[2], H[3]}
    od = __builtin_amdgcn_mfma_f32_32x32x16_bf16(pa0, FA_PK(l0, h0), od, 0, 0, 0);
    od = __builtin_amdgcn_mfma_f32_32x32x16_bf16(pa1, FA_PK(l1, h1), od, 0, 0, 0);
    od = __builtin_amdgcn_mfma_f32_32x32x16_bf16(pa2, FA_PK(l2, h2), od, 0, 0, 0);
    od = __builtin_amdgcn_mfma_f32_32x32x16_bf16(pa3, FA_PK(l3, h3), od, 0, 0, 0);
#undef FA_PK
}
DEV void pv_d0(f32x16* o, int vb, bf16x8 pa0, bf16x8 pa1, bf16x8 pa2, bf16x8 pa3) {
    pv_one<0>(o[0], vb, pa0, pa1, pa2, pa3); pv_one<1>(o[1], vb, pa0, pa1, pa2, pa3); pv_one<2>(o[2], vb, pa0, pa1, pa2, pa3); pv_one<3>(o[3], vb, pa0, pa1, pa2, pa3);
}
template <int DQ>
DEV void attn_body(const bf16_t* __restrict__ Qb, const bf16_t* __restrict__ Kh, const bf16_t* __restrict__ Vh, bf16_t* __restrict__ Ob, int LDO_, int seq_, char* lds) {
    constexpr int LDO = D, seq = S; (void)LDO_; (void)seq_;
    constexpr int NKC = DQ / 64, KC8 = DQ / 8;
    constexpr int SHM_V = KVBLK * 128 * 2, SHM_K = KVBLK * DQ * 2;
    const int tid = tid_opaque(), wid = tid >> 6, lane = tid & 63, r32 = lane & 31, hi = lane >> 5;
    char* V_lds = lds; char* K_lds = lds + 2 * SHM_V;
    float* wsx = (float*)(lds + 2 * SHM_V + 2 * SHM_K) + wid * 64; float* li_l = wsx; float* al_l = wsx + 32;
    float m_reg = -1e30f, l_reg = 0; f32x16 o[4] = {}; bf16x8 qr[DQ / 16];
    const bf16_t* Qw = Qb + (size_t)(wid * QBLK + r32) * DQ + hi * 8;
#pragma unroll
    for (int d0 = 0; d0 < DQ / 16; ++d0) qr[d0] = *reinterpret_cast<const bf16x8*>(Qw + d0 * 16);
    const int sr = tid >> 4, sc = (tid & 15) * 8;
    const int vb0 = (int)(uintptr_t)V_lds + v_rd_base(lane);
    struct { bf16x8 vs0, vs1, ks[NKC]; } sr_[2];
#define SLOAD(i, k0) do { sr_[i].vs0 = *reinterpret_cast<const bf16x8*>(&Vh[(size_t)((k0) + sr) * 128 + sc]); sr_[i].vs1 = *reinterpret_cast<const bf16x8*>(&Vh[(size_t)((k0) + 32 + sr) * 128 + sc]); \
    _Pragma("unroll") for (int _c = 0; _c < NKC; ++_c) { const int ch = tid + _c * 512, kr = ch / KC8, kc = ch - kr * KC8; sr_[i].ks[_c] = *reinterpret_cast<const bf16x8*>(&Kh[(size_t)((k0) + kr) * DQ + kc * 8]); } } while (0)
#define SWRITE(b, i) do { const int t2_ = tid_opaque(), sr2_ = t2_ >> 4, sc2_ = (t2_ & 15) * 8; *(bf16x8*)(V_lds + (b) * SHM_V + v_st(sr2_, sc2_)) = sr_[i].vs0; *(bf16x8*)(V_lds + (b) * SHM_V + v_st(32 + sr2_, sc2_)) = sr_[i].vs1; \
    _Pragma("unroll") for (int _c = 0; _c < NKC; ++_c) { const int ch = tid + _c * 512, kr = ch / KC8, kc = ch - kr * KC8; *(bf16x8*)(K_lds + (b) * SHM_K + kswz<DQ>(kr, kc * 16)) = sr_[i].ks[_c]; } } while (0)
#define SWAIT() do { if constexpr (NKC == 2) asm volatile("s_waitcnt vmcnt(4)" ::: "memory"); else asm volatile("s_waitcnt vmcnt(5)" ::: "memory"); } while (0)
#define RESC(a_) do { if (__any((a_) < 1.f)) { if (hi == 0) al_l[r32] = (a_); asm volatile("s_waitcnt lgkmcnt(0)" ::: "memory"); \
    _Pragma("unroll") for (int d = 0; d < 4; ++d) _Pragma("unroll") for (int r = 0; r < 16; ++r) o[d][r] *= al_l[crow(r, hi)]; } } while (0)
    f32x16 pA0, pA1, pB0, pB1; float mnA, mnB, alA, alB; bf16x8 pa0, pa1, pa2, pa3; const int NTL = seq / KVBLK;
    constexpr int SE = 0, SO = 1;
    SLOAD(SE, 0); asm volatile("s_waitcnt vmcnt(0)" ::: "memory"); SWRITE(0, SE); __syncthreads();
    qkt<DQ>(pA0, pA1, K_lds, qr, r32, hi); partialSM<DQ>(pA0, pA1, m_reg, mnA, alA);
    SLOAD(SO, KVBLK); if (2 < NTL) SLOAD(SE, 2 * KVBLK);
    SWAIT(); SWRITE(1, SO); __syncthreads();
    for (int j = 1; j + 1 < NTL; j += 2) {
        FA_SBAR(); qkt<DQ>(pB0, pB1, K_lds + SHM_K, qr, r32, hi);
        finishSM(pA0, pA1, alA, l_reg, pa0, pa1, pa2, pa3); FA_SBAR();
        SLOAD(SO, (j + 2) * KVBLK); FA_SBAR();
        pv_d0(o, vb0, pa0, pa1, pa2, pa3); partialSM<DQ>(pB0, pB1, m_reg, mnB, alB);
        __syncthreads(); SWAIT(); SWRITE(0, SE);
        RESC(alB); __syncthreads();
        FA_SBAR(); qkt<DQ>(pA0, pA1, K_lds, qr, r32, hi);
        finishSM(pB0, pB1, alB, l_reg, pa0, pa1, pa2, pa3); FA_SBAR();
        if (j + 3 < NTL) SLOAD(SE, (j + 3) * KVBLK); FA_SBAR();
        pv_d0(o, vb0 + SHM_V, pa0, pa1, pa2, pa3); partialSM<DQ>(pA0, pA1, m_reg, mnA, alA);
        __syncthreads(); SWAIT(); SWRITE(1, SO);
        RESC(alA); __syncthreads();
    }
    FA_SBAR(); qkt<DQ>(pB0, pB1, K_lds + SHM_K, qr, r32, hi);
    finishSM(pA0, pA1, alA, l_reg, pa0, pa1, pa2, pa3); FA_SBAR();
    pv_d0(o, vb0, pa0, pa1, pa2, pa3); partialSM<DQ>(pB0, pB1, m_reg, mnB, alB);
    __syncthreads(); RESC(alB);
    finishSM(pB0, pB1, alB, l_reg, pa0, pa1, pa2, pa3); FA_SBAR();
    pv_d0(o, vb0 + SHM_V, pa0, pa1, pa2, pa3);
    if (hi == 0) li_l[r32] = l_reg; asm volatile("s_waitcnt lgkmcnt(0)" ::: "memory");
    float rli[16];
#pragma unroll
    for (int r = 0; r < 16; ++r) rli[r] = __builtin_amdgcn_rcpf(li_l[crow(r, hi)]);
    bf16_t* Ow = Ob + (size_t)(wid * QBLK) * LDO;
#pragma unroll
    for (int r = 0; r < 16; ++r) { const int orow = crow(r, hi);
#pragma unroll
        for (int d0 = 0; d0 < 4; ++d0) Ow[(size_t)orow * LDO + d0 * 32 + r32] = f2bf(o[d0][r] * rli[r]); }
    __syncthreads();
#undef SLOAD
#undef SWRITE
#undef SWAIT
#undef RESC
}

template <int DQ>
DEV void attn_body_simple(const bf16_t* __restrict__ Qb, const bf16_t* __restrict__ Kh, const bf16_t* __restrict__ Vh, bf16_t* __restrict__ Ob, int LDO, int seq, char* lds) {
    constexpr int NKC = DQ / 64, KC8 = DQ / 8;
    constexpr int SHM_V = KVBLK * 128 * 2, SHM_K = KVBLK * DQ * 2;
    const int tid = tid_opaque(), wid = tid >> 6, lane = tid & 63, r32 = lane & 31, hi = lane >> 5;
    char* V_lds = lds; char* K_lds = lds + 2 * SHM_V;
    float* wsx = (float*)(lds + 2 * SHM_V + 2 * SHM_K) + wid * 64; float* li_l = wsx; float* al_l = wsx + 32;
    float m_reg = -1e30f, l_reg = 0; f32x16 o[4] = {}; bf16x8 qr[DQ / 16];
    const bf16_t* Qw = Qb + (size_t)(wid * QBLK + r32) * DQ + hi * 8;
#pragma unroll
    for (int d0 = 0; d0 < DQ / 16; ++d0) qr[d0] = *reinterpret_cast<const bf16x8*>(Qw + d0 * 16);
    const int sr = tid >> 4, sc = (tid & 15) * 8, vst0 = v_st(sr, sc), vst1 = v_st(32 + sr, sc);
    const int vb0 = (int)(uintptr_t)V_lds + v_rd_base(lane);
    bf16x8 vs0, vs1, ks[NKC];
#define SLOAD(k0) do { vs0 = *reinterpret_cast<const bf16x8*>(&Vh[(size_t)((k0) + sr) * 128 + sc]); vs1 = *reinterpret_cast<const bf16x8*>(&Vh[(size_t)((k0) + 32 + sr) * 128 + sc]); \
    _Pragma("unroll") for (int _c = 0; _c < NKC; ++_c) { const int ch = tid + _c * 512, kr = ch / KC8, kc = ch - kr * KC8; ks[_c] = *reinterpret_cast<const bf16x8*>(&Kh[(size_t)((k0) + kr) * DQ + kc * 8]); } } while (0)
#define SWRITE(b) do { *(bf16x8*)(V_lds + (b) * SHM_V + vst0) = vs0; *(bf16x8*)(V_lds + (b) * SHM_V + vst1) = vs1; \
    _Pragma("unroll") for (int _c = 0; _c < NKC; ++_c) { const int ch = tid + _c * 512, kr = ch / KC8, kc = ch - kr * KC8; *(bf16x8*)(K_lds + (b) * SHM_K + kswz<DQ>(kr, kc * 16)) = ks[_c]; } } while (0)
    f32x16 p0, p1; float mn, al; bf16x8 pa0, pa1, pa2, pa3; const int NTL = seq / KVBLK;
    SLOAD(0); SWRITE(0); __syncthreads();
    for (int j = 0; j < NTL; ++j) {
        const int bsel = j & 1;
        if (j + 1 < NTL) SLOAD((j + 1) * KVBLK);
        FA_SBAR(); qkt<DQ>(p0, p1, K_lds + bsel * SHM_K, qr, r32, hi);
        partialSM<DQ>(p0, p1, m_reg, mn, al);
        if (__any(al < 1.f)) { if (hi == 0) al_l[r32] = al; asm volatile("s_waitcnt lgkmcnt(0)" ::: "memory");
#pragma unroll
            for (int d = 0; d < 4; ++d)
#pragma unroll
                for (int r = 0; r < 16; ++r) o[d][r] *= al_l[crow(r, hi)]; }
        finishSM(p0, p1, al, l_reg, pa0, pa1, pa2, pa3); FA_SBAR();
        pv_d0(o, vb0 + bsel * SHM_V, pa0, pa1, pa2, pa3);
        if (j + 1 < NTL) SWRITE(bsel ^ 1);
        __syncthreads();
    }
    if (hi == 0) li_l[r32] = l_reg; asm volatile("s_waitcnt lgkmcnt(0)" ::: "memory");
    float rli[16];
#pragma unroll
    for (int r = 0; r < 16; ++r) rli[r] = __builtin_amdgcn_rcpf(li_l[crow(r, hi)]);
    bf16_t* Ow = Ob + (size_t)(wid * QBLK) * LDO;
#pragma unroll
    for (int r = 0; r < 16; ++r) { const int orow = crow(r, hi);
#pragma unroll
        for (int d0 = 0; d0 < 4; ++d0) Ow[(size_t)orow * LDO + d0 * 32 + r32] = f2bf(o[d0][r] * rli[r]); }
    __syncthreads();
#undef SLOAD
#undef SWRITE
}
}

template <int DQ, int HKV, bool WITH_CTX>
DEV void attn_phase(const Args& a, int colbase, char* smem) {
    const bf16_t* Qb = (const bf16_t*)(a.ws + WS_QB); const bf16_t* Kb = (const bf16_t*)(a.ws + WS_KB); const bf16_t* Vb = (const bf16_t*)(a.ws + WS_VB);
    bf16_t* A2 = (bf16_t*)(a.ws + WS_A2);
    const int nunits = 256 + (WITH_CTX ? 32 : 0);
    for (int u = blockIdx.x; u < nunits; u += gridDim.x) {
        int b, hh, qb, nk;
        if (u < 256) { if (HKV == 8) { const int bh = u & 31; b = bh >> 3; hh = bh & 7; qb = 1 + (u >> 5); }
                       else { const int pr = u & 7, rest = u >> 3; b = pr >> 1; hh = (pr & 1) * 4 + (rest & 3); qb = 1 + (rest >> 2); }
                       nk = S; }
        else { const int bh = u - 256; b = bh >> 3; hh = bh & 7; qb = 0; nk = TC; }
        const int hk = hh / (8 / HKV);
        if constexpr (DQ == 192) fa::attn_body_simple<DQ>(Qb + (((size_t)b * 8 + hh) * S + qb * 256) * DQ, Kb + ((size_t)b * HKV + hk) * S * DQ, Vb + ((size_t)b * HKV + hk) * S * 128,
                          A2 + ((size_t)b * S + qb * 256) * D + colbase + hh * 128, D, nk, smem);
        else fa::attn_body<DQ>(Qb + (((size_t)b * 8 + hh) * S + qb * 256) * DQ, Kb + ((size_t)b * HKV + hk) * S * DQ, Vb + ((size_t)b * HKV + hk) * S * 128,
                          A2 + ((size_t)b * S + qb * 256) * D + colbase + hh * 128, D, nk, smem);
    }
}

template <int MODE>
DEV void mixout_phase(const Args& a, bool latent_only) {
    const int tid = tid_opaque(), w = tid >> 6, lane = tid & 63;
    constexpr int NH = MODE == 0 ? 8 : 4, DV = MODE == 0 ? 128 : 256, LDP = MODE == 0 ? AB_INP : CD_INP, GC = MODE == 0 ? 4096 : 3584, CB = MODE == 0 ? 0 : 1024, PER = DV / 64;
    const bf16_t* P = (const bf16_t*)(a.ws + WS_P); const float* odir = (const float*)(a.ws + WS_ODIR); bf16_t* A2 = (bf16_t*)(a.ws + WS_A2);
    const float* g = MODE == 0 ? a.in[12] : a.in[23];
    for (int it = blockIdx.x * 8 + w; it < R * NH; it += gridDim.x * 8) {
        const int r = it / NH, hd = it - r * NH; const int t = r % S; if (latent_only && t < TC) continue;
        float o[PER]; float ss = 0.f;
#pragma unroll
        for (int j = 0; j < PER; ++j) { const int c = hd * DV + j * 64 + lane; o[j] = odir[(size_t)r * 1024 + c] + odir[((size_t)R + r) * 1024 + c]; ss += o[j] * o[j]; }
        ss = wave_sum(ss); const float rs = rsqrtf(ss * (1.f / DV) + EPS);
#pragma unroll
        for (int j = 0; j < PER; ++j) { const int c = hd * DV + j * 64 + lane; const float gt = bf2f(P[(size_t)r * LDP + GC + c]);
            const float act = MODE == 0 ? sigmoidf_(gt) : siluf_(gt);
            A2[(size_t)r * D + CB + c] = f2bf(o[j] * rs * g[j * 64 + lane] * act); }
    }
}

#define GAS __attribute__((address_space(1)))
typedef GAS unsigned gu32; typedef GAS unsigned long long gu64;
#define RLX_AGENT __ATOMIC_RELAXED, __HIP_MEMORY_SCOPE_AGENT
struct EpiMoeUpSc1 { bf16_t* hid; int rowbase, nvalid;
    DEV void operator()(const f32x4 (&acc)[2][2][4][2], int brow, int bcol, int wr, int wc, int fr, int fq) const {
        const int hc = (bcol >> 1) + wc * 32 + fq * 4;
#pragma unroll
        for (int ai = 0; ai < 2; ++ai)
#pragma unroll
            for (int m = 0; m < 4; ++m) { const int lr = ai * HALF + wr * 64 + m * 16 + fr;
                if (lr < nvalid) { bf16_t* rowp = hid + (size_t)(rowbase + lr) * EDIM + hc;
#pragma unroll
                    for (int n = 0; n < 2; ++n) { const f32x4 a_ = acc[ai][0][m][n], b_ = acc[ai][1][m][n];
                        const unsigned lo = cvtpk(siluf_(a_[0]) * b_[0], siluf_(a_[1]) * b_[1]), hi = cvtpk(siluf_(a_[2]) * b_[2], siluf_(a_[3]) * b_[3]);
                        __hip_atomic_store((gu64*)(rowp + n * 16), (unsigned long long)lo | ((unsigned long long)hi << 32), RLX_AGENT); } } }
    } };
DEV void moe_phase_fused(const Args& a, int l, char* smem) {
    const int tid = tid_opaque();
    unsigned* ctl = (unsigned*)(a.ws + WS_CTL);
    unsigned* cnt = ctl + CW_CNT + l * 16 * CNT_STRIDE; unsigned* head = ctl + CW_MOEQ + l * 64; unsigned* ready = ctl + CW_RDY + l * (NE * 36 * 16);
    const int* list = (const int*)(a.ws + WS_LIST);
    const bf16_t* h = (const bf16_t*)(a.ws + WS_H); const bf16_t* w13 = moe_w13(a, l); const bf16_t* w2 = moe_w2(a, l);
    bf16_t* hid = (bf16_t*)(a.ws + WS_QB); bf16_t* y = (bf16_t*)(a.ws + WS_P);
    volatile int* tab = (volatile int*)(smem + SHM_GEMM);
    if (tid == 0) { int ub = 0, of = 0, nts[NE];
        for (int e = 0; e < NE; ++e) { const int n = (int)__hip_atomic_load((gu32*)(cnt + e * CNT_STRIDE), RLX_AGENT); nts[e] = (n + 255) >> 8; tab[e] = n; tab[16 + e] = ub; tab[50 + e] = of; ub += nts[e] * 4; of += n; }
        tab[32] = ub; int db = ub;
        for (int e = 0; e < NE; ++e) { tab[33 + e] = db; db += nts[e] * 8; }
        tab[49] = db; }
    for (;;) {
        __syncthreads();
        if (tid == 0) tab[66] = (int)__hip_atomic_fetch_add((gu32*)head, 1u, RLX_AGENT);
        __syncthreads();
        const int item = __builtin_amdgcn_readfirstlane(tab[66]), nup = __builtin_amdgcn_readfirstlane(tab[32]), ntot = __builtin_amdgcn_readfirstlane(tab[49]);
        if (item >= ntot) break;
        const bool up = item < nup; const int tb0 = up ? 16 : 33;
        int e = 0;
#pragma unroll 1
        for (int q = 1; q < NE; ++q) if (item >= __builtin_amdgcn_readfirstlane(tab[tb0 + q])) e = q;
        const int n = __builtin_amdgcn_readfirstlane(tab[e]), nt_ = (n + 255) >> 8, t = item - __builtin_amdgcn_readfirstlane(tab[tb0 + e]), off = __builtin_amdgcn_readfirstlane(tab[50 + e]);
        const int i = t % nt_, pn = t / nt_, nv = min(256, n - i * 256);
        gu32* flag = (gu32*)(ready + (e * 36 + i) * 16);
        if (up) {
            EpiMoeUpSc1 epi{hid, off + i * 256, nv};
            gemm_tile<true>(h, w13 + (size_t)e * 1024 * D, D, D, 0, pn * 256, list + (size_t)e * R + i * 256, nv, smem, epi);
            asm volatile("s_waitcnt vmcnt(0)" ::: "memory");
            __syncthreads();
            if (tid == 0) __hip_atomic_fetch_add(flag, 1u, RLX_AGENT);
        } else {
            if (tid < 64) { unsigned spins = 0;
                while ((unsigned)__builtin_amdgcn_readfirstlane(__hip_atomic_load(flag, RLX_AGENT)) < 4u) { __builtin_amdgcn_s_sleep(2); if (++spins > (1u << 22)) break; }
                __builtin_amdgcn_fence(__ATOMIC_ACQUIRE, "agent");
                asm volatile("s_waitcnt vmcnt(0)" ::: "memory"); }
            __syncthreads();
            EpiMoeDown epi{y, list + (size_t)e * R + i * 256, nv};
            gemm_tile<false>(hid, w2 + (size_t)e * D * EDIM, EDIM, EDIM, off + i * 256, pn * 256, nullptr, 0, smem, epi);
        }
    }
    __syncthreads();
}

DEV void moe_phase_up(const Args& a, int l, char* smem) {
    unsigned* cnt = (unsigned*)(a.ws + WS_CTL) + CW_CNT + l * 16 * CNT_STRIDE;
    const int* list = (const int*)(a.ws + WS_LIST);
    const bf16_t* h = (const bf16_t*)(a.ws + WS_H); const bf16_t* w13 = moe_w13(a, l); bf16_t* hid = (bf16_t*)(a.ws + WS_QB);
    int u = blockIdx.x, base = 0, off = 0;
    for (int e = 0; e < NE; ++e) { const int n = (int)__builtin_amdgcn_readfirstlane(__hip_atomic_load(cnt + e * CNT_STRIDE, __ATOMIC_RELAXED, __HIP_MEMORY_SCOPE_AGENT)), nt_ = (n + 255) >> 8, nu = nt_ * 4;
        for (; u < base + nu; u += gridDim.x) { const int t = u - base, i = t % nt_, pn = t / nt_; const int nv = min(256, n - i * 256);
            EpiMoeUp epi{hid, off + i * 256, nv};
            gemm_tile<true>(h, w13 + (size_t)e * 1024 * D, D, D, 0, pn * 256, list + (size_t)e * R + i * 256, nv, smem, epi); }
        base += nu; off += n; }
}
DEV void moe_phase_down(const Args& a, int l, char* smem) {
    unsigned* cnt = (unsigned*)(a.ws + WS_CTL) + CW_CNT + l * 16 * CNT_STRIDE;
    const int* list = (const int*)(a.ws + WS_LIST);
    const bf16_t* hid = (const bf16_t*)(a.ws + WS_QB); const bf16_t* w2 = moe_w2(a, l); bf16_t* y = (bf16_t*)(a.ws + WS_P);
    int u = blockIdx.x, base = 0, off = 0;
    for (int e = 0; e < NE; ++e) { const int n = (int)__builtin_amdgcn_readfirstlane(__hip_atomic_load(cnt + e * CNT_STRIDE, __ATOMIC_RELAXED, __HIP_MEMORY_SCOPE_AGENT)), nt_ = (n + 255) >> 8, nu = nt_ * 8;
        for (; u < base + nu; u += gridDim.x) { const int t = u - base, i = t % nt_, pn = t / nt_; const int nv = min(256, n - i * 256);
            EpiMoeDown epi{y, list + (size_t)e * R + i * 256, nv};
            gemm_tile<false>(hid, w2 + (size_t)e * D * EDIM, EDIM, EDIM, off + i * 256, pn * 256, nullptr, 0, smem, epi); }
        base += nu; off += n; }
}
template <bool FINAL>
DEV void combine_phase(const Args& a, int l, bool latent_only, bool dry = false) {
    const int tid = tid_opaque(), w = tid >> 6, lane = tid & 63;
    bf16_t* xres = (bf16_t*)(a.ws + WS_XRES); const bf16_t* y = (const bf16_t*)(a.ws + WS_P); const float* tokf = (const float*)(a.ws + WS_TOK);
    const float* modv = (const float*)(a.ws + WS_MODV) + (size_t)l * 5 * MODN; bf16_t* h = (bf16_t*)(a.ws + WS_H);
    const float* gain = FINAL ? a.in[8] : a.in[6] + (size_t)(l + 1) * D;
    const int stride = gridDim.x * 8;
#define CB_SKIP(rr) while ((rr) < R && latent_only && ((rr) % S) < TC) (rr) += stride
#define CB_LOAD(rr, Y0, Y1, XQ, W0, W1) do { const bf16_t* y0_ = y + (size_t)(2 * (rr)) * D; const bf16_t* xp_ = xres + (size_t)(rr) * D; W0 = tokf[(rr) * 4 + 2]; W1 = tokf[(rr) * 4 + 3]; \
        _Pragma("unroll") for (int j = 0; j < 8; ++j) { const int c = j * 256 + lane * 4; Y0[j] = *(const u32x2*)(y0_ + c); Y1[j] = *(const u32x2*)(y0_ + D + c); XQ[j] = *(const u32x2*)(xp_ + c); } } while (0)
    int r = blockIdx.x * 8 + w; CB_SKIP(r);
    u32x2 ny0[8], ny1[8], nxq[8]; float nw0 = 0.f, nw1 = 0.f;
    if (r < R) CB_LOAD(r, ny0, ny1, nxq, nw0, nw1);
    while (r < R) {
        const float w0 = nw0, w1 = nw1;
        const int b = r / S, t = r - b * S; const int v = t < TC ? 4 : b;
        const float* g2 = modv + (size_t)v * MODN + 5 * D; bf16_t* xp = xres + (size_t)r * D;
        f32x4 g2v[8];
#pragma unroll
        for (int j = 0; j < 8; ++j) g2v[j] = *(const f32x4*)(g2 + j * 256 + lane * 4);
        __builtin_amdgcn_sched_barrier(0);
        f32x4 x[8]; float ss = 0.f;
#pragma unroll
        for (int j = 0; j < 8; ++j) { const int c = j * 256 + lane * 4;
            const u32x2 a0 = ny0[j], a1 = ny1[j], xq = nxq[j];
            const f32x4 yy = {w0 * bflo(a0.x) + w1 * bflo(a1.x), w0 * bfhi(a0.x) + w1 * bfhi(a1.x), w0 * bflo(a0.y) + w1 * bflo(a1.y), w0 * bfhi(a0.y) + w1 * bfhi(a1.y)};
            x[j] = (f32x4){bflo(xq.x), bfhi(xq.x), bflo(xq.y), bfhi(xq.y)} + g2v[j] * yy;
            if (!FINAL && !dry) { u32x2 xw; xw.x = cvtpk(x[j][0], x[j][1]); xw.y = cvtpk(x[j][2], x[j][3]); *(u32x2*)(xp + c) = xw; }
            ss += x[j][0] * x[j][0] + x[j][1] * x[j][1] + x[j][2] * x[j][2] + x[j][3] * x[j][3]; }
        __builtin_amdgcn_sched_barrier(0);
        const float* sh = modv + 5 * MODN + (size_t)v * MODN; const float* sc = sh + D;
        f32x4 gv[8], scv[FINAL ? 1 : 8], shv[FINAL ? 1 : 8];
#pragma unroll
        for (int j = 0; j < 8; ++j) { const int c = j * 256 + lane * 4; gv[j] = *(const f32x4*)(gain + c); if (!FINAL) { scv[j] = *(const f32x4*)(sc + c); shv[j] = *(const f32x4*)(sh + c); } }
        __builtin_amdgcn_sched_barrier(0);
        int rn = r + stride; CB_SKIP(rn);
        { const int rp_ = rn < R ? rn : r; CB_LOAD(rp_, ny0, ny1, nxq, nw0, nw1); }
        __builtin_amdgcn_sched_barrier(0);
        ss = wave_sum(ss); const float rs = rsqrtf(ss * (1.f / D) + EPS);
        if (FINAL) { float* op = a.out + ((size_t)b * TL + (t - TC)) * D;
#pragma unroll
            for (int j = 0; j < 8; ++j) { const int c = j * 256 + lane * 4; *(f32x4*)(op + c) = x[j] * rs * gv[j]; } }
        else {
#pragma unroll
            for (int j = 0; j < 8; ++j) { const int c = j * 256 + lane * 4;
                const f32x4 yv = (x[j] * rs * gv[j]) * (1.f + scv[FINAL ? 0 : j]) + shv[FINAL ? 0 : j];
                u32x2 pk; pk.x = cvtpk(yv[0], yv[1]); pk.y = cvtpk(yv[2], yv[3]); if (!dry) *(u32x2*)(h + (size_t)r * D + c) = pk; } }
        __builtin_amdgcn_sched_barrier(0);
        r = rn;
    }
#undef CB_LOAD
#undef CB_SKIP
}

constexpr int LDS_BYTES = LDS_BYTES_C;
constexpr int NPHASES = 25;
__global__ void __launch_bounds__(NT, 2) fwd(Args a) {
    extern __shared__ __attribute__((aligned(16))) char smem[];
    unsigned char* ws = a.ws;
    const int lo = a.ph_lo, hi = a.ph_hi;
    volatile LAS unsigned* xbw = (volatile LAS unsigned*)(smem + LDS_BYTES - 16);
    if (threadIdx.x < 4) xbw[threadIdx.x] = 0u;
    __syncthreads();
    XcdBarrier bar; bar.bar = (unsigned*)(ws + WS_CTL); bar.x = 0; bar.st = xbw;
    if (hi - lo > 1) bar = xcd_barrier_post((unsigned*)(ws + WS_CTL), xbw);
#ifndef BARRIER_REP
#define BARRIER_REP 1
#endif
#ifndef TPROBE_MASK
#define TPROBE_MASK 0u
#endif
#ifndef TPROBE_ALPHA
#define TPROBE_ALPHA 4
#endif
    unsigned long long tp_prev = TPROBE_MASK ? __builtin_amdgcn_s_memrealtime() : 0ull, tp_acc = 0ull;
#define TPROBE(k) do { if (TPROBE_MASK) { const unsigned long long tn_ = __builtin_amdgcn_s_memrealtime(); if ((TPROBE_MASK >> (k)) & 1u) tp_acc += tn_ - tp_prev; tp_prev = tn_; } } while (0)
#ifndef WPROBE_MASK
#define WPROBE_MASK 0u
#endif
    unsigned long long wp_acc = 0ull;
#define SEAM(k) do { if (IN(k) && IN((k) + 1)) { const unsigned long long wa_ = WPROBE_MASK ? __builtin_amdgcn_s_memrealtime() : 0ull; for (int br_ = 0; br_ < BARRIER_REP; ++br_) xcd_barrier(bar); \
        if (WPROBE_MASK && ((WPROBE_MASK >> (k)) & 1u)) wp_acc += __builtin_amdgcn_s_memrealtime() - wa_; TPROBE(k); } } while (0)
#ifndef PHASE_MASK
#define PHASE_MASK 0xFFFFFFFFu
#endif
#define IN(k) (((PHASE_MASK >> (k)) & 1u) && lo <= (k) && (k) < hi)
#ifndef REPEAT_MASK
#define REPEAT_MASK 0u
#endif
#ifndef SUBREP
#define SUBREP 0
#endif
#define PHASE(k) if (IN(k)) for (int rep_ = 0; rep_ < ((((REPEAT_MASK) >> (k)) & 1u) ? 2 : 1); ++rep_, ((((REPEAT_MASK) >> (k)) & 1u) ? __syncthreads() : (void)0))
    const float* modv = (const float*)(ws + WS_MODV);
    bf16_t* H = (bf16_t*)(ws + WS_H); bf16_t* P = (bf16_t*)(ws + WS_P); bf16_t* A2 = (bf16_t*)(ws + WS_A2); bf16_t* XR = (bf16_t*)(ws + WS_XRES);
    PHASE(0) {
        cvt_weight(a.in[9], (bf16_t*)(ws + WS_WABIN), D, AB_IN, AB_INP, 1, 0, 0, 128, 0, nullptr, smem, 2);
        mod_phase<false>(a, 0, smem);
        misc_phase(a);
    }
    SEAM(0);
    PHASE(1) norm_phase<false, true>(a, 0, 0, a.in[6], false, smem);
    SEAM(1);
    PHASE(2) { int cur = 0; EpiInAB e{P, (float*)(ws + WS_SSQ), (bf16_t*)(ws + WS_KB), (const float2*)(ws + WS_TABB), smem};
#ifdef SEAM_PROBE
                 gemm_phase(H, (const bf16_t*)(ws + WS_WABIN), R, AB_INP, D, smem, e, cur, 0, 512); xcd_barrier(bar); cur = 0; gemm_phase(H, (const bf16_t*)(ws + WS_WABIN), R, AB_INP, D, smem, e, cur, 512, 864);
#else
                 gemm_phase(H, (const bf16_t*)(ws + WS_WABIN), R, AB_INP, D, smem, e, cur);
#endif
                 if (rep_ == 0) { cvt_cd_dynamic(a, smem); mod_phase<true>(a, 1, smem); } }
    SEAM(2);
    PHASE(3) { int cur = 0; EpiUQ e1{(bf16_t*)(ws + WS_QB), (const float*)(ws + WS_SSQ), (const float2*)(ws + WS_TABB)};
                 gemm_phase<false, AB_INP>(P + 5120, (const bf16_t*)(ws + WS_WUQ), R, 1536, 512, smem, e1, cur);
                 EpiUKV e2{(bf16_t*)(ws + WS_KB), (bf16_t*)(ws + WS_VB), (const float*)(ws + WS_SSQ)};
                 gemm_phase<false, AB_INP>(P + 5632, (const bf16_t*)(ws + WS_WUKV), R, 2048, 256, smem, e2, cur);
                 scan_prep_phase<0>(a, smem); if (SUBREP & 1) scan_prep_phase<0>(a, smem); }
    SEAM(3);
    PHASE(6) scan_seq_phase<0>(a, smem);
    PHASE(7) attn_phase<192, 8, true>(a, 1024, smem);
    SEAM(7);
    PHASE(8) { mixout_phase<0>(a, false); if (SUBREP & 2) mixout_phase<0>(a, false); }
    SEAM(8);
    PHASE(9) { int cur = 0; EpiResidGate<true> e{XR, modv + 2 * D, false, a.in[0], a.in[2]}; gemm_phase(A2, (const bf16_t*)(ws + WS_WABOUT), R, D, D, smem, e, cur); cvt_moe_dynamic(a, 0, smem); }
    SEAM(9);
    PHASE(10) norm_router_phase(a, 0, 3, a.in[7], false, smem);
    SEAM(10);
#ifndef MOE_SPLIT
    PHASE(11) { moe_phase_fused(a, 0, smem); cvt_moe_dynamic(a, 1, smem); }
    SEAM(11);
#else
    PHASE(11) { moe_phase_up(a, 0, smem); cvt_moe_dynamic(a, 1, smem); }
    SEAM(11);
    PHASE(12) { moe_phase_down(a, 0, smem); cvt_moe_dynamic(a, 1, smem); }
    SEAM(12);
#endif
    PHASE(13) { combine_phase<false>(a, 0, false, rep_ > 0); cvt_moe_dynamic(a, 1, smem); }
    SEAM(13);
    PHASE(15) { int cur = 0; EpiInCD e{P, (bf16_t*)(ws + WS_QB), (bf16_t*)(ws + WS_KB), (bf16_t*)(ws + WS_VB), (const float2*)(ws + WS_TABC), a.in[19], a.in[20], smem}; gemm_phase(H, (const bf16_t*)(ws + WS_WCDIN), R, CD_INP, D, smem, e, cur); }
    SEAM(15);
    PHASE(16) { scan_prep_phase<1>(a, smem); if (SUBREP & 1) scan_prep_phase<1>(a, smem); }
    SEAM(16);
    PHASE(17) scan_seq_phase<1>(a, smem);
    PHASE(18) attn_phase<128, 2, false>(a, 0, smem);
    SEAM(18);
    PHASE(19) { mixout_phase<1>(a, true); if (SUBREP & 2) mixout_phase<1>(a, true); }
    SEAM(19);
    PHASE(20) { int cur = 0; EpiResidGate<false> e{XR, modv + 5 * MODN + 2 * D, false, nullptr, nullptr}; gemm_phase<true>(A2, (const bf16_t*)(ws + WS_WCDOUT), NB * TL, D, D, smem, e, cur); }
    SEAM(20);
    PHASE(21) norm_router_phase(a, 1, 3, a.in[7] + D, true, smem);
    SEAM(21);
#ifndef MOE_SPLIT
    PHASE(22) moe_phase_fused(a, 1, smem);
    SEAM(22);
#else
    PHASE(22) moe_phase_up(a, 1, smem);
    SEAM(22);
    PHASE(23) moe_phase_down(a, 1, smem);
    SEAM(23);
#endif
    PHASE(24) combine_phase<true>(a, 1, true);
    if (TPROBE_MASK) { TPROBE(24);
        if (blockIdx.x == 0) { const unsigned long long t0_ = __builtin_amdgcn_s_memrealtime(); while (__builtin_amdgcn_s_memrealtime() - t0_ < (unsigned long long)TPROBE_ALPHA * tp_acc) __builtin_amdgcn_s_sleep(8); } }
    if (WPROBE_MASK) { unsigned* wsum = (unsigned*)(ws + WS_CTL) + 30000;
        if (threadIdx.x == 0) atomicAdd(wsum, (unsigned)wp_acc);
        xcd_barrier(bar);
        if (blockIdx.x == 0) { const unsigned long long tot_ = __hip_atomic_load(wsum, __ATOMIC_RELAXED, __HIP_MEMORY_SCOPE_AGENT) / gridDim.x;
            const unsigned long long t0_ = __builtin_amdgcn_s_memrealtime(); while (__builtin_amdgcn_s_memrealtime() - t0_ < (unsigned long long)TPROBE_ALPHA * tot_) __builtin_amdgcn_s_sleep(8); } }
#undef IN
#undef PHASE
#undef SEAM
}

extern "C" void kernel_launch(void* const* d_in, const int* in_sizes, int n_in, void* d_out, int out_size, void* d_ws, size_t ws_size, hipStream_t stream) {
    static int grid = 0;
    if (grid == 0) {
        if (n_in != 29 || out_size != NB * TL * D || ws_size < WS_END) { fprintf(stderr, "kernel_launch: shape/workspace mismatch: n_in %d out %d ws %zu (need %zu)\n", n_in, out_size, ws_size, (size_t)WS_END); grid = -1; return; }
        int dev = 0, cus = 0;
        if (hipGetDevice(&dev) != hipSuccess || hipDeviceGetAttribute(&cus, hipDeviceAttributeMultiprocessorCount, dev) != hipSuccess) { grid = -1; return; }
        if (hipFuncSetAttribute((const void*)fwd, hipFuncAttributeMaxDynamicSharedMemorySize, LDS_BYTES) != hipSuccess) { fprintf(stderr, "kernel_launch: hipFuncSetAttribute failed\n"); grid = -1; return; }
        grid = cus > 0 ? cus : 256;
    }
    if (grid < 0) return;
    (void)hipMemsetAsync((char*)d_ws + WS_CTL, 0, CTL_BYTES, stream);
    Args a{};
    for (int i = 0; i < 29; ++i) a.in[i] = (const float*)d_in[i];
    a.out = (float*)d_out; a.ws = (unsigned char*)d_ws;
#ifndef MK_PER_PHASE
    a.ph_lo = 0; a.ph_hi = NPHASES; hipLaunchKernelGGL(fwd, dim3(grid), dim3(NT), LDS_BYTES, stream, a);
#else
    for (int ph = 0; ph < NPHASES; ++ph) { a.ph_lo = ph; a.ph_hi = ph + 1; hipLaunchKernelGGL(fwd, dim3(grid), dim3(NT), LDS_BYTES, stream, a); }
#endif
}
```

```cpp
#include <hip/hip_runtime.h>
#include <cstdio>
#include <cstdint>

#define DEV __device__ __forceinline__
typedef unsigned short bf16_t;
typedef short bf16x8 __attribute__((ext_vector_type(8)));
typedef float f32x4 __attribute__((ext_vector_type(4)));
typedef float f32x2 __attribute__((ext_vector_type(2)));
typedef unsigned u32x4 __attribute__((ext_vector_type(4)));
typedef unsigned u32x2 __attribute__((ext_vector_type(2)));

constexpr int NB = 4, TL = 2048, TC = 256, S = TL + TC, R = NB * S, D = 2048;
constexpr int NT = 512;
constexpr float EPS = 1e-6f;
constexpr int AB_IN = 5952, AB_INP = 6144, CD_IN = 4640, CD_INP = 4864;
constexpr int NE = 16, EDIM = 512;
constexpr int MODN = 6 * D;

constexpr size_t al256(size_t x) { return (x + 255) & ~(size_t)255; }
constexpr size_t WS_CTL = 0;
constexpr int    CW_CNT = 26624;
constexpr int    CNT_STRIDE = 64;
constexpr int    CW_CVT = 4224;
constexpr size_t CTL_BYTES = 131072;
constexpr int    CW_MOEQ = 4608;
constexpr int    CW_RDY = 8192;
constexpr size_t WS_MODV = WS_CTL + CTL_BYTES;
constexpr size_t WS_LB   = al256(WS_MODV + (size_t)2 * 5 * MODN * 4);
constexpr size_t WS_TABB = al256(WS_LB + 2 * 1024 * 4);
constexpr size_t WS_TABC = al256(WS_TABB + (size_t)S * 32 * 8);
constexpr size_t WS_TOK  = al256(WS_TABC + (size_t)S * 64 * 8);
constexpr size_t WS_LIST = al256(WS_TOK + (size_t)R * 16);
constexpr size_t WS_WABIN = al256(WS_LIST + (size_t)NE * R * 4);
constexpr size_t WS_WABOUT = al256(WS_WABIN + (size_t)AB_INP * D * 2);
constexpr size_t WS_WUQ  = al256(WS_WABOUT + (size_t)D * D * 2);
constexpr size_t WS_WUKV = al256(WS_WUQ + (size_t)1536 * 512 * 2);
constexpr size_t WS_WCDIN = al256(WS_WUKV + (size_t)2048 * 256 * 2);
constexpr size_t WS_WCDOUT = al256(WS_WCDIN + (size_t)CD_INP * D * 2);
constexpr size_t WS_W13  = al256(WS_WCDOUT + (size_t)D * D * 2);
constexpr size_t WS_W2   = al256(WS_W13 + (size_t)NE * 1024 * D * 2);
constexpr size_t WS_XRES = al256(WS_W2 + (size_t)NE * D * EDIM * 2);
constexpr size_t WS_H    = al256(WS_XRES + (size_t)R * D * 2);
constexpr size_t WS_P    = al256(WS_H + (size_t)R * D * 2);
constexpr size_t WS_ODIR = al256(WS_P + (size_t)R * AB_INP * 2);
constexpr size_t WS_QF   = WS_ODIR;
constexpr size_t WS_KVF  = al256(WS_QF + (size_t)R * 1536 * 2);
static_assert(WS_KVF + (size_t)R * 2048 * 2 <= WS_ODIR + (size_t)2 * R * 1024 * 4, "QF/KVF alias ODIR");
constexpr size_t WS_A2   = al256(WS_ODIR + (size_t)2 * R * 1024 * 4);
constexpr size_t WS_QB   = al256(WS_A2 + (size_t)R * D * 2);
constexpr size_t WS_KB   = al256(WS_QB + (size_t)NB * 8 * S * 192 * 2);
constexpr size_t WS_VB   = al256(WS_KB + (size_t)NB * 8 * S * 192 * 2);
constexpr size_t WS_SSQ  = al256(WS_VB + (size_t)NB * 8 * S * 128 * 2);
constexpr size_t WS_P5N_UNUSED = al256(WS_VB + (size_t)NB * 8 * S * 128 * 2);
constexpr size_t WS_P6N  = al256(WS_SSQ + (size_t)R * 16);
constexpr size_t WS_SVT  = WS_P6N;
constexpr size_t WS_SREC = al256(WS_SVT + (size_t)NB * 8 * 2 * 36 * 128 * 144);
constexpr int LDS_BYTES_C = 160 * 1024;
constexpr int PA = 144, PQ = 272;
constexpr int REC_A = 0, REC_QH = 64 * PA, REC_KHT = REC_QH + 64 * PQ, REC_AL = REC_KHT + 128 * PA, REC_BYTES = REC_AL + 512;
constexpr size_t WS_END  = al256(WS_SREC + (size_t)NB * 8 * 2 * 36 * REC_BYTES);
constexpr size_t WS_SVT1 = WS_W13;
constexpr size_t WS_SREC1 = al256(WS_SVT1 + (size_t)NB * 4 * 2 * 36 * 256 * 144);
static_assert(WS_SREC1 + (size_t)NB * 4 * 2 * 36 * REC_BYTES <= WS_XRES, "layer-1 scan images alias");
static_assert(WS_SVT + (size_t)NE * 1024 * D * 2 + (size_t)NE * D * EDIM * 2 <= WS_END, "layer-1 MoE weights alias");
static_assert((size_t)(2 * R + 256) * 512 * 2 <= WS_KB - WS_QB, "HIDDEN alias");
static_assert((size_t)R * 2 * D * 2 <= WS_ODIR - WS_P, "YSLOTS alias");

struct Args { const float* in[29]; float* out; unsigned char* ws; int ph_lo, ph_hi; };

typedef __bf16 bf16v2_t __attribute__((ext_vector_type(2)));
DEV unsigned cvtpk(float lo, float hi) { bf16v2_t v; v.x = (__bf16)lo; v.y = (__bf16)hi; return __builtin_bit_cast(unsigned, v); }
DEV bf16_t f2bf(float x) { return (bf16_t)(cvtpk(x, 0.f) & 0xffffu); }
DEV float bf2f(bf16_t x) { return __uint_as_float(((unsigned)x) << 16); }
DEV float bflo(unsigned w) { return __uint_as_float(w << 16); }
DEV float bfhi(unsigned w) { return __uint_as_float(w & 0xffff0000u); }
DEV float sigmoidf_(float x) { return 1.f / (1.f + __expf(-x)); }
DEV float siluf_(float x) { return x / (1.f + __expf(-x)); }
DEV float wave_sum(float v) {
#pragma unroll
    for (int o = 32; o >= 1; o >>= 1) v += __shfl_xor(v, o);
    return v;
}
DEV float wave_max(float v) {
#pragma unroll
    for (int o = 32; o >= 1; o >>= 1) v = fmaxf(v, __shfl_xor(v, o));
    return v;
}
DEV int tid_opaque() { int t = threadIdx.x; asm volatile("" : "+v"(t)); return t; }
DEV int modvec_of_row(int r) { const int b = r / S, t = r - b * S; return t < TC ? 4 : b; }

#define XB_TMO      128
#define XB_XCNT(j)  (256  + 64 * (j))
#define XB_XSUB(j)  (1280 + 64 * (j))
#define XB_XGEN(j)  (2304 + 64 * (j))
#define XB_TOP      3328
#define XB_TOPGEN   3392
#define XCD_BAR_WORDS 3456
#define XB_SPIN_CAP (1u << 18)
#define LAS __attribute__((address_space(3)))

__device__ __forceinline__ unsigned xb_ld(unsigned* p)              { return __hip_atomic_load(p, __ATOMIC_RELAXED, __HIP_MEMORY_SCOPE_AGENT); }
__device__ __forceinline__ unsigned xb_add(unsigned* p, unsigned v) { return __hip_atomic_fetch_add(p, v, __ATOMIC_RELAXED, __HIP_MEMORY_SCOPE_AGENT); }
__device__ __forceinline__ unsigned xb_xcc_id() { return (unsigned)__builtin_amdgcn_s_getreg((3 << 11) | 20) & 0xFu; }
#define XB_SPIN(cond, bar) do { unsigned _sp = 0; while (cond) { __builtin_amdgcn_s_sleep(1); \
    if ((++_sp & 255u) == 0u) { if (xb_ld(&(bar)[XB_TMO])) break; if (_sp > XB_SPIN_CAP) { atomicAdd(&(bar)[XB_TMO], 1u); break; } } } } while (0)

struct XcdBarrier {
    unsigned* bar; unsigned x;
    volatile LAS unsigned* st;
};

__device__ __forceinline__ XcdBarrier xcd_barrier_post(unsigned* bar, volatile LAS unsigned* st) {
    XcdBarrier b; b.bar = bar; b.x = xb_xcc_id(); b.st = st;
    if (threadIdx.x == 0) (void)xb_add(&bar[XB_XCNT(b.x)], 1u);
    return b;
}
__device__ __forceinline__ void xcd_barrier_complete(unsigned* bar, unsigned x, unsigned& nloc, unsigned& nx) {
    const unsigned G = gridDim.x * gridDim.y * gridDim.z;
    unsigned sum, cnt, mine, sp = 0u;
    for (;;) {
        sum = 0u; cnt = 0u; mine = 0u;
#pragma unroll
        for (unsigned j = 0; j < 16; ++j) { const unsigned c = xb_ld(&bar[XB_XCNT(j)]); sum += c; cnt += (c > 0u) ? 1u : 0u; mine = (j == x) ? c : mine; }
        if (sum == G) break;
        __builtin_amdgcn_s_sleep(1);
        if ((++sp & 255u) == 0u) { if (xb_ld(&bar[XB_TMO])) break; if (sp > XB_SPIN_CAP) { atomicAdd(&bar[XB_TMO], 1u); break; } }
    }
    nloc = mine > 0u ? mine : 1u; nx = cnt > 0u ? cnt : 1u;
}

__device__ __forceinline__ void xcd_barrier(const XcdBarrier& b) {
    asm volatile("s_waitcnt vmcnt(0)" ::: "memory");
    __syncthreads();
    if (threadIdx.x == 0) {
        unsigned* bar = b.bar;
        __builtin_amdgcn_s_waitcnt(0);
        unsigned nloc = b.st[0], nx = b.st[1];
        if (nloc == 0u) { xcd_barrier_complete(bar, b.x, nloc, nx); b.st[0] = nloc; b.st[1] = nx; }
        const unsigned old = xb_add(&bar[XB_XSUB(b.x)], 1u);
        const unsigned gen = old / nloc;
        if (old + 1u == (gen + 1u) * nloc) {
            __builtin_amdgcn_fence(__ATOMIC_RELEASE, "agent");
            asm volatile("s_waitcnt vmcnt(0)" ::: "memory");
            const unsigned og = xb_add(&bar[XB_TOP], 1u);
            const unsigned tg = og / nx;
            if (og + 1u == (tg + 1u) * nx) xb_add(&bar[XB_TOPGEN], 1u);
            else XB_SPIN(xb_ld(&bar[XB_TOPGEN]) == tg, bar);
            __builtin_amdgcn_fence(__ATOMIC_ACQUIRE, "agent");
            xb_add(&bar[XB_XGEN(b.x)], 1u);
            asm volatile("s_waitcnt vmcnt(0)" ::: "memory");
        } else {
            XB_SPIN(xb_ld(&bar[XB_XGEN(b.x)]) == gen, bar);
            __builtin_amdgcn_fence(__ATOMIC_ACQUIRE, "agent");
            asm volatile("s_waitcnt vmcnt(0)" ::: "memory");
        }
    }
    __syncthreads();
}


constexpr int BM = 256, BK = 64, HALF = 128, HT = HALF * BK, SHM_GEMM = 8 * HT * 2;
DEV int lds_byte(int r, int c) { int st = (r >> 4) * 2 + (c >> 5), rr = r & 15, cc = c & 31, ob = rr * 64 + cc * 2; return st * 1024 + (ob ^ (((ob >> 9) & 1) << 5)); }
DEV void stage_rc(int b, int& Rr, int& Cc) { int st = b / 1024, sb = b % 1024, swz = sb ^ (((sb >> 9) & 1) << 5); Rr = (st >> 1) * 16 + swz / 64; Cc = (st & 1) * 32 + (swz % 64) / 2; }

template <bool GATHER, int LDA_ = 0, class Epi>
DEV void gemm_tile(const bf16_t* __restrict__ A, const bf16_t* __restrict__ Bt, int ld, int K, int brow, int bcol,
                   const int* __restrict__ rowmap, int nvalid, char* smem, const Epi& epi) {
    bf16_t* shm = (bf16_t*)smem;
#define SA(b, h) (shm + ((b) * 2 + (h)) * HT)
#define SB(b, h) (shm + (4 + (b) * 2 + (h)) * HT)
#define GLDS(gp, lp) __builtin_amdgcn_global_load_lds((const unsigned*)(gp), (unsigned*)(lp), 16, 0, 0)
#define STAGE_A(P, h, kt) do { _Pragma("unroll") for (int _i = 0; _i < 2; ++_i) { \
        const char* _sb = GATHER ? (const char*)A + (size_t)(kt) * (BK * 2) : (const char*)A + ((size_t)(brow + (h) * HALF + _i * 64) * (LDA_ ? LDA_ : ld) + (size_t)(kt) * BK) * 2; \
        GLDS(_sb + (GATHER ? voffa[h][_i] : voffA), (char*)(P) + tid16 + _i * 8192); } } while (0)
#define STAGE_B(P, h, kt) do { _Pragma("unroll") for (int _i = 0; _i < 2; ++_i) { \
        const char* _sb = (const char*)Bt + ((size_t)(bcol + (h) * HALF + _i * 64) * ld + (size_t)(kt) * BK) * 2; \
        GLDS(_sb + voff, (char*)(P) + tid16 + _i * 8192); } } while (0)
#define LDA(dst, b, h) _Pragma("unroll") for (int m = 0; m < 4; ++m) _Pragma("unroll") for (int k = 0; k < 2; ++k) \
        dst[m][k] = *reinterpret_cast<const bf16x8*>((char*)SA(b, h) + lds_byte(wr * 64 + m * 16 + fr, k * 32 + fq * 8))
#define LDB(dst, b, h) _Pragma("unroll") for (int n = 0; n < 2; ++n) _Pragma("unroll") for (int k = 0; k < 2; ++k) \
        dst[n][k] = *reinterpret_cast<const bf16x8*>((char*)SB(b, h) + lds_byte(wc * 32 + n * 16 + fr, k * 32 + fq * 8))
#define MMA(ai, bj, At_, Bt_) do { __builtin_amdgcn_s_setprio(1); \
        _Pragma("unroll") for (int m = 0; m < 4; ++m) _Pragma("unroll") for (int n = 0; n < 2; ++n) _Pragma("unroll") for (int k = 0; k < 2; ++k) \
            acc[ai][bj][m][n] = __builtin_amdgcn_mfma_f32_16x16x32_bf16(Bt_[n][k], At_[m][k], acc[ai][bj][m][n], 0, 0, 0); \
        __builtin_amdgcn_s_setprio(0); } while (0)
#define WAIT_V(n) asm volatile("s_waitcnt vmcnt(" #n ")" ::: "memory")
#define WAIT_L(n) asm volatile("s_waitcnt lgkmcnt(" #n ")" ::: "memory")
#define BAR __builtin_amdgcn_s_barrier()
#define SCHED __builtin_amdgcn_sched_barrier(0)
    int tid = threadIdx.x; asm volatile("" : "+v"(tid));
    int wid = tid >> 6, lane = tid & 63, wr = wid >> 2, wc = wid & 3, fr = lane & 15, fq = lane >> 4;
    const int tid16 = tid * 16;
    unsigned voff, voffA; unsigned voffa[2][2];
    {
        int r0, c0; stage_rc(tid16, r0, c0);
        voff = (unsigned)(r0 * ld + c0) * 2u; voffA = LDA_ ? (unsigned)(r0 * LDA_ + c0) * 2u : voff;
#pragma unroll
        for (int h = 0; h < 2; ++h)
#pragma unroll
            for (int i = 0; i < 2; ++i) {
                if (GATHER) { int l0 = h * HALF + i * 64 + r0; l0 = l0 < nvalid ? l0 : nvalid - 1; voffa[h][i] = (unsigned)((rowmap[l0] >> 1) * ld + c0) * 2u; }
                else voffa[h][i] = 0u;
            }
    }
    f32x4 acc[2][2][4][2] = {};
    bf16x8 At[4][2], B0[2][2], B1[2][2];
    const int nt = K / BK;
    STAGE_B(SB(0, 0), 0, 0); STAGE_A(SA(0, 0), 0, 0);
    STAGE_B(SB(0, 1), 1, 0); STAGE_A(SA(0, 1), 1, 0);
    if (wr == 1) BAR;
    WAIT_V(4); BAR;
    STAGE_B(SB(1, 0), 0, 1); STAGE_A(SA(1, 0), 0, 1); STAGE_B(SB(1, 1), 1, 1);
    WAIT_V(6); BAR;
    for (int t = 0; t < nt - 2; t += 2) {
        LDB(B0, 0, 0); SCHED; LDA(At, 0, 0); STAGE_A(SA(1, 1), 1, t + 1);
        WAIT_L(8); BAR; WAIT_L(0); MMA(0, 0, At, B0); BAR; SCHED;
        LDB(B1, 0, 1); STAGE_B(SB(0, 0), 0, t + 2);
        BAR; WAIT_L(0); MMA(0, 1, At, B1); BAR;
        LDA(At, 0, 1); STAGE_A(SA(0, 0), 0, t + 2);
        BAR; WAIT_L(0); MMA(1, 0, At, B0); BAR; SCHED;
        STAGE_B(SB(0, 1), 1, t + 2);
        WAIT_V(6); BAR; MMA(1, 1, At, B1); BAR;
        LDB(B0, 1, 0); SCHED; LDA(At, 1, 0); STAGE_A(SA(0, 1), 1, t + 2);
        WAIT_L(8); BAR; WAIT_L(0); MMA(0, 0, At, B0); BAR; SCHED;
        LDB(B1, 1, 1); STAGE_B(SB(1, 0), 0, t + 3);
        BAR; WAIT_L(0); MMA(0, 1, At, B1); BAR;
        LDA(At, 1, 1); STAGE_A(SA(1, 0), 0, t + 3);
        BAR; WAIT_L(0); MMA(1, 0, At, B0); BAR; SCHED;
        STAGE_B(SB(1, 1), 1, t + 3);
        WAIT_V(6); BAR; MMA(1, 1, At, B1); BAR;
    }
    { LDB(B0, 0, 0); WAIT_V(0); LDA(At, 0, 0); STAGE_A(SA(1, 1), 1, nt - 1);
      BAR; WAIT_L(0); MMA(0, 0, At, B0); BAR;
      LDB(B1, 0, 1); BAR; WAIT_L(0); MMA(0, 1, At, B1); BAR;
      LDA(At, 0, 1); WAIT_V(4); BAR; WAIT_L(0); MMA(1, 0, At, B0); MMA(1, 1, At, B1); BAR; }
    { LDB(B0, 1, 0); LDA(At, 1, 0); WAIT_V(2); BAR; WAIT_L(0); MMA(0, 0, At, B0); BAR;
      LDB(B1, 1, 1); WAIT_V(0); BAR; WAIT_L(0); MMA(0, 1, At, B1); BAR;
      LDA(At, 1, 1); BAR; WAIT_L(0); MMA(1, 0, At, B0); MMA(1, 1, At, B1); BAR; }
    if (wr == 0) BAR;
    int tz = threadIdx.x; asm volatile("" : "+v"(tz)); wid = tz >> 6; lane = tz & 63; wr = wid >> 2; wc = wid & 3; fr = lane & 15; fq = lane >> 4;
    epi(acc, brow, bcol, wr, wc, fr, fq);
#undef SA
#undef SB
#undef STAGE_A
#undef STAGE_B
#undef GLDS
#undef LDA
#undef LDB
#undef MMA
}

struct EpiStoreF32 { float* C; int ldc;
    DEV void operator()(const f32x4 (&acc)[2][2][4][2], int brow, int bcol, int wr, int wc, int fr, int fq) const {
#pragma unroll
        for (int ai = 0; ai < 2; ++ai)
#pragma unroll
            for (int m = 0; m < 4; ++m) { float* rowp = C + (size_t)(brow + ai * HALF + wr * 64 + m * 16 + fr) * ldc + bcol + wc * 32 + fq * 4;
#pragma unroll
                for (int bj = 0; bj < 2; ++bj)
#pragma unroll
                    for (int n = 0; n < 2; ++n) *(f32x4*)(rowp + bj * HALF + n * 16) = acc[ai][bj][m][n]; }
    } };
struct EpiStoreBf16 { bf16_t* C; int ldc;
    DEV void operator()(const f32x4 (&acc)[2][2][4][2], int brow, int bcol, int wr, int wc, int fr, int fq) const {
#pragma unroll
        for (int ai = 0; ai < 2; ++ai)
#pragma unroll
            for (int m = 0; m < 4; ++m) { bf16_t* rowp = C + (size_t)(brow + ai * HALF + wr * 64 + m * 16 + fr) * ldc + bcol + wc * 32 + fq * 4;
#pragma unroll
                for (int bj = 0; bj < 2; ++bj)
#pragma unroll
                    for (int n = 0; n < 2; ++n) { const f32x4 v = acc[ai][bj][m][n]; u32x2 w; w.x = cvtpk(v[0], v[1]); w.y = cvtpk(v[2], v[3]); *(u32x2*)(rowp + bj * HALF + n * 16) = w; } }
    } };
template <bool FROM_IN>
struct EpiResidGate { bf16_t* X; const float* gate; bool dry; const float* xin; const float* cin;
    DEV void operator()(const f32x4 (&acc)[2][2][4][2], int brow, int bcol, int wr, int wc, int fr, int fq) const {
        const float* g = gate + (size_t)modvec_of_row(brow) * MODN + bcol + wc * 32 + fq * 4;
        f32x4 gv[2][2];
#pragma unroll
        for (int bj = 0; bj < 2; ++bj)
#pragma unroll
            for (int n = 0; n < 2; ++n) gv[bj][n] = *(const f32x4*)(g + bj * HALF + n * 16);
#pragma unroll
        for (int ai = 0; ai < 2; ++ai)
#pragma unroll
            for (int m = 0; m < 4; ++m) { const int lrow = ai * HALF + wr * 64 + m * 16 + fr; bf16_t* rowp = X + (size_t)(brow + lrow) * D + bcol + wc * 32 + fq * 4;
                f32x4 x[2][2];
                if (FROM_IN) { const int b = brow / S, t0 = brow - b * S;
                    const float* srcp = (t0 < TC ? cin + ((size_t)b * TC + t0 + lrow) * D : xin + ((size_t)b * TL + (t0 - TC) + lrow) * D) + bcol + wc * 32 + fq * 4;
#pragma unroll
                    for (int bj = 0; bj < 2; ++bj)
#pragma unroll
                        for (int n = 0; n < 2; ++n) x[bj][n] = __builtin_nontemporal_load((const f32x4*)(srcp + bj * HALF + n * 16)); }
                else {
#pragma unroll
                    for (int bj = 0; bj < 2; ++bj)
#pragma unroll
                        for (int n = 0; n < 2; ++n) { const u32x2 p = *(const u32x2*)(rowp + bj * HALF + n * 16); x[bj][n] = (f32x4){bflo(p.x), bfhi(p.x), bflo(p.y), bfhi(p.y)}; } }
#pragma unroll
                for (int bj = 0; bj < 2; ++bj)
#pragma unroll
                    for (int n = 0; n < 2; ++n) { f32x4 xv = x[bj][n];
                        if (!dry) xv += gv[bj][n] * acc[ai][bj][m][n];
                        u32x2 w; w.x = cvtpk(xv[0], xv[1]); w.y = cvtpk(xv[2], xv[3]); *(u32x2*)(rowp + bj * HALF + n * 16) = w; }
                if (m == 3) asm volatile("" ::: "memory"); }
    } };
struct EpiMoeUp { bf16_t* hid; int rowbase, nvalid;
    DEV void operator()(const f32x4 (&acc)[2][2][4][2], int brow, int bcol, int wr, int wc, int fr, int fq) const {
        const int hc = (bcol >> 1) + wc * 32 + fq * 4;
#pragma unroll
        for (int ai = 0; ai < 2; ++ai)
#pragma unroll
            for (int m = 0; m < 4; ++m) { const int lr = ai * HALF + wr * 64 + m * 16 + fr;
                if (lr < nvalid) { bf16_t* rowp = hid + (size_t)(rowbase + lr) * EDIM + hc;
#pragma unroll
                    for (int n = 0; n < 2; ++n) { const f32x4 a = acc[ai][0][m][n], b = acc[ai][1][m][n];
                        u32x2 w; w.x = cvtpk(siluf_(a[0]) * b[0], siluf_(a[1]) * b[1]); w.y = cvtpk(siluf_(a[2]) * b[2], siluf_(a[3]) * b[3]);
                        *(u32x2*)(rowp + n * 16) = w; } } }
    } };
struct EpiMoeDown { bf16_t* y; const int* list; int nvalid;
    DEV void operator()(const f32x4 (&acc)[2][2][4][2], int brow, int bcol, int wr, int wc, int fr, int fq) const {
        int li[2][4];
#pragma unroll
        for (int ai = 0; ai < 2; ++ai)
#pragma unroll
            for (int m = 0; m < 4; ++m) { const int lr = ai * HALF + wr * 64 + m * 16 + fr; li[ai][m] = list[lr < nvalid ? lr : nvalid - 1]; }
#pragma unroll
        for (int ai = 0; ai < 2; ++ai)
#pragma unroll
            for (int m = 0; m < 4; ++m) { const int lr = ai * HALF + wr * 64 + m * 16 + fr;
                if (lr < nvalid) { bf16_t* rowp = y + (size_t)li[ai][m] * D + bcol + wc * 32 + fq * 4;
#pragma unroll
                    for (int bj = 0; bj < 2; ++bj)
#pragma unroll
                        for (int n = 0; n < 2; ++n) { const f32x4 v = acc[ai][bj][m][n]; u32x2 w; w.x = cvtpk(v[0], v[1]); w.y = cvtpk(v[2], v[3]); *(u32x2*)(rowp + bj * HALF + n * 16) = w; } } }
    } };

DEV void row_bt(int r, int& b, int& t) { b = r / S; t = r - b * S; }
#define LDS_BARRIER() do { asm volatile("s_waitcnt lgkmcnt(0)" ::: "memory"); __builtin_amdgcn_s_barrier(); asm volatile("" ::: "memory"); } while (0)
struct EpiInAB { bf16_t* P; float* ssq; bf16_t* Kb; const float2* tb; char* smem;
    DEV void operator()(const f32x4 (&acc)[2][2][4][2], int brow, int bcol, int wr, int wc, int fr, int fq) const {
        const int pn = bcol >> 8;
        if (pn < 23) {
#pragma unroll
            for (int ai = 0; ai < 2; ++ai)
#pragma unroll
                for (int m = 0; m < 4; ++m) { bf16_t* rowp = P + (size_t)(brow + ai * HALF + wr * 64 + m * 16 + fr) * AB_INP + bcol + wc * 32 + fq * 4;
#pragma unroll
                    for (int bj = 0; bj < 2; ++bj)
#pragma unroll
                        for (int n = 0; n < 2; ++n) { const f32x4 v = acc[ai][bj][m][n]; u32x2 w; w.x = cvtpk(v[0], v[1]); w.y = cvtpk(v[2], v[3]); *(u32x2*)(rowp + bj * HALF + n * 16) = w; } }
            if (pn >= 20) {
                float* red = (float*)smem;
#pragma unroll
                for (int ai = 0; ai < 2; ++ai)
#pragma unroll
                    for (int m = 0; m < 4; ++m) { float sq = 0.f;
#pragma unroll
                        for (int bj = 0; bj < 2; ++bj)
#pragma unroll
                            for (int n = 0; n < 2; ++n) { const f32x4 v = acc[ai][bj][m][n]; sq += v[0] * v[0] + v[1] * v[1] + v[2] * v[2] + v[3] * v[3]; }
                        sq += __shfl_xor(sq, 16); sq += __shfl_xor(sq, 32);
                        if (fq == 0) red[(ai * HALF + wr * 64 + m * 16 + fr) * 4 + wc] = sq; }
                LDS_BARRIER();
                const int t_ = tid_opaque();
                if (t_ < 256) { const f32x4 q = *(const f32x4*)(red + t_ * 4); ssq[(size_t)(pn - 20) * R + brow + t_] = (q[0] + q[1]) + (q[2] + q[3]); }
                LDS_BARRIER();
            }
        } else if (wc < 2) {
            f32x4 cc[2][4][2];
#pragma unroll
            for (int ai = 0; ai < 2; ++ai)
#pragma unroll
                for (int m = 0; m < 4; ++m) { int b, t; row_bt(brow + ai * HALF + wr * 64 + m * 16 + fr, b, t);
#pragma unroll
                    for (int n = 0; n < 2; ++n) cc[ai][m][n] = *(const f32x4*)(tb + t * 32 + 16 * wc + 8 * n + 2 * fq); }
#pragma unroll
            for (int ai = 0; ai < 2; ++ai)
#pragma unroll
                for (int m = 0; m < 4; ++m) { int b, t; row_bt(brow + ai * HALF + wr * 64 + m * 16 + fr, b, t);
#pragma unroll
                    for (int n = 0; n < 2; ++n) { const f32x4 v = acc[ai][0][m][n]; const int p0 = 16 * wc + 8 * n + 2 * fq;
                        const float2 c0 = make_float2(cc[ai][m][n][0], cc[ai][m][n][1]), c1 = make_float2(cc[ai][m][n][2], cc[ai][m][n][3]);
                        const unsigned lo = cvtpk(v[0] * c0.x - v[1] * c0.y, v[2] * c1.x - v[3] * c1.y), hi = cvtpk(v[1] * c0.x + v[0] * c0.y, v[3] * c1.x + v[2] * c1.y);
#pragma unroll
                        for (int hh = 0; hh < 8; ++hh) { bf16_t* kp = Kb + (((size_t)b * 8 + hh) * S + t) * 192 + 128 + p0; *(unsigned*)kp = lo; *(unsigned*)(kp + 32) = hi; } } }
        }
    } };
struct EpiInCD { bf16_t* P; bf16_t* Qb; bf16_t* Kb; bf16_t* Vb; const float2* tc; const float* gq; const float* gk; char* smem;
    DEV void operator()(const f32x4 (&acc)[2][2][4][2], int brow, int bcol, int wr, int wc, int fr, int fq) const {
        const int pn = bcol >> 8;
        if (pn <= 4) {
            float* red = (float*)smem;
            f32x4 cc[2][4][2];
#pragma unroll
            for (int ai = 0; ai < 2; ++ai)
#pragma unroll
                for (int m = 0; m < 4; ++m) { int b, t; row_bt(brow + ai * HALF + wr * 64 + m * 16 + fr, b, t);
#pragma unroll
                    for (int n = 0; n < 2; ++n) cc[ai][m][n] = *(const f32x4*)(tc + t * 64 + 16 * wc + 8 * n + 2 * fq); }
#pragma unroll
            for (int ai = 0; ai < 2; ++ai)
#pragma unroll
                for (int m = 0; m < 4; ++m)
#pragma unroll
                    for (int bj = 0; bj < 2; ++bj) { float sq = 0.f;
#pragma unroll
                        for (int n = 0; n < 2; ++n) { const f32x4 v = acc[ai][bj][m][n]; sq += v[0] * v[0] + v[1] * v[1] + v[2] * v[2] + v[3] * v[3]; }
                        sq += __shfl_xor(sq, 16); sq += __shfl_xor(sq, 32);
                        if (fq == 0) red[((ai * HALF + wr * 64 + m * 16 + fr) * 2 + bj) * 4 + wc] = sq; }
            LDS_BARRIER();
            const float* gp = pn < 4 ? gq : gk;
            float g1[2][2], g2[2][2];
#pragma unroll
            for (int n = 0; n < 2; ++n) { const int p0 = 16 * wc + 8 * n + 2 * fq; g1[n][0] = gp[p0]; g1[n][1] = gp[p0 + 1]; g2[n][0] = gp[p0 + 64]; g2[n][1] = gp[p0 + 65]; }
#pragma unroll
            for (int ai = 0; ai < 2; ++ai)
#pragma unroll
                for (int m = 0; m < 4; ++m) { const int lr = ai * HALF + wr * 64 + m * 16 + fr; int b, t; row_bt(brow + lr, b, t);
#pragma unroll
                    for (int bj = 0; bj < 2; ++bj) { const f32x4 q4 = *(const f32x4*)(red + (lr * 2 + bj) * 4); const float rs = rsqrtf(((q4[0] + q4[1]) + (q4[2] + q4[3])) * (1.f / 128.f) + EPS);
                        bf16_t* dst = pn < 4 ? Qb + (((size_t)b * 8 + pn * 2 + bj) * S + t) * 128 : Kb + (((size_t)b * 2 + bj) * S + t) * 128;
#pragma unroll
                        for (int n = 0; n < 2; ++n) { const f32x4 v = acc[ai][bj][m][n]; const int p0 = 16 * wc + 8 * n + 2 * fq;
                            const float2 c0 = make_float2(cc[ai][m][n][0], cc[ai][m][n][1]), c1 = make_float2(cc[ai][m][n][2], cc[ai][m][n][3]);
                            const float x1a = v[0] * rs * g1[n][0], x2a = v[1] * rs * g2[n][0], x1b = v[2] * rs * g1[n][1], x2b = v[3] * rs * g2[n][1];
                            *(unsigned*)(dst + p0) = cvtpk(x1a * c0.x - x2a * c0.y, x1b * c1.x - x2b * c1.y);
                            *(unsigned*)(dst + 64 + p0) = cvtpk(x2a * c0.x + x1a * c0.y, x2b * c1.x + x1b * c1.y); } } }
            LDS_BARRIER();
        } else if (pn == 5) {
#pragma unroll
            for (int ai = 0; ai < 2; ++ai)
#pragma unroll
                for (int m = 0; m < 4; ++m) { int b, t; row_bt(brow + ai * HALF + wr * 64 + m * 16 + fr, b, t);
#pragma unroll
                    for (int bj = 0; bj < 2; ++bj)
#pragma unroll
                        for (int n = 0; n < 2; ++n) { const f32x4 v = acc[ai][bj][m][n]; u32x2 w; w.x = cvtpk(v[0], v[1]); w.y = cvtpk(v[2], v[3]);
                            *(u32x2*)(Vb + (((size_t)b * 2 + bj) * S + t) * 128 + wc * 32 + n * 16 + fq * 4) = w; } }
        } else {
#pragma unroll
            for (int ai = 0; ai < 2; ++ai)
#pragma unroll
                for (int m = 0; m < 4; ++m) { bf16_t* rowp = P + (size_t)(brow + ai * HALF + wr * 64 + m * 16 + fr) * CD_INP + bcol + wc * 32 + fq * 4;
#pragma unroll
                    for (int bj = 0; bj < 2; ++bj)
#pragma unroll
                        for (int n = 0; n < 2; ++n) { const f32x4 v = acc[ai][bj][m][n]; u32x2 w; w.x = cvtpk(v[0], v[1]); w.y = cvtpk(v[2], v[3]); *(u32x2*)(rowp + bj * HALF + n * 16) = w; } }
        }
    } };
struct EpiUQ { bf16_t* Qb; const float* ssq; const float2* tb;
    DEV void operator()(const f32x4 (&acc)[2][2][4][2], int brow, int bcol, int wr, int wc, int fr, int fq) const {
        const int pn = bcol >> 8;
        float sa[2][4], sb[2][4];
#pragma unroll
        for (int ai = 0; ai < 2; ++ai)
#pragma unroll
            for (int m = 0; m < 4; ++m) { const int r = brow + ai * HALF + wr * 64 + m * 16 + fr; sa[ai][m] = ssq[r]; sb[ai][m] = ssq[R + r]; }
        if (pn < 4) {
#pragma unroll
            for (int ai = 0; ai < 2; ++ai)
#pragma unroll
                for (int m = 0; m < 4; ++m) { const int r = brow + ai * HALF + wr * 64 + m * 16 + fr; int b, t; row_bt(r, b, t);
                    const float rs = rsqrtf((sa[ai][m] + sb[ai][m]) * (1.f / 512.f) + EPS);
#pragma unroll
                    for (int bj = 0; bj < 2; ++bj)
#pragma unroll
                        for (int n = 0; n < 2; ++n) { const f32x4 v = acc[ai][bj][m][n] * rs;
                            const int hh = pn * 2 + bj; bf16_t* qp = Qb + (((size_t)b * 8 + hh) * S + t) * 192 + wc * 32 + n * 16 + fq * 4;
                            u32x2 w; w.x = cvtpk(v[0], v[1]); w.y = cvtpk(v[2], v[3]); *(u32x2*)qp = w; } }
        } else {
#pragma unroll
            for (int ai = 0; ai < 2; ++ai) {
                f32x4 cc[4][2];
#pragma unroll
                for (int m = 0; m < 4; ++m) { const int r = brow + ai * HALF + wr * 64 + m * 16 + fr; int b, t; row_bt(r, b, t);
#pragma unroll
                    for (int n = 0; n < 2; ++n) cc[m][n] = *(const f32x4*)(tb + t * 32 + (((wc & 1) * 32 + n * 16 + fq * 4) >> 1)); }
                __builtin_amdgcn_sched_barrier(0);
#pragma unroll
                for (int m = 0; m < 4; ++m) { const int r = brow + ai * HALF + wr * 64 + m * 16 + fr; int b, t; row_bt(r, b, t);
                    const float rs = rsqrtf((sa[ai][m] + sb[ai][m]) * (1.f / 512.f) + EPS);
#pragma unroll
                    for (int bj = 0; bj < 2; ++bj)
#pragma unroll
                        for (int n = 0; n < 2; ++n) { const f32x4 v = acc[ai][bj][m][n] * rs;
                            const int cr = (pn - 4) * 256 + bj * HALF + wc * 32 + n * 16 + fq * 4, hh = cr >> 6, p0 = (cr & 63) >> 1;
                            const float2 c0 = make_float2(cc[m][n][0], cc[m][n][1]), c1 = make_float2(cc[m][n][2], cc[m][n][3]);
                            bf16_t* qp = Qb + (((size_t)b * 8 + hh) * S + t) * 192 + 128 + p0;
                            *(unsigned*)qp = cvtpk(v[0] * c0.x - v[1] * c0.y, v[2] * c1.x - v[3] * c1.y); *(unsigned*)(qp + 32) = cvtpk(v[1] * c0.x + v[0] * c0.y, v[3] * c1.x + v[2] * c1.y); } }
                __builtin_amdgcn_sched_barrier(0); }
        }
    } };
struct EpiUKV { bf16_t* Kb; bf16_t* Vb; const float* ssq;
    DEV void operator()(const f32x4 (&acc)[2][2][4][2], int brow, int bcol, int wr, int wc, int fr, int fq) const {
        const int hh = bcol >> 8;
        float sa[2][4];
#pragma unroll
        for (int ai = 0; ai < 2; ++ai)
#pragma unroll
            for (int m = 0; m < 4; ++m) sa[ai][m] = ssq[2 * R + brow + ai * HALF + wr * 64 + m * 16 + fr];
#pragma unroll
        for (int ai = 0; ai < 2; ++ai)
#pragma unroll
            for (int m = 0; m < 4; ++m) { const int r = brow + ai * HALF + wr * 64 + m * 16 + fr; int b, t; row_bt(r, b, t);
                const float rs = rsqrtf(sa[ai][m] * (1.f / 256.f) + EPS); const size_t rowi = ((size_t)b * 8 + hh) * S + t;
#pragma unroll
                for (int n = 0; n < 2; ++n) { const f32x4 kv = acc[ai][0][m][n] * rs, vv = acc[ai][1][m][n] * rs; const int c = wc * 32 + n * 16 + fq * 4;
                    u32x2 w; w.x = cvtpk(kv[0], kv[1]); w.y = cvtpk(kv[2], kv[3]); *(u32x2*)(Kb + rowi * 192 + c) = w;
                    w.x = cvtpk(vv[0], vv[1]); w.y = cvtpk(vv[2], vv[3]); *(u32x2*)(Vb + rowi * 128 + c) = w; } }
    } };

template <bool LATENT = false, int LDA_ = 0, class Epi>
DEV void gemm_phase(const bf16_t* A, const bf16_t* Bt, int M, int N, int K, char* smem, const Epi& epi, int& cursor, int tlo = 0, int thi = 1 << 30) {
    const int nM = M / BM, nN = N / BM, n = nM * nN;
    int first = cursor; cursor += n;
    int u = blockIdx.x; while (u < first) u += gridDim.x;
    for (; u < first + n; u += gridDim.x) { const int t = u - first; if (t < tlo || t >= thi) continue; const int pm = t % nM, pn = t / nM;
        const int prow = LATENT ? (pm >> 3) * 9 + 1 + (pm & 7) : pm;
        gemm_tile<false, LDA_>(A, Bt, K, K, prow * BM, pn * BM, nullptr, 0, smem, epi); }
}

template <bool LATENT = false, int LDA_ = 0, class Epi>
DEV int gemm_phase_xcd(const bf16_t* A, const bf16_t* Bt, int M, int N, int K, char* smem, const Epi& epi, int& most) {
    const int nM = M / BM, nN = N / BM, g = gridDim.x, L = (g & 7) ? 1 : 8;
    const int x = blockIdx.x % L, j = blockIdx.x / L, W = g / L, cx = (nM - x + L - 1) / L, nx = cx * nN;
    most = (((nM + L - 1) / L) * nN + W - 1) / W;
    int done = 0;
    for (int idx = j; idx < nx; idx += W, ++done) { const int pn = idx / cx, pm = x + L * (idx - pn * cx);
        const int prow = LATENT ? (pm >> 3) * 9 + 1 + (pm & 7) : pm;
        gemm_tile<false, LDA_>(A, Bt, K, K, prow * BM, pn * BM, nullptr, 0, smem, epi); }
    return done;
}

struct CvtJob { const float* src; bf16_t* dst; int K, N, Nout, nb; size_t src_bs, dst_bs; int blk_rs, blk_base; const float* kscale; int perm = 0; int ntst = 0; };
constexpr int CVT_LDS_WAVE = 64 * 65 * 4, CVT_SLOT_OFF = 8 * CVT_LDS_WAVE;
DEV void cvt_issue(const CvtJob& j, int u, int lane, f32x4 (&e)[16]) {
    const int tN = j.Nout / 64, per = (j.K / 64) * tN;
    const int bt = u / per, rem = u - bt * per, kt = rem / tN, ntl = rem - kt * tN;
    const int n0 = ntl * 64 + (lane & 15) * 4;
    const float* sp = j.src + (size_t)bt * j.src_bs + (size_t)(kt * 64 + (lane >> 4)) * j.N + (n0 < j.N ? n0 : 0);
#pragma unroll
    for (int q = 0; q < 16; ++q) e[q] = __builtin_nontemporal_load((const f32x4*)(sp + (size_t)(q * 4) * j.N));
}
DEV void cvt_finish(const CvtJob& j, int u, int lane, float* tile, const f32x4 (&e)[16]) {
    const int tN = j.Nout / 64, per = (j.K / 64) * tN;
    const int bt = u / per, rem = u - bt * per, kt = rem / tN, ntl = rem - kt * tN;
    const int r0 = lane >> 4, c4 = lane & 15; const bool valid = ntl * 64 + c4 * 4 < j.N;
#pragma unroll
    for (int q = 0; q < 16; ++q) { f32x4 x = e[q]; const int k = r0 + 4 * q; if (j.kscale) x *= j.kscale[kt * 64 + k]; if (!valid) x = (f32x4){0.f, 0.f, 0.f, 0.f};
        float* tp = tile + k * 65 + c4 * 4; tp[0] = x[0]; tp[1] = x[1]; tp[2] = x[2]; tp[3] = x[3]; }
    const int nl0 = lane >> 3, kc = (lane & 7) * 8;
#pragma unroll
    for (int p = 0; p < 8; ++p) { const int nl = p * 8 + nl0, nn = ntl * 64 + nl; float v[8];
#pragma unroll
        for (int i = 0; i < 8; ++i) v[i] = tile[(kc + i) * 65 + nl];
        int drow = (nn >> 7) * j.blk_rs + j.blk_base + (nn & 127);
        if (j.perm == 1) { const int hh = nn / 192, c = nn - hh * 192, i = c - 128; drow = c < 128 ? hh * 128 + c : 1024 + hh * 64 + (i < 32 ? 2 * i : 2 * (i - 32) + 1); }
        if (j.perm == 3 && nn < 1280) { const int c = nn & 127; drow = (nn & ~127) + (c < 64 ? 2 * c : 2 * (c - 64) + 1); }
        if (j.perm == 2 && nn >= 5888) { const int i = nn - 5888; drow = i < 64 ? 5888 + (i < 32 ? 2 * i : 2 * (i - 32) + 1) : nn; }
        const u32x4 ov = (u32x4){cvtpk(v[0], v[1]), cvtpk(v[2], v[3]), cvtpk(v[4], v[5]), cvtpk(v[6], v[7])}; u32x4* op_ = (u32x4*)(j.dst + (size_t)bt * j.dst_bs + (size_t)drow * j.K + kt * 64 + kc);
        if (j.ntst) __builtin_nontemporal_store(ov, op_); else *op_ = ov; }
}
DEV void cvt_run(const CvtJob& j, int u0, int ustep, int n, int lane, float* tile) {
    f32x4 eA[16], eB[16];
    cvt_issue(j, u0, lane, eA);
    int i = 0;
#pragma unroll 1
    for (; i + 2 < n; i += 2) {
        cvt_issue(j, u0 + (i + 1) * ustep, lane, eB);
        __builtin_amdgcn_sched_barrier(0);
        cvt_finish(j, u0 + i * ustep, lane, tile, eA);
        __builtin_amdgcn_sched_barrier(0);
        cvt_issue(j, u0 + (i + 2) * ustep, lane, eA);
        __builtin_amdgcn_sched_barrier(0);
        cvt_finish(j, u0 + (i + 1) * ustep, lane, tile, eB);
        __builtin_amdgcn_sched_barrier(0);
    }
    if (i + 1 < n) {
        cvt_issue(j, u0 + (i + 1) * ustep, lane, eB);
        __builtin_amdgcn_sched_barrier(0);
        cvt_finish(j, u0 + i * ustep, lane, tile, eA);
        __builtin_amdgcn_sched_barrier(0);
        cvt_finish(j, u0 + (i + 1) * ustep, lane, tile, eB);
    } else cvt_finish(j, u0 + i * ustep, lane, tile, eA);
}
DEV void cvt_weight(const float* __restrict__ src, bf16_t* __restrict__ dst, int K, int N, int Nout, int nb, size_t src_bs, size_t dst_bs,
                    int blk_rs, int blk_base, const float* __restrict__ kscale, char* smem, int perm = 0) {
    const CvtJob j{src, dst, K, N, Nout, nb, src_bs, dst_bs, blk_rs, blk_base, kscale, perm};
    const int tid = tid_opaque(), lane = tid & 63, w = tid >> 6, total = nb * (K / 64) * (Nout / 64);
    float* tile = (float*)(smem + w * CVT_LDS_WAVE);
    const int u0 = blockIdx.x * 8 + w, ustep = gridDim.x * 8;
    if (u0 < total) cvt_run(j, u0, ustep, (total - u0 + ustep - 1) / ustep, lane, tile);
    __syncthreads();
}
DEV bf16_t* moe_w13(const Args& a, int l) { return (bf16_t*)(a.ws + (l == 0 ? WS_W13 : WS_SVT)); }
DEV bf16_t* moe_w2(const Args& a, int l) { return (bf16_t*)(a.ws + (l == 0 ? WS_W2 : WS_SVT + (size_t)NE * 1024 * D * 2)); }
constexpr int CVT_IT = 4;
DEV void cvt_moe_dynamic(const Args& a, int l, char* smem) {
    const int tid = tid_opaque(), lane = tid & 63, w = tid >> 6;
    unsigned* counter = (unsigned*)(a.ws + WS_CTL) + CW_CVT + l * 64;
    volatile int* slot = (volatile int*)(smem + CVT_SLOT_OFF); float* tile = (float*)(smem + w * CVT_LDS_WAVE);
    const CvtJob j1{a.in[26] + (size_t)l * NE * D * EDIM, moe_w13(a, l), D, EDIM, EDIM, NE, (size_t)D * EDIM, (size_t)1024 * D, 256, 0, nullptr, 0, l};
    const CvtJob j3{a.in[27] + (size_t)l * NE * D * EDIM, moe_w13(a, l), D, EDIM, EDIM, NE, (size_t)D * EDIM, (size_t)1024 * D, 256, 128, nullptr, 0, l};
    const CvtJob j2{a.in[28] + (size_t)l * NE * EDIM * D, moe_w2(a, l), EDIM, D, D, NE, (size_t)EDIM * D, (size_t)D * EDIM, 128, 0, nullptr, 0, l};
    constexpr int CPJ = 4096 / (8 * CVT_IT), NCHUNK = 3 * CPJ;
    for (;;) {
        __syncthreads();
        if (tid == 0) *slot = (int)atomicAdd(counter, 1u);
        __syncthreads();
        const int chunk = *slot;
        if (chunk >= NCHUNK) break;
        const int job = chunk / CPJ, u0 = (chunk - job * CPJ) * (8 * CVT_IT) + w;
        if (job == 0) cvt_run(j1, u0, 8, CVT_IT, lane, tile); else if (job == 1) cvt_run(j3, u0, 8, CVT_IT, lane, tile); else cvt_run(j2, u0, 8, CVT_IT, lane, tile);
    }
    __syncthreads();
}

DEV void cvt_cd_dynamic(const Args& a, char* smem) {
    const int tid = tid_opaque(), lane = tid & 63, w = tid >> 6;
    unsigned* counter = (unsigned*)(a.ws + WS_CTL) + CW_CVT + 3 * 64;
    volatile int* slot = (volatile int*)(smem + CVT_SLOT_OFF); float* tile = (float*)(smem + w * CVT_LDS_WAVE);
    const CvtJob jin{a.in[17], (bf16_t*)(a.ws + WS_WCDIN), D, CD_IN, CD_INP, 1, 0, 0, 128, 0, nullptr, 3, 1};
    const CvtJob jout{a.in[18], (bf16_t*)(a.ws + WS_WCDOUT), D, D, D, 1, 0, 0, 128, 0, nullptr, 0, 1};
    const CvtJob jabo{a.in[10], (bf16_t*)(a.ws + WS_WABOUT), D, D, D, 1, 0, 0, 128, 0, nullptr};
    const CvtJob juq{a.in[14], (bf16_t*)(a.ws + WS_WUQ), 512, 1536, 1536, 1, 0, 0, 128, 0, a.in[13], 1};
    const CvtJob jukv{a.in[16], (bf16_t*)(a.ws + WS_WUKV), 256, 2048, 2048, 1, 0, 0, 128, 0, a.in[15]};
    constexpr int TIN = 32 * (CD_INP / 64), T1 = TIN + 32 * 32, T2 = T1 + 32 * 32, T3 = T2 + 8 * 24, T4 = T3 + 4 * 32, NCHUNK = T4 / (8 * CVT_IT);
    static_assert(TIN % (8 * CVT_IT) == 0 && T1 % (8 * CVT_IT) == 0 && T2 % (8 * CVT_IT) == 0 && T3 % (8 * CVT_IT) == 0 && T4 % (8 * CVT_IT) == 0, "chunk boundary");
    for (;;) {
        __syncthreads();
        if (tid == 0) *slot = (int)atomicAdd(counter, 1u);
        __syncthreads();
        const int chunk = *slot;
        if (chunk >= NCHUNK) break;
        const int g = chunk * (8 * CVT_IT) + w;
        if (g < TIN) cvt_run(jin, g, 8, CVT_IT, lane, tile); else if (g < T1) cvt_run(jout, g - TIN, 8, CVT_IT, lane, tile); else if (g < T2) cvt_run(jabo, g - T1, 8, CVT_IT, lane, tile);
        else if (g < T3) cvt_run(juq, g - T2, 8, CVT_IT, lane, tile); else cvt_run(jukv, g - T3, 8, CVT_IT, lane, tile);
    }
    __syncthreads();
}

template <bool DYN>
DEV void mod_phase(const Args& a, int l, char* smem, int qid = 2, int u_lo = 0, int u_hi = MODN / 32) {
    float* sc = (float*)smem;
    float* red = sc + 5 * D;
    const int tid = tid_opaque(), w = tid >> 6, lane = tid & 63, cg = lane & 7, rr = lane >> 3;
    bool ready = false;
    float* modv = (float*)(a.ws + WS_MODV);
    unsigned* counter = (unsigned*)(a.ws + WS_CTL) + CW_CVT + qid * 64; volatile int* slot = (volatile int*)(red + 8 * 5 * 32);
    for (int u = gridDim.x - 1 - blockIdx.x;; u += gridDim.x) {
        if (DYN) { __syncthreads(); if (tid == 0) *slot = (int)atomicAdd(counter, 1u); __syncthreads(); u = u_lo + *slot; }
        if (u >= u_hi) break;
        if (!ready) { ready = true; float xv[5 * D / NT];
#pragma unroll
            for (int q = 0; q < 5 * D / NT; ++q) { const int i = tid + q * NT, v = i / D, k = i - v * D; xv[q] = v < 4 ? a.in[1][v * D + k] : a.in[3][k]; }
#pragma unroll
            for (int q = 0; q < 5 * D / NT; ++q) sc[tid + q * NT] = siluf_(xv[q]);
            __syncthreads(); }
        const int c0 = u * 32;
        const float* wp = a.in[4] + (size_t)l * D * MODN + c0 + cg * 4;
        f32x4 acc[5] = {};
        for (int it0 = 0; it0 < D / 64; it0 += 8) { f32x4 wv[8];
#pragma unroll
            for (int q = 0; q < 8; ++q) wv[q] = __builtin_nontemporal_load((const f32x4*)(wp + (size_t)((it0 + q) * 64 + w * 8 + rr) * MODN));
#pragma unroll
            for (int q = 0; q < 8; ++q) { const int k = (it0 + q) * 64 + w * 8 + rr;
#pragma unroll
                for (int v = 0; v < 5; ++v) acc[v] += wv[q] * sc[v * D + k]; } }
#pragma unroll
        for (int v = 0; v < 5; ++v)
#pragma unroll
            for (int j = 0; j < 4; ++j) { float x = acc[v][j]; x += __shfl_xor(x, 8); x += __shfl_xor(x, 16); x += __shfl_xor(x, 32); acc[v][j] = x; }
        if (rr == 0) {
#pragma unroll
            for (int v = 0; v < 5; ++v)
#pragma unroll
                for (int j = 0; j < 4; ++j) red[(w * 5 + v) * 32 + cg * 4 + j] = acc[v][j]; }
        __syncthreads();
        if (tid < 160) { const int v = tid >> 5, c = tid & 31; float s = 0.f;
#pragma unroll
            for (int ww = 0; ww < 8; ++ww) s += red[(ww * 5 + v) * 32 + c];
            modv[((size_t)l * 5 + v) * MODN + c0 + c] = s + a.in[5][l * MODN + c0 + c]; }
        __syncthreads();
    }
}

DEV void misc_phase(const Args& a) {
    const int gt = blockIdx.x * NT + tid_opaque(), gs = gridDim.x * NT;
    float* lb = (float*)(a.ws + WS_LB);
    for (int i = gt; i < 2 * 1024; i += gs) { const int d = i >> 10, c = i & 1023; const float* p = a.in[11] + (size_t)d * 3 * 1024 + c;
        const float x0 = p[0], x1 = p[1024], x2 = p[2048], m = fmaxf(x0, fmaxf(x1, x2));
        const float e0 = expf(x0 - m), e1 = expf(x1 - m), e2 = expf(x2 - m); lb[i] = e0 / (e0 + e1 + e2); }
    float2* tb = (float2*)(a.ws + WS_TABB); float2* tc = (float2*)(a.ws + WS_TABC);
    for (int i = gt; i < S * 32; i += gs) { const int t = (i >> 5) - TC, j = i & 31, q = j & 15; const float fr = powf(10000.f, -(float)q / 16.f);
        const float pos = (j < 16) ? (float)(t >> 6) : (float)(t & 63); const float an = pos * fr; tb[i] = t < 0 ? make_float2(1.f, 0.f) : make_float2(cosf(an), sinf(an)); }
    for (int i = gt; i < S * 64; i += gs) { const int t = (i >> 6) - TC, j = i & 63, q = j & 31; const float fr = powf(10000.f, -(float)q / 32.f);
        const float pos = (j < 32) ? (float)(t >> 6) : (float)(t & 63); const float an = pos * fr; tc[i] = t < 0 ? make_float2(1.f, 0.f) : make_float2(cosf(an), sinf(an)); }
}

template <bool ROUTER, bool FROM_IN = false>
DEV void norm_phase(const Args& a, int l, int chunk_shift, const float* gain, bool latent_only, char* smem, bool dry = false) {
    const int tid = tid_opaque(), w = tid >> 6, lane = tid & 63;
    const bf16_t* xres = (const bf16_t*)(a.ws + WS_XRES); bf16_t* h = (bf16_t*)(a.ws + WS_H);
    const float* modv = (const float*)(a.ws + WS_MODV) + (size_t)l * 5 * MODN;
    unsigned* cnt = (unsigned*)(a.ws + WS_CTL) + CW_CNT + l * 16 * CNT_STRIDE;
    int* tok = (int*)(a.ws + WS_TOK); int* list = (int*)(a.ws + WS_LIST);
    float* rw = (float*)smem;
    int* ent = (int*)(smem + 139264);
    if (ROUTER) { for (int i = tid; i < D * 16 / 4; i += NT) { const int c = i >> 2, q = i & 3; *(f32x4*)(rw + c * 16 + (c >> 2) * 4 + q * 4) = ((const f32x4*)a.in[24])[i]; }
                  if (tid < 128) ent[tid] = -1; __syncthreads(); }
    const int stride = gridDim.x * 8, rfirst = blockIdx.x * 8 + w;
#define NP_SKIP(rr) while ((rr) < R && latent_only && ((rr) % S) < TC) (rr) += stride
#define NP_LOAD(rr, XF, XB) do { const int b_ = (rr) / S, t_ = (rr) - b_ * S; const float* xp_ = t_ < TC ? a.in[2] + ((size_t)b_ * TC + t_) * D : a.in[0] + ((size_t)b_ * TL + (t_ - TC)) * D; const bf16_t* xb_ = xres + (size_t)(rr) * D; \
        _Pragma("unroll") for (int j = 0; j < 8; ++j) { if (FROM_IN) XF[j] = __builtin_nontemporal_load((const f32x4*)(xp_ + j * 256 + lane * 4)); else XB[j] = *(const u32x2*)(xb_ + j * 256 + lane * 4); } } while (0)
    float* lmod = (float*)smem;
    static_assert(!ROUTER, "the router form lives in norm_router_phase (its LDS image would collide with these copies)");
    if (!ROUTER) { for (int i = tid; i < 10 * D / 4; i += NT) { const int q = i / (D / 4), k4 = i - q * (D / 4), v_ = q < 5 ? q : q - 5;
            ((f32x4*)lmod)[i] = *(const f32x4*)(modv + (size_t)v_ * MODN + (chunk_shift + (q < 5 ? 0 : 1)) * D + k4 * 4); }
        __syncthreads(); }
    int r = rfirst; NP_SKIP(r);
    f32x4 gv[8];
#pragma unroll
    for (int j = 0; j < 8; ++j) gv[j] = *(const f32x4*)(gain + j * 256 + lane * 4);
    f32x4 nxf[8]; u32x2 nxb[8];
    if (r < R) NP_LOAD(r, nxf, nxb);
    while (r < R) {
        const int nent = (r - rfirst) / stride;
        f32x4 x[8]; float ss = 0.f;
#pragma unroll
        for (int j = 0; j < 8; ++j) { if (FROM_IN) x[j] = nxf[j]; else { const u32x2 p = nxb[j]; x[j] = (f32x4){bflo(p.x), bfhi(p.x), bflo(p.y), bfhi(p.y)}; } }
        const int b = r / S, t = r - b * S; const int v = t < TC ? 4 : b;
        const float* sh = lmod + v * D; const float* sc = lmod + (5 + v) * D;
        int rn = r + stride; NP_SKIP(rn);
        { const int rp_ = rn < R ? rn : r; NP_LOAD(rp_, nxf, nxb); }
        __builtin_amdgcn_sched_barrier(0);
#pragma unroll
        for (int j = 0; j < 8; ++j) ss += x[j][0] * x[j][0] + x[j][1] * x[j][1] + x[j][2] * x[j][2] + x[j][3] * x[j][3];
        ss = wave_sum(ss); const float rstd = rsqrtf(ss * (1.f / D) + EPS);
        float lg[16]; f32x2 lgp[8];
        if (ROUTER) {
#pragma unroll
            for (int e = 0; e < 8; ++e) lgp[e] = (f32x2){0.f, 0.f}; }
#pragma unroll
        for (int j = 0; j < 8; ++j) { const int c = j * 256 + lane * 4;
            const f32x4 g = gv[j], s1 = *(const f32x4*)(sc + c), s0 = *(const f32x4*)(sh + c);
            f32x4 y = (x[j] * rstd * g) * (1.f + s1) + s0;
            u32x2 pk; pk.x = cvtpk(y[0], y[1]); pk.y = cvtpk(y[2], y[3]); *(u32x2*)(h + (size_t)r * D + c) = pk;
            if (ROUTER) {
#pragma unroll
                for (int i = 0; i < 4; ++i) { const f32x4* wrow = (const f32x4*)(rw + (c + i) * 16 + (c >> 2) * 4);
#pragma unroll
                    for (int q = 0; q < 4; ++q) { const f32x4 wv = wrow[q]; const f32x2 yy = (f32x2){y[i], y[i]};
                        lgp[q * 2 + 0] += yy * (f32x2){wv[0], wv[1]}; lgp[q * 2 + 1] += yy * (f32x2){wv[2], wv[3]}; } }
                __builtin_amdgcn_sched_barrier(0); }
        }
        if (ROUTER) {
#pragma unroll
            for (int e = 0; e < 16; ++e) lg[e] = wave_sum(lgp[e >> 1][e & 1]);
            if (lane == 0 && !dry) {
                float scv[16], sel[16];
#pragma unroll
                for (int e = 0; e < 16; ++e) { scv[e] = 1.f / (1.f + __expf(-lg[e])); sel[e] = scv[e] + a.in[25][e]; }
                int gbest = 0; float gbv = -1e30f;
#pragma unroll
                for (int g = 0; g < 4; ++g) { float m1 = -1e30f, m2 = -1e30f;
#pragma unroll
                    for (int i = 0; i < 4; ++i) { const float s_ = sel[g * 4 + i]; if (s_ > m1) { m2 = m1; m1 = s_; } else if (s_ > m2) m2 = s_; }
                    const float gs = m1 + m2; if (gs > gbv) { gbv = gs; gbest = g; } }
                int e0 = 0, e1 = 0; float m1 = -1e30f, m2 = -1e30f; float w0 = 0.f, w1 = 0.f;
#pragma unroll
                for (int g = 0; g < 4; ++g) if (g == gbest) {
#pragma unroll
                    for (int i = 0; i < 4; ++i) { const float s_ = sel[g * 4 + i]; const int e = g * 4 + i;
                        if (s_ > m1) { m2 = m1; e1 = e0; w1 = w0; m1 = s_; e0 = e; w0 = scv[e]; } else if (s_ > m2) { m2 = s_; e1 = e; w1 = scv[e]; } } }
                const float inv = 1.f / (w0 + w1);
                ent[nent * 16 + w * 2 + 0] = (e0 << 24) | (r * 2); ent[nent * 16 + w * 2 + 1] = (e1 << 24) | (r * 2 + 1);
                tok[r * 4 + 0] = e0; tok[r * 4 + 1] = e1; ((float*)tok)[r * 4 + 2] = w0 * inv; ((float*)tok)[r * 4 + 3] = w1 * inv;
            }
        }
        __builtin_amdgcn_sched_barrier(0);
        r = rn;
    }
#undef NP_LOAD
#undef NP_SKIP
    if (ROUTER) {
        __syncthreads();
        if (tid < NE) { int c_ = 0;
            for (int j = 0; j < 128; ++j) c_ += ((ent[j] >> 24) == tid) ? 1 : 0;
            if (c_) { unsigned pos = atomicAdd(&cnt[tid * CNT_STRIDE], (unsigned)c_);
                for (int j = 0; j < 128; ++j) { const int en = ent[j]; if ((en >> 24) == tid) { __hip_atomic_store((__attribute__((address_space(1))) int*)(list + (size_t)tid * R + pos), en & 0xffffff, __ATOMIC_RELAXED, __HIP_MEMORY_SCOPE_AGENT); ++pos; } } } }
        __syncthreads();
    }
}

DEV void norm_router_phase(const Args& a, int l, int chunk_shift, const float* gain, bool latent_only, char* smem) {
    constexpr int WP = 2 * D + 16;
    constexpr int OFF_WLO = 16 * WP, OFF_ENT = 2 * 16 * WP, OFF_ROW = OFF_ENT + 512, OFF_RED = OFF_ROW + 256;
    static_assert(OFF_RED + 8 * 3 * 256 * 4 <= LDS_BYTES_C - 16, "router LDS");
    const int tid = tid_opaque(), w = tid >> 6, lane = tid & 63;
    const bf16_t* xres = (const bf16_t*)(a.ws + WS_XRES); bf16_t* h = (bf16_t*)(a.ws + WS_H); bf16_t* hlo = (bf16_t*)(a.ws + WS_P);
    const float* modv = (const float*)(a.ws + WS_MODV) + (size_t)l * 5 * MODN;
    unsigned* cnt = (unsigned*)(a.ws + WS_CTL) + CW_CNT + l * 16 * CNT_STRIDE;
    int* tok = (int*)(a.ws + WS_TOK); int* list = (int*)(a.ws + WS_LIST);
    char* whi = smem; char* wlo = smem + OFF_WLO; int* ent = (int*)(smem + OFF_ENT); int* rowtab = (int*)(smem + OFF_ROW); float* red = (float*)(smem + OFF_RED);
    float* lmod = (float*)smem;
    for (int i = tid; i < 10 * D / 4; i += NT) { const int q = i / (D / 4), k4 = i - q * (D / 4), v_ = q < 5 ? q : q - 5;
        ((f32x4*)lmod)[i] = *(const f32x4*)(modv + (size_t)v_ * MODN + (chunk_shift + (q < 5 ? 0 : 1)) * D + k4 * 4); }
    if (tid < 128) ent[tid] = -1;
    if (tid < 64) rowtab[tid] = -1;
    __syncthreads();
    const int stride = gridDim.x * 8, rfirst = blockIdx.x * 8 + w;
#define NR_SKIP(rr) while ((rr) < R && latent_only && ((rr) % S) < TC) (rr) += stride
#define NR_LOAD(rr, XB) do { const bf16_t* xb_ = xres + (size_t)(rr) * D; _Pragma("unroll") for (int j = 0; j < 8; ++j) XB[j] = *(const u32x2*)(xb_ + j * 256 + lane * 4); } while (0)
    int r = rfirst; NR_SKIP(r);
    f32x4 gv[8];
#pragma unroll
    for (int j = 0; j < 8; ++j) gv[j] = *(const f32x4*)(gain + j * 256 + lane * 4);
    u32x2 nxb[8];
    if (r < R) NR_LOAD(r, nxb);
    while (r < R) {
        const int nent = (r - rfirst) / stride;
        f32x4 x[8]; float ss = 0.f;
#pragma unroll
        for (int j = 0; j < 8; ++j) { const u32x2 p = nxb[j]; x[j] = (f32x4){bflo(p.x), bfhi(p.x), bflo(p.y), bfhi(p.y)}; }
        const int b = r / S, t = r - b * S; const int v = t < TC ? 4 : b;
        const float* sh = lmod + v * D; const float* sc = lmod + (5 + v) * D;
        int rn = r + stride; NR_SKIP(rn);
        { const int rp_ = rn < R ? rn : r; NR_LOAD(rp_, nxb); }
        __builtin_amdgcn_sched_barrier(0);
#pragma unroll
        for (int j = 0; j < 8; ++j) ss += x[j][0] * x[j][0] + x[j][1] * x[j][1] + x[j][2] * x[j][2] + x[j][3] * x[j][3];
        ss = wave_sum(ss); const float rstd = rsqrtf(ss * (1.f / D) + EPS);
#pragma unroll
        for (int j = 0; j < 8; ++j) { const int c = j * 256 + lane * 4;
            const f32x4 g = gv[j], s1 = *(const f32x4*)(sc + c), s0 = *(const f32x4*)(sh + c);
            const f32x4 y = (x[j] * rstd * g) * (1.f + s1) + s0;
            u32x2 pk; pk.x = cvtpk(y[0], y[1]); pk.y = cvtpk(y[2], y[3]); *(u32x2*)(h + (size_t)r * D + c) = pk;
            u32x2 pl; pl.x = cvtpk(y[0] - bflo(pk.x), y[1] - bfhi(pk.x)); pl.y = cvtpk(y[2] - bflo(pk.y), y[3] - bfhi(pk.y)); *(u32x2*)(hlo + (size_t)r * D + c) = pl; }
        if (lane == 0) rowtab[nent * 8 + w] = r;
        __builtin_amdgcn_sched_barrier(0);
        r = rn;
    }
#undef NR_LOAD
#undef NR_SKIP
    asm volatile("s_waitcnt vmcnt(0)" ::: "memory");
    __syncthreads();
    for (int i = tid; i < (D / 2) * 4; i += NT) { const int kp = i >> 2, q = i & 3;
        const f32x4 w0 = ((const f32x4*)a.in[24])[(2 * kp) * 4 + q], w1 = ((const f32x4*)a.in[24])[(2 * kp + 1) * 4 + q];
#pragma unroll
        for (int e = 0; e < 4; ++e) { const unsigned hi = cvtpk(w0[e], w1[e]); const unsigned lo = cvtpk(w0[e] - bflo(hi), w1[e] - bfhi(hi));
            *(unsigned*)(whi + (q * 4 + e) * WP + kp * 4) = hi; *(unsigned*)(wlo + (q * 4 + e) * WP + kp * 4) = lo; } }
    __syncthreads();
    { const int rl = lane & 15, kq = lane >> 4; f32x4 acc[3] = {};
#pragma unroll
      for (int g = 0; g < 3; ++g) { int rr = rowtab[g * 16 + rl]; rr = rr < 0 ? 0 : rr;
          const bf16_t* ph = h + (size_t)rr * D + w * 256 + kq * 8; const bf16_t* pl = hlo + (size_t)rr * D + w * 256 + kq * 8;
          bf16x8 ah[8], al_[8];
#pragma unroll
          for (int kc = 0; kc < 8; ++kc) { ah[kc] = *(const bf16x8*)(ph + kc * 32); al_[kc] = *(const bf16x8*)(pl + kc * 32); }
#pragma unroll
          for (int kc = 0; kc < 8; ++kc) { const int kb = (w * 256 + kc * 32 + kq * 8) * 2;
              const bf16x8 bh = *(const bf16x8*)(whi + rl * WP + kb), bl = *(const bf16x8*)(wlo + rl * WP + kb);
              acc[g] = __builtin_amdgcn_mfma_f32_16x16x32_bf16(ah[kc], bh, acc[g], 0, 0, 0);
              acc[g] = __builtin_amdgcn_mfma_f32_16x16x32_bf16(ah[kc], bl, acc[g], 0, 0, 0);
              acc[g] = __builtin_amdgcn_mfma_f32_16x16x32_bf16(al_[kc], bh, acc[g], 0, 0, 0); }
#pragma unroll
          for (int q = 0; q < 4; ++q) red[((w * 3 + g) * 16 + kq * 4 + q) * 16 + rl] = acc[g][q]; } }
    __syncthreads();
    if (tid < 48) { const int rr = rowtab[tid];
        if (rr >= 0) { const int g = tid >> 4, tk = tid & 15;
            float lg[16];
#pragma unroll
            for (int e = 0; e < 16; ++e) { float s_ = 0.f;
#pragma unroll
                for (int ww = 0; ww < 8; ++ww) s_ += red[((ww * 3 + g) * 16 + tk) * 16 + e];
                lg[e] = s_; }
            float scv[16], sel[16];
#pragma unroll
            for (int e = 0; e < 16; ++e) { scv[e] = 1.f / (1.f + __expf(-lg[e])); sel[e] = scv[e] + a.in[25][e]; }
            int gbest = 0; float gbv = -1e30f;
#pragma unroll
            for (int gg = 0; gg < 4; ++gg) { float m1 = -1e30f, m2 = -1e30f;
#pragma unroll
                for (int i = 0; i < 4; ++i) { const float s_ = sel[gg * 4 + i]; if (s_ > m1) { m2 = m1; m1 = s_; } else if (s_ > m2) m2 = s_; }
                const float gs = m1 + m2; if (gs > gbv) { gbv = gs; gbest = gg; } }
            int e0 = 0, e1 = 0; float m1 = -1e30f, m2 = -1e30f; float w0 = 0.f, w1 = 0.f;
#pragma unroll
            for (int gg = 0; gg < 4; ++gg) if (gg == gbest) {
#pragma unroll
                for (int i = 0; i < 4; ++i) { const float s_ = sel[gg * 4 + i]; const int e = gg * 4 + i;
                    if (s_ > m1) { m2 = m1; e1 = e0; w1 = w0; m1 = s_; e0 = e; w0 = scv[e]; } else if (s_ > m2) { m2 = s_; e1 = e; w1 = scv[e]; } } }
            const float inv = 1.f / (w0 + w1);
            ent[tid * 2 + 0] = (e0 << 24) | (rr * 2); ent[tid * 2 + 1] = (e1 << 24) | (rr * 2 + 1);
            tok[rr * 4 + 0] = e0; tok[rr * 4 + 1] = e1; ((float*)tok)[rr * 4 + 2] = w0 * inv; ((float*)tok)[rr * 4 + 3] = w1 * inv; } }
    __syncthreads();
    if (tid < NE) { int c_ = 0;
        for (int j = 0; j < 128; ++j) c_ += ((ent[j] >> 24) == tid) ? 1 : 0;
        if (c_) { unsigned pos = atomicAdd(&cnt[tid * CNT_STRIDE], (unsigned)c_);
            for (int j = 0; j < 128; ++j) { const int en = ent[j]; if ((en >> 24) == tid) { __hip_atomic_store((__attribute__((address_space(1))) int*)(list + (size_t)tid * R + pos), en & 0xffffff, __ATOMIC_RELAXED, __HIP_MEMORY_SCOPE_AGENT); ++pos; } } } }
    __syncthreads();
}

DEV int scan_tok(int dir, int pos) { return dir == 0 ? pos : (pos < TC ? (TC - 1 - pos) : (S - 1 - (pos - TC))); }
template <int MODE>
DEV void scan_prep_phase(const Args& a, char* smem) {
    constexpr int NH = MODE == 0 ? 8 : 4, DV = MODE == 0 ? 128 : 256, LDP = MODE == 0 ? AB_INP : CD_INP, NVP = DV / 128;
    const int tid = tid_opaque(), dp = tid & 63, pg = tid >> 6, wid = tid >> 6, lane = tid & 63, l15 = lane & 15, l4 = lane >> 4;
    char* QT = smem; char* KT = smem + 64 * PQ; float* tot = (float*)(smem + 2 * 64 * PQ);
    float* aT = tot + 8 * 128;
    const bf16_t* P = (const bf16_t*)(a.ws + WS_P); const float* lb = (const float*)(a.ws + WS_LB);
    const float qscale = 0.08838834764831845f;
    const int nitems = NB * NH * 2 * 36;
#define SP_LOADS(it_, Q_, Z_, V_) do { const int c_ = (it_) % 36, dir_ = ((it_) / 36) & 1, hd_ = ((it_) / 72) % NH, b_ = (it_) / (72 * NH); \
        const int qcol_ = (MODE == 0 ? hd_ * 128 : 1536 + hd_ * 128) + 2 * dp, zcol_ = (MODE == 0 ? 1024 * (1 + dir_) + hd_ * 128 : 2048 + hd_ * 128) + 2 * dp, vcol_ = (MODE == 0 ? 3072 + hd_ * 128 : 2560 + hd_ * 256) + 2 * dp; \
        _Pragma("unroll") for (int j = 0; j < 8; ++j) { const bf16_t* pr = P + (size_t)(b_ * S + scan_tok(dir_, c_ * 64 + pg * 8 + j)) * LDP; \
            Q_[j] = *(const unsigned*)(pr + qcol_); Z_[j] = *(const unsigned*)(pr + zcol_); \
            _Pragma("unroll") for (int vv = 0; vv < NVP; ++vv) V_[vv][j] = *(const unsigned*)(pr + vcol_ + vv * 128); } } while (0)
    unsigned nz[8], nq[8], nv[NVP][8];
    if ((int)blockIdx.x < nitems) SP_LOADS((int)blockIdx.x, nq, nz, nv);
    for (int item = blockIdx.x; item < nitems; item += gridDim.x) {
        const int c = item % 36, dir = (item / 36) & 1, hd = (item / 72) % NH, b = item / (72 * NH);
        char* rec = (char*)(a.ws + (MODE == 0 ? WS_SREC : WS_SREC1)) + (size_t)item * REC_BYTES;
        char* vt = (char*)(a.ws + (MODE == 0 ? WS_SVT : WS_SVT1)) + (size_t)item * (DV * PA);
        unsigned zq[8], qq[8], kq[8], vq[NVP][8];
#pragma unroll
        for (int j = 0; j < 8; ++j) { qq[j] = nq[j]; zq[j] = nz[j]; kq[j] = nz[j];
#pragma unroll
            for (int vv = 0; vv < NVP; ++vv) vq[vv][j] = nv[vv][j]; }
        float lb0 = 0.f, lb1 = 0.f, gb0 = 0.f, gb1 = 0.f; float w0[16], w1[16]; u32x2 av = {0u, 0u};
        if (MODE == 0) { lb0 = lb[dir * 1024 + hd * 128 + 2 * dp]; lb1 = lb[dir * 1024 + hd * 128 + 2 * dp + 1]; }
        else { const int wc_ = hd * 128 + 2 * dp; gb0 = a.in[22][dir * 512 + wc_]; gb1 = a.in[22][dir * 512 + wc_ + 1];
#pragma unroll
            for (int i = 0; i < 16; ++i) { const float2 wv = *(const float2*)(a.in[21] + (size_t)(dir * 16 + i) * 512 + wc_); w0[i] = wv.x; w1[i] = wv.y; }
            const int pos = (tid & 255) >> 2, qd = tid & 3; const int r = b * S + scan_tok(dir, c * 64 + pos);
            av = *(const u32x2*)(P + (size_t)r * LDP + 4608 + dir * 16 + qd * 4); }
        __builtin_amdgcn_sched_barrier(0);
        { const int nxt = item + (int)gridDim.x < nitems ? item + (int)gridDim.x : item; SP_LOADS(nxt, nq, nz, nv); }
        __builtin_amdgcn_sched_barrier(0);
        if (MODE == 1) { if (tid < 256) { const int pos = tid >> 2, qd = tid & 3; *(f32x4*)(aT + pos * 16 + qd * 4) = (f32x4){bflo(av.x), bfhi(av.x), bflo(av.y), bfhi(av.y)}; }
            LDS_BARRIER(); }
        float g0[8], g1[8], k0[8], k1[8];
        if (MODE == 0) {
#pragma unroll
            for (int j = 0; j < 8; ++j) { const float f0 = lb0 + (1.f - lb0) * sigmoidf_(bflo(zq[j])), f1 = lb1 + (1.f - lb1) * sigmoidf_(bfhi(zq[j]));
                g0[j] = __logf(f0); g1[j] = __logf(f1); k0[j] = 1.f - f0; k1[j] = 1.f - f1; } }
        else {
#pragma unroll
            for (int j = 0; j < 8; ++j) { float z0 = gb0, z1 = gb1;
#pragma unroll
                for (int i4 = 0; i4 < 4; ++i4) { const f32x4 av = *(const f32x4*)(aT + (pg * 8 + j) * 16 + i4 * 4);
#pragma unroll
                    for (int e = 0; e < 4; ++e) { z0 += av[e] * w0[i4 * 4 + e]; z1 += av[e] * w1[i4 * 4 + e]; } }
                g0[j] = (fminf(z0, 0.f) - __logf(1.f + __expf(-fabsf(z0)))) * (1.f / 16.f); g1[j] = (fminf(z1, 0.f) - __logf(1.f + __expf(-fabsf(z1)))) * (1.f / 16.f);
                k0[j] = bflo(kq[j]); k1[j] = bfhi(kq[j]); } }
#pragma unroll
        for (int j = 1; j < 8; ++j) { g0[j] += g0[j - 1]; g1[j] += g1[j - 1]; }
        *(float2*)(tot + pg * 128 + 2 * dp) = make_float2(g0[7], g1[7]);
        LDS_BARRIER();
        float off0 = 0.f, off1 = 0.f, ref0 = 0.f, ref1 = 0.f, last0 = 0.f, last1 = 0.f;
#pragma unroll
        for (int p = 0; p < 8; ++p) { const float2 tp = *(const float2*)(tot + p * 128 + 2 * dp);
            if (p < pg) { off0 += tp.x; off1 += tp.y; } if (p < 4) { ref0 += tp.x; ref1 += tp.y; } last0 += tp.x; last1 += tp.y; }
        unsigned kh0[4], kh1[4];
        const float eref0 = __expf(ref0), eref1 = __expf(ref1), elr0 = __expf(last0 - ref0), elr1 = __expf(last1 - ref1);
#pragma unroll
        for (int j = 0; j < 8; j += 2) { float kha[2], khb[2];
#pragma unroll
            for (int e = 0; e < 2; ++e) { const int i = pg * 8 + j + e; const float G0 = off0 + g0[j + e], G1 = off1 + g1[j + e];
                float q0 = bflo(qq[j + e]), q1 = bfhi(qq[j + e]); if (MODE == 0) { q0 = siluf_(q0); q1 = siluf_(q1); } q0 *= qscale; q1 *= qscale;
                const float kk0 = k0[j + e], kk1 = k1[j + e];
                const float qt0 = q0 * __expf(G0 - ref0), qt1 = q1 * __expf(G1 - ref1), kt0 = kk0 * __expf(ref0 - G0), kt1 = kk1 * __expf(ref1 - G1);
                *(unsigned*)(QT + i * PQ + dp * 4) = cvtpk(qt0, qt1);
                *(unsigned*)(KT + i * PQ + dp * 4) = cvtpk(kt0, kt1);
                *(unsigned*)(rec + REC_QH + i * PQ + dp * 4) = cvtpk(qt0 * eref0, qt1 * eref1);
                kha[e] = kt0 * elr0; khb[e] = kt1 * elr1; }
            kh0[j >> 1] = cvtpk(kha[0], kha[1]); kh1[j >> 1] = cvtpk(khb[0], khb[1]); }
        *(u32x4*)(rec + REC_KHT + (2 * dp) * PA + pg * 16) = (u32x4){kh0[0], kh0[1], kh0[2], kh0[3]};
        *(u32x4*)(rec + REC_KHT + (2 * dp + 1) * PA + pg * 16) = (u32x4){kh1[0], kh1[1], kh1[2], kh1[3]};
        if (pg == 0) *(float2*)(rec + REC_AL + dp * 8) = make_float2(__expf(last0), __expf(last1));
#pragma unroll
        for (int vv = 0; vv < NVP; ++vv) { const int v0 = vv * 128 + 2 * dp; unsigned lo[4], hi[4];
#pragma unroll
            for (int j = 0; j < 8; j += 2) { lo[j >> 1] = (vq[vv][j] & 0xffffu) | (vq[vv][j + 1] << 16); hi[j >> 1] = (vq[vv][j] >> 16) | (vq[vv][j + 1] & 0xffff0000u); }
            *(u32x4*)(vt + v0 * PA + pg * 16) = (u32x4){lo[0], lo[1], lo[2], lo[3]};
            *(u32x4*)(vt + (v0 + 1) * PA + pg * 16) = (u32x4){hi[0], hi[1], hi[2], hi[3]}; }
        asm volatile("s_waitcnt lgkmcnt(0)" ::: "memory"); __builtin_amdgcn_s_barrier();
        { const int ti = wid >> 1; f32x4 acc[2] = {};
#pragma unroll
          for (int kk = 0; kk < 4; ++kk) { const int i = ti * 16 + l15;
              const bf16x8 bq = *(const bf16x8*)(QT + i * PQ + (kk * 32 + l4 * 8) * 2);
#pragma unroll
              for (int t2_ = 0; t2_ < 2; ++t2_) { const int sidx = ((wid & 1) * 2 + t2_) * 16 + l15;
                  const bf16x8 ak = *(const bf16x8*)(KT + sidx * PQ + (kk * 32 + l4 * 8) * 2);
                  acc[t2_] = __builtin_amdgcn_mfma_f32_16x16x32_bf16(ak, bq, acc[t2_], 0, 0, 0); } }
#pragma unroll
          for (int t2_ = 0; t2_ < 2; ++t2_) { const int tj = (wid & 1) * 2 + t2_, i = ti * 16 + l15, s0 = tj * 16 + 4 * l4;
              float x0 = (s0 + 0 <= i) ? acc[t2_][0] : 0.f, x1 = (s0 + 1 <= i) ? acc[t2_][1] : 0.f, x2 = (s0 + 2 <= i) ? acc[t2_][2] : 0.f, x3 = (s0 + 3 <= i) ? acc[t2_][3] : 0.f;
              u32x2 w_; w_.x = cvtpk(x0, x1); w_.y = cvtpk(x2, x3);
              *(u32x2*)(rec + REC_A + i * PA + s0 * 2) = w_; } }
    }
#undef SP_LOADS
    __syncthreads();
}
template <int MODE>
DEV void scan_seq_phase(const Args& a, char* smem) {
    constexpr int NH = MODE == 0 ? 8 : 4, DV = MODE == 0 ? 128 : 256, NVS = DV / 32;
    constexpr int B_A = REC_A, B_QH = REC_QH, B_KHT = REC_KHT, B_AL = REC_AL, B_VT = REC_BYTES, VTS = 32 * PA, BUFB = REC_BYTES + VTS;
    constexpr int NPIECE = BUFB / 16, NREC = REC_BYTES / 16, STB = 32 * PQ, NLD = 7 * 64;
    constexpr int NRL = (REC_BYTES / 128 + NVS - 1) / NVS, TOUCH_OFF = 3 * BUFB + STB;
    static_assert(NPIECE == 7 * NLD && REC_BYTES % 128 == 0 && VTS == 36 * 128 && NRL + 36 <= 128 && TOUCH_OFF + 256 <= LDS_BYTES_C - 16, "scan_seq layout");
    const int tid = tid_opaque(), wid = tid >> 6, lane = tid & 63, l15 = lane & 15, l4 = lane >> 4;
    char* ST = smem + 3 * BUFB;
    float* odir = (float*)(a.ws + WS_ODIR);
    for (int item = blockIdx.x; item < NB * NH * 2 * NVS; item += gridDim.x) {
        const int vs = (item >> 3) % NVS, rest = (item & 7) + 8 * ((item >> 3) / NVS);
        const int dir = rest & 1, hd = (rest >> 1) % NH, b = (rest >> 1) / NH;
        const char* rec0 = (const char*)(a.ws + (MODE == 0 ? WS_SREC : WS_SREC1)) + (size_t)rest * 36 * REC_BYTES;
        const char* vt0 = (const char*)(a.ws + (MODE == 0 ? WS_SVT : WS_SVT1)) + (size_t)rest * 36 * (DV * PA) + vs * VTS;
#define SC_LOAD(cc, bb) do { if (wid < 7) { const char* _r = rec0 + (size_t)(cc) * REC_BYTES; const char* _v = vt0 + (size_t)(cc) * (DV * PA) - REC_BYTES; char* _l = smem + (bb) * BUFB; \
        _Pragma("unroll") for (int _k = 0; _k < 7; ++_k) { const int _p = tid + _k * NLD; \
            __builtin_amdgcn_global_load_lds((const unsigned*)((_p < NREC ? _r : _v) + _p * 16), (unsigned*)(_l + _p * 16), 16, 0, 0); } } } while (0)
#define SC_TOUCH(cc) do { if (wid == 7) { _Pragma("unroll") for (int _q = 0; _q < 2; ++_q) { const int L_ = _q * 64 + lane; const char* tp_; \
        if (L_ < NRL) { int li_ = vs * NRL + L_; li_ = li_ < REC_BYTES / 128 - 1 ? li_ : REC_BYTES / 128 - 1; tp_ = rec0 + (size_t)(cc) * REC_BYTES + li_ * 128; } \
        else { int li_ = L_ - NRL; li_ = li_ < 35 ? li_ : 35; tp_ = vt0 + (size_t)(cc) * (DV * PA) + li_ * 128; } \
        __builtin_amdgcn_global_load_lds((const unsigned*)tp_, (unsigned*)(smem + TOUCH_OFF), 4, 0, 0); } } } while (0)
        for (int i = tid; i < STB / 16; i += NT) ((u32x4*)ST)[i] = (u32x4){0u, 0u, 0u, 0u};
        f32x4 Sacc[2] = {};
        SC_LOAD(0, 0); SC_LOAD(1, 1); SC_TOUCH(2); SC_TOUCH(3);
        asm volatile("s_waitcnt vmcnt(0) lgkmcnt(0)" ::: "memory"); __builtin_amdgcn_s_barrier(); asm volatile("" ::: "memory");
        int rb = 0;
#pragma unroll 1
        for (int c = 0; c < 36; ++c) {
            const char* buf = smem + rb * BUFB; const char* STr = ST; char* STw = ST;
            { const int nb2 = rb == 0 ? 2 : rb - 1;
              if (c + 2 < 36) SC_LOAD(c + 2, nb2); }
            rb = rb == 2 ? 0 : rb + 1;
            { const int ti = wid >> 1, tj = wid & 1, i = ti * 16 + l15, v = tj * 16 + l15, dr = wid * 16 + l15;
              bf16x8 ba[2], as_[4], bq[4], ak[2], bv[2][2];
#pragma unroll
              for (int kk = 0; kk < 2; ++kk) { ba[kk] = *(const bf16x8*)(buf + B_A + i * PA + (kk * 32 + l4 * 8) * 2); ak[kk] = *(const bf16x8*)(buf + B_KHT + dr * PA + (kk * 32 + l4 * 8) * 2);
                  bv[0][kk] = *(const bf16x8*)(buf + B_VT + l15 * PA + (kk * 32 + l4 * 8) * 2); bv[1][kk] = *(const bf16x8*)(buf + B_VT + (16 + l15) * PA + (kk * 32 + l4 * 8) * 2); }
              const f32x4 al = *(const f32x4*)(buf + B_AL + (wid * 16 + 4 * l4) * 4);
#pragma unroll
              for (int kk = 0; kk < 4; ++kk) { as_[kk] = *(const bf16x8*)(STr + v * PQ + (kk * 32 + l4 * 8) * 2); bq[kk] = *(const bf16x8*)(buf + B_QH + i * PQ + (kk * 32 + l4 * 8) * 2); }
              __builtin_amdgcn_sched_barrier(0);
              asm volatile("s_waitcnt lgkmcnt(0)" : "+v"(as_[0]), "+v"(as_[1]), "+v"(as_[2]), "+v"(as_[3]) :: "memory"); __builtin_amdgcn_s_barrier(); asm volatile("" ::: "memory");
              f32x4 acc = {}; Sacc[0] *= al; Sacc[1] *= al;
#pragma unroll
              for (int kk = 0; kk < 2; ++kk) {
                  acc = __builtin_amdgcn_mfma_f32_16x16x32_bf16(tj ? bv[1][kk] : bv[0][kk], ba[kk], acc, 0, 0, 0);
                  Sacc[0] = __builtin_amdgcn_mfma_f32_16x16x32_bf16(ak[kk], bv[0][kk], Sacc[0], 0, 0, 0);
                  Sacc[1] = __builtin_amdgcn_mfma_f32_16x16x32_bf16(ak[kk], bv[1][kk], Sacc[1], 0, 0, 0); }
#pragma unroll
              for (int kk = 0; kk < 4; ++kk) acc = __builtin_amdgcn_mfma_f32_16x16x32_bf16(as_[kk], bq[kk], acc, 0, 0, 0);
#pragma unroll
              for (int tv = 0; tv < 2; ++tv) { u32x2 w_; w_.x = cvtpk(Sacc[tv][0], Sacc[tv][1]); w_.y = cvtpk(Sacc[tv][2], Sacc[tv][3]);
                  *(u32x2*)(STw + (tv * 16 + l15) * PQ + (wid * 16 + 4 * l4) * 2) = w_; }
              const int r = b * S + scan_tok(dir, c * 64 + i);
              *(f32x4*)(odir + ((size_t)dir * R + r) * 1024 + hd * DV + vs * 32 + tj * 16 + 4 * l4) = acc; }
            SC_TOUCH(c + 4 < 36 ? c + 4 : 35);
            if (wid < 7) { if (c + 2 < 36) asm volatile("s_waitcnt vmcnt(8)" ::: "memory"); else asm volatile("s_waitcnt vmcnt(1)" ::: "memory"); } else asm volatile("s_waitcnt vmcnt(9)" ::: "memory");
            asm volatile("s_waitcnt lgkmcnt(0)" ::: "memory"); __builtin_amdgcn_s_barrier(); asm volatile("" ::: "memory");
        }
#undef SC_LOAD
#undef SC_TOUCH
    }
    asm volatile("s_waitcnt vmcnt(0)" ::: "memory"); __syncthreads();
}

namespace fa {
typedef short s16x4 __attribute__((ext_vector_type(4)));
typedef float f32x16 __attribute__((ext_vector_type(16)));
constexpr int QBLK = 32, KVBLK = 64, NW = 8;
constexpr float THR = 8.f;
#define FA_SBAR() __builtin_amdgcn_sched_barrier(0)
DEV int crow(int r, int hi) { return (r & 3) + 8 * (r >> 2) + 4 * hi; }
template <int DQ> DEV int kswz(int row, int colB) { return row * (DQ * 2) + (colB ^ ((row & 7) << 4)); }
template <int DQ> DEV void partialSM(f32x16& p0, f32x16& p1, float& m_reg, float& mn, float& alpha) {
    constexpr float SCALE = DQ == 128 ? 0.08838834764831845f : 0.07216878364870322f;
    constexpr float C = SCALE * 1.4426950408889634f;
    float pmax = p0[0];
#pragma unroll
    for (int r = 1; r < 16; ++r) pmax = fmaxf(pmax, p0[r]);
#pragma unroll
    for (int r = 0; r < 16; ++r) pmax = fmaxf(pmax, p1[r]);
    { auto rr = __builtin_amdgcn_permlane32_swap(__float_as_uint(pmax), __float_as_uint(pmax), false, false);
      pmax = fmaxf(__uint_as_float(rr[0]), __uint_as_float(rr[1])); }
    if (__builtin_expect(__all(pmax - m_reg <= THR / SCALE), 1)) { mn = m_reg; alpha = 1.f; }
    else { mn = fmaxf(m_reg, pmax); alpha = __builtin_amdgcn_exp2f((m_reg - mn) * C); m_reg = mn; }
    const float mnC = -mn * C;
#pragma unroll
    for (int r = 0; r < 16; ++r) p0[r] = fmaf(p0[r], C, mnC);
#pragma unroll
    for (int r = 0; r < 16; ++r) p1[r] = fmaf(p1[r], C, mnC);
#pragma unroll
    for (int r = 0; r < 16; ++r) p0[r] = __builtin_amdgcn_exp2f(p0[r]);
}
DEV void finishSM(f32x16& p0, f32x16& p1, float alpha, float& l_reg, bf16x8& pa0, bf16x8& pa1, bf16x8& pa2, bf16x8& pa3) {
#pragma unroll
    for (int r = 0; r < 16; ++r) p1[r] = __builtin_amdgcn_exp2f(p1[r]);
    float ps = 0;
#pragma unroll
    for (int r = 0; r < 16; ++r) ps += p0[r];
#pragma unroll
    for (int r = 0; r < 16; ++r) ps += p1[r];
    { auto rr = __builtin_amdgcn_permlane32_swap(__float_as_uint(ps), __float_as_uint(ps), false, false);
      ps = __uint_as_float(rr[0]) + __uint_as_float(rr[1]); }
    l_reg = l_reg * alpha + ps;
#define FA_PK4(P, BASE, OUT) do { unsigned a0 = cvtpk(P[BASE + 0], P[BASE + 1]), a1 = cvtpk(P[BASE + 2], P[BASE + 3]);   \
    unsigned b0 = cvtpk(P[BASE + 4], P[BASE + 5]), b1 = cvtpk(P[BASE + 6], P[BASE + 7]);                              \
    auto r0 = __builtin_amdgcn_permlane32_swap(a0, b0, false, false); auto r1 = __builtin_amdgcn_permlane32_swap(a1, b1, false, false); \
    u32x4 w = {r0[0], r1[0], r0[1], r1[1]}; OUT = *reinterpret_cast<bf16x8*>(&w); } while (0)
    FA_PK4(p0, 0, pa0); FA_PK4(p0, 8, pa1); FA_PK4(p1, 0, pa2); FA_PK4(p1, 8, pa3);
#undef FA_PK4
}
template <int DQ> DEV void qkt(f32x16& p0, f32x16& p1, const char* Ks, const bf16x8* qr, int r32, int hi) {
    p0 = f32x16{}; p1 = f32x16{};
#pragma unroll
    for (int d0 = 0; d0 < DQ / 16; ++d0) { const int cb = (d0 * 16 + hi * 8) * 2;
        const bf16x8 b0 = *reinterpret_cast<const bf16x8*>(Ks + kswz<DQ>(r32, cb));
        const bf16x8 b1 = *reinterpret_cast<const bf16x8*>(Ks + kswz<DQ>(32 + r32, cb));
        p0 = __builtin_amdgcn_mfma_f32_32x32x16_bf16(b0, qr[d0], p0, 0, 0, 0);
        p1 = __builtin_amdgcn_mfma_f32_32x32x16_bf16(b1, qr[d0], p1, 0, 0, 0); }
}
DEV int v_st(int k, int c) { const int kk = (k & ~0xC) | ((k & 4) << 1) | ((k & 8) >> 1); return ((kk >> 3) * 4 + (c >> 5)) * 512 + ((kk & 7) * 32 + (c & 31)) * 2; }
DEV int v_rd_base(int lane) { return ((lane & 3) << 3) | (((lane >> 2) & 3) << 6) | (((lane >> 4) & 1) << 5) | (((lane >> 5) & 1) << 8); }
constexpr int v_rd_off(int d0, int ks, int half) { return d0 * 512 + ks * 4096 + half * 2048; }
template <int OFF> DEV s16x4 tr_read(int vb) { s16x4 r; asm volatile("ds_read_b64_tr_b16 %0, %1 offset:%2" : "=&v"(r) : "v"(vb), "i"(OFF) : "memory"); return r; }
template <int D0> DEV void pv_one(f32x16& od, int vb, bf16x8 pa0, bf16x8 pa1, bf16x8 pa2, bf16x8 pa3) {
    const s16x4 l0 = tr_read<v_rd_off(D0, 0, 0)>(vb), h0 = tr_read<v_rd_off(D0, 0, 1)>(vb), l1 = tr_read<v_rd_off(D0, 1, 0)>(vb), h1 = tr_read<v_rd_off(D0, 1, 1)>(vb);
    const s16x4 l2 = tr_read<v_rd_off(D0, 2, 0)>(vb), h2 = tr_read<v_rd_off(D0, 2, 1)>(vb), l3 = tr_read<v_rd_off(D0, 3, 0)>(vb), h3 = tr_read<v_rd_off(D0, 3, 1)>(vb);
    asm volatile("s_waitcnt lgkmcnt(0)" ::: "memory"); FA_SBAR();
#define FA_PK(L, H) (bf16x8){L[0], L[1], L[2], L[3], H[0], H[1], H[2], H[3]}
    od = __builtin_amdgcn_mfma_f32_32x32x16_bf16(pa0, FA_PK(l0, h0), od, 0, 0, 0);
    od = __builtin_amdgcn_mfma_f32_32x32x16_bf16(pa1, FA_PK(l1, h1), od, 0, 0, 0);
    od = __builtin_amdgcn_mfma_f32_32x32x16_bf16(pa2, FA_PK(l2, h2), od, 0, 0, 0);
    od = __builtin_amdgcn_mfma_f32_32x32x16_bf16(pa3, FA_PK(l3, h3), od, 0, 0, 0);
#undef FA_PK
}
DEV void pv_d0(f32x16* o, int vb, bf16x8 pa0, bf16x8 pa1, bf16x8 pa2, bf16x8 pa3) {
    pv_one<0>(o[0], vb, pa0, pa1, pa2, pa3); pv_one<1>(o[1], vb, pa0, pa1, pa2, pa3); pv_one<2>(o[2], vb, pa0, pa1, pa2, pa3); pv_one<3>(o[3], vb, pa0, pa1, pa2, pa3);
}
template <int DQ>
DEV void attn_body(const bf16_t* __restrict__ Qb, const bf16_t* __restrict__ Kh, const bf16_t* __restrict__ Vh, bf16_t* __restrict__ Ob, int LDO_, int seq_, char* lds) {
    constexpr int LDO = D, seq = S; (void)LDO_; (void)seq_;
    constexpr int NKC = DQ / 64, KC8 = DQ / 8;
    constexpr int SHM_V = KVBLK * 128 * 2, SHM_K = KVBLK * DQ * 2;
    const int tid = tid_opaque(), wid = tid >> 6, lane = tid & 63, r32 = lane & 31, hi = lane >> 5;
    char* V_lds = lds; char* K_lds = lds + 2 * SHM_V;
    float* wsx = (float*)(lds + 2 * SHM_V + 2 * SHM_K) + wid * 64; float* li_l = wsx; float* al_l = wsx + 32;
    float m_reg = -1e30f, l_reg = 0; f32x16 o[4] = {}; bf16x8 qr[DQ / 16];
    const bf16_t* Qw = Qb + (size_t)(wid * QBLK + r32) * DQ + hi * 8;
#pragma unroll
    for (int d0 = 0; d0 < DQ / 16; ++d0) qr[d0] = *reinterpret_cast<const bf16x8*>(Qw + d0 * 16);
    const int sr = tid >> 4, sc = (tid & 15) * 8;
    const int vb0 = (int)(uintptr_t)V_lds + v_rd_base(lane);
    struct { bf16x8 vs0, vs1, ks[NKC]; } sr_[2];
#define SLOAD(i, k0) do { sr_[i].vs0 = *reinterpret_cast<const bf16x8*>(&Vh[(size_t)((k0) + sr) * 128 + sc]); sr_[i].vs1 = *reinterpret_cast<const bf16x8*>(&Vh[(size_t)((k0) + 32 + sr) * 128 + sc]); \
    _Pragma("unroll") for (int _c = 0; _c < NKC; ++_c) { const int ch = tid + _c * 512, kr = ch / KC8, kc = ch - kr * KC8; sr_[i].ks[_c] = *reinterpret_cast<const bf16x8*>(&Kh[(size_t)((k0) + kr) * DQ + kc * 8]); } } while (0)
#define SWRITE(b, i) do { const int t2_ = tid_opaque(), sr2_ = t2_ >> 4, sc2_ = (t2_ & 15) * 8; *(bf16x8*)(V_lds + (b) * SHM_V + v_st(sr2_, sc2_)) = sr_[i].vs0; *(bf16x8*)(V_lds + (b) * SHM_V + v_st(32 + sr2_, sc2_)) = sr_[i].vs1; \
    _Pragma("unroll") for (int _c = 0; _c < NKC; ++_c) { const int ch = tid + _c * 512, kr = ch / KC8, kc = ch - kr * KC8; *(bf16x8*)(K_lds + (b) * SHM_K + kswz<DQ>(kr, kc * 16)) = sr_[i].ks[_c]; } } while (0)
#define SWAIT() do { if constexpr (NKC == 2) asm volatile("s_waitcnt vmcnt(4)" ::: "memory"); else asm volatile("s_waitcnt vmcnt(5)" ::: "memory"); } while (0)
#define RESC(a_) do { if (__any((a_) < 1.f)) { if (hi == 0) al_l[r32] = (a_); asm volatile("s_waitcnt lgkmcnt(0)" ::: "memory"); \
    _Pragma("unroll") for (int d = 0; d < 4; ++d) _Pragma("unroll") for (int r = 0; r < 16; ++r) o[d][r] *= al_l[crow(r, hi)]; } } while (0)
    f32x16 pA0, pA1, pB0, pB1; float mnA, mnB, alA, alB; bf16x8 pa0, pa1, pa2, pa3; const int NTL = seq / KVBLK;
    constexpr int SE = 0, SO = 1;
    SLOAD(SE, 0); asm volatile("s_waitcnt vmcnt(0)" ::: "memory"); SWRITE(0, SE); __syncthreads();
    qkt<DQ>(pA0, pA1, K_lds, qr, r32, hi); partialSM<DQ>(pA0, pA1, m_reg, mnA, alA);
    SLOAD(SO, KVBLK); if (2 < NTL) SLOAD(SE, 2 * KVBLK);
    SWAIT(); SWRITE(1, SO); __syncthreads();
    for (int j = 1; j + 1 < NTL; j += 2) {
        FA_SBAR(); qkt<DQ>(pB0, pB1, K_lds + SHM_K, qr, r32, hi);
        finishSM(pA0, pA1, alA, l_reg, pa0, pa1, pa2, pa3); FA_SBAR();
        SLOAD(SO, (j + 2) * KVBLK); FA_SBAR();
        pv_d0(o, vb0, pa0, pa1, pa2, pa3); partialSM<DQ>(pB0, pB1, m_reg, mnB, alB);
        __syncthreads(); SWAIT(); SWRITE(0, SE);
        RESC(alB); __syncthreads();
        FA_SBAR(); qkt<DQ>(pA0, pA1, K_lds, qr, r32, hi);
        finishSM(pB0, pB1, alB, l_reg, pa0, pa1, pa2, pa3); FA_SBAR();
        if (j + 3 < NTL) SLOAD(SE, (j + 3) * KVBLK); FA_SBAR();
        pv_d0(o, vb0 + SHM_V, pa0, pa1, pa2, pa3); partialSM<DQ>(pA0, pA1, m_reg, mnA, alA);
        __syncthreads(); SWAIT(); SWRITE(1, SO);
        RESC(alA); __syncthreads();
    }
    FA_SBAR(); qkt<DQ>(pB0, pB1, K_lds + SHM_K, qr, r32, hi);
    finishSM(pA0, pA1, alA, l_reg, pa0, pa1, pa2, pa3); FA_SBAR();
    pv_d0(o, vb0, pa0, pa1, pa2, pa3); partialSM<DQ>(pB0, pB1, m_reg, mnB, alB);
    __syncthreads(); RESC(alB);
    finishSM(pB0, pB1, alB, l_reg, pa0, pa1, pa2, pa3); FA_SBAR();
    pv_d0(o, vb0 + SHM_V, pa0, pa1, pa2, pa3);
    if (hi == 0) li_l[r32] = l_reg; asm volatile("s_waitcnt lgkmcnt(0)" ::: "memory");
    float rli[16];
#pragma unroll
    for (int r = 0; r < 16; ++r) rli[r] = __builtin_amdgcn_rcpf(li_l[crow(r, hi)]);
    bf16_t* Ow = Ob + (size_t)(wid * QBLK) * LDO;
#pragma unroll
    for (int r = 0; r < 16; ++r) { const int orow = crow(r, hi);
#pragma unroll
        for (int d0 = 0; d0 < 4; ++d0) Ow[(size_t)orow * LDO + d0 * 32 + r32] = f2bf(o[d0][r] * rli[r]); }
    __syncthreads();
#undef SLOAD
#undef SWRITE
#undef SWAIT
#undef RESC
}

template <int DQ>
DEV void attn_body_simple(const bf16_t* __restrict__ Qb, const bf16_t* __restrict__ Kh, const bf16_t* __restrict__ Vh, bf16_t* __restrict__ Ob, int LDO, int seq, char* lds) {
    constexpr int NKC = DQ / 64, KC8 = DQ / 8;
    constexpr int SHM_V = KVBLK * 128 * 2, SHM_K = KVBLK * DQ * 2;
    const int tid = tid_opaque(), wid = tid >> 6, lane = tid & 63, r32 = lane & 31, hi = lane >> 5;
    char* V_lds = lds; char* K_lds = lds + 2 * SHM_V;
    float* wsx = (float*)(lds + 2 * SHM_V + 2 * SHM_K) + wid * 64; float* li_l = wsx; float* al_l = wsx + 32;
    float m_reg = -1e30f, l_reg = 0; f32x16 o[4] = {}; bf16x8 qr[DQ / 16];
    const bf16_t* Qw = Qb + (size_t)(wid * QBLK + r32) * DQ + hi * 8;
#pragma unroll
    for (int d0 = 0; d0 < DQ / 16; ++d0) qr[d0] = *reinterpret_cast<const bf16x8*>(Qw + d0 * 16);
    const int sr = tid >> 4, sc = (tid & 15) * 8, vst0 = v_st(sr, sc), vst1 = v_st(32 + sr, sc);
    const int vb0 = (int)(uintptr_t)V_lds + v_rd_base(lane);
    bf16x8 vs0, vs1, ks[NKC];
#define SLOAD(k0) do { vs0 = *reinterpret_cast<const bf16x8*>(&Vh[(size_t)((k0) + sr) * 128 + sc]); vs1 = *reinterpret_cast<const bf16x8*>(&Vh[(size_t)((k0) + 32 + sr) * 128 + sc]); \
    _Pragma("unroll") for (int _c = 0; _c < NKC; ++_c) { const int ch = tid + _c * 512, kr = ch / KC8, kc = ch - kr * KC8; ks[_c] = *reinterpret_cast<const bf16x8*>(&Kh[(size_t)((k0) + kr) * DQ + kc * 8]); } } while (0)
#define SWRITE(b) do { *(bf16x8*)(V_lds + (b) * SHM_V + vst0) = vs0; *(bf16x8*)(V_lds + (b) * SHM_V + vst1) = vs1; \
    _Pragma("unroll") for (int _c = 0; _c < NKC; ++_c) { const int ch = tid + _c * 512, kr = ch / KC8, kc = ch - kr * KC8; *(bf16x8*)(K_lds + (b) * SHM_K + kswz<DQ>(kr, kc * 16)) = ks[_c]; } } while (0)
    f32x16 p0, p1; float mn, al; bf16x8 pa0, pa1, pa2, pa3; const int NTL = seq / KVBLK;
    SLOAD(0); SWRITE(0); __syncthreads();
    for (int j = 0; j < NTL; ++j) {
        const int bsel = j & 1;
        if (j + 1 < NTL) SLOAD((j + 1) * KVBLK);
        FA_SBAR(); qkt<DQ>(p0, p1, K_lds + bsel * SHM_K, qr, r32, hi);
        partialSM<DQ>(p0, p1, m_reg, mn, al);
        if (__any(al < 1.f)) { if (hi == 0) al_l[r32] = al; asm volatile("s_waitcnt lgkmcnt(0)" ::: "memory");
#pragma unroll
            for (int d = 0; d < 4; ++d)
#pragma unroll
                for (int r = 0; r < 16; ++r) o[d][r] *= al_l[crow(r, hi)]; }
        finishSM(p0, p1, al, l_reg, pa0, pa1, pa2, pa3); FA_SBAR();
        pv_d0(o, vb0 + bsel * SHM_V, pa0, pa1, pa2, pa3);
        if (j + 1 < NTL) SWRITE(bsel ^ 1);
        __syncthreads();
    }
    if (hi == 0) li_l[r32] = l_reg; asm volatile("s_waitcnt lgkmcnt(0)" ::: "memory");
    float rli[16];
#pragma unroll
    for (int r = 0; r < 16; ++r) rli[r] = __builtin_amdgcn_rcpf(li_l[crow(r, hi)]);
    bf16_t* Ow = Ob + (size_t)(wid * QBLK) * LDO;
#pragma unroll
    for (int r = 0; r < 16; ++r) { const int orow = crow(r, hi);
#pragma unroll
        for (int d0 = 0; d0 < 4; ++d0) Ow[(size_t)orow * LDO + d0 * 32 + r32] = f2bf(o[d0][r] * rli[r]); }
    __syncthreads();
#undef SLOAD
#undef SWRITE
}
}

template <int DQ, int HKV, bool WITH_CTX>
DEV void attn_phase(const Args& a, int colbase, char* smem) {
    const bf16_t* Qb = (const bf16_t*)(a.ws + WS_QB); const bf16_t* Kb = (const bf16_t*)(a.ws + WS_KB); const bf16_t* Vb = (const bf16_t*)(a.ws + WS_VB);
    bf16_t* A2 = (bf16_t*)(a.ws + WS_A2);
    unsigned* ctxq = (unsigned*)(a.ws + WS_CTL) + CW_CVT + 4 * 64; volatile int* qslot = (volatile int*)(smem + LDS_BYTES_C - 64);
    int u = blockIdx.x; bool dyn = false;
    for (;; u += gridDim.x) {
        if (!dyn && u >= 256) { if (!WITH_CTX) break; dyn = true; }
        if (dyn) { __syncthreads(); if (threadIdx.x == 0) *qslot = (int)atomicAdd(ctxq, 1u); __syncthreads();
            const int c_ = *qslot; if (c_ >= 32) break; u = 256 + c_; }
        int b, hh, qb, nk;
        if (u < 256) { if (HKV == 8) { const int bh = u & 31; b = bh >> 3; hh = bh & 7; qb = 1 + (u >> 5); }
                       else { const int pr = u & 7, rest = u >> 3; b = pr >> 1; hh = (pr & 1) * 4 + (rest & 3); qb = 1 + (rest >> 2); }
                       nk = S; }
        else { const int bh = u - 256; b = bh >> 3; hh = bh & 7; qb = 0; nk = TC; }
        const int hk = hh / (8 / HKV);
        if constexpr (DQ == 192) fa::attn_body_simple<DQ>(Qb + (((size_t)b * 8 + hh) * S + qb * 256) * DQ, Kb + ((size_t)b * HKV + hk) * S * DQ, Vb + ((size_t)b * HKV + hk) * S * 128,
                          A2 + ((size_t)b * S + qb * 256) * D + colbase + hh * 128, D, nk, smem);
        else fa::attn_body<DQ>(Qb + (((size_t)b * 8 + hh) * S + qb * 256) * DQ, Kb + ((size_t)b * HKV + hk) * S * DQ, Vb + ((size_t)b * HKV + hk) * S * 128,
                          A2 + ((size_t)b * S + qb * 256) * D + colbase + hh * 128, D, nk, smem);
    }
}

template <int MODE>
DEV void mixout_phase(const Args& a, bool latent_only) {
    const int tid = tid_opaque(), w = tid >> 6, lane = tid & 63;
    constexpr int NH = MODE == 0 ? 8 : 4, DV = MODE == 0 ? 128 : 256, LDP = MODE == 0 ? AB_INP : CD_INP, GC = MODE == 0 ? 4096 : 3584, CB = MODE == 0 ? 0 : 1024, PER = DV / 64;
    const bf16_t* P = (const bf16_t*)(a.ws + WS_P); const float* odir = (const float*)(a.ws + WS_ODIR); bf16_t* A2 = (bf16_t*)(a.ws + WS_A2);
    const float* g = MODE == 0 ? a.in[12] : a.in[23];
    for (int it = blockIdx.x * 8 + w; it < R * NH; it += gridDim.x * 8) {
        const int r = it / NH, hd = it - r * NH; const int t = r % S; if (latent_only && t < TC) continue;
        float o[PER]; float ss = 0.f;
#pragma unroll
        for (int j = 0; j < PER; ++j) { const int c = hd * DV + j * 64 + lane; o[j] = __builtin_nontemporal_load(odir + (size_t)r * 1024 + c) + __builtin_nontemporal_load(odir + ((size_t)R + r) * 1024 + c); ss += o[j] * o[j]; }
        ss = wave_sum(ss); const float rs = rsqrtf(ss * (1.f / DV) + EPS);
#pragma unroll
        for (int j = 0; j < PER; ++j) { const int c = hd * DV + j * 64 + lane; const float gt = bf2f(P[(size_t)r * LDP + GC + c]);
            const float act = MODE == 0 ? sigmoidf_(gt) : siluf_(gt);
            A2[(size_t)r * D + CB + c] = f2bf(o[j] * rs * g[j * 64 + lane] * act); }
    }
}

#define GAS __attribute__((address_space(1)))
typedef GAS unsigned gu32; typedef GAS unsigned long long gu64;
#define RLX_AGENT __ATOMIC_RELAXED, __HIP_MEMORY_SCOPE_AGENT
struct EpiMoeUpSc1 { bf16_t* hid; int rowbase, nvalid;
    DEV void operator()(const f32x4 (&acc)[2][2][4][2], int brow, int bcol, int wr, int wc, int fr, int fq) const {
        const int hc = (bcol >> 1) + wc * 32 + fq * 4;
#pragma unroll
        for (int ai = 0; ai < 2; ++ai)
#pragma unroll
            for (int m = 0; m < 4; ++m) { const int lr = ai * HALF + wr * 64 + m * 16 + fr;
                if (lr < nvalid) { bf16_t* rowp = hid + (size_t)(rowbase + lr) * EDIM + hc;
#pragma unroll
                    for (int n = 0; n < 2; ++n) { const f32x4 a_ = acc[ai][0][m][n], b_ = acc[ai][1][m][n];
                        const unsigned lo = cvtpk(siluf_(a_[0]) * b_[0], siluf_(a_[1]) * b_[1]), hi = cvtpk(siluf_(a_[2]) * b_[2], siluf_(a_[3]) * b_[3]);
                        __hip_atomic_store((gu64*)(rowp + n * 16), (unsigned long long)lo | ((unsigned long long)hi << 32), RLX_AGENT); } } }
    } };
DEV void moe_phase_fused(const Args& a, int l, char* smem) {
    const int tid = tid_opaque();
    unsigned* ctl = (unsigned*)(a.ws + WS_CTL);
    unsigned* cnt = ctl + CW_CNT + l * 16 * CNT_STRIDE; unsigned* head = ctl + CW_MOEQ + l * 64; unsigned* ready = ctl + CW_RDY + l * (NE * 36 * 16);
    const int* list = (const int*)(a.ws + WS_LIST);
    const bf16_t* h = (const bf16_t*)(a.ws + WS_H); const bf16_t* w13 = moe_w13(a, l); const bf16_t* w2 = moe_w2(a, l);
    bf16_t* hid = (bf16_t*)(a.ws + WS_QB); bf16_t* y = (bf16_t*)(a.ws + WS_P);
    volatile int* tab = (volatile int*)(smem + SHM_GEMM);
    if (tid < NE) tab[tid] = (int)__hip_atomic_load((gu32*)(cnt + tid * CNT_STRIDE), RLX_AGENT);
    __syncthreads();
    if (tid == 0) { int ub = 0, of = 0, nts[NE];
        for (int e = 0; e < NE; ++e) { const int n = tab[e]; nts[e] = (n + 255) >> 8; tab[16 + e] = ub; tab[50 + e] = of; ub += nts[e] * 4; of += n; }
        tab[32] = ub; int db = ub;
        for (int e = 0; e < NE; ++e) { tab[33 + e] = db; db += nts[e] * 8; }
        tab[49] = db; }
    for (;;) {
        __syncthreads();
        if (tid == 0) tab[66] = (int)__hip_atomic_fetch_add((gu32*)head, 1u, RLX_AGENT);
        __syncthreads();
        const int item = __builtin_amdgcn_readfirstlane(tab[66]), nup = __builtin_amdgcn_readfirstlane(tab[32]), ntot = __builtin_amdgcn_readfirstlane(tab[49]);
        if (item >= ntot) break;
        const bool up = item < nup; const int tb0 = up ? 16 : 33;
        const int bq_ = tab[tb0 + (tid & 15)];
        const int e = __popcll(__ballot((tid & 63) >= 1 && (tid & 63) < NE && item >= bq_));
        const int n = __builtin_amdgcn_readfirstlane(tab[e]), nt_ = (n + 255) >> 8, t = item - __builtin_amdgcn_readfirstlane(tab[tb0 + e]), off = __builtin_amdgcn_readfirstlane(tab[50 + e]);
        const int i = t % nt_, pn = t / nt_, nv = min(256, n - i * 256);
        gu32* flag = (gu32*)(ready + (e * 36 + i) * 16);
        if (up) {
            EpiMoeUpSc1 epi{hid, off + i * 256, nv};
            gemm_tile<true>(h, w13 + (size_t)e * 1024 * D, D, D, 0, pn * 256, list + (size_t)e * R + i * 256, nv, smem, epi);
            asm volatile("s_waitcnt vmcnt(0)" ::: "memory");
            __syncthreads();
            if (tid == 0) __hip_atomic_fetch_add(flag, 1u, RLX_AGENT);
        } else {
            if (tid < 64) { unsigned spins = 0;
                while ((unsigned)__builtin_amdgcn_readfirstlane(__hip_atomic_load(flag, RLX_AGENT)) < 4u) { __builtin_amdgcn_s_sleep(2); if (++spins > (1u << 22)) break; }
                __builtin_amdgcn_fence(__ATOMIC_ACQUIRE, "agent");
                asm volatile("s_waitcnt vmcnt(0)" ::: "memory"); }
            __syncthreads();
            EpiMoeDown epi{y, list + (size_t)e * R + i * 256, nv};
            gemm_tile<false>(hid, w2 + (size_t)e * D * EDIM, EDIM, EDIM, off + i * 256, pn * 256, nullptr, 0, smem, epi);
        }
    }
    __syncthreads();
}

DEV void moe_phase_up(const Args& a, int l, char* smem) {
    unsigned* cnt = (unsigned*)(a.ws + WS_CTL) + CW_CNT + l * 16 * CNT_STRIDE;
    const int* list = (const int*)(a.ws + WS_LIST);
    const bf16_t* h = (const bf16_t*)(a.ws + WS_H); const bf16_t* w13 = moe_w13(a, l); bf16_t* hid = (bf16_t*)(a.ws + WS_QB);
    int u = blockIdx.x, base = 0, off = 0;
    for (int e = 0; e < NE; ++e) { const int n = (int)__builtin_amdgcn_readfirstlane(__hip_atomic_load(cnt + e * CNT_STRIDE, __ATOMIC_RELAXED, __HIP_MEMORY_SCOPE_AGENT)), nt_ = (n + 255) >> 8, nu = nt_ * 4;
        for (; u < base + nu; u += gridDim.x) { const int t = u - base, i = t % nt_, pn = t / nt_; const int nv = min(256, n - i * 256);
            EpiMoeUp epi{hid, off + i * 256, nv};
            gemm_tile<true>(h, w13 + (size_t)e * 1024 * D, D, D, 0, pn * 256, list + (size_t)e * R + i * 256, nv, smem, epi); }
        base += nu; off += n; }
}
DEV void moe_phase_down(const Args& a, int l, char* smem) {
    unsigned* cnt = (unsigned*)(a.ws + WS_CTL) + CW_CNT + l * 16 * CNT_STRIDE;
    const int* list = (const int*)(a.ws + WS_LIST);
    const bf16_t* hid = (const bf16_t*)(a.ws + WS_QB); const bf16_t* w2 = moe_w2(a, l); bf16_t* y = (bf16_t*)(a.ws + WS_P);
    int u = blockIdx.x, base = 0, off = 0;
    for (int e = 0; e < NE; ++e) { const int n = (int)__builtin_amdgcn_readfirstlane(__hip_atomic_load(cnt + e * CNT_STRIDE, __ATOMIC_RELAXED, __HIP_MEMORY_SCOPE_AGENT)), nt_ = (n + 255) >> 8, nu = nt_ * 8;
        for (; u < base + nu; u += gridDim.x) { const int t = u - base, i = t % nt_, pn = t / nt_; const int nv = min(256, n - i * 256);
            EpiMoeDown epi{y, list + (size_t)e * R + i * 256, nv};
            gemm_tile<false>(hid, w2 + (size_t)e * D * EDIM, EDIM, EDIM, off + i * 256, pn * 256, nullptr, 0, smem, epi); }
        base += nu; off += n; }
}
template <bool FINAL>
DEV void combine_phase(const Args& a, int l, bool latent_only, char* smem, bool dry = false) {
    const int tid = tid_opaque(), w = tid >> 6, lane = tid & 63;
    bf16_t* xres = (bf16_t*)(a.ws + WS_XRES); const bf16_t* y = (const bf16_t*)(a.ws + WS_P); const float* tokf = (const float*)(a.ws + WS_TOK);
    const float* modv = (const float*)(a.ws + WS_MODV) + (size_t)l * 5 * MODN; bf16_t* h = (bf16_t*)(a.ws + WS_H);
    const float* gain = FINAL ? a.in[8] : a.in[6] + (size_t)(l + 1) * D;
    const int stride = gridDim.x * 8;
#define CB_SKIP(rr) while ((rr) < R && latent_only && ((rr) % S) < TC) (rr) += stride
#define CB_LOAD(rr, Y0, Y1, XQ, W0, W1) do { const bf16_t* y0_ = y + (size_t)(2 * (rr)) * D; const bf16_t* xp_ = xres + (size_t)(rr) * D; W0 = tokf[(rr) * 4 + 2]; W1 = tokf[(rr) * 4 + 3]; \
        _Pragma("unroll") for (int j = 0; j < 8; ++j) { const int c = j * 256 + lane * 4; Y0[j] = __builtin_nontemporal_load((const u32x2*)(y0_ + c)); Y1[j] = __builtin_nontemporal_load((const u32x2*)(y0_ + D + c)); XQ[j] = *(const u32x2*)(xp_ + c); } } while (0)
    float* lg2 = (float*)smem; float* lsh = lg2 + 5 * D; float* lsc = lsh + 5 * D;
    for (int i = tid; i < (FINAL ? 5 : 15) * D / 4; i += NT) { const int q = i / (D / 4), k4 = i - q * (D / 4), v_ = q % 5;
        const float* src = q < 5 ? modv + (size_t)v_ * MODN + 5 * D : modv + 5 * MODN + (size_t)v_ * MODN + (q < 10 ? 0 : D);
        ((f32x4*)lg2)[i] = *(const f32x4*)(src + k4 * 4); }
    __syncthreads();
    int r = blockIdx.x * 8 + w; CB_SKIP(r);
    f32x4 gv[8];
#pragma unroll
    for (int j = 0; j < 8; ++j) gv[j] = *(const f32x4*)(gain + j * 256 + lane * 4);
    u32x2 ny0[8], ny1[8], nxq[8]; float nw0 = 0.f, nw1 = 0.f;
    if (r < R) CB_LOAD(r, ny0, ny1, nxq, nw0, nw1);
    while (r < R) {
        const float w0 = nw0, w1 = nw1;
        const int b = r / S, t = r - b * S; const int v = t < TC ? 4 : b;
        const float* g2 = lg2 + v * D; bf16_t* xp = xres + (size_t)r * D;
        f32x4 x[8]; float ss = 0.f;
#pragma unroll
        for (int j = 0; j < 8; ++j) { const int c = j * 256 + lane * 4;
            const u32x2 a0 = ny0[j], a1 = ny1[j], xq = nxq[j];
            const f32x4 yy = {w0 * bflo(a0.x) + w1 * bflo(a1.x), w0 * bfhi(a0.x) + w1 * bfhi(a1.x), w0 * bflo(a0.y) + w1 * bflo(a1.y), w0 * bfhi(a0.y) + w1 * bfhi(a1.y)};
            x[j] = (f32x4){bflo(xq.x), bfhi(xq.x), bflo(xq.y), bfhi(xq.y)} + *(const f32x4*)(g2 + c) * yy;
            if (!FINAL && !dry) { u32x2 xw; xw.x = cvtpk(x[j][0], x[j][1]); xw.y = cvtpk(x[j][2], x[j][3]); *(u32x2*)(xp + c) = xw; }
            ss += x[j][0] * x[j][0] + x[j][1] * x[j][1] + x[j][2] * x[j][2] + x[j][3] * x[j][3]; }
        __builtin_amdgcn_sched_barrier(0);
        const float* sh = lsh + v * D; const float* sc = lsc + v * D;
        int rn = r + stride; CB_SKIP(rn);
        { const int rp_ = rn < R ? rn : r; CB_LOAD(rp_, ny0, ny1, nxq, nw0, nw1); }
        __builtin_amdgcn_sched_barrier(0);
        ss = wave_sum(ss); const float rs = rsqrtf(ss * (1.f / D) + EPS);
        if (FINAL) { float* op = a.out + ((size_t)b * TL + (t - TC)) * D;
#pragma unroll
            for (int j = 0; j < 8; ++j) { const int c = j * 256 + lane * 4; __builtin_nontemporal_store(x[j] * rs * gv[j], (f32x4*)(op + c)); } }
        else {
#pragma unroll
            for (int j = 0; j < 8; ++j) { const int c = j * 256 + lane * 4;
                const f32x4 yv = (x[j] * rs * gv[j]) * (1.f + *(const f32x4*)(sc + c)) + *(const f32x4*)(sh + c);
                u32x2 pk; pk.x = cvtpk(yv[0], yv[1]); pk.y = cvtpk(yv[2], yv[3]); if (!dry) *(u32x2*)(h + (size_t)r * D + c) = pk; } }
        __builtin_amdgcn_sched_barrier(0);
        r = rn;
    }
#undef CB_LOAD
#undef CB_SKIP
}

constexpr int LDS_BYTES = LDS_BYTES_C;
constexpr int NPHASES = 25;
__global__ void __launch_bounds__(NT, 2) fwd(Args a) {
    extern __shared__ __attribute__((aligned(16))) char smem[];
    unsigned char* ws = a.ws;
    const int lo = a.ph_lo, hi = a.ph_hi;
    volatile LAS unsigned* xbw = (volatile LAS unsigned*)(smem + LDS_BYTES - 16);
    if (threadIdx.x < 4) xbw[threadIdx.x] = 0u;
    __syncthreads();
    XcdBarrier bar; bar.bar = (unsigned*)(ws + WS_CTL); bar.x = 0; bar.st = xbw;
    if (hi - lo > 1) bar = xcd_barrier_post((unsigned*)(ws + WS_CTL), xbw);
#ifndef BARRIER_REP
#define BARRIER_REP 1
#endif
#ifndef TPROBE_MASK
#define TPROBE_MASK 0u
#endif
#ifndef TPROBE_ALPHA
#define TPROBE_ALPHA 4
#endif
    unsigned long long tp_prev = TPROBE_MASK ? __builtin_amdgcn_s_memrealtime() : 0ull, tp_acc = 0ull;
#define TPROBE(k) do { if (TPROBE_MASK) { const unsigned long long tn_ = __builtin_amdgcn_s_memrealtime(); if ((TPROBE_MASK >> (k)) & 1u) tp_acc += tn_ - tp_prev; tp_prev = tn_; } } while (0)
#ifndef WPROBE_MASK
#define WPROBE_MASK 0u
#endif
    unsigned long long wp_acc = 0ull;
#define SEAM(k) do { if (IN(k) && IN((k) + 1)) { const unsigned long long wa_ = WPROBE_MASK ? __builtin_amdgcn_s_memrealtime() : 0ull; for (int br_ = 0; br_ < BARRIER_REP; ++br_) xcd_barrier(bar); \
        if (WPROBE_MASK && ((WPROBE_MASK >> (k)) & 1u)) wp_acc += __builtin_amdgcn_s_memrealtime() - wa_; TPROBE(k); } } while (0)
#ifndef PHASE_MASK
#define PHASE_MASK 0xFFFFFFFFu
#endif
#define IN(k) (((PHASE_MASK >> (k)) & 1u) && lo <= (k) && (k) < hi)
#ifndef REPEAT_MASK
#define REPEAT_MASK 0u
#endif
#ifndef SUBREP
#define SUBREP 0
#endif
#define PHASE(k) if (IN(k)) for (int rep_ = 0; rep_ < ((((REPEAT_MASK) >> (k)) & 1u) ? 2 : 1); ++rep_, ((((REPEAT_MASK) >> (k)) & 1u) ? __syncthreads() : (void)0))
    const float* modv = (const float*)(ws + WS_MODV);
    bf16_t* H = (bf16_t*)(ws + WS_H); bf16_t* P = (bf16_t*)(ws + WS_P); bf16_t* A2 = (bf16_t*)(ws + WS_A2); bf16_t* XR = (bf16_t*)(ws + WS_XRES);
    PHASE(0) {
        cvt_weight(a.in[9], (bf16_t*)(ws + WS_WABIN), D, AB_IN, AB_INP, 1, 0, 0, 128, 0, nullptr, smem, 2);
        mod_phase<false>(a, 0, smem);
        misc_phase(a);
    }
    SEAM(0);
    PHASE(1) norm_phase<false, true>(a, 0, 0, a.in[6], false, smem);
    SEAM(1);
    PHASE(2) { int cur = 0; EpiInAB e{P, (float*)(ws + WS_SSQ), (bf16_t*)(ws + WS_KB), (const float2*)(ws + WS_TABB), smem};
#ifdef SEAM_PROBE
                 gemm_phase(H, (const bf16_t*)(ws + WS_WABIN), R, AB_INP, D, smem, e, cur, 0, 512); xcd_barrier(bar); cur = 0; gemm_phase(H, (const bf16_t*)(ws + WS_WABIN), R, AB_INP, D, smem, e, cur, 512, 864);
#else
                 { int most_; (void)gemm_phase_xcd(H, (const bf16_t*)(ws + WS_WABIN), R, AB_INP, D, smem, e, most_); }
#endif
                 if (rep_ == 0) { cvt_cd_dynamic(a, smem); mod_phase<true>(a, 1, smem, 2, 0, 2 * D / 32); } }
    SEAM(2);
    PHASE(3) { int cur = 0; EpiUQ e1{(bf16_t*)(ws + WS_QB), (const float*)(ws + WS_SSQ), (const float2*)(ws + WS_TABB)};
                 gemm_phase<false, AB_INP>(P + 5120, (const bf16_t*)(ws + WS_WUQ), R, 1536, 512, smem, e1, cur);
                 EpiUKV e2{(bf16_t*)(ws + WS_KB), (bf16_t*)(ws + WS_VB), (const float*)(ws + WS_SSQ)};
                 gemm_phase<false, AB_INP>(P + 5632, (const bf16_t*)(ws + WS_WUKV), R, 2048, 256, smem, e2, cur);
                 scan_prep_phase<0>(a, smem); if (SUBREP & 1) scan_prep_phase<0>(a, smem); }
    SEAM(3);
    PHASE(6) scan_seq_phase<0>(a, smem);
    PHASE(7) attn_phase<192, 8, true>(a, 1024, smem);
    SEAM(7);
    PHASE(8) { mixout_phase<0>(a, false); if (SUBREP & 2) mixout_phase<0>(a, false); }
    SEAM(8);
    PHASE(9) { int cur = 0; EpiResidGate<true> e{XR, modv + 2 * D, false, a.in[0], a.in[2]}; int most_; (void)gemm_phase_xcd(A2, (const bf16_t*)(ws + WS_WABOUT), R, D, D, smem, e, most_); cvt_moe_dynamic(a, 0, smem); }
    SEAM(9);
    PHASE(10) norm_router_phase(a, 0, 3, a.in[7], false, smem);
    SEAM(10);
#ifndef MOE_SPLIT
    PHASE(11) { moe_phase_fused(a, 0, smem); cvt_moe_dynamic(a, 1, smem); }
    SEAM(11);
#else
    PHASE(11) { moe_phase_up(a, 0, smem); cvt_moe_dynamic(a, 1, smem); }
    SEAM(11);
    PHASE(12) { moe_phase_down(a, 0, smem); cvt_moe_dynamic(a, 1, smem); }
    SEAM(12);
#endif
    PHASE(13) combine_phase<false>(a, 0, false, smem, rep_ > 0);
    SEAM(13);
    PHASE(15) { int cur = 0; EpiInCD e{P, (bf16_t*)(ws + WS_QB), (bf16_t*)(ws + WS_KB), (bf16_t*)(ws + WS_VB), (const float2*)(ws + WS_TABC), a.in[19], a.in[20], smem}; int most = 0; const int mine = gemm_phase_xcd(H, (const bf16_t*)(ws + WS_WCDIN), R, CD_INP, D, smem, e, most);
                  { const int ntl = (R / BM) * (CD_INP / BM), g_ = (int)gridDim.x;
                    if (mine < most || most * g_ == ntl) { __syncthreads(); mod_phase<true>(a, 1, smem, 5, 2 * D / 32, MODN / 32); } } }
    SEAM(15);
    PHASE(16) { scan_prep_phase<1>(a, smem); if (SUBREP & 1) scan_prep_phase<1>(a, smem); }
    SEAM(16);
    PHASE(17) scan_seq_phase<1>(a, smem);
    PHASE(18) attn_phase<128, 2, false>(a, 0, smem);
    SEAM(18);
    PHASE(19) { mixout_phase<1>(a, true); if (SUBREP & 2) mixout_phase<1>(a, true); }
    SEAM(19);
    PHASE(20) { int cur = 0; EpiResidGate<false> e{XR, modv + 5 * MODN + 2 * D, false, nullptr, nullptr}; int most_; (void)gemm_phase_xcd<true>(A2, (const bf16_t*)(ws + WS_WCDOUT), NB * TL, D, D, smem, e, most_); }
    SEAM(20);
    PHASE(21) norm_router_phase(a, 1, 3, a.in[7] + D, true, smem);
    SEAM(21);
#ifndef MOE_SPLIT
    PHASE(22) moe_phase_fused(a, 1, smem);
    SEAM(22);
#else
    PHASE(22) moe_phase_up(a, 1, smem);
    SEAM(22);
    PHASE(23) moe_phase_down(a, 1, smem);
    SEAM(23);
#endif
    PHASE(24) combine_phase<true>(a, 1, true, smem);
    if (TPROBE_MASK) { TPROBE(24);
        if (blockIdx.x == 0) { const unsigned long long t0_ = __builtin_amdgcn_s_memrealtime(); while (__builtin_amdgcn_s_memrealtime() - t0_ < (unsigned long long)TPROBE_ALPHA * tp_acc) __builtin_amdgcn_s_sleep(8); } }
    if (WPROBE_MASK) { unsigned* wsum = (unsigned*)(ws + WS_CTL) + 30000;
        if (threadIdx.x == 0) atomicAdd(wsum, (unsigned)wp_acc);
        xcd_barrier(bar);
        if (blockIdx.x == 0) { const unsigned long long tot_ = __hip_atomic_load(wsum, __ATOMIC_RELAXED, __HIP_MEMORY_SCOPE_AGENT) / gridDim.x;
            const unsigned long long t0_ = __builtin_amdgcn_s_memrealtime(); while (__builtin_amdgcn_s_memrealtime() - t0_ < (unsigned long long)TPROBE_ALPHA * tot_) __builtin_amdgcn_s_sleep(8); } }
#undef IN
#undef PHASE
#undef SEAM
}

extern "C" void kernel_launch(void* const* d_in, const int* in_sizes, int n_in, void* d_out, int out_size, void* d_ws, size_t ws_size, hipStream_t stream) {
    static int grid = 0;
    if (grid == 0) {
        if (n_in != 29 || out_size != NB * TL * D || ws_size < WS_END) { fprintf(stderr, "kernel_launch: shape/workspace mismatch: n_in %d out %d ws %zu (need %zu)\n", n_in, out_size, ws_size, (size_t)WS_END); grid = -1; return; }
        int dev = 0, cus = 0;
        if (hipGetDevice(&dev) != hipSuccess || hipDeviceGetAttribute(&cus, hipDeviceAttributeMultiprocessorCount, dev) != hipSuccess) { grid = -1; return; }
        if (hipFuncSetAttribute((const void*)fwd, hipFuncAttributeMaxDynamicSharedMemorySize, LDS_BYTES) != hipSuccess) { fprintf(stderr, "kernel_launch: hipFuncSetAttribute failed\n"); grid = -1; return; }
        grid = cus > 0 ? cus : 256;
        if (grid * 8 * 6 < R) { fprintf(stderr, "kernel_launch: %d CUs: the router pass assumes at most 6 rows per wave (>= 192 workgroups)\n", grid); grid = -1; return; }
    }
    if (grid < 0) return;
    (void)hipMemsetAsync((char*)d_ws + WS_CTL, 0, CTL_BYTES, stream);
    Args a{};
    for (int i = 0; i < 29; ++i) a.in[i] = (const float*)d_in[i];
    a.out = (float*)d_out; a.ws = (unsigned char*)d_ws;
#ifndef MK_PER_PHASE
    a.ph_lo = 0; a.ph_hi = NPHASES; hipLaunchKernelGGL(fwd, dim3(grid), dim3(NT), LDS_BYTES, stream, a);
#else
    for (int ph = 0; ph < NPHASES; ++ph) { a.ph_lo = ph; a.ph_hi = ph + 1; hipLaunchKernelGGL(fwd, dim3(grid), dim3(NT), LDS_BYTES, stream, a); }
#endif
}
```
